# Optimizing an MI355X kernel written in HIP

```python
import math
import jax, jax.numpy as jnp
from jax import lax
import numpy as np

D_MODEL = 1024
BATCH = 16
SEQ = 2048
DEPTH = 2

N_A = DEPTH // 2
N_B = DEPTH - N_A
N_EVEN = (DEPTH + 1) // 2
N_ODD = DEPTH // 2

SSM_GROUP = 16
N_GROUPS = D_MODEL // SSM_GROUP
SSM_STATE = 64
SSM_CHUNK = 128
DT_MIN = 1e-3
DT_MAX = 1e-1

N_HEADS = 8
HEAD_DIM = D_MODEL // N_HEADS
MOBA_BLOCK = 256
MOBA_TOPK = 3
QUERY_CHUNK = 16
ROPE_THETA = 500000.0
ROT_DIM = HEAD_DIM // 4

D_FF_DENSE = 2816
N_EXPERTS = 8
MOE_TOPK = 2
D_FF_EXPERT = 3584
MOE_ROWS = 256

NORM_EPS = 1e-6
NEG_INF = -1e30

kernel_name = "yoco_s5_moba_moe_hybrid"


def rmsnorm(x, g):
    xf = x.astype(jnp.float32)
    y = xf * lax.rsqrt(jnp.mean(xf * xf, axis=-1, keepdims=True) + NORM_EPS)
    return (y * g.astype(jnp.float32)).astype(x.dtype)


def partial_rotary(x, positions):
    half = ROT_DIM // 2
    inv_freq = 1.0 / (ROPE_THETA ** (jnp.arange(half, dtype=jnp.float32) / half))
    ang = positions[:, None, :, None].astype(jnp.float32) * inv_freq
    cos, sin = jnp.cos(ang), jnp.sin(ang)
    xr = x[..., :ROT_DIM].astype(jnp.float32)
    x1, x2 = xr[..., :half], xr[..., half:]
    rot = jnp.concatenate([x1 * cos - x2 * sin, x2 * cos + x1 * sin], axis=-1)
    return jnp.concatenate([rot.astype(x.dtype), x[..., ROT_DIM:]], axis=-1)


def _complex_combine(e1, e2):
    a1r, a1i, b1r, b1i = e1
    a2r, a2i, b2r, b2i = e2
    return (a2r * a1r - a2i * a1i,
            a2r * a1i + a2i * a1r,
            a2r * b1r - a2i * b1i + b2r,
            a2r * b1i + a2i * b1r + b2i)


def s5_mixer(h, lam_re, lam_im, log_dt, b_re, b_im, c_re, c_im, d_skip, w_glu):
    f32 = jnp.float32
    Bsz, S, D = h.shape
    G, P = lam_re.shape
    lr, li = lam_re.astype(f32), lam_im.astype(f32)
    dt = jnp.exp(log_dt.astype(f32))[:, None]
    zr, zi = lr * dt, li * dt
    mag = jnp.exp(zr)
    a_r, a_i = mag * jnp.cos(zr * 0 + zi), mag * jnp.sin(zi)
    den = lr * lr + li * li
    coef_r = ((a_r - 1.0) * lr + a_i * li) / den
    coef_i = (a_i * lr - (a_r - 1.0) * li) / den
    br, bi = b_re.astype(f32), b_im.astype(f32)
    bb_r = coef_r[:, :, None] * br - coef_i[:, :, None] * bi
    bb_i = coef_r[:, :, None] * bi + coef_i[:, :, None] * br
    cr, ci = c_re.astype(f32), c_im.astype(f32)

    L = SSM_CHUNK
    nc = S // L
    steps = jnp.arange(1, L + 1, dtype=f32)[:, None, None]
    pmag = jnp.exp(steps * zr)
    pw_r, pw_i = pmag * jnp.cos(steps * zi), pmag * jnp.sin(steps * zi)
    ar_full = jnp.broadcast_to(a_r, (Bsz, L, G, P))
    ai_full = jnp.broadcast_to(a_i, (Bsz, L, G, P))

    u = h.astype(f32).reshape(Bsz, nc, L, G, SSM_GROUP).transpose(1, 0, 2, 3, 4)

    def chunk_step(carry, u_c):
        sr0, si0 = carry
        bu_r = jnp.einsum('blgi,gpi->blgp', u_c, bb_r)
        bu_i = jnp.einsum('blgi,gpi->blgp', u_c, bb_i)
        _, _, sr, si = lax.associative_scan(_complex_combine, (ar_full, ai_full, bu_r, bu_i), axis=1)
        sr = sr + pw_r * sr0[:, None] - pw_i * si0[:, None]
        si = si + pw_r * si0[:, None] + pw_i * sr0[:, None]
        y = jnp.einsum('blgp,gip->blgi', sr, cr) - jnp.einsum('blgp,gip->blgi', si, ci)
        return (sr[:, -1], si[:, -1]), y

    init = (jnp.zeros((Bsz, G, P), f32), jnp.zeros((Bsz, G, P), f32))
    _, ys = lax.scan(chunk_step, init, u)
    y = ys.transpose(1, 0, 2, 3, 4).reshape(Bsz, S, D) + d_skip.astype(f32) * h.astype(f32)
    g = jax.nn.gelu(y).astype(h.dtype)
    z = jnp.dot(g, w_glu)
    val, gate = z[..., :D], z[..., D:]
    return (val.astype(f32) * jax.nn.sigmoid(gate.astype(f32))).astype(h.dtype)


def shared_kv(s, g_kv, w_kv, positions):
    Bsz, S, D = s.shape
    hk = rmsnorm(s, g_kv)
    kv = jnp.dot(hk, w_kv)
    k = kv[..., :N_HEADS * HEAD_DIM].reshape(Bsz, S, N_HEADS, HEAD_DIM).transpose(0, 2, 1, 3)
    v = kv[..., N_HEADS * HEAD_DIM:].reshape(Bsz, S, N_HEADS, HEAD_DIM).transpose(0, 2, 1, 3)
    k = partial_rotary(k, positions)
    nb = -(-S // MOBA_BLOCK)
    pad = nb * MOBA_BLOCK - S
    k = jnp.pad(k, ((0, 0), (0, 0), (0, pad), (0, 0)))
    v = jnp.pad(v, ((0, 0), (0, 0), (0, pad), (0, 0)))
    kb = k.reshape(Bsz, N_HEADS, nb, MOBA_BLOCK, HEAD_DIM)
    vb = v.reshape(Bsz, N_HEADS, nb, MOBA_BLOCK, HEAD_DIM)
    kmean = jnp.mean(kb.astype(jnp.float32), axis=3)
    return kb, vb, kmean


def moba_attention(q, kb, vb, kmean):
    Bsz, H, S, Dh = q.shape
    nb = kb.shape[2]
    scale = Dh ** -0.5
    qblk = jnp.arange(S) // MOBA_BLOCK
    gate = jnp.einsum('bhsd,bhnd->bhsn', q.astype(jnp.float32), kmean)
    past = jnp.arange(nb)[None, :] < qblk[:, None]
    gate = jnp.where(past, gate, NEG_INF)
    k_sel = min(MOBA_TOPK, nb)
    _, idx = lax.top_k(gate, k_sel)
    valid = jnp.arange(k_sel)[None, :] < qblk[:, None]

    nq = S // QUERY_CHUNK
    q_c = q.reshape(Bsz, H, nq, QUERY_CHUNK, Dh).transpose(2, 0, 1, 3, 4)
    idx_c = idx.reshape(Bsz, H, nq, QUERY_CHUNK, k_sel).transpose(2, 0, 1, 3, 4)
    valid_c = valid.reshape(nq, QUERY_CHUNK, k_sel)
    b_ix = jnp.arange(Bsz)[:, None, None, None]
    h_ix = jnp.arange(H)[None, :, None, None]

    def one_chunk(args):
        qc, ic, vc, c = args
        t0 = c * QUERY_CHUNK
        qpos = t0 + jnp.arange(QUERY_CHUNK)
        j = t0 // MOBA_BLOCK
        ok = lax.dynamic_index_in_dim(kb, j, axis=2, keepdims=False)
        ov = lax.dynamic_index_in_dim(vb, j, axis=2, keepdims=False)
        gk = kb[b_ix, h_ix, ic]
        gv = vb[b_ix, h_ix, ic]
        s_sel = jnp.einsum('bhtd,bhtkid->bhtki', qc, gk).astype(jnp.float32) * scale
        s_sel = jnp.where(vc[None, None, :, :, None], s_sel, NEG_INF)
        s_sel = s_sel.reshape(Bsz, H, QUERY_CHUNK, k_sel * MOBA_BLOCK)
        s_own = jnp.einsum('bhtd,bhid->bhti', qc, ok).astype(jnp.float32) * scale
        kpos = j * MOBA_BLOCK + jnp.arange(MOBA_BLOCK)
        s_own = jnp.where(kpos[None, :] <= qpos[:, None], s_own, NEG_INF)
        p = jax.nn.softmax(jnp.concatenate([s_sel, s_own], axis=-1), axis=-1)
        p_sel = p[..., :k_sel * MOBA_BLOCK].reshape(Bsz, H, QUERY_CHUNK, k_sel, MOBA_BLOCK).astype(vb.dtype)
        p_own = p[..., k_sel * MOBA_BLOCK:].astype(vb.dtype)
        return (jnp.einsum('bhtki,bhtkid->bhtd', p_sel, gv)
                + jnp.einsum('bhti,bhid->bhtd', p_own, ov))

    outs = lax.map(one_chunk, (q_c, idx_c, valid_c, jnp.arange(nq)))
    return outs.transpose(1, 2, 0, 3, 4).reshape(Bsz, H, S, Dh)


def moba_mixer(h, w_q, w_o, kb, vb, kmean, positions):
    Bsz, S, D = h.shape
    q = jnp.dot(h, w_q).reshape(Bsz, S, N_HEADS, HEAD_DIM).transpose(0, 2, 1, 3)
    q = partial_rotary(q, positions)
    o = moba_attention(q, kb, vb, kmean)
    o = o.transpose(0, 2, 1, 3).reshape(Bsz, S, N_HEADS * HEAD_DIM)
    return jnp.dot(o, w_o)


def dense_swiglu(h, w1, w3, w2):
    return jnp.dot(jax.nn.silu(jnp.dot(h, w1)) * jnp.dot(h, w3), w2)


def moe_swiglu(h, w_router, b_router, w1, w3, w2):
    Bsz, S, D = h.shape
    N = Bsz * S
    E, R = N_EXPERTS, MOE_ROWS
    t = h.reshape(N, D)
    logits = jnp.dot(t, w_router).astype(jnp.float32) + b_router.astype(jnp.float32)
    top_v, top_e = lax.top_k(logits, MOE_TOPK)
    top_w = jax.nn.softmax(top_v, axis=-1)
    A = N * MOE_TOPK
    flat_e = top_e.reshape(A)
    flat_w = top_w.reshape(A)
    flat_tok = jnp.arange(A, dtype=jnp.int32) // MOE_TOPK
    order = jnp.argsort(flat_e)
    se = flat_e[order]
    counts = jnp.zeros((E,), jnp.int32).at[flat_e].add(1)
    starts = jnp.cumsum(counts) - counts
    pcounts = (counts + R - 1) // R * R
    pends = jnp.cumsum(pcounts)
    pstarts = pends - pcounts
    dest = pstarts[se] + jnp.arange(A, dtype=jnp.int32) - starts[se]
    total = A + E * R
    nblk = total // R
    row_tok = jnp.full((total,), N, jnp.int32).at[dest].set(flat_tok[order])
    row_w = jnp.zeros((total,), jnp.float32).at[dest].set(flat_w[order])
    blk_e = jnp.minimum(jnp.searchsorted(pends, jnp.arange(nblk, dtype=jnp.int32) * R, side='right'), E - 1)
    t_pad = jnp.concatenate([t, jnp.zeros((1, D), t.dtype)], axis=0)
    xin = t_pad[row_tok].reshape(nblk, R, D)

    def expert_block(args):
        xb, e = args
        return jnp.dot(jax.nn.silu(jnp.dot(xb, w1[e])) * jnp.dot(xb, w3[e]), w2[e])

    yb = lax.map(expert_block, (xin, blk_e)).reshape(total, D)
    out = jnp.zeros((N + 1, D), t.dtype).at[row_tok].add(
        (yb.astype(jnp.float32) * row_w[:, None]).astype(t.dtype))
    return out[:N].reshape(Bsz, S, D)


def setup_inputs(seed: int = 0) -> dict:
    key = jax.random.key(seed)
    ks = jax.random.split(key, 24)
    f32 = jnp.float32
    D, G, P, Q = D_MODEL, N_GROUPS, SSM_STATE, SSM_GROUP
    HD = N_HEADS * HEAD_DIM
    nrm = lambda k, shape, s: jax.random.normal(k, shape, f32) * s
    x = jax.random.normal(ks[0], (BATCH, SEQ, D), f32)
    offset = jax.random.randint(ks[1], (BATCH, 1), 0, 4096, dtype=jnp.int32)
    positions = offset + jnp.arange(SEQ, dtype=jnp.int32)[None, :]
    norms = 1.0 + nrm(ks[2], (DEPTH, 4, D), 0.02)
    s5_lam_re = -0.5 + nrm(ks[3], (N_A, G, P), 0.01)
    s5_lam_im = math.pi * jnp.arange(P, dtype=f32)[None, None, :] + nrm(ks[4], (N_A, G, P), 0.01)
    s5_log_dt = jax.random.uniform(ks[5], (N_A, G), f32, math.log(DT_MIN), math.log(DT_MAX))
    s5_b_re = nrm(ks[6], (N_A, G, P, Q), (2 * Q) ** -0.5)
    s5_b_im = nrm(ks[7], (N_A, G, P, Q), (2 * Q) ** -0.5)
    s5_c_re = nrm(ks[8], (N_A, G, Q, P), 0.5)
    s5_c_im = nrm(ks[9], (N_A, G, Q, P), 0.5)
    s5_d = nrm(ks[10], (N_A, D), 0.5)
    s5_w_glu = nrm(ks[11], (N_A, D, 2 * D), D ** -0.5)
    kv_norm = 1.0 + nrm(ks[12], (D,), 0.02)
    w_kv = nrm(ks[13], (D, 2 * HD), D ** -0.5)
    w_q = nrm(ks[14], (N_B, D, HD), D ** -0.5)
    w_o = nrm(ks[15], (N_B, HD, D), HD ** -0.5)
    ffn_w1 = nrm(ks[16], (N_EVEN, D, D_FF_DENSE), D ** -0.5)
    ffn_w3 = nrm(ks[17], (N_EVEN, D, D_FF_DENSE), D ** -0.5)
    ffn_w2 = nrm(ks[18], (N_EVEN, D_FF_DENSE, D), D_FF_DENSE ** -0.5)
    moe_router = nrm(ks[19], (N_ODD, D, N_EXPERTS), D ** -0.5)
    moe_bias = nrm(ks[20], (N_ODD, N_EXPERTS), 0.01)
    moe_w1 = nrm(ks[21], (N_ODD, N_EXPERTS, D, D_FF_EXPERT), D ** -0.5)
    moe_w3 = nrm(ks[22], (N_ODD, N_EXPERTS, D, D_FF_EXPERT), D ** -0.5)
    moe_w2 = nrm(ks[23], (N_ODD, N_EXPERTS, D_FF_EXPERT, D), D_FF_EXPERT ** -0.5)
    return {"x": x, "positions": positions, "norms": norms,
            "s5_lam_re": s5_lam_re, "s5_lam_im": s5_lam_im, "s5_log_dt": s5_log_dt,
            "s5_b_re": s5_b_re, "s5_b_im": s5_b_im, "s5_c_re": s5_c_re, "s5_c_im": s5_c_im,
            "s5_d": s5_d, "s5_w_glu": s5_w_glu,
            "kv_norm": kv_norm, "w_kv": w_kv, "w_q": w_q, "w_o": w_o,
            "ffn_w1": ffn_w1, "ffn_w3": ffn_w3, "ffn_w2": ffn_w2,
            "moe_router": moe_router, "moe_bias": moe_bias,
            "moe_w1": moe_w1, "moe_w3": moe_w3, "moe_w2": moe_w2}


def reference(x, positions, norms, s5_lam_re, s5_lam_im, s5_log_dt, s5_b_re, s5_b_im,
              s5_c_re, s5_c_im, s5_d, s5_w_glu, kv_norm, w_kv, w_q, w_o,
              ffn_w1, ffn_w3, ffn_w2, moe_router, moe_bias, moe_w1, moe_w3, moe_w2):
    h = x
    kb = vb = kmean = None
    for layer in range(DEPTH):
        g = norms[layer]
        if layer < N_A:
            mix = s5_mixer(rmsnorm(h, g[0]), s5_lam_re[layer], s5_lam_im[layer], s5_log_dt[layer],
                           s5_b_re[layer], s5_b_im[layer], s5_c_re[layer], s5_c_im[layer],
                           s5_d[layer], s5_w_glu[layer])
        else:
            if layer == N_A:
                kb, vb, kmean = shared_kv(h, kv_norm, w_kv, positions)
            i = layer - N_A
            mix = moba_mixer(rmsnorm(h, g[0]), w_q[i], w_o[i], kb, vb, kmean, positions)
        h = h + rmsnorm(mix, g[1])
        f_in = rmsnorm(h, g[2])
        if layer % 2 == 0:
            j = layer // 2
            f = dense_swiglu(f_in, ffn_w1[j], ffn_w3[j], ffn_w2[j])
        else:
            j = layer // 2
            f = moe_swiglu(f_in, moe_router[j], moe_bias[j], moe_w1[j], moe_w3[j], moe_w2[j])
        h = h + rmsnorm(f, g[3])
    return h
```

```cpp
#include <hip/hip_runtime.h>
#include <stdio.h>
#include <stdint.h>

#ifndef MK_ONE_LAUNCH
#define MK_ONE_LAUNCH 1
#endif
#ifndef MK_F8
#define MK_F8 1
#endif
#ifndef MK_QKV8
#define MK_QKV8 1
#endif
#ifndef MK_SUPER
#define MK_SUPER 1
#endif
#ifndef MK_FFN2F8
#define MK_FFN2F8 1
#endif
#ifndef MK_MOE_NMAJOR
#define MK_MOE_NMAJOR 1
#endif
#ifndef MK_DUP_MASK
#define MK_DUP_MASK 0u
#endif

#define GAS __attribute__((address_space(1)))
#define LAS __attribute__((address_space(3)))
typedef unsigned short bf16;
typedef unsigned v4u __attribute__((ext_vector_type(4)));
typedef unsigned v2u __attribute__((ext_vector_type(2)));
typedef float f32x2 __attribute__((ext_vector_type(2)));
typedef float f32x4 __attribute__((ext_vector_type(4)));
typedef float f32x16 __attribute__((ext_vector_type(16)));
typedef short bf16x8 __attribute__((ext_vector_type(8)));
typedef short s16x4 __attribute__((ext_vector_type(4)));
typedef int i32x4 __attribute__((ext_vector_type(4)));
typedef int i32x8 __attribute__((ext_vector_type(8)));

constexpr int BATCH = 16, SEQ = 2048, DM = 1024, NTOK = BATCH * SEQ;
constexpr int NG = 64, NP = 64, CL = 16, NCH = SEQ / CL, GROWS = BATCH * NCH, UAK = 384;
constexpr int NH = 8, HD = 128, MBLK = 256, NBLK = SEQ / MBLK;
constexpr int FFD = 2816, NE = 8, FFE = 3584, LCAP = 32768;
constexpr float NORM_EPS = 1e-6f;
constexpr int NWAVES = 8;
constexpr int KSPLIT = 7, LPMAX = 7;
constexpr int ASPLIT = 128;

constexpr size_t MiB = 1u << 20;
constexpr size_t WS_CTL = 0, WS_KMEAN = 1 * MiB, ZERO_BYTES = 2 * MiB;
constexpr size_t WS_ROPE = 2 * MiB, WS_ROWSS = 6 * MiB, WS_LIST = 10 * MiB, WS_SLOT = 11 * MiB, WS_TOKW = WS_SLOT + 256 * 1024, WS_WR = WS_TOKW + 256 * 1024, WS_SPAR = WS_WR + 64 * 1024;
constexpr size_t WS_WQ13 = 13 * MiB, WS_XQ3 = 69 * MiB, WS_RSC = 101 * MiB, WS_WM2 = 125 * MiB;
constexpr size_t WS_COLMAX_F = 1536 * 1024 + 57344 * 4, WS_COLMAX_QKV = WS_COLMAX_F + 5632 * 4, WS_COLMAX_W2 = WS_COLMAX_QKV + 3072 * 4;
constexpr size_t WS_ROWNORM = 12 * MiB + 256 * 1024, WS_SB8 = 12 * MiB + 512 * 1024;
constexpr size_t WS_W8M2 = 125 * MiB, WS_PSQ = 153 * MiB, WS_PSQD = 180 * MiB;
constexpr int CW_EA = 9216;
constexpr size_t WS_WQF13 = 102 * MiB, WS_WQQKV = 108 * MiB;
constexpr size_t WS_COLMAX = 1536 * 1024;
constexpr size_t WS_WGLU = 181 * MiB, WS_WQKV = 185 * MiB, WS_WO = 191 * MiB, WS_WF13 = 193 * MiB, WS_WF2 = 204 * MiB, WS_BTA = 210 * MiB, WS_BTC = 218 * MiB;
constexpr size_t WS_UA = 230 * MiB, WS_SLOC = 326 * MiB, WS_GBUF = 390 * MiB, WS_MIX0 = 454 * MiB;
constexpr size_t WS_XH1 = 210 * MiB, WS_ACTD = 274 * MiB, WS_F0 = 450 * MiB;
constexpr size_t WS_XH2 = 450 * MiB, WS_Q = 230 * MiB, WS_K = 294 * MiB, WS_V = 358 * MiB;
constexpr size_t WS_O = WS_Q;
constexpr size_t WS_RS = 12 * MiB;
constexpr size_t WS_MIX1 = 294 * MiB, WS_XH3 = 450 * MiB;
constexpr size_t WS_Y = 181 * MiB, WS_ACTM = 313 * MiB, WS_YP = 425 * MiB;
constexpr size_t WS_END = 518 * MiB;
constexpr int CW_TMO = 0, CW_BAR = 4096, CW_ECNT = 8192, CW_WQ = 9344;

constexpr int RING_BYTES = 131072, LDSCTL_OFF = RING_BYTES, MISC_OFF = LDSCTL_OFF + 320, IDX_OFF = RING_BYTES + 1024, SCL_OFF = RING_BYTES + 2048, UT_OFF = RING_BYTES + 8192, LDS_BYTES = 147456;

#define LDS_WAIT() asm volatile("s_waitcnt lgkmcnt(0)" ::: "memory")
#define VM_WAIT() asm volatile("s_waitcnt vmcnt(0)" ::: "memory")
__device__ __forceinline__ unsigned f2bf(float f) { unsigned u = __builtin_bit_cast(unsigned, f); return (u + 0x7fffu + ((u >> 16) & 1u)) >> 16; }
__device__ __forceinline__ unsigned pk2(float lo, float hi) { return f2bf(lo) | (f2bf(hi) << 16); }
__device__ __forceinline__ float bf2f(unsigned b) { return __builtin_bit_cast(float, b << 16); }
__device__ __forceinline__ unsigned cvt_pk_bf16(float lo, float hi) { unsigned r; asm volatile("v_cvt_pk_bf16_f32 %0, %1, %2" : "=v"(r) : "v"(lo), "v"(hi)); return r; }
__device__ __forceinline__ float wave_sum(float v) {
#pragma unroll
    for (int o = 1; o < 64; o <<= 1) v += __shfl_xor(v, o);
    return v;
}
__device__ __forceinline__ float fast_sigmoid(float x) { return __builtin_amdgcn_rcpf(1.0f + __builtin_amdgcn_exp2f(-1.4426950408889634f * x)); }

namespace pg8 {
constexpr int BM = 256, BK = 64, HALF = 128, HTB = HALF * BK * 2, NXCD = 8, WGM = 4;
__host__ __device__ __forceinline__ int lds_byte(int r, int c) { const int st = (r >> 4) * 2 + (c >> 5), rr = r & 15, cc = c & 31, ob = rr * 64 + cc * 2; return st * 1024 + (ob ^ (((ob >> 9) & 1) << 5)); }
__host__ __device__ __forceinline__ void stage_rc(int b, int& R, int& C) { const int st = b / 1024, sb = b % 1024, swz = sb ^ (((sb >> 9) & 1) << 5); R = (st >> 1) * 16 + swz / 64; C = (st & 1) * 32 + (swz % 64) / 2; }
__host__ __device__ __forceinline__ int perm32(int rho) { const int n = rho >> 4, i = rho & 15; return 8 * (i >> 2) + 4 * n + (i & 3); }

__device__ __forceinline__ void lane_rc(int i, int& R, int& C) { int t = threadIdx.x; asm volatile("" : "+v"(t)); stage_rc(t * 16 + i * 8192, R, C); }
struct GUnit { int pm, pn, e, aux, rs, sa; };
__device__ __forceinline__ void tile_of(int L, int nM, int nN, int& pm, int& pn) {
    const int nwg = nM * nN; int wgid = L;
    { const int q = nwg / NXCD, r = nwg % NXCD, xcd = wgid % NXCD, off = wgid / NXCD; wgid = (xcd < r ? xcd * (q + 1) : r * (q + 1) + (xcd - r) * q) + off; }
    const int nig = WGM * nN, gid = wgid / nig, fm = gid * WGM, gsz = (nM - fm) < WGM ? (nM - fm) : WGM;
    pm = fm + ((wgid % nig) % gsz); pn = (wgid % nig) / gsz;
}

template <int MM> struct AccSel { typedef f32x4 T; };
template <> struct AccSel<1> { typedef i32x4 T; };
#define V8LO(v) __builtin_shufflevector(v, v, 0, 1, 2, 3)
#define V8HI(v) __builtin_shufflevector(v, v, 4, 5, 6, 7)
template <int MM, class T> __device__ __forceinline__ void mma2(T& acc, const i32x8& b, const i32x8& a, int sb, int sa) {
    if constexpr (MM == 2) asm volatile("v_mfma_scale_f32_16x16x128_f8f6f4 %0, %1, %2, %0, %3, %4 op_sel_hi:[0,0,0]" : "+v"(acc) : "v"(b), "v"(a), "v"(sb), "v"(sa));
    else if constexpr (MM == 1) { acc = __builtin_amdgcn_mfma_i32_16x16x64_i8(V8LO(b), V8LO(a), acc, 0, 0, 0); acc = __builtin_amdgcn_mfma_i32_16x16x64_i8(V8HI(b), V8HI(a), acc, 0, 0, 0); }
    else { acc = __builtin_amdgcn_mfma_f32_16x16x32_bf16(__builtin_bit_cast(bf16x8, V8LO(b)), __builtin_bit_cast(bf16x8, V8LO(a)), acc, 0, 0, 0);
           acc = __builtin_amdgcn_mfma_f32_16x16x32_bf16(__builtin_bit_cast(bf16x8, V8HI(b)), __builtin_bit_cast(bf16x8, V8HI(a)), acc, 0, 0, 0); }
}
template <class Epi, class Sched>
__device__ __forceinline__ void gemm_phase(LAS unsigned char* lds, const Sched& S, const Epi& E) {
    int tid_ = threadIdx.x; asm volatile("" : "+v"(tid_));
    const int tid = tid_, wid = __builtin_amdgcn_readfirstlane(tid >> 6), lane = tid & 63, wr = wid >> 2, wc = wid & 3, fr = lane & 15, fq = lane >> 4;
    const int nt = S.K / BK;
    unsigned voffB[2];
#pragma unroll
    for (int i = 0; i < 2; ++i) { int R, C; stage_rc(tid * 16 + i * 8192, R, C); const int Rb = Epi::PERM ? ((R & ~31) + perm32(R & 31)) : R; voffB[i] = (unsigned)(Rb * S.ldb + C) * 2u; }
    const unsigned kstep = BK * 2u;
    const unsigned hstepB = (unsigned)HALF * S.ldb * 2u;
    const unsigned ldsw = (unsigned)wid * 1024u;
    const int aoff = lds_byte(wr * 64 + fr, fq * 8), boff = lds_byte(wc * 32 + fr, fq * 8);
#define PG8_SA(b, h) (((b) * 2 + (h)) * HTB)
#define PG8_SB(b, h) ((4 + (b) * 2 + (h)) * HTB)
#define PG8_STAGE_A(bufoff, abase, soff, voff) do { const char* _g = (abase) + (unsigned)__builtin_amdgcn_readfirstlane((int)(soff)); asm volatile("" : "+s"(_g)); _Pragma("unroll") for (int _i = 0; _i < 2; ++_i) \
        __builtin_amdgcn_global_load_lds((const unsigned*)(_g + (voff)[_i]), (LAS unsigned*)(lds + (bufoff) + ldsw + _i * 8192), 16, 0, 0); } while (0)
#define PG8_STAGE_B(bufoff, soff) do { const char* _g = S.Bbase + (unsigned)__builtin_amdgcn_readfirstlane((int)(soff)); asm volatile("" : "+s"(_g)); _Pragma("unroll") for (int _i = 0; _i < 2; ++_i) \
        __builtin_amdgcn_global_load_lds((const unsigned*)(_g + voffB[_i]), (LAS unsigned*)(lds + (bufoff) + ldsw + _i * 8192), 16, 0, 0); } while (0)
#define PG8_LDA(dst, b, h) do { _Pragma("unroll") for (int m = 0; m < 4; ++m) dst[m] = __builtin_shufflevector(*(const LAS i32x4*)(lds + PG8_SA(b, h) + aoff + m * 2048), *(const LAS i32x4*)(lds + PG8_SA(b, h) + aoff + m * 2048 + 1024), 0, 1, 2, 3, 4, 5, 6, 7); } while (0)
#define PG8_LDB(dst, b, h) do { _Pragma("unroll") for (int n = 0; n < 2; ++n) dst[n] = __builtin_shufflevector(*(const LAS i32x4*)(lds + PG8_SB(b, h) + boff + n * 2048), *(const LAS i32x4*)(lds + PG8_SB(b, h) + boff + n * 2048 + 1024), 0, 1, 2, 3, 4, 5, 6, 7); } while (0)
#define PG8_MMA(ai, bj, At, Bt) do { __builtin_amdgcn_s_setprio(1); _Pragma("unroll") for (int m = 0; m < 4; ++m) _Pragma("unroll") for (int n = 0; n < 2; ++n) \
        mma2<Epi::MM>(acc[ai][bj][m][n], Bt[n], At[m], fsb[bj][n], fsa); __builtin_amdgcn_s_setprio(0); } while (0)
#define PG8_WAIT_V(n) asm volatile("s_waitcnt vmcnt(" #n ")" ::: "memory")
#define PG8_WAIT_L(n) asm volatile("s_waitcnt lgkmcnt(" #n ")" ::: "memory")
#define PG8_BAR __builtin_amdgcn_s_barrier()
#define PG8_SCHED __builtin_amdgcn_sched_barrier(0)
    if (wid == 0) { GUnit u; const bool ok = S.next(lane, u); LAS int* tb = (LAS int*)(lds + UT_OFF) + lane * 8;
        tb[0] = ok ? u.pm : -1; tb[1] = u.pn; tb[2] = u.e; tb[3] = u.aux; tb[4] = u.rs; tb[5] = u.sa; tb[6] = ok ? (int)S.b_off(u) : 0; tb[7] = ok ? (int)S.a_tile(u) : 0; }
    asm volatile("s_waitcnt lgkmcnt(0)" ::: "memory"); __syncthreads();
#define PG8_UNIT(i, u, bo, ao, ok) do { const LAS int* tb_ = (const LAS int*)(lds + UT_OFF) + ((i) & 63) * 8; \
        u.pm = __builtin_amdgcn_readfirstlane(tb_[0]); u.pn = __builtin_amdgcn_readfirstlane(tb_[1]); u.e = __builtin_amdgcn_readfirstlane(tb_[2]); u.aux = __builtin_amdgcn_readfirstlane(tb_[3]); \
        u.rs = __builtin_amdgcn_readfirstlane(tb_[4]); u.sa = __builtin_amdgcn_readfirstlane(tb_[5]); bo = (unsigned)__builtin_amdgcn_readfirstlane(tb_[6]); ao = (unsigned)__builtin_amdgcn_readfirstlane(tb_[7]); \
        ok = (i) < 64 && u.pm >= 0; } while (0)
    GUnit cur, nxt; int ui = 0; unsigned cB, cA, nB, nA; bool ok0;
    PG8_UNIT(0, cur, cB, cA, ok0);
    if (!ok0) return;
    const char* cAp = S.a_base(cur); const char* nAp = cAp;
    typedef typename AccSel<Epi::MM>::T AccT;
    int fsa = 127, fsb[2][2] = {{127, 127}, {127, 127}};
    AccT acc[2][2][4][2];
#pragma unroll
    for (int a = 0; a < 2; ++a)
#pragma unroll
        for (int b = 0; b < 2; ++b)
#pragma unroll
            for (int m = 0; m < 4; ++m)
#pragma unroll
                for (int n = 0; n < 2; ++n) acc[a][b][m][n] = AccT{};
    i32x8 At[4], B0[2], B1[2];
    unsigned oC[2][2], oN[2][2];
    if constexpr (Sched::GATHER) { S.a_off_first(cur, oC);
#pragma unroll
        for (int h = 0; h < 2; ++h)
#pragma unroll
            for (int i = 0; i < 2; ++i) oN[h][i] = oC[h][i]; }
    else { GUnit z; z.pm = 0; z.pn = 0; z.e = 0; z.aux = 0; z.rs = 0; z.sa = 127; S.a_off_first(z, oC);
#pragma unroll
        for (int h = 0; h < 2; ++h)
#pragma unroll
            for (int i = 0; i < 2; ++i) oN[h][i] = oC[h][i]; }
    if constexpr (Epi::MM == 2) S.f8_scales(cur, wc, fr, fsa, fsb);
    if constexpr (Epi::LDSS) E.prefetch_scales(cur, 0, lds);
    PG8_STAGE_B(PG8_SB(0, 0), cB); PG8_STAGE_B(PG8_SB(0, 1), cB + hstepB); PG8_STAGE_A(PG8_SA(0, 0), cAp, cA, oC[0]); PG8_STAGE_A(PG8_SA(0, 1), cAp, cA, oC[1]);
    if (wr == 1) PG8_BAR;
    PG8_WAIT_V(2); PG8_BAR;
    PG8_STAGE_B(PG8_SB(1, 0), cB + kstep); PG8_STAGE_A(PG8_SA(1, 0), cAp, cA + kstep, oC[0]); PG8_STAGE_B(PG8_SB(1, 1), cB + hstepB + kstep);
    PG8_WAIT_V(6); PG8_BAR;
    for (;;) {
        bool has_next; PG8_UNIT(ui + 1, nxt, nB, nA, has_next);
        if (!has_next) { nB = cB; nA = cA; nAp = cAp; } else nAp = S.a_base(nxt);
        if (has_next) S.prefetch(nxt, lds);
        if constexpr (Epi::LDSS) { if (has_next) E.prefetch_scales(nxt, (ui + 1) % 3, lds); }
        for (int t = 0; t < nt; t += 2) {
            const bool last = (t == nt - 2);
            const unsigned a1 = cA + (unsigned)(t + 1) * kstep;
            const unsigned a2 = last ? nA : cA + (unsigned)(t + 2) * kstep, b2 = last ? nB : cB + (unsigned)(t + 2) * kstep;
            const unsigned a3 = a2 + kstep, b3 = b2 + kstep; const char* const ap2 = last ? nAp : cAp;
            if constexpr (Sched::GATHER) { if (last && has_next) S.a_off_next(nxt, oN, lds); }
            PG8_LDB(B0, 0, 0); PG8_LDB(B1, 0, 1); PG8_SCHED; PG8_LDA(At, 0, 0); PG8_STAGE_A(PG8_SA(1, 1), cAp, a1, oC[1]);
            PG8_WAIT_V(8); PG8_WAIT_L(0); PG8_BAR; PG8_MMA(0, 0, At, B0); PG8_MMA(0, 1, At, B1); PG8_BAR; PG8_SCHED;
            PG8_LDA(At, 0, 1); PG8_STAGE_B(PG8_SB(0, 0), b2); PG8_STAGE_B(PG8_SB(0, 1), b2 + hstepB); PG8_STAGE_A(PG8_SA(0, 0), ap2, a2, oN[0]);
            PG8_WAIT_V(8); PG8_WAIT_L(0); PG8_BAR; PG8_MMA(1, 0, At, B0); PG8_MMA(1, 1, At, B1); PG8_BAR; PG8_SCHED;
            PG8_LDB(B0, 1, 0); PG8_LDB(B1, 1, 1); PG8_SCHED; PG8_LDA(At, 1, 0); PG8_STAGE_A(PG8_SA(0, 1), ap2, a2, oN[1]);
            PG8_WAIT_V(8); PG8_WAIT_L(0); PG8_BAR; PG8_MMA(0, 0, At, B0); PG8_MMA(0, 1, At, B1); PG8_BAR; PG8_SCHED;
            PG8_LDA(At, 1, 1); PG8_STAGE_B(PG8_SB(1, 0), b3); PG8_STAGE_B(PG8_SB(1, 1), b3 + hstepB); PG8_STAGE_A(PG8_SA(1, 0), ap2, a3, oN[0]);
            PG8_WAIT_V(8); PG8_WAIT_L(0); PG8_BAR; PG8_MMA(1, 0, At, B0); PG8_MMA(1, 1, At, B1); PG8_BAR; PG8_SCHED;
        }
        if (wr == 0) PG8_BAR;
        if constexpr (Epi::MM == 2) asm volatile("s_nop 15\n\ts_nop 15" ::: "memory");
        if constexpr (Epi::LDSS) E(acc, cur, wr, wc, fr, fq, lds + SCL_OFF + (ui % 3) * 2048); else E(acc, cur, wr, wc, fr, fq);
        if (!has_next) break;
#pragma unroll
        for (int a = 0; a < 2; ++a)
#pragma unroll
            for (int b = 0; b < 2; ++b)
#pragma unroll
                for (int m = 0; m < 4; ++m)
#pragma unroll
                    for (int n = 0; n < 2; ++n) acc[a][b][m][n] = AccT{};
        cur = nxt; cB = nB; cA = nA; cAp = nAp; ++ui;
        if constexpr (Epi::MM == 2) S.f8_scales(cur, wc, fr, fsa, fsb);
        if constexpr (Sched::GATHER) {
#pragma unroll
        for (int h = 0; h < 2; ++h)
#pragma unroll
            for (int i = 0; i < 2; ++i) oC[h][i] = oN[h][i]; }
        if (wr == 1) PG8_BAR;
    }
    PG8_WAIT_V(0);
    PG8_BAR;
#undef PG8_UNIT
#undef PG8_SA
#undef PG8_SB
#undef PG8_STAGE_A
#undef PG8_STAGE_B
#undef PG8_LDA
#undef PG8_LDB
#undef PG8_MMA
#undef PG8_WAIT_V
#undef PG8_WAIT_L
#undef PG8_BAR
#undef PG8_SCHED
}
}

using pg8::GUnit;
struct PlainSched {
    static constexpr bool GATHER = false;
    __device__ __forceinline__ const char* a_base(const GUnit&) const { return Abase; }
    __device__ __forceinline__ unsigned a_tile(const GUnit& u) const { return (unsigned)(u.pm * 256 * lda) * 2u; }
    const char* Abase; const char* Bbase; int K, lda, ldb, nM, nN, G, c, pmdiv; size_t bstride; int sa = 127; const int* sb8 = nullptr;
    __device__ __forceinline__ bool next(int i, GUnit& u) const { const long L = (long)i * G + c; if (L >= (long)nM * nN) return false; pg8::tile_of((int)L, nM, nN, u.pm, u.pn); u.e = u.pm / pmdiv; u.aux = u.pm; u.rs = u.pm * 256; u.sa = sa; return true; }
    __device__ __forceinline__ void f8_scales(const GUnit& u, int wc, int fr, int& sa_, int (&sb)[2][2]) const { sa_ = u.sa;
#pragma unroll
        for (int bj = 0; bj < 2; ++bj)
#pragma unroll
            for (int n = 0; n < 2; ++n) sb[bj][n] = sb8[u.pn * 256 + bj * 128 + wc * 32 + pg8::perm32(n * 16 + fr)]; }
    __device__ __forceinline__ void a_off_first(const GUnit& u, unsigned (&off)[2][2]) const { int R[2], C[2]; pg8::lane_rc(0, R[0], C[0]); pg8::lane_rc(1, R[1], C[1]);
#pragma unroll
        for (int h = 0; h < 2; ++h)
#pragma unroll
            for (int i = 0; i < 2; ++i) off[h][i] = (unsigned)((u.pm * 256 + h * 128 + R[i]) * lda + C[i]) * 2u; }
    __device__ __forceinline__ void a_off_next(const GUnit& u, unsigned (&off)[2][2], LAS unsigned char*) const { a_off_first(u, off); }
    __device__ __forceinline__ void prefetch(const GUnit&, LAS unsigned char*) const {}
    __device__ __forceinline__ unsigned b_off(const GUnit& u) const { return (unsigned)((size_t)u.e * bstride + (size_t)u.pn * 256 * ldb * 2); }
};
constexpr int ET_OFF = RING_BYTES + 512;
__device__ __forceinline__ void etab_build(LAS unsigned char* lds, const unsigned* ctl) {
    if (threadIdx.x < 64) { const int l = threadIdx.x & 63; int v = 0;
        if (l < NE) { v = (int)__hip_atomic_load(ctl + CW_ECNT + 64 * l, __ATOMIC_RELAXED, __HIP_MEMORY_SCOPE_AGENT); v = v < 0 ? 0 : (v > LCAP ? LCAP : v); }
        else if (l < 2 * NE) v = (int)__hip_atomic_load(ctl + CW_EA + (l - NE), __ATOMIC_RELAXED, __HIP_MEMORY_SCOPE_AGENT);
        int np = (l < NE) ? ((v + 255) >> 8) : 0, ps = np;
#pragma unroll
        for (int o = 1; o < NE; o <<= 1) { const int t = __shfl_up(ps, o); if (l >= o) ps += t; }
        if (l < NE) { *(LAS int*)(lds + ET_OFF + 4 * l) = v; *(LAS int*)(lds + ET_OFF + 32 + 4 * l) = ps - np; if (l == NE - 1) *(LAS int*)(lds + ET_OFF + 32 + 4 * NE) = ps; }
        else if (l < 2 * NE) *(LAS int*)(lds + ET_OFF + 72 + 4 * (l - NE)) = v; }
    __syncthreads();
}
__device__ __forceinline__ int et_cnt(LAS unsigned char* lds, int e) { return __builtin_amdgcn_readfirstlane(*(const LAS int*)(lds + ET_OFF + 4 * e)); }
__device__ __forceinline__ int et_ps(LAS unsigned char* lds, int e) { return __builtin_amdgcn_readfirstlane(*(const LAS int*)(lds + ET_OFF + 32 + 4 * e)); }
__device__ __forceinline__ int et_sa(LAS unsigned char* lds, int e) { return __builtin_amdgcn_readfirstlane(*(const LAS int*)(lds + ET_OFF + 72 + 4 * e)); }
__device__ __forceinline__ int et_ps_l(LAS unsigned char* lds, int e) { return *(const LAS int*)(lds + ET_OFF + 32 + 4 * e); }
__device__ __forceinline__ int et_sa_l(LAS unsigned char* lds, int e) { return *(const LAS int*)(lds + ET_OFF + 72 + 4 * e); }
__device__ __forceinline__ int et_expert(LAS unsigned char* lds, int p) { int e = 0;
#pragma unroll
    for (int k = 1; k < NE; ++k) e += (p >= et_ps_l(lds, k)) ? 1 : 0;
    return e; }
struct MoeSched1 {
    static constexpr bool GATHER = true;
    __device__ __forceinline__ const char* a_base(const GUnit&) const { return Abase; }
    __device__ __forceinline__ unsigned a_tile(const GUnit&) const { return 0u; }
    const char* Abase; const char* Bbase; const int* list; int K, ldb, nM, nN, G, c, p0; LAS unsigned char* EL;
    __device__ __forceinline__ bool next(int i, GUnit& u) const { const long L = (long)i * G + c; if (L >= (long)nM * nN) return false; if (MK_MOE_NMAJOR) pg8::tile_of((int)L, nN, nM, u.pn, u.pm); else pg8::tile_of((int)L, nM, nN, u.pm, u.pn); u.aux = p0 + u.pm; u.e = et_expert(EL, u.aux); u.rs = u.e * LCAP + (u.aux - et_ps_l(EL, u.e)) * 256; u.sa = et_sa_l(EL, u.e); return true; }
    __device__ __forceinline__ void a_off_first(const GUnit& u, unsigned (&off)[2][2]) const { int R[2], C[2]; pg8::lane_rc(0, R[0], C[0]); pg8::lane_rc(1, R[1], C[1]);
        const int cn = et_cnt(EL, u.e), ps = et_ps(EL, u.e);
        const int lp = (u.aux - ps) * 256;
#pragma unroll
        for (int h = 0; h < 2; ++h)
#pragma unroll
            for (int i = 0; i < 2; ++i) { const int pos = lp + h * 128 + R[i]; int tok = list[u.e * LCAP + (pos < LCAP ? pos : 0)]; tok = (pos < cn) ? tok : 0; tok = ((unsigned)tok < (unsigned)NTOK) ? tok : 0; off[h][i] = (unsigned)(tok * K + C[i]) * 2u; } }
    __device__ __forceinline__ void prefetch(const GUnit& u, LAS unsigned char* lds) const {
        const int wid = __builtin_amdgcn_readfirstlane(threadIdx.x >> 6), lane = threadIdx.x & 63;
        if (wid < 4) { const int ps = et_ps(EL, u.e);
            const int pos = (u.aux - ps) * 256 + wid * 64 + lane;
            __builtin_amdgcn_global_load_lds((const unsigned*)(list + u.e * LCAP + (pos < LCAP ? pos : 0)), (LAS unsigned*)(lds + IDX_OFF + wid * 256), 4, 0, 0); } }
    __device__ __forceinline__ void a_off_next(const GUnit& u, unsigned (&off)[2][2], LAS unsigned char* lds) const { int R[2], C[2]; pg8::lane_rc(0, R[0], C[0]); pg8::lane_rc(1, R[1], C[1]);
        const int cn = et_cnt(EL, u.e), ps = et_ps(EL, u.e);
        const int lp = (u.aux - ps) * 256;
#pragma unroll
        for (int h = 0; h < 2; ++h)
#pragma unroll
            for (int i = 0; i < 2; ++i) { const int rr = h * 128 + R[i]; int tok = *(const LAS int*)(lds + IDX_OFF + rr * 4); tok = (lp + rr < cn) ? tok : 0; tok = ((unsigned)tok < (unsigned)NTOK) ? tok : 0; off[h][i] = (unsigned)(tok * K + C[i]) * 2u; } }
    __device__ __forceinline__ unsigned b_off(const GUnit& u) const { return (unsigned)((size_t)u.e * ((size_t)2 * FFE * DM) + (size_t)u.pn * 256 * ldb * 2); }
};
struct MoeSched2 {
    static constexpr bool GATHER = false;
    __device__ __forceinline__ const char* a_base(const GUnit& u) const { return u.pm < ASPLIT ? Abase : Abase2; }
    __device__ __forceinline__ unsigned a_tile(const GUnit& u) const { return (unsigned)((u.pm < ASPLIT ? u.pm : u.pm - ASPLIT) * 256 * lda) * 2u; }
    const char* Abase; const char* Abase2; const char* Bbase; const int* sb8; int K, lda, ldb, nM, nN, G, c, p0; LAS unsigned char* EL;
    __device__ __forceinline__ bool next(int i, GUnit& u) const { const long L = (long)i * G + c; if (L >= (long)nM * nN) return false; pg8::tile_of((int)L, nM, nN, u.pm, u.pn); u.aux = p0 + u.pm; u.e = et_expert(EL, u.aux); u.rs = 0; u.sa = et_sa_l(EL, u.e); return true; }
    __device__ __forceinline__ void a_off_first(const GUnit& u, unsigned (&off)[2][2]) const { int R[2], C[2]; pg8::lane_rc(0, R[0], C[0]); pg8::lane_rc(1, R[1], C[1]);
#pragma unroll
        for (int h = 0; h < 2; ++h)
#pragma unroll
            for (int i = 0; i < 2; ++i) off[h][i] = (unsigned)((u.pm * 256 + h * 128 + R[i]) * lda + C[i]) * 2u; }
    __device__ __forceinline__ void a_off_next(const GUnit& u, unsigned (&off)[2][2], LAS unsigned char*) const { a_off_first(u, off); }
    __device__ __forceinline__ void prefetch(const GUnit&, LAS unsigned char*) const {}
    __device__ __forceinline__ unsigned b_off(const GUnit& u) const { return (unsigned)((size_t)u.e * ((size_t)DM * FFE) + (size_t)u.pn * 256 * ldb * 2); }
    __device__ __forceinline__ void f8_scales(const GUnit& u, int wc, int fr, int& sa, int (&sb)[2][2]) const { sa = u.sa;
#pragma unroll
        for (int bj = 0; bj < 2; ++bj)
#pragma unroll
            for (int n = 0; n < 2; ++n) sb[bj][n] = sb8[u.e * DM + u.pn * 256 + bj * 128 + wc * 32 + pg8::perm32(n * 16 + fr)]; }
};

struct MoeSched2K {
    static constexpr bool GATHER = false;
    __device__ __forceinline__ const char* a_base(const GUnit& u) const { return u.pm < ASPLIT ? Abase : Abase2; }
    __device__ __forceinline__ unsigned a_tile(const GUnit& u) const { return (unsigned)((u.pm < ASPLIT ? u.pm : u.pm - ASPLIT) * 256 * lda) * 2u + (unsigned)u.rs * 512u; }
    const char* Abase; const char* Abase2; const char* Bbase; const int* sb8; int K, lda, ldb, nLeft, G, c; LAS unsigned char* EL;
    __device__ __forceinline__ bool next(int i, GUnit& u) const { const long L = (long)i * G + c; if (L >= (long)nLeft * 4 * KSPLIT) return false; const int kc = (int)(L % KSPLIT), t = (int)(L / KSPLIT), lp = t >> 2;
        u.pn = t & 3; u.pm = 256 + lp; u.rs = kc; u.aux = kc * LPMAX + lp; u.e = et_expert(EL, u.pm); u.sa = et_sa_l(EL, u.e); return true; }
    __device__ __forceinline__ void a_off_first(const GUnit& u, unsigned (&off)[2][2]) const { int R[2], C[2]; pg8::lane_rc(0, R[0], C[0]); pg8::lane_rc(1, R[1], C[1]);
#pragma unroll
        for (int h = 0; h < 2; ++h)
#pragma unroll
            for (int i = 0; i < 2; ++i) off[h][i] = (unsigned)((u.pm * 256 + h * 128 + R[i]) * lda + C[i]) * 2u; }
    __device__ __forceinline__ void a_off_next(const GUnit& u, unsigned (&off)[2][2], LAS unsigned char*) const { a_off_first(u, off); }
    __device__ __forceinline__ void prefetch(const GUnit&, LAS unsigned char*) const {}
    __device__ __forceinline__ unsigned b_off(const GUnit& u) const { return (unsigned)((size_t)u.e * ((size_t)DM * FFE) + (size_t)u.pn * 256 * ldb * 2) + (unsigned)u.rs * 512u; }
    __device__ __forceinline__ void f8_scales(const GUnit& u, int wc, int fr, int& sa, int (&sb)[2][2]) const { sa = u.sa;
#pragma unroll
        for (int bj = 0; bj < 2; ++bj)
#pragma unroll
            for (int n = 0; n < 2; ++n) sb[bj][n] = sb8[u.e * DM + u.pn * 256 + bj * 128 + wc * 32 + pg8::perm32(n * 16 + fr)]; }
};

struct MoeSched2B {
    static constexpr bool GATHER = false;
    __device__ __forceinline__ const char* a_base(const GUnit&) const { return Abase; }
    __device__ __forceinline__ unsigned a_tile(const GUnit& u) const { return (unsigned)(u.pm * 256 * lda) * 2u; }
    const char* Abase; const char* Bbase; int K, lda, ldb, nM, nN, G, c, p0; LAS unsigned char* EL;
    __device__ __forceinline__ bool next(int i, GUnit& u) const { const long L = (long)i * G + c; if (L >= (long)nM * nN) return false; pg8::tile_of((int)L, nM, nN, u.pm, u.pn); u.aux = p0 + u.pm; u.e = et_expert(EL, u.aux); u.rs = 0; u.sa = 127; return true; }
    __device__ __forceinline__ void a_off_first(const GUnit& u, unsigned (&off)[2][2]) const { int R[2], C[2]; pg8::lane_rc(0, R[0], C[0]); pg8::lane_rc(1, R[1], C[1]);
#pragma unroll
        for (int h = 0; h < 2; ++h)
#pragma unroll
            for (int i = 0; i < 2; ++i) off[h][i] = (unsigned)((u.pm * 256 + h * 128 + R[i]) * lda + C[i]) * 2u; }
    __device__ __forceinline__ void a_off_next(const GUnit& u, unsigned (&off)[2][2], LAS unsigned char*) const { a_off_first(u, off); }
    __device__ __forceinline__ void prefetch(const GUnit&, LAS unsigned char*) const {}
    __device__ __forceinline__ unsigned b_off(const GUnit& u) const { return (unsigned)((size_t)u.e * ((size_t)DM * FFE * 2) + (size_t)u.pn * 256 * ldb * 2); }
};

typedef const f32x4 (&AccRef)[2][2][4][2];
struct EpiS5A { static constexpr bool PERM = false, LDSS = false; static constexpr int MM = 0; float* sloc;
    __device__ __forceinline__ void operator()(AccRef acc, const GUnit& u, int wr, int wc, int fr, int fq) const {
        float* base = sloc + (size_t)(u.pm * 256 + wr * 64 + fr) * 128 + wc * 32 + 4 * fq;
#pragma unroll
        for (int ai = 0; ai < 2; ++ai)
#pragma unroll
            for (int m = 0; m < 4; ++m)
#pragma unroll
                for (int n = 0; n < 2; ++n) *(f32x4*)(base + (size_t)(ai * 128 + m * 16) * 128 + n * 16) = acc[ai][0][m][n]; } };
struct EpiS5C { static constexpr bool PERM = true, LDSS = false; static constexpr int MM = 0; const bf16* ua; const float* dsk; const float* g0; bf16* gbuf;
    __device__ __forceinline__ void operator()(AccRef acc, const GUnit& u, int wr, int wc, int fr, int fq) const {
        const int g = u.pm >> 3, i0 = 8 * (fq & 1);
        f32x4 d0 = *(const f32x4*)(dsk + g * 16 + i0) * *(const f32x4*)(g0 + g * 16 + i0), d1 = *(const f32x4*)(dsk + g * 16 + i0 + 4) * *(const f32x4*)(g0 + g * 16 + i0 + 4);
#pragma unroll
        for (int ai = 0; ai < 2; ++ai)
#pragma unroll
            for (int m = 0; m < 4; ++m) { const int r = ai * 128 + wr * 64 + m * 16 + fr, rowg = (u.pm & 7) * 256 + r, b = rowg >> 7, c = rowg & 127;
#pragma unroll
                for (int bj = 0; bj < 2; ++bj) { const int col = 128 * bj + 32 * wc + 8 * fq, t = col >> 4;
                    const v4u uu = *(const v4u*)(ua + (size_t)(u.pm * 256 + r) * UAK + col);
                    f32x4 y0 = acc[ai][bj][m][0], y1 = acc[ai][bj][m][1];
                    y0[0] += d0[0] * bf2f(uu.x & 0xffffu); y0[1] += d0[1] * bf2f(uu.x >> 16); y0[2] += d0[2] * bf2f(uu.y & 0xffffu); y0[3] += d0[3] * bf2f(uu.y >> 16);
                    y1[0] += d1[0] * bf2f(uu.z & 0xffffu); y1[1] += d1[1] * bf2f(uu.z >> 16); y1[2] += d1[2] * bf2f(uu.w & 0xffffu); y1[3] += d1[3] * bf2f(uu.w >> 16);
#pragma unroll
                    for (int k = 0; k < 4; ++k) { const float a = y0[k], bq = y1[k]; y0[k] = a * fast_sigmoid(1.5957691216f * (a + 0.044715f * a * a * a)); y1[k] = bq * fast_sigmoid(1.5957691216f * (bq + 0.044715f * bq * bq * bq)); }
                    v4u w; w.x = cvt_pk_bf16(y0[0], y0[1]); w.y = cvt_pk_bf16(y0[2], y0[3]); w.z = cvt_pk_bf16(y1[0], y1[1]); w.w = cvt_pk_bf16(y1[2], y1[3]);
                    *(v4u*)(gbuf + (size_t)(b * SEQ + c * CL + t) * DM + g * 16 + i0) = w; }
                asm volatile("" ::: "memory"); } } };
template <int MODE> struct EpiGated { static constexpr bool PERM = true, LDSS = false; static constexpr int MM = 0; bf16* out; int ldc; float* rowss; int rowsel;
    __device__ __forceinline__ void operator()(AccRef acc, const GUnit& u, int wr, int wc, int fr, int fq) const {
#pragma unroll
        for (int ai = 0; ai < 2; ++ai)
#pragma unroll
            for (int m = 0; m < 4; ++m) { const int row = u.pm * 256 + ai * 128 + wr * 64 + m * 16 + fr; float o[8]; float ss = 0.f;
#pragma unroll
                for (int n = 0; n < 2; ++n)
#pragma unroll
                    for (int k = 0; k < 4; ++k) { const float a = acc[ai][0][m][n][k], bq = acc[ai][1][m][n][k]; const float v = (MODE == 0) ? a * fast_sigmoid(bq) : a * fast_sigmoid(a) * bq; o[n * 4 + k] = v; ss += v * v; }
                v4u w; w.x = cvt_pk_bf16(o[0], o[1]); w.y = cvt_pk_bf16(o[2], o[3]); w.z = cvt_pk_bf16(o[4], o[5]); w.w = cvt_pk_bf16(o[6], o[7]);
                *(v4u*)(out + (size_t)row * ldc + u.pn * 128 + wc * 32 + fq * 8) = w;
                if (MODE == 0) { ss += __shfl_xor(ss, 16); ss += __shfl_xor(ss, 32); if (fq == 0) rowss[(size_t)row * 32 + u.pn * 4 + wc] = ss; } } } };
__device__ __forceinline__ void scales_to_lds(const float* rs256, const float* cm256, int buf, LAS unsigned char* lds) {
    const int wid = __builtin_amdgcn_readfirstlane(threadIdx.x >> 6), lane = threadIdx.x & 63;
    const float* src = (wid < 4) ? rs256 + wid * 64 + lane : cm256 + (wid - 4) * 64 + lane;
    __builtin_amdgcn_global_load_lds((const unsigned*)src, (LAS unsigned*)(lds + SCL_OFF + buf * 2048 + wid * 256), 4, 0, 0);
}
template <bool F8OUT> struct EpiGatedI8 { static constexpr bool PERM = true, LDSS = true; static constexpr int MM = 1; bf16* out; int ldc; const float* rowscale; const float* colmax; int cstride; unsigned char* out2;
    __device__ __forceinline__ void prefetch_scales(const GUnit& u, int buf, LAS unsigned char* lds) const { scales_to_lds(rowscale + u.rs, colmax + (size_t)u.e * cstride + u.pn * 256, buf, lds); }
    __device__ __forceinline__ void operator()(const i32x4 (&acc)[2][2][4][2], const GUnit& u, int wr, int wc, int fr, int fq, LAS unsigned char* tab) const {
        const LAS float* cm = (const LAS float*)(tab + 1024) + wc * 32 + 8 * fq; const float k127 = 1.0f / 127.0f;
        float fscale = 1.0f; if constexpr (F8OUT) fscale = __builtin_bit_cast(float, (unsigned)(254 - u.sa) << 23);
        const float L2E = 1.4426950408889634f, k1 = k127 * L2E, k3 = k127 * fscale * (1.0f / L2E);
        const f32x4 s1a = *(const LAS f32x4*)cm * k1, s1b = *(const LAS f32x4*)(cm + 4) * k1, s3a = *(const LAS f32x4*)(cm + 128) * k3, s3b = *(const LAS f32x4*)(cm + 132) * k3;
        const f32x2 c1[4] = {{s1a[0], s1a[1]}, {s1a[2], s1a[3]}, {s1b[0], s1b[1]}, {s1b[2], s1b[3]}}, c3[4] = {{s3a[0], s3a[1]}, {s3a[2], s3a[3]}, {s3b[0], s3b[1]}, {s3b[2], s3b[3]}};
        const LAS float* rsc = (const LAS float*)tab + wr * 64 + fr;
#pragma unroll
        for (int ai = 0; ai < 2; ++ai)
#pragma unroll
            for (int m = 0; m < 4; ++m) { const int r = ai * 128 + wr * 64 + m * 16 + fr; const float sA = rsc[ai * 128 + m * 16]; const f32x2 sAA = {sA, sA}; float o[8];
#pragma unroll
                for (int q = 0; q < 4; ++q) { const int n = q >> 1, k0 = (q & 1) * 2;
                    const f32x2 av = (f32x2){(float)acc[ai][0][m][n][k0], (float)acc[ai][0][m][n][k0 + 1]} * (c1[q] * sAA), bv = (f32x2){(float)acc[ai][1][m][n][k0], (float)acc[ai][1][m][n][k0 + 1]} * (c3[q] * sAA);
                    const f32x2 d = (f32x2){__builtin_amdgcn_exp2f(-av[0]), __builtin_amdgcn_exp2f(-av[1])} + (f32x2){1.0f, 1.0f};
                    const f32x2 ov = (av * bv) * (f32x2){__builtin_amdgcn_rcpf(d[0]), __builtin_amdgcn_rcpf(d[1])};
                    o[2 * q] = ov[0]; o[2 * q + 1] = ov[1]; }
                if constexpr (F8OUT) {
                    int p0 = __builtin_amdgcn_cvt_pk_fp8_f32(o[0], o[1], 0, false); p0 = __builtin_amdgcn_cvt_pk_fp8_f32(o[2], o[3], p0, true);
                    int p1 = __builtin_amdgcn_cvt_pk_fp8_f32(o[4], o[5], 0, false); p1 = __builtin_amdgcn_cvt_pk_fp8_f32(o[6], o[7], p1, true);
                    v2u w; w.x = (unsigned)p0; w.y = (unsigned)p1;
                    unsigned char* const ob = (u.pm < ASPLIT) ? (unsigned char*)out + (size_t)(u.pm * 256) * ldc : out2 + (size_t)((u.pm - ASPLIT) * 256) * ldc;
                    *(v2u*)(ob + (size_t)r * ldc + u.pn * 128 + wc * 32 + fq * 8) = w; }
                else {
                v4u w; w.x = cvt_pk_bf16(o[0], o[1]); w.y = cvt_pk_bf16(o[2], o[3]); w.z = cvt_pk_bf16(o[4], o[5]); w.w = cvt_pk_bf16(o[6], o[7]);
                *(v4u*)(out + (size_t)(u.pm * 256 + r) * ldc + u.pn * 128 + wc * 32 + fq * 8) = w; } } } };
template <bool SS, bool USEAUX, int MMODE = 0> struct EpiPlain { static constexpr bool PERM = true, LDSS = false; static constexpr int MM = MMODE; bf16* out; int ldc; float* rowss;
    __device__ __forceinline__ void operator()(AccRef acc, const GUnit& u, int wr, int wc, int fr, int fq) const {
        const int rb = (USEAUX ? u.aux : u.pm) * 256;
#pragma unroll
        for (int ai = 0; ai < 2; ++ai)
#pragma unroll
            for (int m = 0; m < 4; ++m) { const int row = rb + ai * 128 + wr * 64 + m * 16 + fr; float ss = 0.f;
#pragma unroll
                for (int bj = 0; bj < 2; ++bj) { const f32x4 v0 = acc[ai][bj][m][0], v1 = acc[ai][bj][m][1];
                    if (SS) ss += (v0[0] * v0[0] + v0[1] * v0[1]) + (v0[2] * v0[2] + v0[3] * v0[3]) + (v1[0] * v1[0] + v1[1] * v1[1]) + (v1[2] * v1[2] + v1[3] * v1[3]);
                    v4u w; w.x = cvt_pk_bf16(v0[0], v0[1]); w.y = cvt_pk_bf16(v0[2], v0[3]); w.z = cvt_pk_bf16(v1[0], v1[1]); w.w = cvt_pk_bf16(v1[2], v1[3]);
                    *(v4u*)(out + (size_t)row * ldc + u.pn * 256 + bj * 128 + wc * 32 + fq * 8) = w; }
                if (SS) { ss += __shfl_xor(ss, 16); ss += __shfl_xor(ss, 32); if (fq == 0) rowss[(size_t)row * 32 + u.pn * 4 + wc] = ss; } } } };
template <bool I8Q> struct EpiQKV { static constexpr bool PERM = true, LDSS = I8Q; static constexpr int MM = I8Q ? 1 : 0; bf16* qkv; const float* rope; float* kmean; const float* rowscale; const float* colmax;
    __device__ __forceinline__ void prefetch_scales(const GUnit& u, int buf, LAS unsigned char* lds) const { scales_to_lds(rowscale + u.rs, colmax + u.pn * 256, buf, lds); }
    template <class AccT> __device__ __forceinline__ void operator()(const AccT (&acc)[2][2][4][2], const GUnit& u, int wr, int wc, int fr, int fq, LAS unsigned char* tab = nullptr) const {
        const int sel = u.pn >> 2; bf16* const outb = qkv + (size_t)sel * (size_t)(32u << 20);
        const int colt = (u.pn & 3) * 256;
        f32x4 sb[2][2];
        if constexpr (I8Q) { const LAS float* cm = (const LAS float*)(tab + 1024) + wc * 32 + 8 * fq; const float k127 = 1.0f / 127.0f;
            sb[0][0] = *(const LAS f32x4*)cm * k127; sb[0][1] = *(const LAS f32x4*)(cm + 4) * k127; sb[1][0] = *(const LAS f32x4*)(cm + 128) * k127; sb[1][1] = *(const LAS f32x4*)(cm + 132) * k127; }
        float cs[2][2][4];
#pragma unroll
        for (int bj = 0; bj < 2; ++bj)
#pragma unroll
            for (int n = 0; n < 2; ++n)
#pragma unroll
                for (int kk = 0; kk < 4; ++kk) cs[bj][n][kk] = 0.f;
#pragma unroll
        for (int ai = 0; ai < 2; ++ai)
#pragma unroll
            for (int m = 0; m < 4; ++m) { const int rl = ai * 128 + wr * 64 + m * 16 + fr, row = u.pm * 256 + rl;
                float sA = 1.0f; if constexpr (I8Q) sA = ((const LAS float*)tab)[rl];
                f32x4 co = (f32x4){1.f, 1.f, 1.f, 1.f}, si = (f32x4){0.f, 0.f, 0.f, 0.f};
                if (sel < 2 && wc == 0) { co = *(const f32x4*)(rope + (size_t)row * 32 + 4 * fq); si = *(const f32x4*)(rope + (size_t)row * 32 + 16 + 4 * fq); }
#pragma unroll
                for (int bj = 0; bj < 2; ++bj) { f32x4 v0, v1;
                    if constexpr (I8Q) {
#pragma unroll
                        for (int kk = 0; kk < 4; ++kk) { v0[kk] = (float)acc[ai][bj][m][0][kk] * (sA * sb[bj][0][kk]); v1[kk] = (float)acc[ai][bj][m][1][kk] * (sA * sb[bj][1][kk]); } }
                    else {
#pragma unroll
                        for (int kk = 0; kk < 4; ++kk) { v0[kk] = acc[ai][bj][m][0][kk]; v1[kk] = acc[ai][bj][m][1][kk]; } }
                    if (sel < 2 && wc == 0) {
                        const float a0 = v0[0] * co[0] - v0[1] * si[0], a1 = v0[1] * co[0] + v0[0] * si[0], a2 = v0[2] * co[1] - v0[3] * si[1], a3 = v0[3] * co[1] + v0[2] * si[1];
                        const float b0 = v1[0] * co[2] - v1[1] * si[2], b1 = v1[1] * co[2] + v1[0] * si[2], b2 = v1[2] * co[3] - v1[3] * si[3], b3 = v1[3] * co[3] + v1[2] * si[3];
                        v0 = (f32x4){a0, a1, a2, a3}; v1 = (f32x4){b0, b1, b2, b3}; }
                    if (sel == 1) {
#pragma unroll
                        for (int kk = 0; kk < 4; ++kk) { cs[bj][0][kk] += v0[kk]; cs[bj][1][kk] += v1[kk]; } }
                    v4u w; w.x = cvt_pk_bf16(v0[0], v0[1]); w.y = cvt_pk_bf16(v0[2], v0[3]); w.z = cvt_pk_bf16(v1[0], v1[1]); w.w = cvt_pk_bf16(v1[2], v1[3]);
                    *(v4u*)(outb + (size_t)row * DM + colt + bj * 128 + wc * 32 + fq * 8) = w; } }
        if (sel == 1) {
            const int b = u.pm >> 3, blk = u.pm & 7;
#pragma unroll
            for (int bj = 0; bj < 2; ++bj)
#pragma unroll
                for (int n = 0; n < 2; ++n)
#pragma unroll
                    for (int kk = 0; kk < 4; ++kk) { float s = cs[bj][n][kk]; s += __shfl_xor(s, 1); s += __shfl_xor(s, 2); s += __shfl_xor(s, 4); s += __shfl_xor(s, 8);
                        if (fr == 0) { const int h = (u.pn & 3) * 2 + bj; atomicAdd(kmean + ((size_t)((b * NH + h) * NBLK + blk)) * HD + wc * 32 + fq * 8 + n * 4 + kk, s * (1.0f / 256.0f)); } } } } };

namespace attn {
constexpr int D = 128, TS = DM;
constexpr float SCALE = 0.08838834764831845f, THR = 8.f;
constexpr int NW = 8, QBLK = 32, KVBLK = 64, QB = NW * QBLK;
constexpr int SHM_V = KVBLK * D * 2, SHM_K = KVBLK * D * 2;
constexpr int ATT_LDS = 2 * SHM_V + 2 * SHM_K + NW * 64 * 4;
#define KSWZ(row, colB) ((row) * 256 + ((colB) ^ (((row) & 7) << 4)))
#define SBAR() __builtin_amdgcn_sched_barrier(0)
__device__ __forceinline__ int v_st(int k, int c) { const int kk = (k & ~0xC) | ((k & 4) << 1) | ((k & 8) >> 1); return ((kk >> 3) * 4 + (c >> 5)) * 512 + ((kk & 7) * 32 + (c & 31)) * 2; }
__device__ __forceinline__ int v_rd_base(int lane) { return ((lane & 3) << 3) | (((lane >> 2) & 3) << 6) | (((lane >> 4) & 1) << 5) | (((lane >> 5) & 1) << 8); }
constexpr int v_rd_off(int d0, int ks, int half) { return d0 * 512 + ks * 4096 + half * 2048; }
__device__ __forceinline__ int crow(int r, int hi) { return (r & 3) + 8 * (r >> 2) + 4 * hi; }
__device__ __forceinline__ bf16x8 load8(const bf16* p) { return *reinterpret_cast<const bf16x8*>(p); }
__device__ __forceinline__ void mask_tile(f32x16& p0, f32x16& p1, int dq) {
    const float NEG = -__builtin_inff();
#pragma unroll
    for (int r = 0; r < 16; ++r) { const int c = (r & 3) + 8 * (r >> 2); if (dq - c < 0) p0[r] = NEG; if (dq - c - 32 < 0) p1[r] = NEG; }
}
__device__ __forceinline__ void drop_tile(f32x16& p0, f32x16& p1, bool drop) {
    const float NEG = -__builtin_inff();
#pragma unroll
    for (int r = 0; r < 16; ++r) { p0[r] = drop ? NEG : p0[r]; p1[r] = drop ? NEG : p1[r]; }
}
__device__ __forceinline__ void partialSM(f32x16& p0, f32x16& p1, float& m_reg, float& mn, float& alpha, bool drop = false) {
    float pmax = p0[0];
#pragma unroll
    for (int r = 1; r < 16; ++r) pmax = fmaxf(pmax, p0[r]);
#pragma unroll
    for (int r = 0; r < 16; ++r) pmax = fmaxf(pmax, p1[r]);
    { auto rr = __builtin_amdgcn_permlane32_swap(__float_as_uint(pmax), __float_as_uint(pmax), false, false);
      pmax = fmaxf(__uint_as_float(rr[0]), __uint_as_float(rr[1])); }
    pmax = drop ? -__builtin_inff() : pmax;
    constexpr float C2 = 1.4426950408889634f * SCALE;
    if (__builtin_expect(__all((pmax - m_reg) * SCALE <= THR), 1)) { mn = m_reg; alpha = 1.f; }
    else { mn = fmaxf(m_reg, pmax); alpha = __builtin_amdgcn_exp2f((m_reg - mn) * C2); m_reg = mn; }
    const float mnL = drop ? -__builtin_inff() : -mn * C2;
#pragma unroll
    for (int r = 0; r < 16; ++r) p0[r] = fmaf(p0[r], C2, mnL);
#pragma unroll
    for (int r = 0; r < 16; ++r) p1[r] = fmaf(p1[r], C2, mnL);
#pragma unroll
    for (int r = 0; r < 16; ++r) p0[r] = __builtin_amdgcn_exp2f(p0[r]);
}
__device__ __forceinline__ void finishSM(f32x16& p0, f32x16& p1, float alpha, float& l_reg, bf16x8& pa0, bf16x8& pa1, bf16x8& pa2, bf16x8& pa3) {
#pragma unroll
    for (int r = 0; r < 16; ++r) p1[r] = __builtin_amdgcn_exp2f(p1[r]);
    float ps = 0;
#pragma unroll
    for (int r = 0; r < 16; ++r) ps += p0[r];
#pragma unroll
    for (int r = 0; r < 16; ++r) ps += p1[r];
    { auto rr = __builtin_amdgcn_permlane32_swap(__float_as_uint(ps), __float_as_uint(ps), false, false);
      ps = __uint_as_float(rr[0]) + __uint_as_float(rr[1]); }
    l_reg = l_reg * alpha + ps;
#define PK4(P, B_, OUT) do { unsigned a0 = cvt_pk_bf16(P[B_+0], P[B_+1]), a1 = cvt_pk_bf16(P[B_+2], P[B_+3]);                          \
        unsigned b0 = cvt_pk_bf16(P[B_+4], P[B_+5]), b1 = cvt_pk_bf16(P[B_+6], P[B_+7]);                                             \
        auto r0 = __builtin_amdgcn_permlane32_swap(a0, b0, false, false); auto r1 = __builtin_amdgcn_permlane32_swap(a1, b1, false, false); \
        v4u w = {r0[0], r1[0], r0[1], r1[1]}; OUT = *reinterpret_cast<bf16x8*>(&w); } while (0)
    PK4(p0, 0, pa0); PK4(p0, 8, pa1); PK4(p1, 0, pa2); PK4(p1, 8, pa3);
#undef PK4
}
template <int KB>
__device__ __forceinline__ void qkt(f32x16& p0, f32x16& p1, const char* K_lds, int r32, int hi, const bf16x8* qr) {
    p0 = f32x16{}; p1 = f32x16{};
    const char* kb[4];
#pragma unroll
    for (int dd = 0; dd < 4; ++dd) kb[dd] = K_lds + KB * SHM_K + KSWZ(r32, (dd * 16 + hi * 8) * 2);
#pragma unroll
    for (int d0 = 0; d0 < 8; ++d0) { const char* a = kb[d0 & 3] + (d0 >> 2) * 128;
        bf16x8 b0 = *reinterpret_cast<const bf16x8*>(a);
        bf16x8 b1 = *reinterpret_cast<const bf16x8*>(a + 32 * 256);
        p0 = __builtin_amdgcn_mfma_f32_32x32x16_bf16(b0, qr[d0], p0, 0, 0, 0);
        p1 = __builtin_amdgcn_mfma_f32_32x32x16_bf16(b1, qr[d0], p1, 0, 0, 0); }
}
template <int VB>
__device__ __forceinline__ void pv_tile(f32x16* o, int vb0, bf16x8 pa0, bf16x8 pa1, bf16x8 pa2, bf16x8 pa3) {
#define TRRD(dst, off) asm volatile("ds_read_b64_tr_b16 %0, %1 offset:%2" : "=&v"(dst) : "v"(vb0), "i"(off) : "memory")
#define PV_RD(d0, X) do { constexpr int b_ = VB * SHM_V + v_rd_off(d0, 0, 0); \
        TRRD(X##l0, b_); TRRD(X##h0, b_ + 2048); TRRD(X##l1, b_ + 4096); TRRD(X##h1, b_ + 6144); TRRD(X##l2, b_ + 8192); TRRD(X##h2, b_ + 10240); TRRD(X##l3, b_ + 12288); TRRD(X##h3, b_ + 14336); } while (0)
#define PV_MM(d0, X) do { \
        o[d0] = __builtin_amdgcn_mfma_f32_32x32x16_bf16(pa0, (bf16x8){X##l0[0], X##l0[1], X##l0[2], X##l0[3], X##h0[0], X##h0[1], X##h0[2], X##h0[3]}, o[d0], 0, 0, 0);   \
        o[d0] = __builtin_amdgcn_mfma_f32_32x32x16_bf16(pa1, (bf16x8){X##l1[0], X##l1[1], X##l1[2], X##l1[3], X##h1[0], X##h1[1], X##h1[2], X##h1[3]}, o[d0], 0, 0, 0);   \
        o[d0] = __builtin_amdgcn_mfma_f32_32x32x16_bf16(pa2, (bf16x8){X##l2[0], X##l2[1], X##l2[2], X##l2[3], X##h2[0], X##h2[1], X##h2[2], X##h2[3]}, o[d0], 0, 0, 0);   \
        o[d0] = __builtin_amdgcn_mfma_f32_32x32x16_bf16(pa3, (bf16x8){X##l3[0], X##l3[1], X##l3[2], X##l3[3], X##h3[0], X##h3[1], X##h3[2], X##h3[3]}, o[d0], 0, 0, 0); } while (0)
#define PV_WAIT(n) do { asm volatile("s_waitcnt lgkmcnt(" #n ")" ::: "memory"); SBAR(); } while (0)
    { s16x4 al0, al1, al2, al3, ah0, ah1, ah2, ah3, bl0, bl1, bl2, bl3, bh0, bh1, bh2, bh3;
      PV_RD(0, a); PV_RD(1, b);
      PV_WAIT(8); PV_MM(0, a); SBAR(); PV_RD(2, a);
      PV_WAIT(8); PV_MM(1, b); SBAR(); PV_RD(3, b);
      PV_WAIT(8); PV_MM(2, a);
      PV_WAIT(0); PV_MM(3, b); }
#undef PV_RD
#undef PV_MM
#undef PV_WAIT
#undef TRRD
}
struct BlockRef { const bf16* Q; const bf16* K; const bf16* V; bf16* O; const float* KM; int P0; };
struct Seam { bf16x8 qr[8]; bf16x8 st_v0, st_v1, st_k0, st_k1; };
#define ROW(p, k0, rr) ((p) + (size_t)((k0) + (rr)) * TS + sc)
#define VMW() asm volatile("s_waitcnt vmcnt(0)" ::: "memory")
#define VMWN(n) asm volatile("s_waitcnt vmcnt(%0)" :: "i"(n) : "memory")
#define SLOAD_H(Kp, Vp, k0) do { S.st_v0 = load8(ROW(Vp, k0, sr)); S.st_v1 = load8(ROW(Vp, k0, 32 + sr));              \
                         S.st_k0 = load8(ROW(Kp, k0, sr)); S.st_k1 = load8(ROW(Kp, k0, 32 + sr)); } while (0)
#define SWRITE_HK(bf) do { *(bf16x8*)(K_lds + (bf) * SHM_K + kws) = S.st_k0; *(bf16x8*)(K_lds + (bf) * SHM_K + kws + 32 * 256) = S.st_k1; } while (0)
#define SWRITE_HV(bf) do { *(bf16x8*)(V_lds + (bf) * SHM_V + vst0) = S.st_v0; *(bf16x8*)(V_lds + (bf) * SHM_V + vst1) = S.st_v1; } while (0)
#define SWRITE_H(bf) do { SWRITE_HV(bf); SWRITE_HK(bf); } while (0)
__device__ __forceinline__ void moba_prime(const BlockRef& cur, char* lds, Seam& S) {
    const int tid = threadIdx.x, wid = __builtin_amdgcn_readfirstlane(tid >> 6), lane = tid & 63, r32 = lane & 31, hi = lane >> 5;
    const int sr = tid >> 4, sc = (tid & 15) * 8, kws = KSWZ(sr, sc * 2); char* K_lds = lds + 2 * SHM_V;
#pragma unroll
    for (int d0 = 0; d0 < 8; ++d0) S.qr[d0] = load8(cur.Q + (size_t)(wid * QBLK + r32) * TS + d0 * 16 + hi * 8);
    SLOAD_H(cur.K, cur.V, 0); VMW(); SWRITE_HK(0);
    __syncthreads();
}
__device__ __forceinline__ void moba_block(const BlockRef& cur, const BlockRef& nxt, char* lds, Seam& S) {
    const int tid = threadIdx.x, wid = __builtin_amdgcn_readfirstlane(tid >> 6), lane = tid & 63, r32 = lane & 31, hi = lane >> 5;
    const int NT = cur.P0 / KVBLK + QB / KVBLK;
    const int qlo = cur.P0 + wid * QBLK, qm = qlo + r32 - 4 * hi;
    char* V_lds = lds; char* K_lds = lds + 2 * SHM_V;
    float* ws = (float*)(lds + 2 * SHM_V + 2 * SHM_K) + wid * 64; float* li_l = ws, * al_l = ws + 32;
    int sel = 0xff; const int qb = cur.P0 >> 8;
    if (qb > 3) {
        float g[7];
#pragma unroll
        for (int j = 0; j < 7; ++j) { float s = -__builtin_inff();
            asm volatile("" ::: "memory");
            if (j < qb) { int hoff = hi * 8; asm volatile("" : "+v"(hoff)); const float* km = cur.KM + j * HD + hoff; s = 0.f;
#pragma unroll
                for (int d0 = 0; d0 < 8; ++d0) { const f32x4 k0 = *(const f32x4*)(km + d0 * 16), k1 = *(const f32x4*)(km + d0 * 16 + 4); const bf16x8 qv = S.qr[d0];
                    s += bf2f((unsigned short)qv[0]) * k0[0] + bf2f((unsigned short)qv[1]) * k0[1] + bf2f((unsigned short)qv[2]) * k0[2] + bf2f((unsigned short)qv[3]) * k0[3]
                       + bf2f((unsigned short)qv[4]) * k1[0] + bf2f((unsigned short)qv[5]) * k1[1] + bf2f((unsigned short)qv[6]) * k1[2] + bf2f((unsigned short)qv[7]) * k1[3]; }
                auto rr = __builtin_amdgcn_permlane32_swap(__float_as_uint(s), __float_as_uint(s), false, false); s = __uint_as_float(rr[0]) + __uint_as_float(rr[1]); }
            g[j] = s; }
        sel = 0;
#pragma unroll
        for (int j = 0; j < 7; ++j) { int rank = 0;
#pragma unroll
            for (int k = 0; k < 7; ++k) if (k != j) rank += (g[k] > g[j] || (g[k] == g[j] && k < j)) ? 1 : 0;
            if (j < qb && rank < 3) sel |= 1 << j; }
        sel |= 1 << qb;
    }
    float m_reg = -1e30f, l_reg = 0; f32x16 o[4] = {};
    const int sr = tid >> 4, sc = (tid & 15) * 8, vst0 = v_st(sr, sc), vst1 = v_st(32 + sr, sc), kws = KSWZ(sr, sc * 2);
    const int vb0 = (int)(uintptr_t)V_lds + v_rd_base(lane);
    const bf16* Kh = cur.K; const bf16* Vh = cur.V;
#define RESC(a) do { if (__any((a) < 1.f)) { if (hi == 0) al_l[r32] = (a); asm volatile("s_waitcnt lgkmcnt(0)" ::: "memory");              \
                     for (int d_ = 0; d_ < 4; ++d_) for (int r = 0; r < 16; ++r) o[d_][r] *= al_l[crow(r, hi)]; } } while (0)
#define KBASE(t) ((t) * KVBLK)
#define MASKT(P0_, P1_, t) do { const int kb_ = KBASE(t); if (kb_ + KVBLK - 1 > qlo) mask_tile(P0_, P1_, qm - kb_); \
        dropT = (kb_ < cur.P0) && ((sel >> (kb_ >> 8)) & 1) == 0; } while (0)
    constexpr int NQL = 8;
#define SEAM_K0() do { VMWN(NQL); SWRITE_HK(0); SBAR(); } while (0)
    f32x16 pA0, pA1, pB0, pB1; float mnA, mnB, alA, alB; bf16x8 pa0, pa1, pa2, pa3; bool dropT = false;
    SWRITE_HV(0); SBAR();
    if (NT > 1) SLOAD_H(Kh, Vh, KBASE(1));
    SBAR(); qkt<0>(pA0, pA1, K_lds, r32, hi, S.qr);
    MASKT(pA0, pA1, 0); partialSM(pA0, pA1, m_reg, mnA, alA, dropT);
    if (NT > 1) { VMW(); SWRITE_H(1); }
    __syncthreads();
#define HALF_STEP(PX0, PX1, mnX, alX, PY0, PY1, alY, t, KB, VB, SB) do {                                                      \
        SBAR(); qkt<KB>(PX0, PX1, K_lds, r32, hi, S.qr);                                                                      \
        finishSM(PY0, PY1, alY, l_reg, pa0, pa1, pa2, pa3); SBAR();                                                           \
        if ((t) + 1 < NT) { SLOAD_H(Kh, Vh, KBASE((t) + 1)); SBAR(); }                                                        \
        pv_tile<VB>(o, vb0, pa0, pa1, pa2, pa3); MASKT(PX0, PX1, (t)); partialSM(PX0, PX1, m_reg, mnX, alX, dropT);            \
        __syncthreads();                                                                                                      \
        if ((t) + 1 < NT) { VMW(); SWRITE_H(SB); }                                                                            \
        RESC(alX); __syncthreads(); } while (0)
    for (int t = 1; t + 1 < NT; t += 2) {
        HALF_STEP(pB0, pB1, mnB, alB, pA0, pA1, alA, t, 1, 0, 0);
        HALF_STEP(pA0, pA1, mnA, alA, pB0, pB1, alB, t + 1, 0, 1, 1);
    }
    SBAR(); qkt<1>(pB0, pB1, K_lds, r32, hi, S.qr); SBAR();
    SLOAD_H(nxt.K, nxt.V, 0); SBAR();
#pragma unroll
    for (int d0 = 0; d0 < 8; ++d0) S.qr[d0] = load8(nxt.Q + (size_t)(wid * QBLK + r32) * TS + d0 * 16 + hi * 8);
    SBAR();
    finishSM(pA0, pA1, alA, l_reg, pa0, pa1, pa2, pa3); SBAR();
    pv_tile<0>(o, vb0, pa0, pa1, pa2, pa3);
    MASKT(pB0, pB1, NT - 1); partialSM(pB0, pB1, m_reg, mnB, alB, dropT); __syncthreads(); RESC(alB);
    finishSM(pB0, pB1, alB, l_reg, pa0, pa1, pa2, pa3); SBAR(); pv_tile<1>(o, vb0, pa0, pa1, pa2, pa3);
    SBAR(); SEAM_K0();
    if (hi == 0) li_l[r32] = l_reg; asm volatile("s_waitcnt lgkmcnt(0)" ::: "memory");
    float rli[16];
#pragma unroll
    for (int r = 0; r < 16; ++r) rli[r] = __builtin_amdgcn_rcpf(li_l[crow(r, hi)]);
    bf16* Ow = cur.O + (size_t)(wid * QBLK) * TS;
#pragma unroll
    for (int r = 0; r < 16; ++r) { const int orow = crow(r, hi);
#pragma unroll
        for (int d0 = 0; d0 < 4; ++d0) { const float v = o[d0][r] * rli[r];
            const float vn = __shfl_xor(v, 1);
            if ((r32 & 1) == 0) *(unsigned*)(Ow + (size_t)orow * TS + d0 * 32 + r32) = cvt_pk_bf16(v, vn); } }
    __syncthreads();
#undef RESC
#undef KBASE
#undef MASKT
#undef SEAM_K0
#undef HALF_STEP
}
#undef ROW
#undef VMW
#undef VMWN
#undef SLOAD_H
#undef SWRITE_HK
#undef SWRITE_HV
#undef SWRITE_H
}

#define XB_TMO      128
#define XB_XCNT(j)  (256  + 64 * (j))
#define XB_XSUB(j)  (1280 + 64 * (j))
#define XB_XGEN(j)  (2304 + 64 * (j))
#define XB_TOP      3328
#define XB_TOPGEN   3392
#define XCD_BAR_WORDS 3456
#define XB_SPIN_CAP (1u << 18)
__device__ __forceinline__ unsigned xb_ld(unsigned* p)              { return __hip_atomic_load(p, __ATOMIC_RELAXED, __HIP_MEMORY_SCOPE_AGENT); }
__device__ __forceinline__ unsigned xb_add(unsigned* p, unsigned v) { return __hip_atomic_fetch_add(p, v, __ATOMIC_RELAXED, __HIP_MEMORY_SCOPE_AGENT); }
__device__ __forceinline__ unsigned xb_xcc_id() { return (unsigned)__builtin_amdgcn_s_getreg((3 << 11) | 20) & 0xFu; }
#define XB_SPIN(cond, bar) do { unsigned _sp = 0; while (cond) { __builtin_amdgcn_s_sleep(1); \
    if ((++_sp & 255u) == 0u) { if (xb_ld(&(bar)[XB_TMO])) break; if (_sp > XB_SPIN_CAP) { atomicAdd(&(bar)[XB_TMO], 1u); break; } } } } while (0)
struct XcdBarrier { unsigned* bar; unsigned x; volatile LAS unsigned* st; };
__device__ __forceinline__ XcdBarrier xcd_barrier_post(unsigned* bar, volatile LAS unsigned* st) {
    XcdBarrier b; b.bar = bar; b.x = xb_xcc_id(); b.st = st;
    if (threadIdx.x == 0) (void)xb_add(&bar[XB_XCNT(b.x)], 1u);
    return b;
}
__device__ __forceinline__ void xcd_barrier_complete(unsigned* bar, unsigned x, unsigned& nloc, unsigned& nx) {
    const unsigned G = gridDim.x * gridDim.y * gridDim.z;
    unsigned sum, cnt, mine, sp = 0u;
    for (;;) {
        sum = 0u; cnt = 0u;
#pragma unroll 1
        for (unsigned j = 0; j < 16; ++j) { const unsigned c = xb_ld(&bar[XB_XCNT(j)]); sum += c; cnt += (c > 0u) ? 1u : 0u; }
        if (sum == G) break;
        __builtin_amdgcn_s_sleep(1);
        if ((++sp & 255u) == 0u) { if (xb_ld(&bar[XB_TMO])) break; if (sp > XB_SPIN_CAP) { atomicAdd(&bar[XB_TMO], 1u); break; } }
    }
    mine = xb_ld(&bar[XB_XCNT(x)]);
    nloc = mine > 0u ? mine : 1u; nx = cnt > 0u ? cnt : 1u;
}
__device__ __forceinline__ void xcd_barrier(const XcdBarrier& b) {
    asm volatile("s_waitcnt vmcnt(0)" ::: "memory");
    __syncthreads();
    if (threadIdx.x == 0) {
        unsigned* bar = b.bar;
        __builtin_amdgcn_s_waitcnt(0);
        unsigned nloc = b.st[0], nx = b.st[1];
        if (nloc == 0u) { xcd_barrier_complete(bar, b.x, nloc, nx); b.st[0] = nloc; b.st[1] = nx; }
        const unsigned old = xb_add(&bar[XB_XSUB(b.x)], 1u);
        const unsigned gen = old / nloc;
        if (old + 1u == (gen + 1u) * nloc) {
            __builtin_amdgcn_fence(__ATOMIC_RELEASE, "agent");
            asm volatile("s_waitcnt vmcnt(0)" ::: "memory");
            const unsigned og = xb_add(&bar[XB_TOP], 1u);
            const unsigned tg = og / nx;
            if (og + 1u == (tg + 1u) * nx) xb_add(&bar[XB_TOPGEN], 1u);
            else XB_SPIN(xb_ld(&bar[XB_TOPGEN]) == tg, bar);
            __builtin_amdgcn_fence(__ATOMIC_ACQUIRE, "agent");
            xb_add(&bar[XB_XGEN(b.x)], 1u);
            asm volatile("s_waitcnt vmcnt(0)" ::: "memory");
        } else {
            XB_SPIN(xb_ld(&bar[XB_XGEN(b.x)]) == gen, bar);
            __builtin_amdgcn_fence(__ATOMIC_ACQUIRE, "agent");
            asm volatile("s_waitcnt vmcnt(0)" ::: "memory");
        }
    }
    __syncthreads();
}

struct Frame {
    LAS unsigned char* lds; volatile LAS unsigned* MISC; unsigned* ctl;
    int tid, lane, wave, vcu, G, bx, lo, hi;
    unsigned char* ws;
};
struct Args { const void* in[24]; float* out; unsigned char* ws; int ph_lo, ph_hi; };
typedef const __attribute__((address_space(4))) Args* KArgs;
__device__ __forceinline__ KArgs kargs() { KArgs p = (KArgs)__builtin_amdgcn_kernarg_segment_ptr(); asm volatile("" : "+s"(p)); return p; }
__device__ __forceinline__ void refresh(Frame& F) {
    KArgs k = kargs();
    int t = threadIdx.x; asm volatile("" : "+v"(t)); F.tid = t; F.lane = t & 63; F.wave = __builtin_amdgcn_readfirstlane(t >> 6);
    int g = gridDim.x, bx = blockIdx.x; asm volatile("" : "+s"(g), "+s"(bx)); F.G = g; F.bx = bx; F.vcu = (g % 8 == 0) ? (bx % 8) * (g / 8) + bx / 8 : bx;
    F.ws = k->ws; F.ctl = (unsigned*)(F.ws + WS_CTL); F.lo = k->ph_lo; F.hi = k->ph_hi;
    F.lds = (LAS unsigned char*)0; F.MISC = (volatile LAS unsigned*)(F.lds + MISC_OFF);
}
__device__ __forceinline__ XcdBarrier frame_bar(Frame& F) { XcdBarrier b; b.bar = F.ctl + CW_BAR; b.x = xb_xcc_id(); b.st = F.MISC + 8; return b; }
enum { I_X = 0, I_POS, I_NORMS, I_LAMRE, I_LAMIM, I_LOGDT, I_BRE, I_BIM, I_CRE, I_CIM, I_SD, I_WGLU, I_KVN, I_WKV, I_WQ, I_WO, I_FW1, I_FW3, I_FW2, I_ROUTER, I_RBIAS, I_MW1, I_MW3, I_MW2 };

__device__ __forceinline__ int rot32(int d) { return 8 * ((d & 15) >> 2) + 2 * (d & 3) + (d >> 4); }
constexpr int NKIND = 31;
struct WK { const float* W; const float* gain; unsigned char* dst; unsigned* colmax; float* psq; int ldw, K, N, mode, base, which, ot; };
__device__ __forceinline__ void wk_get(KArgs ap, unsigned char* ws, int kind, WK& k) {
    const auto& a = *ap; const float* norms = (const float*)a.in[I_NORMS]; k.gain = nullptr; k.colmax = nullptr; k.psq = nullptr; k.mode = 0; k.base = 0; k.which = 0; k.ot = 0; k.ldw = DM; k.K = DM; k.N = DM;
    if (kind == 0) { k.W = (const float*)a.in[I_WGLU]; k.ldw = 2 * DM; k.N = 2 * DM; k.dst = ws + WS_WGLU; k.mode = 3; }
    else if (kind == 1) { k.W = (const float*)a.in[I_WQ]; k.gain = norms + 4 * DM; k.mode = 2; k.ot = MK_QKV8; k.dst = MK_QKV8 ? ws + WS_WQQKV : ws + WS_WQKV; k.colmax = (unsigned*)(ws + WS_COLMAX_QKV); }
    else if (kind == 2) { k.W = (const float*)a.in[I_WKV]; k.ldw = 2 * DM; k.N = 2 * DM; k.gain = (const float*)a.in[I_KVN]; k.mode = 4; k.base = DM; k.ot = MK_QKV8; k.dst = MK_QKV8 ? ws + WS_WQQKV : ws + WS_WQKV; k.colmax = (unsigned*)(ws + WS_COLMAX_QKV); }
    else if (kind == 3) { k.W = (const float*)a.in[I_WO]; k.dst = ws + WS_WO; }
    else if (kind == 4 || kind == 5) { k.W = (const float*)a.in[kind == 4 ? I_FW1 : I_FW3]; k.ldw = FFD; k.N = FFD; k.gain = norms + 2 * DM; k.mode = 1; k.which = kind - 4; k.ot = 1; k.dst = ws + WS_WQF13; k.colmax = (unsigned*)(ws + WS_COLMAX_F); k.psq = (float*)(ws + WS_PSQD); }
    else if (kind == 6) { k.W = (const float*)a.in[I_FW2]; k.K = FFD; k.dst = ws + WS_WF2; if (MK_FFN2F8) { k.ot = 2; k.colmax = (unsigned*)(ws + WS_COLMAX_W2) + NE * DM; } }
    else if (kind < 23) { const int e = (kind - 7) & 7, wh = (kind - 7) >> 3; k.W = (const float*)a.in[wh ? I_MW3 : I_MW1] + (size_t)e * DM * FFE; k.ldw = FFE; k.N = FFE; k.gain = norms + 6 * DM; k.mode = 1; k.which = wh; k.ot = 1;
        k.dst = ws + WS_WQ13 + (size_t)e * 2 * FFE * DM; k.colmax = (unsigned*)(ws + WS_COLMAX) + e * 2 * FFE; k.psq = (float*)(ws + WS_PSQ) + e * 2 * FFE; }
    else { const int e = kind - 23; k.W = (const float*)a.in[I_MW2] + (size_t)e * FFE * DM; k.K = FFE; k.ot = 2; k.dst = ws + WS_W8M2 + (size_t)e * DM * FFE; k.colmax = (unsigned*)(ws + WS_COLMAX_W2) + e * DM; }
}
__device__ __forceinline__ int wk_drow(const WK& k, int n) {
    if (k.mode == 1) return (n >> 7) * 256 + k.which * 128 + (n & 127);
    if (k.mode == 3) { const int chn = n & 1023; return (chn >> 7) * 256 + (n >> 10) * 128 + (chn & 127); }
    if (k.mode == 2 || (k.mode == 4 && n < DM)) { const int d = n & 127; return k.base + (n & ~127) + (d < 32 ? rot32(d) : d); }
    return k.base + n;
}
__device__ __forceinline__ int wk_f8ex(float cm) { int ex = 0; if (cm > 0.f) { ex = 134 - (int)((__float_as_uint(cm) >> 23) & 0xffu); ex = ex < -60 ? -60 : (ex > 60 ? 60 : ex); } return ex; }
__device__ __forceinline__ unsigned q8(float x) { int q = (int)rintf(x); q = q < -127 ? -127 : (q > 127 ? 127 : q); return (unsigned)q & 0xffu; }
__device__ __forceinline__ unsigned q8x4(float a, float b, float c, float d, float f) {
    unsigned p = 0;
    p = __builtin_amdgcn_cvt_pk_u8_f32(rintf(fmaf(a, f, 128.0f)), 0, p); p = __builtin_amdgcn_cvt_pk_u8_f32(rintf(fmaf(b, f, 128.0f)), 1, p);
    p = __builtin_amdgcn_cvt_pk_u8_f32(rintf(fmaf(c, f, 128.0f)), 2, p); p = __builtin_amdgcn_cvt_pk_u8_f32(rintf(fmaf(d, f, 128.0f)), 3, p);
    return p ^ 0x80808080u;
}
__device__ __forceinline__ void wk_stats_item(const WK& k, int kb, int nb, int lane) {
    const int nc = nb * 256 + 4 * lane; float mx[4] = {0.f, 0.f, 0.f, 0.f}, sq[4] = {0.f, 0.f, 0.f, 0.f};
#pragma unroll 1
    for (int i0 = 0; i0 < 64; i0 += 16) { f32x4 v[16];
#pragma unroll
        for (int i = 0; i < 16; ++i) v[i] = *(const f32x4*)(k.W + (size_t)(kb * 64 + i0 + i) * k.ldw + nc);
#pragma unroll
        for (int i = 0; i < 16; ++i) { const float gs = k.gain ? k.gain[kb * 64 + i0 + i] : 1.0f;
#pragma unroll
            for (int c = 0; c < 4; ++c) { const float x = v[i][c] * gs; mx[c] = fmaxf(mx[c], fabsf(x)); sq[c] += x * x; } } }
#pragma unroll
    for (int c = 0; c < 4; ++c) { const int dr = wk_drow(k, nc + c); atomicMax(k.colmax + dr, __float_as_uint(mx[c])); if (k.psq) k.psq[(size_t)kb * (NE * 2 * FFE) + dr] = sq[c]; }
}
__device__ __forceinline__ void wk_item(const WK& k, int kb, int nb, int* sb8, LAS float* scr, int lane) {
    const int k0 = kb * 64, n0 = nb * 64;
    f32x4 v[16]; const int r4 = lane >> 4, c4 = (lane & 15) * 4;
#pragma unroll
    for (int i = 0; i < 16; ++i) v[i] = *(const f32x4*)(k.W + (size_t)(k0 + 4 * i + r4) * k.ldw + n0 + c4);
    const int k8 = lane & 3, nl = lane >> 2;
    int dr[4]; float qs[4];
#pragma unroll
    for (int st = 0; st < 4; ++st) { dr[st] = wk_drow(k, n0 + 16 * st + nl); qs[st] = 1.0f;
        if (k.ot == 1) { const float cm = __uint_as_float(k.colmax[dr[st]]); qs[st] = cm > 0.f ? 127.0f / cm : 0.f; }
        if (k.ot == 2) { const int ex = wk_f8ex(__uint_as_float(k.colmax[dr[st]])); qs[st] = __builtin_bit_cast(float, (unsigned)(127 + ex) << 23); if (kb == 0 && k8 == 0) sb8[dr[st]] = 127 - ex; } }
#pragma unroll
    for (int hf = 0; hf < 2; ++hf) {
#pragma unroll
        for (int i = 0; i < 8; ++i) { const int kk = 4 * i + r4; const float gs = k.gain ? k.gain[k0 + hf * 32 + kk] : 1.0f; LAS float* d = scr + kk * 65 + c4; const f32x4 x = v[hf * 8 + i];
            d[0] = x.x * gs; d[1] = x.y * gs; d[2] = x.z * gs; d[3] = x.w * gs; }
        LDS_WAIT(); asm volatile("" ::: "memory");
#pragma unroll
        for (int st = 0; st < 4; ++st) { const int n = 16 * st + nl; const LAS float* sp = scr + (8 * k8) * 65 + n; const float f = qs[st];
            if (k.ot == 0) { v4u o; o.x = cvt_pk_bf16(sp[0 * 65], sp[1 * 65]); o.y = cvt_pk_bf16(sp[2 * 65], sp[3 * 65]); o.z = cvt_pk_bf16(sp[4 * 65], sp[5 * 65]); o.w = cvt_pk_bf16(sp[6 * 65], sp[7 * 65]);
                *(v4u*)((bf16*)k.dst + (size_t)dr[st] * k.K + k0 + hf * 32 + 8 * k8) = o; }
            else { v2u o;
                if (k.ot == 1) { o.x = q8x4(sp[0 * 65], sp[1 * 65], sp[2 * 65], sp[3 * 65], f); o.y = q8x4(sp[4 * 65], sp[5 * 65], sp[6 * 65], sp[7 * 65], f); }
                else { int p0 = __builtin_amdgcn_cvt_pk_fp8_f32(sp[0 * 65] * f, sp[1 * 65] * f, 0, false); p0 = __builtin_amdgcn_cvt_pk_fp8_f32(sp[2 * 65] * f, sp[3 * 65] * f, p0, true);
                       int p1 = __builtin_amdgcn_cvt_pk_fp8_f32(sp[4 * 65] * f, sp[5 * 65] * f, 0, false); p1 = __builtin_amdgcn_cvt_pk_fp8_f32(sp[6 * 65] * f, sp[7 * 65] * f, p1, true); o.x = (unsigned)p0; o.y = (unsigned)p1; }
                *(v2u*)(k.dst + (size_t)dr[st] * k.K + k0 + hf * 32 + 8 * k8) = o; } }
        LDS_WAIT(); asm volatile("" ::: "memory");
    }
}
__device__ __forceinline__ void wk_shape(int kind, int& nkb, int& nn, bool& quant) {
    nkb = DM / 64; nn = DM; quant = false;
    if (kind == 0) nn = 2 * DM;
    else if (kind == 1) quant = MK_QKV8 != 0;
    else if (kind == 2) { nn = 2 * DM; quant = MK_QKV8 != 0; }
    else if (kind == 4 || kind == 5) { nn = FFD; quant = true; }
    else if (kind == 6) { nkb = FFD / 64; quant = MK_FFN2F8 != 0; }
    else if (kind >= 7 && kind < 23) { nn = FFE; quant = true; }
    else if (kind >= 23) { nkb = FFE / 64; quant = true; }
}
template <bool GAIN> __device__ __forceinline__ void wk_tile_stats(const WK& k, int kb, int r4, const f32x4 (&v)[16], float (&mx)[4], float (&sq)[4]) {
    const float* gp = GAIN ? k.gain + kb * 64 + 16 * r4 : nullptr; if (GAIN) asm volatile("" : "+v"(gp));
#pragma unroll
    for (int i = 0; i < 16; ++i) { const float gs = GAIN ? gp[i] : 1.0f;
#pragma unroll
        for (int c = 0; c < 4; ++c) { const float x = v[i][c] * gs; mx[c] = fmaxf(mx[c], fabsf(x)); sq[c] += x * x; } }
}
template <bool GAIN> __device__ __forceinline__ void wk_tile_out(const WK& k, int kb, int r4, const f32x4 (&v)[16], const int (&dr)[4], const float (&qs)[4]) {
    const float* gp = GAIN ? k.gain + kb * 64 + 16 * r4 : nullptr; if (GAIN) asm volatile("" : "+v"(gp));
    float g[16];
#pragma unroll
    for (int i = 0; i < 16; ++i) g[i] = GAIN ? gp[i] : 1.0f;
#pragma unroll
    for (int c = 0; c < 4; ++c) { const float f = qs[c]; v4u o;
        if (k.ot == 1) { o.x = q8x4(v[0][c] * g[0], v[1][c] * g[1], v[2][c] * g[2], v[3][c] * g[3], f); o.y = q8x4(v[4][c] * g[4], v[5][c] * g[5], v[6][c] * g[6], v[7][c] * g[7], f);
                         o.z = q8x4(v[8][c] * g[8], v[9][c] * g[9], v[10][c] * g[10], v[11][c] * g[11], f); o.w = q8x4(v[12][c] * g[12], v[13][c] * g[13], v[14][c] * g[14], v[15][c] * g[15], f); }
        else { unsigned w[4];
#pragma unroll
            for (int q = 0; q < 4; ++q) { int pw = __builtin_amdgcn_cvt_pk_fp8_f32(v[4 * q][c] * g[4 * q] * f, v[4 * q + 1][c] * g[4 * q + 1] * f, 0, false);
                pw = __builtin_amdgcn_cvt_pk_fp8_f32(v[4 * q + 2][c] * g[4 * q + 2] * f, v[4 * q + 3][c] * g[4 * q + 3] * f, pw, true); w[q] = (unsigned)pw; }
            o.x = w[0]; o.y = w[1]; o.z = w[2]; o.w = w[3]; }
        *(v4u*)(k.dst + (size_t)dr[c] * k.K + kb * 64 + 16 * r4) = o; }
}
#define SCHED_FENCE() __builtin_amdgcn_sched_barrier(0)
template <int TPW> __device__ __forceinline__ void wk_super(const WK& k, Frame& F, int sbslot, int nb) {
    LAS float* smax = (LAS float*)(F.lds + F.wave * 16384) + 2080; LAS float* ssq = smax + 64;
    const int lane = F.lane, r4 = lane >> 4, c4 = (lane & 15) * 4, tpw = TPW;
    const float* wbase = k.W + (size_t)(16 * r4) * k.ldw + nb * 64 + c4;
#define WK_LOAD(v, kb) do { const float* p_ = wbase + (size_t)((kb) * 64) * k.ldw; _Pragma("unroll") for (int i_ = 0; i_ < 16; ++i_) { v[i_] = *(const f32x4*)p_; p_ += k.ldw; asm volatile("" : "+v"(p_)); } } while (0)
    float mx[4] = {0.f, 0.f, 0.f, 0.f}, sq[4] = {0.f, 0.f, 0.f, 0.f};
    f32x4 va[16], vb[16];
    const int kbase = F.wave * tpw;
    if constexpr (TPW == 2) { WK_LOAD(va, kbase); WK_LOAD(vb, kbase + 1); wk_tile_stats<TPW == 2>(k, kbase, r4, va, mx, sq); wk_tile_stats<TPW == 2>(k, kbase + 1, r4, vb, mx, sq); }
    else {
        static_assert(TPW == 2 || TPW == 7, "tile schedule below is written for 7 tiles");
        WK_LOAD(va, kbase);
#pragma unroll 1
        for (int t = 0; t < 6; t += 2) { WK_LOAD(vb, kbase + t + 1); SCHED_FENCE(); wk_tile_stats<TPW == 2>(k, kbase + t, r4, va, mx, sq); SCHED_FENCE(); WK_LOAD(va, kbase + t + 2); SCHED_FENCE(); wk_tile_stats<TPW == 2>(k, kbase + t + 1, r4, vb, mx, sq); SCHED_FENCE(); }
        wk_tile_stats<TPW == 2>(k, kbase + 6, r4, va, mx, sq); }
#pragma unroll
    for (int c = 0; c < 4; ++c) { mx[c] = fmaxf(mx[c], __shfl_xor(mx[c], 16)); mx[c] = fmaxf(mx[c], __shfl_xor(mx[c], 32)); sq[c] += __shfl_xor(sq[c], 16); sq[c] += __shfl_xor(sq[c], 32); }
    if (lane < 16) {
#pragma unroll
        for (int c = 0; c < 4; ++c) { smax[c4 + c] = mx[c]; ssq[c4 + c] = sq[c]; } }
    __syncthreads();
    int dr[4]; float qs[4];
#pragma unroll
    for (int c = 0; c < 4; ++c) { const int n = c4 + c; float cm = 0.f;
#pragma unroll
        for (int w = 0; w < NWAVES; ++w) cm = fmaxf(cm, ((const LAS float*)(F.lds + w * 16384))[2080 + n]);
        dr[c] = wk_drow(k, nb * 64 + n); qs[c] = 1.0f;
        if (k.ot == 1) qs[c] = cm > 0.f ? 127.0f / cm : 0.f;
        if (k.ot == 2) { const int ex = wk_f8ex(cm); qs[c] = __builtin_bit_cast(float, (unsigned)(127 + ex) << 23); } }
    if (F.tid < 64) { const int n = F.tid; float cm = 0.f, ss = 0.f;
#pragma unroll
        for (int w = 0; w < NWAVES; ++w) { cm = fmaxf(cm, ((const LAS float*)(F.lds + w * 16384))[2080 + n]); ss += ((const LAS float*)(F.lds + w * 16384))[2144 + n]; }
        const int d = wk_drow(k, nb * 64 + n); k.colmax[d] = __float_as_uint(cm); if (k.psq) k.psq[d] = ss;
        if (k.ot == 2) ((int*)(F.ws + WS_SB8))[sbslot * DM + d] = 127 - wk_f8ex(cm); }
    if constexpr (TPW == 2) { wk_tile_out<TPW == 2>(k, kbase, r4, va, dr, qs); wk_tile_out<TPW == 2>(k, kbase + 1, r4, vb, dr, qs); }
    else {
        wk_tile_out<TPW == 2>(k, kbase + 6, r4, va, dr, qs); SCHED_FENCE();
        WK_LOAD(va, kbase + 4); SCHED_FENCE(); wk_tile_out<TPW == 2>(k, kbase + 5, r4, vb, dr, qs); SCHED_FENCE();
#pragma unroll 1
        for (int t = 4; t >= 2; t -= 2) { WK_LOAD(vb, kbase + t - 1); SCHED_FENCE(); wk_tile_out<TPW == 2>(k, kbase + t, r4, va, dr, qs); SCHED_FENCE(); WK_LOAD(va, kbase + t - 2); SCHED_FENCE(); wk_tile_out<TPW == 2>(k, kbase + t - 1, r4, vb, dr, qs); SCHED_FENCE(); }
        wk_tile_out<TPW == 2>(k, kbase, r4, va, dr, qs); }
#undef WK_LOAD
    __syncthreads();
}
__device__ __forceinline__ void wk_super_g(const WK& k, Frame& F, int sbslot, int nb) {
    LAS float* smax = (LAS float*)(F.lds + F.wave * 16384) + 2080; LAS float* ssq = smax + 64;
    const int lane = F.lane, r4 = lane >> 4, c4 = (lane & 15) * 4, nkb = k.K / 64;
    const float* wbase = k.W + (size_t)(16 * r4) * k.ldw + nb * 64 + c4;
#define WK_LOAD(v, kb) do { const float* p_ = wbase + (size_t)((kb) * 64) * k.ldw; _Pragma("unroll") for (int i_ = 0; i_ < 16; ++i_) { v[i_] = *(const f32x4*)p_; p_ += k.ldw; asm volatile("" : "+v"(p_)); } } while (0)
    float mx[4] = {0.f, 0.f, 0.f, 0.f}, sq[4] = {0.f, 0.f, 0.f, 0.f};
    f32x4 va[16];
#pragma unroll 1
    for (int kb = F.wave; kb < nkb; kb += NWAVES) { WK_LOAD(va, kb); wk_tile_stats<false>(k, kb, r4, va, mx, sq); }
#pragma unroll
    for (int c = 0; c < 4; ++c) { mx[c] = fmaxf(mx[c], __shfl_xor(mx[c], 16)); mx[c] = fmaxf(mx[c], __shfl_xor(mx[c], 32)); sq[c] += __shfl_xor(sq[c], 16); sq[c] += __shfl_xor(sq[c], 32); }
    if (lane < 16) {
#pragma unroll
        for (int c = 0; c < 4; ++c) { smax[c4 + c] = mx[c]; ssq[c4 + c] = sq[c]; } }
    __syncthreads();
    int dr[4]; float qs[4];
#pragma unroll
    for (int c = 0; c < 4; ++c) { const int n = c4 + c; float cm = 0.f;
#pragma unroll
        for (int w = 0; w < NWAVES; ++w) cm = fmaxf(cm, ((const LAS float*)(F.lds + w * 16384))[2080 + n]);
        dr[c] = wk_drow(k, nb * 64 + n); const int ex = wk_f8ex(cm); qs[c] = __builtin_bit_cast(float, (unsigned)(127 + ex) << 23); }
    if (F.tid < 64) { const int n = F.tid; float cm = 0.f;
#pragma unroll
        for (int w = 0; w < NWAVES; ++w) cm = fmaxf(cm, ((const LAS float*)(F.lds + w * 16384))[2080 + n]);
        const int d = wk_drow(k, nb * 64 + n); k.colmax[d] = __float_as_uint(cm); ((int*)(F.ws + WS_SB8))[sbslot * DM + d] = 127 - wk_f8ex(cm); }
#pragma unroll 1
    for (int kb = F.wave; kb < nkb; kb += NWAVES) { WK_LOAD(va, kb); wk_tile_out<false>(k, kb, r4, va, dr, qs); }
#undef WK_LOAD
    __syncthreads();
}
constexpr int WQ_TOTAL = NE * (DM / 64) + 2 * NE * (FFE / 64) + 2 * (FFD / 64) + (MK_QKV8 ? 3 * DM / 64 : 0) + (MK_FFN2F8 ? DM / 64 : 0);
__device__ __forceinline__ void wk_convert_super(KArgs ap, Frame& F) {
    volatile LAS unsigned* qw = F.MISC + 16;
    if (F.tid == 0) qw[0] = __hip_atomic_fetch_add(F.ctl + CW_WQ, 1u, __ATOMIC_RELAXED, __HIP_MEMORY_SCOPE_AGENT);
    __syncthreads();
    int it = __builtin_amdgcn_readfirstlane((int)qw[0]);
#pragma unroll 1
    while (it < WQ_TOTAL) {
        unsigned nxt = 0; if (F.tid == 0) nxt = __hip_atomic_fetch_add(F.ctl + CW_WQ, 1u, __ATOMIC_RELAXED, __HIP_MEMORY_SCOPE_AGENT);
        int kind = 6, rem = it, nkb = 16;
        if (!(MK_FFN2F8 && rem < DM / 64)) { if (MK_FFN2F8) rem -= DM / 64;
#pragma unroll 1
            for (kind = NKIND - 1;; --kind) { if (kind == 6) continue; int nn; bool quant; wk_shape(kind, nkb, nn, quant); const int cnt = quant ? nn / 64 : 0; if (rem < cnt) break; rem -= cnt; } }
        { WK k; wk_get(ap, F.ws, kind, k);
          if (kind == 6) wk_super_g(k, F, NE, rem); else if (nkb == 16) wk_super<2>(k, F, kind - 23, rem); else wk_super<7>(k, F, kind - 23, rem); }
        if (F.tid == 0) qw[0] = nxt;
        __syncthreads();
        it = __builtin_amdgcn_readfirstlane((int)qw[0]);
    }
}
__device__ __forceinline__ void wk_convert(KArgs ap, Frame& F, int pass) {
    LAS float* scr = (LAS float*)(F.lds + F.wave * 16384);
    const int gw = F.vcu * NWAVES + F.wave, NGW = F.G * NWAVES;
    int it = gw;
#pragma unroll 1
    for (int kind = 0; kind < NKIND; ++kind) { WK k; wk_get(ap, F.ws, kind, k);
        const bool quant = k.ot != 0;
        if (pass == 0 && quant) { if (MK_SUPER) continue; const int nkb = k.K / 64, nnb = k.N / 256, cnt = nkb * nnb;
            for (; it < cnt; it += NGW) wk_stats_item(k, it % nkb, it / nkb, F.lane);
            it -= cnt; }
        else if ((pass == 0) != quant) { const int nkb = k.K / 64, nnb = k.N / 64, cnt = nkb * nnb;
            int* sb8 = (int*)(F.ws + WS_SB8) + (kind >= 23 ? (kind - 23) * DM : 0);
            for (; it < cnt; it += NGW) wk_item(k, it / nnb, it % nnb, sb8, scr, F.lane);
            it -= cnt; }
    }
}
__device__ __forceinline__ void p0_s5_group(KArgs ap, Frame& F, int g, int qtr) {
    const auto& a = *ap;
    const float* lam_re = (const float*)a.in[I_LAMRE]; const float* lam_im = (const float*)a.in[I_LAMIM]; const float* log_dt = (const float*)a.in[I_LOGDT];
    const float* b_re = (const float*)a.in[I_BRE]; const float* b_im = (const float*)a.in[I_BIM]; const float* c_re = (const float*)a.in[I_CRE]; const float* c_im = (const float*)a.in[I_CIM];
    const float* g0 = (const float*)a.in[I_NORMS];
    LAS float* apr = (LAS float*)F.lds;
    LAS float* api = apr + 17 * 64;
    LAS float* bbr = api + 17 * 64;
    LAS float* bbi = bbr + 1024;
    LAS float* ccr = bbi + 1024;
    LAS float* cci = ccr + 1024;
    LAS float* ktab = cci + 1024;
    const float dt = expf(log_dt[g]);
    for (int idx = F.tid; idx < 17 * 64; idx += NWAVES * 64) { const int l = idx >> 6, p = idx & 63; const float zr = lam_re[g * 64 + p] * dt, zi = lam_im[g * 64 + p] * dt;
        const float mag = expf((float)l * zr); float sn, cs; sincosf((float)l * zi, &sn, &cs); apr[idx] = mag * cs; api[idx] = mag * sn; }
    for (int idx = F.tid; idx < 1024; idx += NWAVES * 64) { const int p = idx >> 4, j = idx & 15; const float lr = lam_re[g * 64 + p], li = lam_im[g * 64 + p]; const float zr = lr * dt, zi = li * dt;
        const float mag = expf(zr); float sn, cs; sincosf(zi, &sn, &cs); const float ar = mag * cs, ai = mag * sn, den = lr * lr + li * li;
        const float cfr = ((ar - 1.0f) * lr + ai * li) / den, cfi = (ai * lr - (ar - 1.0f) * li) / den;
        const float br = b_re[(size_t)(g * 64 + p) * 16 + j], bi = b_im[(size_t)(g * 64 + p) * 16 + j], gn = g0[g * 16 + j];
        bbr[idx] = (cfr * br - cfi * bi) * gn; bbi[idx] = (cfr * bi + cfi * br) * gn;
        ccr[idx] = c_re[(size_t)g * 1024 + idx]; cci[idx] = c_im[(size_t)g * 1024 + idx]; }
    __syncthreads();
    for (int idx0 = F.tid; idx0 < 1024; idx0 += NWAVES * 64) { const int l = idx0 >> 6, i = 4 * qtr + ((idx0 >> 4) & 3), j = idx0 & 15, idx = (l * 16 + i) * 16 + j; float s = 0.f;
        for (int p = 0; p < 64; ++p) { const float cr = ccr[i * 64 + p], ci = cci[i * 64 + p], ar = apr[l * 64 + p], ai = api[l * 64 + p]; const float car = cr * ar - ci * ai, cai = cr * ai + ci * ar; s += car * bbr[p * 16 + j] - cai * bbi[p * 16 + j]; }
        ktab[idx] = s; }
    __syncthreads();
    bf16* btc = (bf16*)(F.ws + WS_BTC) + (size_t)g * 256 * UAK; bf16* bta = (bf16*)(F.ws + WS_BTA) + (size_t)g * 256 * 256;
    for (int pc = F.tid; pc < 64 * 48; pc += NWAVES * 64) { const int nq = pc / 48, k8 = pc % 48, t = nq >> 2, i = 4 * qtr + (nq & 3), n = t * 16 + i; float v[8];
        if (k8 < 32) { const int s = k8 >> 1, j0 = (k8 & 1) * 8;
#pragma unroll
            for (int jj = 0; jj < 8; ++jj) v[jj] = (t >= s) ? ktab[((t - s) * 16 + i) * 16 + j0 + jj] : 0.f; }
        else { const int pb = (k8 - 32) * 8;
#pragma unroll
            for (int jj = 0; jj < 8; ++jj) { const int p = (pb + jj) & 63; const float cr = ccr[i * 64 + p], ci = cci[i * 64 + p], ar = apr[(t + 1) * 64 + p], ai = api[(t + 1) * 64 + p];
                v[jj] = (pb < 64) ? (cr * ar - ci * ai) : -(cr * ai + ci * ar); } }
        v4u o; o.x = pk2(v[0], v[1]); o.y = pk2(v[2], v[3]); o.z = pk2(v[4], v[5]); o.w = pk2(v[6], v[7]);
        *(v4u*)(btc + (size_t)n * UAK + k8 * 8) = o; }
    for (int pc = F.tid; pc < 64 * 32; pc += NWAVES * 64) { const int n = (pc >> 5) * 4 + qtr, k8 = pc & 31, s = k8 >> 1, j0 = (k8 & 1) * 8; float v[8];
        const int p = n & 63, l = 15 - s; const float ar = apr[l * 64 + p], ai = api[l * 64 + p];
#pragma unroll
        for (int jj = 0; jj < 8; ++jj) { const float br = bbr[p * 16 + j0 + jj], bi = bbi[p * 16 + j0 + jj]; v[jj] = (n < 64) ? (ar * br - ai * bi) : ((n < 128) ? (ar * bi + ai * br) : 0.f); }
        v4u o; o.x = pk2(v[0], v[1]); o.y = pk2(v[2], v[3]); o.z = pk2(v[4], v[5]); o.w = pk2(v[6], v[7]);
        *(v4u*)(bta + (size_t)n * 256 + k8 * 8) = o; }
    float* spar = (float*)(F.ws + WS_SPAR) + g * 128;
    if (qtr == 0 && F.tid < 64) { spar[F.tid] = apr[16 * 64 + F.tid]; spar[64 + F.tid] = api[16 * 64 + F.tid]; }
    __syncthreads();
}
__device__ __forceinline__ void p0_chunk(const float* x, Frame& F, int ch) {
    const int b = ch >> 7, c = ch & 127; LAS unsigned short* tile = (LAS unsigned short*)F.lds;
#pragma unroll
    for (int rr = 0; rr < 2; ++rr) { const int tok = F.wave * 2 + rr; const f32x4* xr = (const f32x4*)(x + (size_t)(b * SEQ + c * CL + tok) * DM) + F.lane;
        f32x4 v[4]; float s = 0.f;
#pragma unroll
        for (int j = 0; j < 4; ++j) { v[j] = xr[64 * j]; s += (v[j].x * v[j].x + v[j].y * v[j].y) + (v[j].z * v[j].z + v[j].w * v[j].w); }
        const float rstd = 1.0f / sqrtf(wave_sum(s) * (1.0f / DM) + NORM_EPS);
#pragma unroll
        for (int j = 0; j < 4; ++j) { v2u w; w.x = pk2(v[j].x * rstd, v[j].y * rstd); w.y = pk2(v[j].z * rstd, v[j].w * rstd); *(LAS v2u*)(tile + tok * 1032 + 4 * F.lane + 256 * j) = w; } }
    __syncthreads();
    bf16* ua = (bf16*)(F.ws + WS_UA);
#pragma unroll
    for (int it = 0; it < 4; ++it) { const int q = it * 512 + F.tid, g = q >> 5, piece = q & 31, tok = piece >> 1, half = piece & 1;
        const v4u w = *(const LAS v4u*)(tile + tok * 1032 + g * 16 + half * 8);
        *(v4u*)(ua + ((size_t)g * GROWS + b * NCH + c) * UAK + tok * 16 + half * 8) = w; }
    __syncthreads();
}
__device__ __forceinline__ void p0_prologue(KArgs ap, Frame& F) {
    const auto& a = *ap;
    const float* norms = (const float*)a.in[I_NORMS];
    for (int task = F.vcu; task < NG * 4; task += F.G) p0_s5_group(ap, F, task >> 2, task & 3);
    { const int gt = F.vcu * (NWAVES * 64) + F.tid, NT = F.G * NWAVES * 64; const int* pos = (const int*)a.in[I_POS]; float* rope = (float*)(F.ws + WS_ROPE);
      for (int idx = gt; idx < NTOK * 16; idx += NT) { const int n = idx >> 4, i = idx & 15; const float inv = 1.0f / powf(500000.0f, (float)i * (1.0f / 16.0f)); const float ang = (float)pos[n] * inv; float sn, cs; sincosf(ang, &sn, &cs); rope[(size_t)n * 32 + i] = cs; rope[(size_t)n * 32 + 16 + i] = sn; }
      const float* wr = (const float*)a.in[I_ROUTER]; float* wro = (float*)(F.ws + WS_WR);
      for (int idx = gt; idx < DM * NE; idx += NT) wro[idx] = wr[idx] * norms[(1 * 4 + 2) * DM + (idx >> 3)]; }
    for (int ch = F.vcu; ch < BATCH * NCH; ch += F.G) p0_chunk((const float*)a.in[I_X], F, ch);
    wk_convert(ap, F, 0);
}
__device__ __forceinline__ void expert_act_scale(Frame& F) {
    if (F.vcu < NE + (MK_FFN2F8 ? 1 : 0)) { const int e = F.vcu; const bool dense = e == NE; const float* pq = dense ? (const float*)(F.ws + WS_PSQD) : (const float*)(F.ws + WS_PSQ) + e * 2 * FFE; float m1 = 0.f, m3 = 0.f;
        const int nrow = dense ? 2 * FFD : 2 * FFE;
        for (int i = F.tid; i < nrow; i += NWAVES * 64) { float ss = 0.f;
#pragma unroll
            for (int kc = 0; kc < (MK_SUPER ? 1 : DM / 64); ++kc) ss += pq[(size_t)kc * (NE * 2 * FFE) + i];
            const float v = sqrtf(ss); if ((i >> 7) & 1) m3 = fmaxf(m3, v); else m1 = fmaxf(m1, v); }
#pragma unroll
        for (int o = 1; o < 64; o <<= 1) { m1 = fmaxf(m1, __shfl_xor(m1, o)); m3 = fmaxf(m3, __shfl_xor(m3, o)); }
        LAS float* red = (LAS float*)(F.lds + 8192);
        if (F.lane == 0) { red[F.wave] = m1; red[8 + F.wave] = m3; }
        __syncthreads();
        if (F.tid == 0) { float a1 = 0.f, a3 = 0.f; for (int w = 0; w < NWAVES; ++w) { a1 = fmaxf(a1, red[w]); a3 = fmaxf(a3, red[8 + w]); }
            const float bound = 1.1f * 1024.0f * a1 * a3;
            const int ex = wk_f8ex(bound);
            __hip_atomic_store(F.ctl + CW_EA + e, (unsigned)(127 - ex), __ATOMIC_RELAXED, __HIP_MEMORY_SCOPE_AGENT); }
        __syncthreads(); }
}
__device__ __forceinline__ void s5_scan_local(Frame& F) {
    const float* spar = (const float*)(F.ws + WS_SPAR); const float* sloc = (const float*)(F.ws + WS_SLOC); bf16* ua = (bf16*)(F.ws + WS_UA);
    const int nunits = (NG * 8 - F.bx + F.G - 1) / F.G;
    for (int t = F.wave; t < 2 * nunits; t += NWAVES) { int pm, pn; pg8::tile_of((t >> 1) * F.G + F.bx, NG * 8, 1, pm, pn);
        const int g = pm >> 3, b = (pm & 7) * 2 + (t & 1), p = F.lane;
        const float ar = spar[g * 128 + p], ai = spar[g * 128 + 64 + p]; float sr = 0.f, si = 0.f;
        const size_t row0 = (size_t)g * GROWS + b * NCH;
        constexpr int SB = 16; float l0r[SB], l0i[SB], l1r[SB], l1i[SB];
#define S5_LD(R, I, c0) do { _Pragma("unroll") for (int j = 0; j < SB; ++j) { R[j] = sloc[(row0 + (c0) + j) * 128 + p]; I[j] = sloc[(row0 + (c0) + j) * 128 + 64 + p]; } } while (0)
#define S5_RUN(R, I, c0) do { _Pragma("unroll") for (int j = 0; j < SB; ++j) { ua[(row0 + (c0) + j) * UAK + 256 + p] = (bf16)f2bf(sr); ua[(row0 + (c0) + j) * UAK + 320 + p] = (bf16)f2bf(si); \
            const float nr = ar * sr - ai * si + R[j], ni = ar * si + ai * sr + I[j]; sr = nr; si = ni; } } while (0)
        S5_LD(l0r, l0i, 0);
#pragma unroll 1
        for (int c0 = 0; c0 < NCH; c0 += 2 * SB) {
            S5_LD(l1r, l1i, c0 + SB); __builtin_amdgcn_sched_barrier(0);
            S5_RUN(l0r, l0i, c0); __builtin_amdgcn_sched_barrier(0);
            if (c0 + 2 * SB < NCH) S5_LD(l0r, l0i, c0 + 2 * SB);
            __builtin_amdgcn_sched_barrier(0);
            S5_RUN(l1r, l1i, c0 + SB); __builtin_amdgcn_sched_barrier(0); }
#undef S5_LD
#undef S5_RUN
    }
}
template <bool ROUTE, bool SRC, bool QOUT>
__device__ __forceinline__ void resid_pass(Frame& F, const float* xin, const bf16* xhin, const bf16* mix, int nslots, const float* gain, bf16* xh, const float* rbias) {
    const float* rowss = (const float*)(F.ws + WS_ROWSS); float* rs = (float*)(F.ws + WS_RS);
    LAS int* l_e = (LAS int*)F.lds; LAS float* l_w = (LAS float*)(F.lds + 1024); LAS int* l_cnt = (LAS int*)(F.lds + 2048); LAS int* l_base = (LAS int*)(F.lds + 2048 + 64); LAS float* l_s = (LAS float*)(F.lds + 3072);
    for (int blk = F.vcu; blk < NTOK / 128; blk += F.G) {
        if (ROUTE) { if (F.tid < NE) l_cnt[F.tid] = 0; __syncthreads(); }
        for (int k = 0; k < 16; ++k) { const int row = blk * 128 + F.wave * 16 + k;
            const v4u m0 = *(const v4u*)(mix + (size_t)row * DM + 8 * F.lane), m1 = *(const v4u*)(mix + (size_t)row * DM + 512 + 8 * F.lane);
            float hn[16];
            if (SRC) { const v4u a0 = *(const v4u*)(xhin + (size_t)row * DM + 8 * F.lane), a1 = *(const v4u*)(xhin + (size_t)row * DM + 512 + 8 * F.lane); const float sc = rs[row];
                hn[0] = bf2f(a0.x & 0xffffu) * sc; hn[1] = bf2f(a0.x >> 16) * sc; hn[2] = bf2f(a0.y & 0xffffu) * sc; hn[3] = bf2f(a0.y >> 16) * sc; hn[4] = bf2f(a0.z & 0xffffu) * sc; hn[5] = bf2f(a0.z >> 16) * sc; hn[6] = bf2f(a0.w & 0xffffu) * sc; hn[7] = bf2f(a0.w >> 16) * sc;
                hn[8] = bf2f(a1.x & 0xffffu) * sc; hn[9] = bf2f(a1.x >> 16) * sc; hn[10] = bf2f(a1.y & 0xffffu) * sc; hn[11] = bf2f(a1.y >> 16) * sc; hn[12] = bf2f(a1.z & 0xffffu) * sc; hn[13] = bf2f(a1.z >> 16) * sc; hn[14] = bf2f(a1.w & 0xffffu) * sc; hn[15] = bf2f(a1.w >> 16) * sc; }
            else { const f32x4* hp = (const f32x4*)(xin + (size_t)row * DM); const f32x4 h0 = hp[2 * F.lane], h1 = hp[2 * F.lane + 1], h2 = hp[128 + 2 * F.lane], h3 = hp[128 + 2 * F.lane + 1];
#pragma unroll
                for (int j = 0; j < 4; ++j) { hn[j] = h0[j]; hn[4 + j] = h1[j]; hn[8 + j] = h2[j]; hn[12 + j] = h3[j]; } }
            const f32x4* gp = (const f32x4*)gain; const f32x4 g0 = gp[2 * F.lane], g1 = gp[2 * F.lane + 1], g2 = gp[128 + 2 * F.lane], g3 = gp[128 + 2 * F.lane + 1];
            const float ssm = wave_sum(F.lane < nslots ? rowss[(size_t)row * 32 + F.lane] : 0.f);
            const float rm = 1.0f / sqrtf(ssm * (1.0f / DM) + NORM_EPS);
            hn[0] += bf2f(m0.x & 0xffffu) * rm * g0[0]; hn[1] += bf2f(m0.x >> 16) * rm * g0[1]; hn[2] += bf2f(m0.y & 0xffffu) * rm * g0[2]; hn[3] += bf2f(m0.y >> 16) * rm * g0[3];
            hn[4] += bf2f(m0.z & 0xffffu) * rm * g1[0]; hn[5] += bf2f(m0.z >> 16) * rm * g1[1]; hn[6] += bf2f(m0.w & 0xffffu) * rm * g1[2]; hn[7] += bf2f(m0.w >> 16) * rm * g1[3];
            hn[8] += bf2f(m1.x & 0xffffu) * rm * g2[0]; hn[9] += bf2f(m1.x >> 16) * rm * g2[1]; hn[10] += bf2f(m1.y & 0xffffu) * rm * g2[2]; hn[11] += bf2f(m1.y >> 16) * rm * g2[3];
            hn[12] += bf2f(m1.z & 0xffffu) * rm * g3[0]; hn[13] += bf2f(m1.z >> 16) * rm * g3[1]; hn[14] += bf2f(m1.w & 0xffffu) * rm * g3[2]; hn[15] += bf2f(m1.w >> 16) * rm * g3[3];
            float s2 = 0.f;
#pragma unroll
            for (int j = 0; j < 16; ++j) s2 += hn[j] * hn[j];
            const float ms = wave_sum(s2) * (1.0f / DM) + NORM_EPS; const float rms = sqrtf(ms), rh = 1.0f / rms;
            if (F.lane == 0) rs[row] = rms;
            v4u w0, w1; w0.x = pk2(hn[0] * rh, hn[1] * rh); w0.y = pk2(hn[2] * rh, hn[3] * rh); w0.z = pk2(hn[4] * rh, hn[5] * rh); w0.w = pk2(hn[6] * rh, hn[7] * rh);
            w1.x = pk2(hn[8] * rh, hn[9] * rh); w1.y = pk2(hn[10] * rh, hn[11] * rh); w1.z = pk2(hn[12] * rh, hn[13] * rh); w1.w = pk2(hn[14] * rh, hn[15] * rh);
            *(v4u*)(xh + (size_t)row * DM + 8 * F.lane) = w0; *(v4u*)(xh + (size_t)row * DM + 512 + 8 * F.lane) = w1;
            if (QOUT) {
                { float am = 0.f;
#pragma unroll
                  for (int j = 0; j < 16; ++j) am = fmaxf(am, fabsf(hn[j]));
#pragma unroll
                  for (int o = 1; o < 64; o <<= 1) am = fmaxf(am, __shfl_xor(am, o));
                  am *= rh; const float inv = am > 0.f ? 127.0f / am : 0.f, qs = rh * inv;
                  v2u q0, q1;
                  q0.x = q8x4(hn[0], hn[1], hn[2], hn[3], qs); q0.y = q8x4(hn[4], hn[5], hn[6], hn[7], qs);
                  q1.x = q8x4(hn[8], hn[9], hn[10], hn[11], qs); q1.y = q8x4(hn[12], hn[13], hn[14], hn[15], qs);
                  unsigned char* xq = F.ws + WS_XQ3 + (size_t)row * DM; *(v2u*)(xq + 8 * F.lane) = q0; *(v2u*)(xq + 512 + 8 * F.lane) = q1;
                  if (F.lane == 0) { if (ROUTE) l_s[F.wave * 16 + k] = am * (1.0f / 127.0f); else ((float*)(F.ws + WS_RSC))[row] = am * (1.0f / 127.0f); } }
            }
            if (ROUTE) {
                const float* wr = (const float*)(F.ws + WS_WR); float lg[NE];
#pragma unroll
                for (int e = 0; e < NE; ++e) lg[e] = 0.f;
#pragma unroll
                for (int half = 0; half < 2; ++half)
#pragma unroll
                    for (int j = 0; j < 8; ++j) { const int cc = half * 512 + 8 * F.lane + j; const f32x4 wa = *(const f32x4*)(wr + cc * 8), wb = *(const f32x4*)(wr + cc * 8 + 4); const float xv = hn[half * 8 + j] * rh;
                        lg[0] += xv * wa[0]; lg[1] += xv * wa[1]; lg[2] += xv * wa[2]; lg[3] += xv * wa[3]; lg[4] += xv * wb[0]; lg[5] += xv * wb[1]; lg[6] += xv * wb[2]; lg[7] += xv * wb[3]; }
#pragma unroll
                for (int e = 0; e < NE; ++e) lg[e] = wave_sum(lg[e]) + rbias[e];
                int e0 = 0; float v0 = lg[0];
#pragma unroll
                for (int e = 1; e < NE; ++e) if (lg[e] > v0) { v0 = lg[e]; e0 = e; }
                int e1 = -1; float v1 = -__builtin_inff();
#pragma unroll
                for (int e = 0; e < NE; ++e) if (e != e0 && lg[e] > v1) { v1 = lg[e]; e1 = e; }
                const float w1s = 1.0f / (1.0f + __expf(v0 - v1)), w0s = 1.0f - w1s;
                if (F.lane == 0) { const int ai = (F.wave * 16 + k) * 2; l_e[ai] = e0; l_e[ai + 1] = e1; l_w[ai] = w0s; l_w[ai + 1] = w1s; }
            }
        }
        if (ROUTE) {
            __syncthreads();
            int* list = (int*)(F.ws + WS_LIST); int* slot = (int*)(F.ws + WS_SLOT); float* tokw = (float*)(F.ws + WS_TOKW);
            int e = 0, rank = 0;
            if (F.tid < 256) { e = l_e[F.tid]; rank = atomicAdd((int*)&l_cnt[e], 1); }
            __syncthreads();
            if (F.tid < NE) l_base[F.tid] = (int)__hip_atomic_fetch_add(F.ctl + CW_ECNT + 64 * F.tid, (unsigned)l_cnt[F.tid], __ATOMIC_RELAXED, __HIP_MEMORY_SCOPE_AGENT);
            __syncthreads();
            if (F.tid < 256) { const int pos = l_base[e] + rank, token = blk * 128 + (F.tid >> 1);
                if (pos < LCAP) { list[e * LCAP + pos] = token; ((float*)(F.ws + WS_RSC))[e * LCAP + pos] = l_s[F.tid >> 1]; }
                slot[token * 2 + (F.tid & 1)] = e * LCAP + pos; tokw[token * 2 + (F.tid & 1)] = l_w[F.tid]; }
            __syncthreads();
        }
    }
}
__device__ __forceinline__ void final_pass(Frame& F, float* out, const bf16* xh, const bf16* y, const float* gain) {
    const int gw = F.vcu * NWAVES + F.wave, NGW = F.G * NWAVES;
    etab_build(F.lds, F.ctl);
    const int* slot = (const int*)(F.ws + WS_SLOT); const float* tokw = (const float*)(F.ws + WS_TOKW);
    for (int row = gw; row < NTOK; row += NGW) {
        const int s0 = slot[row * 2], s1 = slot[row * 2 + 1]; const float w0 = tokw[row * 2], w1 = tokw[row * 2 + 1];
        const int e0 = (s0 >> 15) & 7, e1 = (s1 >> 15) & 7; const int ps0 = *(const LAS int*)(F.lds + ET_OFF + 32 + 4 * e0), ps1 = *(const LAS int*)(F.lds + ET_OFF + 32 + 4 * e1);
        const size_t r0 = (size_t)ps0 * 256 + (s0 & (LCAP - 1)), r1 = (size_t)ps1 * 256 + (s1 & (LCAP - 1));
        float f[16];
        if (r0 >= 65536 || r1 >= 65536) {
            const bf16* yp = (const bf16*)(F.ws + WS_YP);
#pragma unroll
            for (int j = 0; j < 16; ++j) f[j] = 0.f;
#pragma unroll 1
            for (int side = 0; side < 2; ++side) { const size_t r = side ? r1 : r0; const float w = side ? w1 : w0; const int nk = r >= 65536 ? KSPLIT : 1;
                for (int kc = 0; kc < nk; ++kc) { const bf16* src = r >= 65536 ? yp + ((size_t)(kc * LPMAX) * 256 + (r - 65536)) * DM : y + r * DM;
#pragma unroll
                    for (int half = 0; half < 2; ++half) { const v4u a = *(const v4u*)(src + half * 512 + 8 * F.lane);
                        f[half * 8 + 0] += w * bf2f(a.x & 0xffffu); f[half * 8 + 1] += w * bf2f(a.x >> 16); f[half * 8 + 2] += w * bf2f(a.y & 0xffffu); f[half * 8 + 3] += w * bf2f(a.y >> 16);
                        f[half * 8 + 4] += w * bf2f(a.z & 0xffffu); f[half * 8 + 5] += w * bf2f(a.z >> 16); f[half * 8 + 6] += w * bf2f(a.w & 0xffffu); f[half * 8 + 7] += w * bf2f(a.w >> 16); } } } }
        else
#pragma unroll
        for (int half = 0; half < 2; ++half) { const v4u a = *(const v4u*)(y + r0 * DM + half * 512 + 8 * F.lane), bq = *(const v4u*)(y + r1 * DM + half * 512 + 8 * F.lane);
            f[half * 8 + 0] = w0 * bf2f(a.x & 0xffffu) + w1 * bf2f(bq.x & 0xffffu); f[half * 8 + 1] = w0 * bf2f(a.x >> 16) + w1 * bf2f(bq.x >> 16);
            f[half * 8 + 2] = w0 * bf2f(a.y & 0xffffu) + w1 * bf2f(bq.y & 0xffffu); f[half * 8 + 3] = w0 * bf2f(a.y >> 16) + w1 * bf2f(bq.y >> 16);
            f[half * 8 + 4] = w0 * bf2f(a.z & 0xffffu) + w1 * bf2f(bq.z & 0xffffu); f[half * 8 + 5] = w0 * bf2f(a.z >> 16) + w1 * bf2f(bq.z >> 16);
            f[half * 8 + 6] = w0 * bf2f(a.w & 0xffffu) + w1 * bf2f(bq.w & 0xffffu); f[half * 8 + 7] = w0 * bf2f(a.w >> 16) + w1 * bf2f(bq.w >> 16); }
        float ss = 0.f;
#pragma unroll
        for (int j = 0; j < 16; ++j) ss += f[j] * f[j];
        const float rf = 1.0f / sqrtf(wave_sum(ss) * (1.0f / DM) + NORM_EPS);
        f32x4* hp = (f32x4*)(out + (size_t)row * DM); const f32x4* gp = (const f32x4*)gain; const float sc = ((const float*)(F.ws + WS_RS))[row];
#pragma unroll
        for (int half = 0; half < 2; ++half) { const v4u a = *(const v4u*)(xh + (size_t)row * DM + half * 512 + 8 * F.lane);
            const float hv[8] = {bf2f(a.x & 0xffffu), bf2f(a.x >> 16), bf2f(a.y & 0xffffu), bf2f(a.y >> 16), bf2f(a.z & 0xffffu), bf2f(a.z >> 16), bf2f(a.w & 0xffffu), bf2f(a.w >> 16)};
#pragma unroll
            for (int q = 0; q < 2; ++q) { const int idx = half * 128 + 2 * F.lane + q; f32x4 h; const f32x4 g = gp[idx];
#pragma unroll
                for (int j = 0; j < 4; ++j) h[j] = hv[q * 4 + j] * sc + f[half * 8 + q * 4 + j] * rf * g[j];
                hp[idx] = h; } }
    }
}

constexpr int N_PHASES = MK_F8 ? 14 : 20;
__global__ void __launch_bounds__(NWAVES * 64, 2) mk_fwd(Args args) {
    extern __shared__ __attribute__((aligned(16))) unsigned char lds_raw[];
    Frame F; refresh(F);
    for (int u = F.tid; u < (LDS_BYTES - LDSCTL_OFF) / 4; u += NWAVES * 64) ((LAS unsigned*)(F.lds + LDSCTL_OFF))[u] = 0u;
    __syncthreads();
    if (F.hi - F.lo > 1) (void)xcd_barrier_post(F.ctl + CW_BAR, F.MISC + 8);
#ifndef MK_ONLY
#define MK_ONLY -1
#endif
#define IN(k) ((MK_ONLY < 0 || (k) == MK_ONLY) && (refresh(F), F.lo <= (k) && (k) < F.hi))
#define SEAM(k) do { refresh(F); if (F.lo <= (k) && (k) + 1 < F.hi) xcd_barrier(frame_bar(F)); } while (0)
#define ws (F.ws)
#define cblk (F.bx)
    if (IN(0)) { p0_prologue(kargs(), F); } SEAM(0);
    if (IN(1)) {
        if (MK_SUPER) wk_convert_super(kargs(), F); else wk_convert(kargs(), F, 1);
        __syncthreads();
        { PlainSched S{(const char*)(ws + WS_UA), (const char*)(ws + WS_BTA), 256, UAK, 256, NG * 8, 1, F.G, cblk, 8, (size_t)256 * 256 * 2};
          EpiS5A E{(float*)(ws + WS_SLOC)};
          pg8::gemm_phase(F.lds, S, E); }
        __builtin_amdgcn_fence(__ATOMIC_ACQUIRE, "agent"); VM_WAIT(); __syncthreads();
        s5_scan_local(F);
        VM_WAIT(); __syncthreads(); __builtin_amdgcn_fence(__ATOMIC_ACQUIRE, "agent"); VM_WAIT(); __syncthreads();
        { KArgs ka = kargs(); PlainSched S{(const char*)(ws + WS_UA), (const char*)(ws + WS_BTC), UAK, UAK, UAK, NG * 8, 1, F.G, cblk, 8, (size_t)256 * UAK * 2};
          EpiS5C E{(const bf16*)(ws + WS_UA), (const float*)ka->in[I_SD], (const float*)ka->in[I_NORMS], (bf16*)(ws + WS_GBUF)};
          pg8::gemm_phase(F.lds, S, E); }
    } SEAM(1);
    if (IN(2)) {
        PlainSched S{(const char*)(ws + WS_GBUF), (const char*)(ws + WS_WGLU), DM, DM, DM, NTOK / 256, 8, F.G, cblk, 1 << 30, 0};
        EpiGated<0> E{(bf16*)(ws + WS_MIX0), DM, (float*)(ws + WS_ROWSS), 0};
        pg8::gemm_phase(F.lds, S, E);
    } SEAM(2);
    if (IN(3)) { KArgs ka = kargs(); resid_pass<false, false, true>(F, (const float*)ka->in[I_X], nullptr, (const bf16*)(ws + WS_MIX0), 32, (const float*)ka->in[I_NORMS] + 1 * DM, (bf16*)(ws + WS_XH1), nullptr);
        expert_act_scale(F); } SEAM(3);
    if (IN(4)) {
        const int sad = MK_FFN2F8 ? (int)__hip_atomic_load(F.ctl + CW_EA + NE, __ATOMIC_RELAXED, __HIP_MEMORY_SCOPE_AGENT) : 127;
        PlainSched S{(const char*)(ws + WS_XQ3), (const char*)(ws + WS_WQF13), DM / 2, DM / 2, DM / 2, NTOK / 256, 2 * FFD / 256, F.G, cblk, 1 << 30, 0, sad};
        EpiGatedI8<MK_FFN2F8 != 0> E{(bf16*)(ws + WS_ACTD), FFD, (const float*)(ws + WS_RSC), (const float*)(ws + WS_COLMAX_F), 0, nullptr};
        pg8::gemm_phase(F.lds, S, E);
    } SEAM(4);
    if (IN(5)) {
#if MK_FFN2F8
        const int sad = (int)__hip_atomic_load(F.ctl + CW_EA + NE, __ATOMIC_RELAXED, __HIP_MEMORY_SCOPE_AGENT);
        PlainSched S{(const char*)(ws + WS_ACTD), (const char*)(ws + WS_WF2), FFD / 2, FFD / 2, FFD / 2, NTOK / 256, DM / 256, F.G, cblk, 1 << 30, 0, sad, (const int*)(ws + WS_SB8) + NE * DM};
        EpiPlain<true, false, 2> E{(bf16*)(ws + WS_F0), DM, (float*)(ws + WS_ROWSS)};
#else
        PlainSched S{(const char*)(ws + WS_ACTD), (const char*)(ws + WS_WF2), FFD, FFD, FFD, NTOK / 256, DM / 256, F.G, cblk, 1 << 30, 0};
        EpiPlain<true, false> E{(bf16*)(ws + WS_F0), DM, (float*)(ws + WS_ROWSS)};
#endif
        pg8::gemm_phase(F.lds, S, E);
    } SEAM(5);
    if (IN(6)) { KArgs ka = kargs(); resid_pass<false, true, MK_QKV8 != 0>(F, nullptr, (const bf16*)(ws + WS_XH1), (const bf16*)(ws + WS_F0), 16, (const float*)ka->in[I_NORMS] + 3 * DM, (bf16*)(ws + WS_XH2), nullptr); } SEAM(6);
    if (IN(7)) {
#if MK_QKV8
        PlainSched S{(const char*)(ws + WS_XQ3), (const char*)(ws + WS_WQQKV), DM / 2, DM / 2, DM / 2, NTOK / 256, 12, F.G, cblk, 1 << 30, 0};
        EpiQKV<true> E{(bf16*)(ws + WS_Q), (const float*)(ws + WS_ROPE), (float*)(ws + WS_KMEAN), (const float*)(ws + WS_RSC), (const float*)(ws + WS_COLMAX_QKV)};
#else
        PlainSched S{(const char*)(ws + WS_XH2), (const char*)(ws + WS_WQKV), DM, DM, DM, NTOK / 256, 12, F.G, cblk, 1 << 30, 0};
        EpiQKV<false> E{(bf16*)(ws + WS_Q), (const float*)(ws + WS_ROPE), (float*)(ws + WS_KMEAN), nullptr, nullptr};
#endif
        pg8::gemm_phase(F.lds, S, E);
    } SEAM(7);
    if (IN(8)) {
        const bf16* Qb = (const bf16*)(ws + WS_Q); const bf16* Kb = (const bf16*)(ws + WS_K); const bf16* Vb = (const bf16*)(ws + WS_V); bf16* Ob = (bf16*)(ws + WS_O); const float* KM = (const float*)(ws + WS_KMEAN);
        const int nitems = (BATCH * NH * 4 - F.vcu + F.G - 1) / F.G, nblocks = 2 * nitems;
        attn::Seam Sm;
#define MK_REF(R, kk) do { const int it_ = F.vcu + ((kk) >> 1) * F.G, bh_ = it_ >> 2, x_ = it_ & 3, qb_ = ((kk) & 1) ? 7 - x_ : x_, b_ = bh_ >> 3, h_ = bh_ & 7; \
        const size_t base_ = (size_t)b_ * SEQ * DM + h_ * HD; R.Q = Qb + base_ + (size_t)qb_ * 256 * DM; R.K = Kb + base_; R.V = Vb + base_; R.O = Ob + base_ + (size_t)qb_ * 256 * DM; R.KM = KM + (size_t)bh_ * NBLK * HD; R.P0 = qb_ * 256; } while (0)
        if (nblocks > 0) {
            attn::BlockRef cur, nxt; MK_REF(cur, 0);
            attn::moba_prime(cur, (char*)lds_raw, Sm);
            for (int kb = 0; kb < nblocks; ++kb) { const int kn = kb + 1 < nblocks ? kb + 1 : kb; MK_REF(nxt, kn); attn::moba_block(cur, nxt, (char*)lds_raw, Sm); cur = nxt; }
        }
#undef MK_REF
    } SEAM(8);
    if (IN(9)) {
        PlainSched S{(const char*)(ws + WS_O), (const char*)(ws + WS_WO), DM, DM, DM, NTOK / 256, DM / 256, F.G, cblk, 1 << 30, 0};
        EpiPlain<true, false> E{(bf16*)(ws + WS_MIX1), DM, (float*)(ws + WS_ROWSS)};
        pg8::gemm_phase(F.lds, S, E);
    } SEAM(9);
    if (IN(10)) { KArgs ka = kargs(); resid_pass<true, true, true>(F, nullptr, (const bf16*)(ws + WS_XH2), (const bf16*)(ws + WS_MIX1), 16, (const float*)ka->in[I_NORMS] + (4 + 1) * DM, (bf16*)(ws + WS_XH3), (const float*)ka->in[I_RBIAS]); } SEAM(10);
#if MK_F8
    if (IN(11)) {
        etab_build(F.lds, F.ctl); int nM = et_ps(F.lds, NE); nM = nM > 264 ? 264 : nM;
        MoeSched1 S{(const char*)(ws + WS_XQ3), (const char*)(ws + WS_WQ13), (const int*)(ws + WS_LIST), DM / 2, DM / 2, nM, 2 * FFE / 256, F.G, cblk, 0, F.lds};
        EpiGatedI8<true> E{(bf16*)(ws + WS_ACTM), FFE, (const float*)(ws + WS_RSC), (const float*)(ws + WS_COLMAX), 2 * FFE, (unsigned char*)kargs()->out};
        pg8::gemm_phase(F.lds, S, E);
    } SEAM(11);
    if (IN(12)) {
        etab_build(F.lds, F.ctl); const int P = et_ps(F.lds, NE); const int nM = P > 256 ? 256 : P; int nLeft = P - 256; nLeft = nLeft < 0 ? 0 : (nLeft > LPMAX ? LPMAX : nLeft);
        { MoeSched2 S{(const char*)(ws + WS_ACTM), (const char*)kargs()->out, (const char*)(ws + WS_W8M2), (const int*)(ws + WS_SB8), FFE / 2, FFE / 2, FFE / 2, nM, DM / 256, F.G, cblk, 0, F.lds};
          EpiPlain<false, true, 2> E{(bf16*)(ws + WS_Y), DM, nullptr};
          pg8::gemm_phase(F.lds, S, E); }
        { MoeSched2K S{(const char*)(ws + WS_ACTM), (const char*)kargs()->out, (const char*)(ws + WS_W8M2), (const int*)(ws + WS_SB8), 256, FFE / 2, FFE / 2, nLeft, F.G, (F.G - 1) - cblk, F.lds};
          EpiPlain<false, true, 2> E{(bf16*)(ws + WS_YP), DM, nullptr};
          pg8::gemm_phase(F.lds, S, E); }
    } SEAM(12);
#else
#pragma unroll
    for (int q = 0; q < 4; ++q) {
        if (IN(11 + 2 * q)) {
            etab_build(F.lds, F.ctl); const int P = et_ps(F.lds, NE); const int p0 = 64 * q; int nM = (q < 3) ? 64 : P - 192; nM = nM > 72 ? 72 : nM; if (p0 + nM > P) nM = P - p0; if (nM < 0) nM = 0;
            MoeSched1 S{(const char*)(ws + WS_XQ3), (const char*)(ws + WS_WQ13), (const int*)(ws + WS_LIST), DM / 2, DM / 2, nM, 2 * FFE / 256, F.G, cblk, p0, F.lds};
            EpiGatedI8<false> E{(bf16*)(ws + WS_ACTM), FFE, (const float*)(ws + WS_RSC), (const float*)(ws + WS_COLMAX), 2 * FFE, nullptr};
            pg8::gemm_phase(F.lds, S, E);
        } SEAM(11 + 2 * q);
        if (IN(12 + 2 * q)) {
            etab_build(F.lds, F.ctl); const int P = et_ps(F.lds, NE); const int p0 = 64 * q; int nM = (q < 3) ? 64 : P - 192; nM = nM > 72 ? 72 : nM; if (p0 + nM > P) nM = P - p0; if (nM < 0) nM = 0;
            MoeSched2B S{(const char*)(ws + WS_ACTM), (const char*)(ws + WS_WM2), FFE, FFE, FFE, nM, DM / 256, F.G, cblk, p0, F.lds};
            EpiPlain<false, true, 0> E{(bf16*)(ws + WS_Y), DM, nullptr};
            pg8::gemm_phase(F.lds, S, E);
        } SEAM(12 + 2 * q);
    }
#endif
    if (IN(N_PHASES - 1)) { KArgs ka = kargs(); final_pass(F, ka->out, (const bf16*)(ws + WS_XH3), (const bf16*)(ws + WS_Y), (const float*)ka->in[I_NORMS] + (4 + 3) * DM); }
#undef IN
#undef SEAM
#undef ws
#undef cblk
}

extern "C" void kernel_launch(void* const* d_in, const int* in_sizes, int n_in, void* d_out, int out_size, void* d_ws, size_t ws_size, hipStream_t stream) {
    static int grid = 0;
    if (grid == 0) {
        if (n_in != 24 || in_sizes[0] != NTOK * DM || out_size != NTOK * DM || ws_size < WS_END) { fprintf(stderr, "kernel_launch: unexpected problem (n_in %d, in0 %d, out %d, ws %zu < %zu)\n", n_in, n_in > 0 ? in_sizes[0] : -1, out_size, ws_size, (size_t)WS_END); grid = -1; return; }
        int dev = 0, cus = 0, per_cu = 0;
        if (hipGetDevice(&dev) != hipSuccess || hipDeviceGetAttribute(&cus, hipDeviceAttributeMultiprocessorCount, dev) != hipSuccess) { grid = -1; return; }
        if (hipFuncSetAttribute((const void*)mk_fwd, hipFuncAttributeMaxDynamicSharedMemorySize, LDS_BYTES) != hipSuccess) { fprintf(stderr, "kernel_launch: hipFuncSetAttribute failed\n"); grid = -1; return; }
        if (hipOccupancyMaxActiveBlocksPerMultiprocessor(&per_cu, (const void*)mk_fwd, NWAVES * 64, LDS_BYTES) != hipSuccess || per_cu < 1) { fprintf(stderr, "kernel_launch: occupancy query says %d blocks per CU\n", per_cu); (void)hipGetLastError(); grid = -1; return; }
        grid = cus;
    }
    if (grid < 0) return;
    if (hipMemsetAsync((char*)d_ws + WS_CTL, 0, ZERO_BYTES, stream) != hipSuccess) return;
    Args a{};
    for (int i = 0; i < 24; ++i) a.in[i] = d_in[i];
    a.out = (float*)d_out; a.ws = (unsigned char*)d_ws;
#if MK_ONE_LAUNCH
    a.ph_lo = 0; a.ph_hi = N_PHASES;
    hipLaunchKernelGGL(mk_fwd, dim3(grid), dim3(NWAVES * 64), LDS_BYTES, stream, a);
#else
    for (int p = 0; p < N_PHASES; ++p) { a.ph_lo = p; a.ph_hi = p + 1; for (int r = 0; r < (((MK_DUP_MASK >> p) & 1u) ? 2 : 1); ++r) hipLaunchKernelGGL(mk_fwd, dim3(grid), dim3(NWAVES * 64), LDS_BYTES, stream, a); }
#endif
}
```

```cpp
#include <hip/hip_runtime.h>
#include <stdio.h>
#include <stdint.h>

#ifndef MK_ONE_LAUNCH
#define MK_ONE_LAUNCH 1
#endif
#ifndef MK_F8
#define MK_F8 1
#endif
#ifndef MK_QKV8
#define MK_QKV8 1
#endif
#ifndef MK_SUPER
#define MK_SUPER 1
#endif
#ifndef MK_FFN2F8
#define MK_FFN2F8 1
#endif
#ifndef MK_MOE_NMAJOR
#define MK_MOE_NMAJOR 1
#endif
#ifndef MK_DUP_MASK
#define MK_DUP_MASK 0u
#endif

#define GAS __attribute__((address_space(1)))
#define LAS __attribute__((address_space(3)))
typedef unsigned short bf16;
typedef unsigned v4u __attribute__((ext_vector_type(4)));
typedef unsigned v2u __attribute__((ext_vector_type(2)));
typedef float f32x2 __attribute__((ext_vector_type(2)));
typedef float f32x4 __attribute__((ext_vector_type(4)));
typedef float f32x16 __attribute__((ext_vector_type(16)));
typedef short bf16x8 __attribute__((ext_vector_type(8)));
typedef short s16x4 __attribute__((ext_vector_type(4)));
typedef int i32x4 __attribute__((ext_vector_type(4)));
typedef int i32x8 __attribute__((ext_vector_type(8)));

constexpr int BATCH = 16, SEQ = 2048, DM = 1024, NTOK = BATCH * SEQ;
constexpr int NG = 64, NP = 64, CL = 16, NCH = SEQ / CL, GROWS = BATCH * NCH, UAK = 384;
constexpr int NH = 8, HD = 128, MBLK = 256, NBLK = SEQ / MBLK;
constexpr int FFD = 2816, NE = 8, FFE = 3584, LCAP = 32768;
constexpr float NORM_EPS = 1e-6f;
constexpr int NWAVES = 8;
constexpr int KSPLIT = 7, LPMAX = 7;
constexpr int ASPLIT = 128;

constexpr size_t MiB = 1u << 20;
constexpr size_t WS_CTL = 0, WS_KMEAN = 1 * MiB, ZERO_BYTES = 2 * MiB;
constexpr size_t WS_ROPE = 2 * MiB, WS_ROWSS = 6 * MiB, WS_LIST = 10 * MiB, WS_SLOT = 11 * MiB, WS_TOKW = WS_SLOT + 256 * 1024, WS_WR = WS_TOKW + 256 * 1024, WS_SPAR = WS_WR + 64 * 1024;
constexpr size_t WS_WQ13 = 13 * MiB, WS_XQ3 = 69 * MiB, WS_RSC = 101 * MiB, WS_WM2 = 125 * MiB;
constexpr size_t WS_COLMAX_F = 1536 * 1024 + 57344 * 4, WS_COLMAX_QKV = WS_COLMAX_F + 5632 * 4, WS_COLMAX_W2 = WS_COLMAX_QKV + 3072 * 4;
constexpr size_t WS_ROWNORM = 12 * MiB + 256 * 1024, WS_SB8 = 12 * MiB + 512 * 1024;
constexpr size_t WS_W8M2 = 125 * MiB, WS_PSQ = 153 * MiB, WS_PSQD = 180 * MiB;
constexpr int CW_EA = 9216;
constexpr size_t WS_WQF13 = 102 * MiB, WS_WQQKV = 108 * MiB;
constexpr size_t WS_COLMAX = 1536 * 1024;
constexpr size_t WS_WGLU = 181 * MiB, WS_WQKV = 185 * MiB, WS_WO = 191 * MiB, WS_WF13 = 193 * MiB, WS_WF2 = 204 * MiB, WS_BTA = 210 * MiB, WS_BTC = 218 * MiB;
constexpr size_t WS_UA = 230 * MiB, WS_SLOC = 326 * MiB, WS_GBUF = 390 * MiB, WS_MIX0 = 454 * MiB;
constexpr size_t WS_XH1 = 210 * MiB, WS_ACTD = 274 * MiB, WS_F0 = 450 * MiB;
constexpr size_t WS_XH2 = 450 * MiB, WS_Q = 230 * MiB, WS_K = 294 * MiB, WS_V = 358 * MiB;
constexpr size_t WS_O = WS_Q;
constexpr size_t WS_RS = 12 * MiB;
constexpr size_t WS_MIX1 = 294 * MiB, WS_XH3 = 450 * MiB;
constexpr size_t WS_Y = 181 * MiB, WS_ACTM = 313 * MiB, WS_YP = 425 * MiB;
constexpr size_t WS_END = 518 * MiB;
constexpr int CW_TMO = 0, CW_BAR = 4096, CW_ECNT = 8192, CW_WQ = 9344;

constexpr int RING_BYTES = 131072, LDSCTL_OFF = RING_BYTES, MISC_OFF = LDSCTL_OFF + 320, IDX_OFF = RING_BYTES + 1024, SCL_OFF = RING_BYTES + 2048, UT_OFF = RING_BYTES + 8192, LDS_BYTES = 147456;

#define LDS_WAIT() asm volatile("s_waitcnt lgkmcnt(0)" ::: "memory")
#define VM_WAIT() asm volatile("s_waitcnt vmcnt(0)" ::: "memory")
__device__ __forceinline__ unsigned f2bf(float f) { unsigned u = __builtin_bit_cast(unsigned, f); return (u + 0x7fffu + ((u >> 16) & 1u)) >> 16; }
__device__ __forceinline__ unsigned pk2(float lo, float hi) { return f2bf(lo) | (f2bf(hi) << 16); }
__device__ __forceinline__ float bf2f(unsigned b) { return __builtin_bit_cast(float, b << 16); }
__device__ __forceinline__ unsigned cvt_pk_bf16(float lo, float hi) { unsigned r; asm volatile("v_cvt_pk_bf16_f32 %0, %1, %2" : "=v"(r) : "v"(lo), "v"(hi)); return r; }
__device__ __forceinline__ float wave_sum(float v) {
#pragma unroll
    for (int o = 1; o < 64; o <<= 1) v += __shfl_xor(v, o);
    return v;
}
__device__ __forceinline__ float fast_sigmoid(float x) { return __builtin_amdgcn_rcpf(1.0f + __builtin_amdgcn_exp2f(-1.4426950408889634f * x)); }

namespace pg8 {
constexpr int BM = 256, BK = 64, HALF = 128, HTB = HALF * BK * 2, NXCD = 8, WGM = 4;
__host__ __device__ __forceinline__ int lds_byte(int r, int c) { const int st = (r >> 4) * 2 + (c >> 5), rr = r & 15, cc = c & 31, ob = rr * 64 + cc * 2; return st * 1024 + (ob ^ (((ob >> 9) & 1) << 5)); }
__host__ __device__ __forceinline__ void stage_rc(int b, int& R, int& C) { const int st = b / 1024, sb = b % 1024, swz = sb ^ (((sb >> 9) & 1) << 5); R = (st >> 1) * 16 + swz / 64; C = (st & 1) * 32 + (swz % 64) / 2; }
__host__ __device__ __forceinline__ int perm32(int rho) { const int n = rho >> 4, i = rho & 15; return 8 * (i >> 2) + 4 * n + (i & 3); }

__device__ __forceinline__ void lane_rc(int i, int& R, int& C) { int t = threadIdx.x; asm volatile("" : "+v"(t)); stage_rc(t * 16 + i * 8192, R, C); }
struct GUnit { int pm, pn, e, aux, rs, sa; };
__device__ __forceinline__ void tile_of(int L, int nM, int nN, int& pm, int& pn) {
    const int nwg = nM * nN; int wgid = L;
    { const int q = nwg / NXCD, r = nwg % NXCD, xcd = wgid % NXCD, off = wgid / NXCD; wgid = (xcd < r ? xcd * (q + 1) : r * (q + 1) + (xcd - r) * q) + off; }
    const int nig = WGM * nN, gid = wgid / nig, fm = gid * WGM, gsz = (nM - fm) < WGM ? (nM - fm) : WGM;
    pm = fm + ((wgid % nig) % gsz); pn = (wgid % nig) / gsz;
}

template <int MM> struct AccSel { typedef f32x4 T; };
template <> struct AccSel<1> { typedef i32x4 T; };
#define V8LO(v) __builtin_shufflevector(v, v, 0, 1, 2, 3)
#define V8HI(v) __builtin_shufflevector(v, v, 4, 5, 6, 7)
template <int MM, class T> __device__ __forceinline__ void mma2(T& acc, const i32x8& b, const i32x8& a, int sb, int sa) {
    if constexpr (MM == 2) asm volatile("v_mfma_scale_f32_16x16x128_f8f6f4 %0, %1, %2, %0, %3, %4 op_sel_hi:[0,0,0]" : "+v"(acc) : "v"(b), "v"(a), "v"(sb), "v"(sa));
    else if constexpr (MM == 1) { acc = __builtin_amdgcn_mfma_i32_16x16x64_i8(V8LO(b), V8LO(a), acc, 0, 0, 0); acc = __builtin_amdgcn_mfma_i32_16x16x64_i8(V8HI(b), V8HI(a), acc, 0, 0, 0); }
    else { acc = __builtin_amdgcn_mfma_f32_16x16x32_bf16(__builtin_bit_cast(bf16x8, V8LO(b)), __builtin_bit_cast(bf16x8, V8LO(a)), acc, 0, 0, 0);
           acc = __builtin_amdgcn_mfma_f32_16x16x32_bf16(__builtin_bit_cast(bf16x8, V8HI(b)), __builtin_bit_cast(bf16x8, V8HI(a)), acc, 0, 0, 0); }
}
template <class Epi, class Sched>
__device__ __forceinline__ void gemm_phase(LAS unsigned char* lds, const Sched& S, const Epi& E) {
    int tid_ = threadIdx.x; asm volatile("" : "+v"(tid_));
    const int tid = tid_, wid = __builtin_amdgcn_readfirstlane(tid >> 6), lane = tid & 63, wr = wid >> 2, wc = wid & 3, fr = lane & 15, fq = lane >> 4;
    const int nt = S.K / BK;
    unsigned voffB[2];
#pragma unroll
    for (int i = 0; i < 2; ++i) { int R, C; stage_rc(tid * 16 + i * 8192, R, C); const int Rb = Epi::PERM ? ((R & ~31) + perm32(R & 31)) : R; voffB[i] = (unsigned)(Rb * S.ldb + C) * 2u; }
    const unsigned kstep = BK * 2u;
    const unsigned hstepB = (unsigned)HALF * S.ldb * 2u;
    const unsigned ldsw = (unsigned)wid * 1024u;
    const int aoff = lds_byte(wr * 64 + fr, fq * 8), boff = lds_byte(wc * 32 + fr, fq * 8);
#define PG8_SA(b, h) (((b) * 2 + (h)) * HTB)
#define PG8_SB(b, h) ((4 + (b) * 2 + (h)) * HTB)
#define PG8_STAGE_A(bufoff, abase, soff, voff) do { const char* _g = (abase) + (unsigned)__builtin_amdgcn_readfirstlane((int)(soff)); asm volatile("" : "+s"(_g)); _Pragma("unroll") for (int _i = 0; _i < 2; ++_i) \
        __builtin_amdgcn_global_load_lds((const unsigned*)(_g + (voff)[_i]), (LAS unsigned*)(lds + (bufoff) + ldsw + _i * 8192), 16, 0, 0); } while (0)
#define PG8_STAGE_B(bufoff, soff) do { const char* _g = S.Bbase + (unsigned)__builtin_amdgcn_readfirstlane((int)(soff)); asm volatile("" : "+s"(_g)); _Pragma("unroll") for (int _i = 0; _i < 2; ++_i) \
        __builtin_amdgcn_global_load_lds((const unsigned*)(_g + voffB[_i]), (LAS unsigned*)(lds + (bufoff) + ldsw + _i * 8192), 16, 0, 0); } while (0)
#define PG8_LDA(dst, b, h) do { _Pragma("unroll") for (int m = 0; m < 4; ++m) dst[m] = __builtin_shufflevector(*(const LAS i32x4*)(lds + PG8_SA(b, h) + aoff + m * 2048), *(const LAS i32x4*)(lds + PG8_SA(b, h) + aoff + m * 2048 + 1024), 0, 1, 2, 3, 4, 5, 6, 7); } while (0)
#define PG8_LDB(dst, b, h) do { _Pragma("unroll") for (int n = 0; n < 2; ++n) dst[n] = __builtin_shufflevector(*(const LAS i32x4*)(lds + PG8_SB(b, h) + boff + n * 2048), *(const LAS i32x4*)(lds + PG8_SB(b, h) + boff + n * 2048 + 1024), 0, 1, 2, 3, 4, 5, 6, 7); } while (0)
#define PG8_MMA(ai, bj, At, Bt) do { __builtin_amdgcn_s_setprio(1); _Pragma("unroll") for (int m = 0; m < 4; ++m) _Pragma("unroll") for (int n = 0; n < 2; ++n) \
        mma2<Epi::MM>(acc[ai][bj][m][n], Bt[n], At[m], fsb[bj][n], fsa); __builtin_amdgcn_s_setprio(0); } while (0)
#define PG8_WAIT_V(n) asm volatile("s_waitcnt vmcnt(" #n ")" ::: "memory")
#define PG8_WAIT_L(n) asm volatile("s_waitcnt lgkmcnt(" #n ")" ::: "memory")
#define PG8_BAR __builtin_amdgcn_s_barrier()
#define PG8_SCHED __builtin_amdgcn_sched_barrier(0)
    if (wid == 0) { GUnit u; const bool ok = S.next(lane, u); LAS int* tb = (LAS int*)(lds + UT_OFF) + lane * 8;
        tb[0] = ok ? u.pm : -1; tb[1] = u.pn; tb[2] = u.e; tb[3] = u.aux; tb[4] = u.rs; tb[5] = u.sa; tb[6] = ok ? (int)S.b_off(u) : 0; tb[7] = ok ? (int)S.a_tile(u) : 0; }
    asm volatile("s_waitcnt lgkmcnt(0)" ::: "memory"); __syncthreads();
#define PG8_UNIT(i, u, bo, ao, ok) do { const LAS int* tb_ = (const LAS int*)(lds + UT_OFF) + ((i) & 63) * 8; \
        u.pm = __builtin_amdgcn_readfirstlane(tb_[0]); u.pn = __builtin_amdgcn_readfirstlane(tb_[1]); u.e = __builtin_amdgcn_readfirstlane(tb_[2]); u.aux = __builtin_amdgcn_readfirstlane(tb_[3]); \
        u.rs = __builtin_amdgcn_readfirstlane(tb_[4]); u.sa = __builtin_amdgcn_readfirstlane(tb_[5]); bo = (unsigned)__builtin_amdgcn_readfirstlane(tb_[6]); ao = (unsigned)__builtin_amdgcn_readfirstlane(tb_[7]); \
        ok = (i) < 64 && u.pm >= 0; } while (0)
    GUnit cur, nxt; int ui = 0; unsigned cB, cA, nB, nA; bool ok0;
    PG8_UNIT(0, cur, cB, cA, ok0);
    if (!ok0) return;
    const char* cAp = S.a_base(cur); const char* nAp = cAp;
    typedef typename AccSel<Epi::MM>::T AccT;
    int fsa = 127, fsb[2][2] = {{127, 127}, {127, 127}};
    AccT acc[2][2][4][2];
#pragma unroll
    for (int a = 0; a < 2; ++a)
#pragma unroll
        for (int b = 0; b < 2; ++b)
#pragma unroll
            for (int m = 0; m < 4; ++m)
#pragma unroll
                for (int n = 0; n < 2; ++n) acc[a][b][m][n] = AccT{};
    i32x8 At[4], B0[2], B1[2];
    unsigned oC[2][2], oN[2][2];
    if constexpr (Sched::GATHER) { S.a_off_first(cur, oC);
#pragma unroll
        for (int h = 0; h < 2; ++h)
#pragma unroll
            for (int i = 0; i < 2; ++i) oN[h][i] = oC[h][i]; }
    else { GUnit z; z.pm = 0; z.pn = 0; z.e = 0; z.aux = 0; z.rs = 0; z.sa = 127; S.a_off_first(z, oC);
#pragma unroll
        for (int h = 0; h < 2; ++h)
#pragma unroll
            for (int i = 0; i < 2; ++i) oN[h][i] = oC[h][i]; }
    if constexpr (Epi::MM == 2) S.f8_scales(cur, wc, fr, fsa, fsb);
    if constexpr (Epi::LDSS) E.prefetch_scales(cur, 0, lds);
    PG8_STAGE_B(PG8_SB(0, 0), cB); PG8_STAGE_B(PG8_SB(0, 1), cB + hstepB); PG8_STAGE_A(PG8_SA(0, 0), cAp, cA, oC[0]); PG8_STAGE_A(PG8_SA(0, 1), cAp, cA, oC[1]);
    if (wr == 1) PG8_BAR;
    PG8_WAIT_V(2); PG8_BAR;
    PG8_STAGE_B(PG8_SB(1, 0), cB + kstep); PG8_STAGE_A(PG8_SA(1, 0), cAp, cA + kstep, oC[0]); PG8_STAGE_B(PG8_SB(1, 1), cB + hstepB + kstep);
    PG8_WAIT_V(6); PG8_BAR;
    for (;;) {
        bool has_next; PG8_UNIT(ui + 1, nxt, nB, nA, has_next);
        if (!has_next) { nB = cB; nA = cA; nAp = cAp; } else nAp = S.a_base(nxt);
        if (has_next) S.prefetch(nxt, lds);
        if constexpr (Epi::LDSS) { if (has_next) E.prefetch_scales(nxt, (ui + 1) % 3, lds); }
        for (int t = 0; t < nt; t += 2) {
            const bool last = (t == nt - 2);
            const unsigned a1 = cA + (unsigned)(t + 1) * kstep;
            const unsigned a2 = last ? nA : cA + (unsigned)(t + 2) * kstep, b2 = last ? nB : cB + (unsigned)(t + 2) * kstep;
            const unsigned a3 = a2 + kstep, b3 = b2 + kstep; const char* const ap2 = last ? nAp : cAp;
            if constexpr (Sched::GATHER) { if (last && has_next) S.a_off_next(nxt, oN, lds); }
            PG8_LDB(B0, 0, 0); PG8_LDB(B1, 0, 1); PG8_SCHED; PG8_LDA(At, 0, 0); PG8_STAGE_A(PG8_SA(1, 1), cAp, a1, oC[1]);
            PG8_WAIT_V(8); PG8_WAIT_L(0); PG8_BAR; PG8_MMA(0, 0, At, B0); PG8_MMA(0, 1, At, B1); PG8_BAR; PG8_SCHED;
            PG8_LDA(At, 0, 1); PG8_STAGE_B(PG8_SB(0, 0), b2); PG8_STAGE_B(PG8_SB(0, 1), b2 + hstepB); PG8_STAGE_A(PG8_SA(0, 0), ap2, a2, oN[0]);
            PG8_WAIT_V(8); PG8_WAIT_L(0); PG8_BAR; PG8_MMA(1, 0, At, B0); PG8_MMA(1, 1, At, B1); PG8_BAR; PG8_SCHED;
            PG8_LDB(B0, 1, 0); PG8_LDB(B1, 1, 1); PG8_SCHED; PG8_LDA(At, 1, 0); PG8_STAGE_A(PG8_SA(0, 1), ap2, a2, oN[1]);
            PG8_WAIT_V(8); PG8_WAIT_L(0); PG8_BAR; PG8_MMA(0, 0, At, B0); PG8_MMA(0, 1, At, B1); PG8_BAR; PG8_SCHED;
            PG8_LDA(At, 1, 1); PG8_STAGE_B(PG8_SB(1, 0), b3); PG8_STAGE_B(PG8_SB(1, 1), b3 + hstepB); PG8_STAGE_A(PG8_SA(1, 0), ap2, a3, oN[0]);
            PG8_WAIT_V(8); PG8_WAIT_L(0); PG8_BAR; PG8_MMA(1, 0, At, B0); PG8_MMA(1, 1, At, B1); PG8_BAR; PG8_SCHED;
        }
        if (wr == 0) PG8_BAR;
        if constexpr (Epi::MM == 2) asm volatile("s_nop 15\n\ts_nop 15" ::: "memory");
        if constexpr (Epi::LDSS) E(acc, cur, wr, wc, fr, fq, lds + SCL_OFF + (ui % 3) * 2048); else E(acc, cur, wr, wc, fr, fq);
        if (!has_next) break;
#pragma unroll
        for (int a = 0; a < 2; ++a)
#pragma unroll
            for (int b = 0; b < 2; ++b)
#pragma unroll
                for (int m = 0; m < 4; ++m)
#pragma unroll
                    for (int n = 0; n < 2; ++n) acc[a][b][m][n] = AccT{};
        cur = nxt; cB = nB; cA = nA; cAp = nAp; ++ui;
        if constexpr (Epi::MM == 2) S.f8_scales(cur, wc, fr, fsa, fsb);
        if constexpr (Sched::GATHER) {
#pragma unroll
        for (int h = 0; h < 2; ++h)
#pragma unroll
            for (int i = 0; i < 2; ++i) oC[h][i] = oN[h][i]; }
        if (wr == 1) PG8_BAR;
    }
    PG8_WAIT_V(0);
    PG8_BAR;
#undef PG8_UNIT
#undef PG8_SA
#undef PG8_SB
#undef PG8_STAGE_A
#undef PG8_STAGE_B
#undef PG8_LDA
#undef PG8_LDB
#undef PG8_MMA
#undef PG8_WAIT_V
#undef PG8_WAIT_L
#undef PG8_BAR
#undef PG8_SCHED
}
}

using pg8::GUnit;
struct PlainSched {
    static constexpr bool GATHER = false;
    __device__ __forceinline__ const char* a_base(const GUnit&) const { return Abase; }
    __device__ __forceinline__ unsigned a_tile(const GUnit& u) const { return (unsigned)(u.pm * 256 * lda) * 2u; }
    const char* Abase; const char* Bbase; int K, lda, ldb, nM, nN, G, c, pmdiv; size_t bstride; int sa = 127; const int* sb8 = nullptr;
    __device__ __forceinline__ bool next(int i, GUnit& u) const { const long L = (long)i * G + c; if (L >= (long)nM * nN) return false; pg8::tile_of((int)L, nM, nN, u.pm, u.pn); u.e = u.pm / pmdiv; u.aux = u.pm; u.rs = u.pm * 256; u.sa = sa; return true; }
    __device__ __forceinline__ void f8_scales(const GUnit& u, int wc, int fr, int& sa_, int (&sb)[2][2]) const { sa_ = u.sa;
#pragma unroll
        for (int bj = 0; bj < 2; ++bj)
#pragma unroll
            for (int n = 0; n < 2; ++n) sb[bj][n] = sb8[u.pn * 256 + bj * 128 + wc * 32 + pg8::perm32(n * 16 + fr)]; }
    __device__ __forceinline__ void a_off_first(const GUnit& u, unsigned (&off)[2][2]) const { int R[2], C[2]; pg8::lane_rc(0, R[0], C[0]); pg8::lane_rc(1, R[1], C[1]);
#pragma unroll
        for (int h = 0; h < 2; ++h)
#pragma unroll
            for (int i = 0; i < 2; ++i) off[h][i] = (unsigned)((u.pm * 256 + h * 128 + R[i]) * lda + C[i]) * 2u; }
    __device__ __forceinline__ void a_off_next(const GUnit& u, unsigned (&off)[2][2], LAS unsigned char*) const { a_off_first(u, off); }
    __device__ __forceinline__ void prefetch(const GUnit&, LAS unsigned char*) const {}
    __device__ __forceinline__ unsigned b_off(const GUnit& u) const { return (unsigned)((size_t)u.e * bstride + (size_t)u.pn * 256 * ldb * 2); }
};
constexpr int ET_OFF = RING_BYTES + 512;
__device__ __forceinline__ void etab_build(LAS unsigned char* lds, const unsigned* ctl) {
    if (threadIdx.x < 64) { const int l = threadIdx.x & 63; int v = 0;
        if (l < NE) { v = (int)__hip_atomic_load(ctl + CW_ECNT + 64 * l, __ATOMIC_RELAXED, __HIP_MEMORY_SCOPE_AGENT); v = v < 0 ? 0 : (v > LCAP ? LCAP : v); }
        else if (l < 2 * NE) v = (int)__hip_atomic_load(ctl + CW_EA + (l - NE), __ATOMIC_RELAXED, __HIP_MEMORY_SCOPE_AGENT);
        int np = (l < NE) ? ((v + 255) >> 8) : 0, ps = np;
#pragma unroll
        for (int o = 1; o < NE; o <<= 1) { const int t = __shfl_up(ps, o); if (l >= o) ps += t; }
        if (l < NE) { *(LAS int*)(lds + ET_OFF + 4 * l) = v; *(LAS int*)(lds + ET_OFF + 32 + 4 * l) = ps - np; if (l == NE - 1) *(LAS int*)(lds + ET_OFF + 32 + 4 * NE) = ps; }
        else if (l < 2 * NE) *(LAS int*)(lds + ET_OFF + 72 + 4 * (l - NE)) = v; }
    __syncthreads();
}
__device__ __forceinline__ int et_cnt(LAS unsigned char* lds, int e) { return __builtin_amdgcn_readfirstlane(*(const LAS int*)(lds + ET_OFF + 4 * e)); }
__device__ __forceinline__ int et_ps(LAS unsigned char* lds, int e) { return __builtin_amdgcn_readfirstlane(*(const LAS int*)(lds + ET_OFF + 32 + 4 * e)); }
__device__ __forceinline__ int et_sa(LAS unsigned char* lds, int e) { return __builtin_amdgcn_readfirstlane(*(const LAS int*)(lds + ET_OFF + 72 + 4 * e)); }
__device__ __forceinline__ int et_ps_l(LAS unsigned char* lds, int e) { return *(const LAS int*)(lds + ET_OFF + 32 + 4 * e); }
__device__ __forceinline__ int et_sa_l(LAS unsigned char* lds, int e) { return *(const LAS int*)(lds + ET_OFF + 72 + 4 * e); }
__device__ __forceinline__ int et_expert(LAS unsigned char* lds, int p) { int e = 0;
#pragma unroll
    for (int k = 1; k < NE; ++k) e += (p >= et_ps_l(lds, k)) ? 1 : 0;
    return e; }
struct MoeSched1 {
    static constexpr bool GATHER = true;
    __device__ __forceinline__ const char* a_base(const GUnit&) const { return Abase; }
    __device__ __forceinline__ unsigned a_tile(const GUnit&) const { return 0u; }
    const char* Abase; const char* Bbase; const int* list; int K, ldb, nM, nN, G, c, p0; LAS unsigned char* EL;
    __device__ __forceinline__ bool next(int i, GUnit& u) const { const long L = (long)i * G + c; if (L >= (long)nM * nN) return false; if (MK_MOE_NMAJOR) pg8::tile_of((int)L, nN, nM, u.pn, u.pm); else pg8::tile_of((int)L, nM, nN, u.pm, u.pn); u.aux = p0 + u.pm; u.e = et_expert(EL, u.aux); u.rs = u.e * LCAP + (u.aux - et_ps_l(EL, u.e)) * 256; u.sa = et_sa_l(EL, u.e); return true; }
    __device__ __forceinline__ void a_off_first(const GUnit& u, unsigned (&off)[2][2]) const { int R[2], C[2]; pg8::lane_rc(0, R[0], C[0]); pg8::lane_rc(1, R[1], C[1]);
        const int cn = et_cnt(EL, u.e), ps = et_ps(EL, u.e);
        const int lp = (u.aux - ps) * 256;
#pragma unroll
        for (int h = 0; h < 2; ++h)
#pragma unroll
            for (int i = 0; i < 2; ++i) { const int pos = lp + h * 128 + R[i]; int tok = list[u.e * LCAP + (pos < LCAP ? pos : 0)]; tok = (pos < cn) ? tok : 0; tok = ((unsigned)tok < (unsigned)NTOK) ? tok : 0; off[h][i] = (unsigned)(tok * K + C[i]) * 2u; } }
    __device__ __forceinline__ void prefetch(const GUnit& u, LAS unsigned char* lds) const {
        const int wid = __builtin_amdgcn_readfirstlane(threadIdx.x >> 6), lane = threadIdx.x & 63;
        if (wid < 4) { const int ps = et_ps(EL, u.e);
            const int pos = (u.aux - ps) * 256 + wid * 64 + lane;
            __builtin_amdgcn_global_load_lds((const unsigned*)(list + u.e * LCAP + (pos < LCAP ? pos : 0)), (LAS unsigned*)(lds + IDX_OFF + wid * 256), 4, 0, 0); } }
    __device__ __forceinline__ void a_off_next(const GUnit& u, unsigned (&off)[2][2], LAS unsigned char* lds) const { int R[2], C[2]; pg8::lane_rc(0, R[0], C[0]); pg8::lane_rc(1, R[1], C[1]);
        const int cn = et_cnt(EL, u.e), ps = et_ps(EL, u.e);
        const int lp = (u.aux - ps) * 256;
#pragma unroll
        for (int h = 0; h < 2; ++h)
#pragma unroll
            for (int i = 0; i < 2; ++i) { const int rr = h * 128 + R[i]; int tok = *(const LAS int*)(lds + IDX_OFF + rr * 4); tok = (lp + rr < cn) ? tok : 0; tok = ((unsigned)tok < (unsigned)NTOK) ? tok : 0; off[h][i] = (unsigned)(tok * K + C[i]) * 2u; } }
    __device__ __forceinline__ unsigned b_off(const GUnit& u) const { return (unsigned)((size_t)u.e * ((size_t)2 * FFE * DM) + (size_t)u.pn * 256 * ldb * 2); }
};
struct MoeSched2 {
    static constexpr bool GATHER = false;
    __device__ __forceinline__ const char* a_base(const GUnit& u) const { return u.pm < ASPLIT ? Abase : Abase2; }
    __device__ __forceinline__ unsigned a_tile(const GUnit& u) const { return (unsigned)((u.pm < ASPLIT ? u.pm : u.pm - ASPLIT) * 256 * lda) * 2u; }
    const char* Abase; const char* Abase2; const char* Bbase; const int* sb8; int K, lda, ldb, nM, nN, G, c, p0; LAS unsigned char* EL;
    __device__ __forceinline__ bool next(int i, GUnit& u) const { const long L = (long)i * G + c; if (L >= (long)nM * nN) return false; pg8::tile_of((int)L, nM, nN, u.pm, u.pn); u.aux = p0 + u.pm; u.e = et_expert(EL, u.aux); u.rs = 0; u.sa = et_sa_l(EL, u.e); return true; }
    __device__ __forceinline__ void a_off_first(const GUnit& u, unsigned (&off)[2][2]) const { int R[2], C[2]; pg8::lane_rc(0, R[0], C[0]); pg8::lane_rc(1, R[1], C[1]);
#pragma unroll
        for (int h = 0; h < 2; ++h)
#pragma unroll
            for (int i = 0; i < 2; ++i) off[h][i] = (unsigned)((u.pm * 256 + h * 128 + R[i]) * lda + C[i]) * 2u; }
    __device__ __forceinline__ void a_off_next(const GUnit& u, unsigned (&off)[2][2], LAS unsigned char*) const { a_off_first(u, off); }
    __device__ __forceinline__ void prefetch(const GUnit&, LAS unsigned char*) const {}
    __device__ __forceinline__ unsigned b_off(const GUnit& u) const { return (unsigned)((size_t)u.e * ((size_t)DM * FFE) + (size_t)u.pn * 256 * ldb * 2); }
    __device__ __forceinline__ void f8_scales(const GUnit& u, int wc, int fr, int& sa, int (&sb)[2][2]) const { sa = u.sa;
#pragma unroll
        for (int bj = 0; bj < 2; ++bj)
#pragma unroll
            for (int n = 0; n < 2; ++n) sb[bj][n] = sb8[u.e * DM + u.pn * 256 + bj * 128 + wc * 32 + pg8::perm32(n * 16 + fr)]; }
};

struct MoeSched2K {
    static constexpr bool GATHER = false;
    __device__ __forceinline__ const char* a_base(const GUnit& u) const { return u.pm < ASPLIT ? Abase : Abase2; }
    __device__ __forceinline__ unsigned a_tile(const GUnit& u) const { return (unsigned)((u.pm < ASPLIT ? u.pm : u.pm - ASPLIT) * 256 * lda) * 2u + (unsigned)u.rs * 512u; }
    const char* Abase; const char* Abase2; const char* Bbase; const int* sb8; int K, lda, ldb, nLeft, G, c; LAS unsigned char* EL;
    __device__ __forceinline__ bool next(int i, GUnit& u) const { const long L = (long)i * G + c; if (L >= (long)nLeft * 4 * KSPLIT) return false; const int kc = (int)(L % KSPLIT), t = (int)(L / KSPLIT), lp = t >> 2;
        u.pn = t & 3; u.pm = 256 + lp; u.rs = kc; u.aux = kc * LPMAX + lp; u.e = et_expert(EL, u.pm); u.sa = et_sa_l(EL, u.e); return true; }
    __device__ __forceinline__ void a_off_first(const GUnit& u, unsigned (&off)[2][2]) const { int R[2], C[2]; pg8::lane_rc(0, R[0], C[0]); pg8::lane_rc(1, R[1], C[1]);
#pragma unroll
        for (int h = 0; h < 2; ++h)
#pragma unroll
            for (int i = 0; i < 2; ++i) off[h][i] = (unsigned)((u.pm * 256 + h * 128 + R[i]) * lda + C[i]) * 2u; }
    __device__ __forceinline__ void a_off_next(const GUnit& u, unsigned (&off)[2][2], LAS unsigned char*) const { a_off_first(u, off); }
    __device__ __forceinline__ void prefetch(const GUnit&, LAS unsigned char*) const {}
    __device__ __forceinline__ unsigned b_off(const GUnit& u) const { return (unsigned)((size_t)u.e * ((size_t)DM * FFE) + (size_t)u.pn * 256 * ldb * 2) + (unsigned)u.rs * 512u; }
    __device__ __forceinline__ void f8_scales(const GUnit& u, int wc, int fr, int& sa, int (&sb)[2][2]) const { sa = u.sa;
#pragma unroll
        for (int bj = 0; bj < 2; ++bj)
#pragma unroll
            for (int n = 0; n < 2; ++n) sb[bj][n] = sb8[u.e * DM + u.pn * 256 + bj * 128 + wc * 32 + pg8::perm32(n * 16 + fr)]; }
};

struct MoeSched2B {
    static constexpr bool GATHER = false;
    __device__ __forceinline__ const char* a_base(const GUnit&) const { return Abase; }
    __device__ __forceinline__ unsigned a_tile(const GUnit& u) const { return (unsigned)(u.pm * 256 * lda) * 2u; }
    const char* Abase; const char* Bbase; int K, lda, ldb, nM, nN, G, c, p0; LAS unsigned char* EL;
    __device__ __forceinline__ bool next(int i, GUnit& u) const { const long L = (long)i * G + c; if (L >= (long)nM * nN) return false; pg8::tile_of((int)L, nM, nN, u.pm, u.pn); u.aux = p0 + u.pm; u.e = et_expert(EL, u.aux); u.rs = 0; u.sa = 127; return true; }
    __device__ __forceinline__ void a_off_first(const GUnit& u, unsigned (&off)[2][2]) const { int R[2], C[2]; pg8::lane_rc(0, R[0], C[0]); pg8::lane_rc(1, R[1], C[1]);
#pragma unroll
        for (int h = 0; h < 2; ++h)
#pragma unroll
            for (int i = 0; i < 2; ++i) off[h][i] = (unsigned)((u.pm * 256 + h * 128 + R[i]) * lda + C[i]) * 2u; }
    __device__ __forceinline__ void a_off_next(const GUnit& u, unsigned (&off)[2][2], LAS unsigned char*) const { a_off_first(u, off); }
    __device__ __forceinline__ void prefetch(const GUnit&, LAS unsigned char*) const {}
    __device__ __forceinline__ unsigned b_off(const GUnit& u) const { return (unsigned)((size_t)u.e * ((size_t)DM * FFE * 2) + (size_t)u.pn * 256 * ldb * 2); }
};

typedef const f32x4 (&AccRef)[2][2][4][2];
struct EpiS5A { static constexpr bool PERM = false, LDSS = false; static constexpr int MM = 0; float* sloc;
    __device__ __forceinline__ void operator()(AccRef acc, const GUnit& u, int wr, int wc, int fr, int fq) const {
        float* base = sloc + (size_t)(u.pm * 256 + wr * 64 + fr) * 128 + wc * 32 + 4 * fq;
#pragma unroll
        for (int ai = 0; ai < 2; ++ai)
#pragma unroll
            for (int m = 0; m < 4; ++m)
#pragma unroll
                for (int n = 0; n < 2; ++n) *(f32x4*)(base + (size_t)(ai * 128 + m * 16) * 128 + n * 16) = acc[ai][0][m][n]; } };
struct EpiS5C { static constexpr bool PERM = true, LDSS = false; static constexpr int MM = 0; const bf16* ua; const float* dsk; const float* g0; bf16* gbuf;
    __device__ __forceinline__ void operator()(AccRef acc, const GUnit& u, int wr, int wc, int fr, int fq) const {
        const int g = u.pm >> 3, i0 = 8 * (fq & 1);
        f32x4 d0 = *(const f32x4*)(dsk + g * 16 + i0) * *(const f32x4*)(g0 + g * 16 + i0), d1 = *(const f32x4*)(dsk + g * 16 + i0 + 4) * *(const f32x4*)(g0 + g * 16 + i0 + 4);
#pragma unroll
        for (int ai = 0; ai < 2; ++ai)
#pragma unroll
            for (int m = 0; m < 4; ++m) { const int r = ai * 128 + wr * 64 + m * 16 + fr, rowg = (u.pm & 7) * 256 + r, b = rowg >> 7, c = rowg & 127;
#pragma unroll
                for (int bj = 0; bj < 2; ++bj) { const int col = 128 * bj + 32 * wc + 8 * fq, t = col >> 4;
                    const v4u uu = *(const v4u*)(ua + (size_t)(u.pm * 256 + r) * UAK + col);
                    f32x4 y0 = acc[ai][bj][m][0], y1 = acc[ai][bj][m][1];
                    y0[0] += d0[0] * bf2f(uu.x & 0xffffu); y0[1] += d0[1] * bf2f(uu.x >> 16); y0[2] += d0[2] * bf2f(uu.y & 0xffffu); y0[3] += d0[3] * bf2f(uu.y >> 16);
                    y1[0] += d1[0] * bf2f(uu.z & 0xffffu); y1[1] += d1[1] * bf2f(uu.z >> 16); y1[2] += d1[2] * bf2f(uu.w & 0xffffu); y1[3] += d1[3] * bf2f(uu.w >> 16);
#pragma unroll
                    for (int k = 0; k < 4; ++k) { const float a = y0[k], bq = y1[k]; y0[k] = a * fast_sigmoid(1.5957691216f * (a + 0.044715f * a * a * a)); y1[k] = bq * fast_sigmoid(1.5957691216f * (bq + 0.044715f * bq * bq * bq)); }
                    v4u w; w.x = cvt_pk_bf16(y0[0], y0[1]); w.y = cvt_pk_bf16(y0[2], y0[3]); w.z = cvt_pk_bf16(y1[0], y1[1]); w.w = cvt_pk_bf16(y1[2], y1[3]);
                    *(v4u*)(gbuf + (size_t)(b * SEQ + c * CL + t) * DM + g * 16 + i0) = w; }
                asm volatile("" ::: "memory"); } } };
template <int MODE> struct EpiGated { static constexpr bool PERM = true, LDSS = false; static constexpr int MM = 0; bf16* out; int ldc; float* rowss; int rowsel;
    __device__ __forceinline__ void operator()(AccRef acc, const GUnit& u, int wr, int wc, int fr, int fq) const {
#pragma unroll
        for (int ai = 0; ai < 2; ++ai)
#pragma unroll
            for (int m = 0; m < 4; ++m) { const int row = u.pm * 256 + ai * 128 + wr * 64 + m * 16 + fr; float o[8]; float ss = 0.f;
#pragma unroll
                for (int n = 0; n < 2; ++n)
#pragma unroll
                    for (int k = 0; k < 4; ++k) { const float a = acc[ai][0][m][n][k], bq = acc[ai][1][m][n][k]; const float v = (MODE == 0) ? a * fast_sigmoid(bq) : a * fast_sigmoid(a) * bq; o[n * 4 + k] = v; ss += v * v; }
                v4u w; w.x = cvt_pk_bf16(o[0], o[1]); w.y = cvt_pk_bf16(o[2], o[3]); w.z = cvt_pk_bf16(o[4], o[5]); w.w = cvt_pk_bf16(o[6], o[7]);
                *(v4u*)(out + (size_t)row * ldc + u.pn * 128 + wc * 32 + fq * 8) = w;
                if (MODE == 0) { ss += __shfl_xor(ss, 16); ss += __shfl_xor(ss, 32); if (fq == 0) rowss[(size_t)row * 32 + u.pn * 4 + wc] = ss; } } } };
__device__ __forceinline__ void scales_to_lds(const float* rs256, const float* cm256, int buf, LAS unsigned char* lds) {
    const int wid = __builtin_amdgcn_readfirstlane(threadIdx.x >> 6), lane = threadIdx.x & 63;
    const float* src = (wid < 4) ? rs256 + wid * 64 + lane : cm256 + (wid - 4) * 64 + lane;
    __builtin_amdgcn_global_load_lds((const unsigned*)src, (LAS unsigned*)(lds + SCL_OFF + buf * 2048 + wid * 256), 4, 0, 0);
}
template <bool F8OUT> struct EpiGatedI8 { static constexpr bool PERM = true, LDSS = true; static constexpr int MM = 1; bf16* out; int ldc; const float* rowscale; const float* colmax; int cstride; unsigned char* out2;
    __device__ __forceinline__ void prefetch_scales(const GUnit& u, int buf, LAS unsigned char* lds) const { scales_to_lds(rowscale + u.rs, colmax + (size_t)u.e * cstride + u.pn * 256, buf, lds); }
    __device__ __forceinline__ void operator()(const i32x4 (&acc)[2][2][4][2], const GUnit& u, int wr, int wc, int fr, int fq, LAS unsigned char* tab) const {
        const LAS float* cm = (const LAS float*)(tab + 1024) + wc * 32 + 8 * fq; const float k127 = 1.0f / 127.0f;
        float fscale = 1.0f; if constexpr (F8OUT) fscale = __builtin_bit_cast(float, (unsigned)(254 - u.sa) << 23);
        const float L2E = 1.4426950408889634f, k1 = k127 * L2E, k3 = k127 * fscale * (1.0f / L2E);
        const f32x4 s1a = *(const LAS f32x4*)cm * k1, s1b = *(const LAS f32x4*)(cm + 4) * k1, s3a = *(const LAS f32x4*)(cm + 128) * k3, s3b = *(const LAS f32x4*)(cm + 132) * k3;
        const f32x2 c1[4] = {{s1a[0], s1a[1]}, {s1a[2], s1a[3]}, {s1b[0], s1b[1]}, {s1b[2], s1b[3]}}, c3[4] = {{s3a[0], s3a[1]}, {s3a[2], s3a[3]}, {s3b[0], s3b[1]}, {s3b[2], s3b[3]}};
        const LAS float* rsc = (const LAS float*)tab + wr * 64 + fr;
#pragma unroll
        for (int ai = 0; ai < 2; ++ai)
#pragma unroll
            for (int m = 0; m < 4; ++m) { const int r = ai * 128 + wr * 64 + m * 16 + fr; const float sA = rsc[ai * 128 + m * 16]; const f32x2 sAA = {sA, sA}; float o[8];
#pragma unroll
                for (int q = 0; q < 4; ++q) { const int n = q >> 1, k0 = (q & 1) * 2;
                    const f32x2 av = (f32x2){(float)acc[ai][0][m][n][k0], (float)acc[ai][0][m][n][k0 + 1]} * (c1[q] * sAA), bv = (f32x2){(float)acc[ai][1][m][n][k0], (float)acc[ai][1][m][n][k0 + 1]} * (c3[q] * sAA);
                    const f32x2 d = (f32x2){__builtin_amdgcn_exp2f(-av[0]), __builtin_amdgcn_exp2f(-av[1])} + (f32x2){1.0f, 1.0f};
                    const f32x2 ov = (av * bv) * (f32x2){__builtin_amdgcn_rcpf(d[0]), __builtin_amdgcn_rcpf(d[1])};
                    o[2 * q] = ov[0]; o[2 * q + 1] = ov[1]; }
                if constexpr (F8OUT) {
                    int p0 = __builtin_amdgcn_cvt_pk_fp8_f32(o[0], o[1], 0, false); p0 = __builtin_amdgcn_cvt_pk_fp8_f32(o[2], o[3], p0, true);
                    int p1 = __builtin_amdgcn_cvt_pk_fp8_f32(o[4], o[5], 0, false); p1 = __builtin_amdgcn_cvt_pk_fp8_f32(o[6], o[7], p1, true);
                    v2u w; w.x = (unsigned)p0; w.y = (unsigned)p1;
                    unsigned char* const ob = (u.pm < ASPLIT) ? (unsigned char*)out + (size_t)(u.pm * 256) * ldc : out2 + (size_t)((u.pm - ASPLIT) * 256) * ldc;
                    *(v2u*)(ob + (size_t)r * ldc + u.pn * 128 + wc * 32 + fq * 8) = w; }
                else {
                v4u w; w.x = cvt_pk_bf16(o[0], o[1]); w.y = cvt_pk_bf16(o[2], o[3]); w.z = cvt_pk_bf16(o[4], o[5]); w.w = cvt_pk_bf16(o[6], o[7]);
                *(v4u*)(out + (size_t)(u.pm * 256 + r) * ldc + u.pn * 128 + wc * 32 + fq * 8) = w; } } } };
template <bool SS, bool USEAUX, int MMODE = 0> struct EpiPlain { static constexpr bool PERM = true, LDSS = false; static constexpr int MM = MMODE; bf16* out; int ldc; float* rowss;
    __device__ __forceinline__ void operator()(AccRef acc, const GUnit& u, int wr, int wc, int fr, int fq) const {
        const int rb = (USEAUX ? u.aux : u.pm) * 256;
#pragma unroll
        for (int ai = 0; ai < 2; ++ai)
#pragma unroll
            for (int m = 0; m < 4; ++m) { const int row = rb + ai * 128 + wr * 64 + m * 16 + fr; float ss = 0.f;
#pragma unroll
                for (int bj = 0; bj < 2; ++bj) { const f32x4 v0 = acc[ai][bj][m][0], v1 = acc[ai][bj][m][1];
                    if (SS) ss += (v0[0] * v0[0] + v0[1] * v0[1]) + (v0[2] * v0[2] + v0[3] * v0[3]) + (v1[0] * v1[0] + v1[1] * v1[1]) + (v1[2] * v1[2] + v1[3] * v1[3]);
                    v4u w; w.x = cvt_pk_bf16(v0[0], v0[1]); w.y = cvt_pk_bf16(v0[2], v0[3]); w.z = cvt_pk_bf16(v1[0], v1[1]); w.w = cvt_pk_bf16(v1[2], v1[3]);
                    *(v4u*)(out + (size_t)row * ldc + u.pn * 256 + bj * 128 + wc * 32 + fq * 8) = w; }
                if (SS) { ss += __shfl_xor(ss, 16); ss += __shfl_xor(ss, 32); if (fq == 0) rowss[(size_t)row * 32 + u.pn * 4 + wc] = ss; } } } };
template <bool I8Q> struct EpiQKV { static constexpr bool PERM = true, LDSS = I8Q; static constexpr int MM = I8Q ? 1 : 0; bf16* qkv; const float* rope; float* kmean; const float* rowscale; const float* colmax;
    __device__ __forceinline__ void prefetch_scales(const GUnit& u, int buf, LAS unsigned char* lds) const { scales_to_lds(rowscale + u.rs, colmax + u.pn * 256, buf, lds); }
    template <class AccT> __device__ __forceinline__ void operator()(const AccT (&acc)[2][2][4][2], const GUnit& u, int wr, int wc, int fr, int fq, LAS unsigned char* tab = nullptr) const {
        const int sel = u.pn >> 2; bf16* const outb = qkv + (size_t)sel * (size_t)(32u << 20);
        const int colt = (u.pn & 3) * 256;
        f32x4 sb[2][2];
        if constexpr (I8Q) { const LAS float* cm = (const LAS float*)(tab + 1024) + wc * 32 + 8 * fq; const float k127 = 1.0f / 127.0f;
            sb[0][0] = *(const LAS f32x4*)cm * k127; sb[0][1] = *(const LAS f32x4*)(cm + 4) * k127; sb[1][0] = *(const LAS f32x4*)(cm + 128) * k127; sb[1][1] = *(const LAS f32x4*)(cm + 132) * k127; }
        float cs[2][2][4];
#pragma unroll
        for (int bj = 0; bj < 2; ++bj)
#pragma unroll
            for (int n = 0; n < 2; ++n)
#pragma unroll
                for (int kk = 0; kk < 4; ++kk) cs[bj][n][kk] = 0.f;
#pragma unroll
        for (int ai = 0; ai < 2; ++ai)
#pragma unroll
            for (int m = 0; m < 4; ++m) { const int rl = ai * 128 + wr * 64 + m * 16 + fr, row = u.pm * 256 + rl;
                float sA = 1.0f; if constexpr (I8Q) sA = ((const LAS float*)tab)[rl];
                f32x4 co = (f32x4){1.f, 1.f, 1.f, 1.f}, si = (f32x4){0.f, 0.f, 0.f, 0.f};
                if (sel < 2 && wc == 0) { co = *(const f32x4*)(rope + (size_t)row * 32 + 4 * fq); si = *(const f32x4*)(rope + (size_t)row * 32 + 16 + 4 * fq); }
#pragma unroll
                for (int bj = 0; bj < 2; ++bj) { f32x4 v0, v1;
                    if constexpr (I8Q) {
#pragma unroll
                        for (int kk = 0; kk < 4; ++kk) { v0[kk] = (float)acc[ai][bj][m][0][kk] * (sA * sb[bj][0][kk]); v1[kk] = (float)acc[ai][bj][m][1][kk] * (sA * sb[bj][1][kk]); } }
                    else {
#pragma unroll
                        for (int kk = 0; kk < 4; ++kk) { v0[kk] = acc[ai][bj][m][0][kk]; v1[kk] = acc[ai][bj][m][1][kk]; } }
                    if (sel < 2 && wc == 0) {
                        const float a0 = v0[0] * co[0] - v0[1] * si[0], a1 = v0[1] * co[0] + v0[0] * si[0], a2 = v0[2] * co[1] - v0[3] * si[1], a3 = v0[3] * co[1] + v0[2] * si[1];
                        const float b0 = v1[0] * co[2] - v1[1] * si[2], b1 = v1[1] * co[2] + v1[0] * si[2], b2 = v1[2] * co[3] - v1[3] * si[3], b3 = v1[3] * co[3] + v1[2] * si[3];
                        v0 = (f32x4){a0, a1, a2, a3}; v1 = (f32x4){b0, b1, b2, b3}; }
                    if (sel == 1) {
#pragma unroll
                        for (int kk = 0; kk < 4; ++kk) { cs[bj][0][kk] += v0[kk]; cs[bj][1][kk] += v1[kk]; } }
                    v4u w; w.x = cvt_pk_bf16(v0[0], v0[1]); w.y = cvt_pk_bf16(v0[2], v0[3]); w.z = cvt_pk_bf16(v1[0], v1[1]); w.w = cvt_pk_bf16(v1[2], v1[3]);
                    *(v4u*)(outb + (size_t)row * DM + colt + bj * 128 + wc * 32 + fq * 8) = w; } }
        if (sel == 1) {
            const int b = u.pm >> 3, blk = u.pm & 7;
#pragma unroll
            for (int bj = 0; bj < 2; ++bj)
#pragma unroll
                for (int n = 0; n < 2; ++n)
#pragma unroll
                    for (int kk = 0; kk < 4; ++kk) { float s = cs[bj][n][kk]; s += __shfl_xor(s, 1); s += __shfl_xor(s, 2); s += __shfl_xor(s, 4); s += __shfl_xor(s, 8);
                        if (fr == 0) { const int h = (u.pn & 3) * 2 + bj; atomicAdd(kmean + ((size_t)((b * NH + h) * NBLK + blk)) * HD + wc * 32 + fq * 8 + n * 4 + kk, s * (1.0f / 256.0f)); } } } } };

namespace attn {
constexpr int D = 128, TS = DM;
constexpr float SCALE = 0.08838834764831845f, THR = 8.f;
constexpr int NW = 8, QBLK = 32, KVBLK = 64, QB = NW * QBLK;
constexpr int SHM_V = KVBLK * D * 2, SHM_K = KVBLK * D * 2;
constexpr int ATT_LDS = 2 * SHM_V + 2 * SHM_K + NW * 64 * 4;
#define KSWZ(row, colB) ((row) * 256 + ((colB) ^ (((row) & 7) << 4)))
#define SBAR() __builtin_amdgcn_sched_barrier(0)
__device__ __forceinline__ int v_st(int k, int c) { const int kk = (k & ~0xC) | ((k & 4) << 1) | ((k & 8) >> 1); return ((kk >> 3) * 4 + (c >> 5)) * 512 + ((kk & 7) * 32 + (c & 31)) * 2; }
__device__ __forceinline__ int v_rd_base(int lane) { return ((lane & 3) << 3) | (((lane >> 2) & 3) << 6) | (((lane >> 4) & 1) << 5) | (((lane >> 5) & 1) << 8); }
constexpr int v_rd_off(int d0, int ks, int half) { return d0 * 512 + ks * 4096 + half * 2048; }
__device__ __forceinline__ int crow(int r, int hi) { return (r & 3) + 8 * (r >> 2) + 4 * hi; }
__device__ __forceinline__ bf16x8 load8(const bf16* p) { return *reinterpret_cast<const bf16x8*>(p); }
__device__ __forceinline__ void mask_tile(f32x16& p0, f32x16& p1, int dq) {
    const float NEG = -__builtin_inff();
#pragma unroll
    for (int r = 0; r < 16; ++r) { const int c = (r & 3) + 8 * (r >> 2); if (dq - c < 0) p0[r] = NEG; if (dq - c - 32 < 0) p1[r] = NEG; }
}
__device__ __forceinline__ void drop_tile(f32x16& p0, f32x16& p1, bool drop) {
    const float NEG = -__builtin_inff();
#pragma unroll
    for (int r = 0; r < 16; ++r) { p0[r] = drop ? NEG : p0[r]; p1[r] = drop ? NEG : p1[r]; }
}
__device__ __forceinline__ void partialSM(f32x16& p0, f32x16& p1, float& m_reg, float& mn, float& alpha, bool drop = false) {
    float pmax = p0[0];
#pragma unroll
    for (int r = 1; r < 16; ++r) pmax = fmaxf(pmax, p0[r]);
#pragma unroll
    for (int r = 0; r < 16; ++r) pmax = fmaxf(pmax, p1[r]);
    { auto rr = __builtin_amdgcn_permlane32_swap(__float_as_uint(pmax), __float_as_uint(pmax), false, false);
      pmax = fmaxf(__uint_as_float(rr[0]), __uint_as_float(rr[1])); }
    pmax = drop ? -__builtin_inff() : pmax;
    constexpr float C2 = 1.4426950408889634f * SCALE;
    if (__builtin_expect(__all((pmax - m_reg) * SCALE <= THR), 1)) { mn = m_reg; alpha = 1.f; }
    else { mn = fmaxf(m_reg, pmax); alpha = __builtin_amdgcn_exp2f((m_reg - mn) * C2); m_reg = mn; }
    const float mnL = drop ? -__builtin_inff() : -mn * C2;
#pragma unroll
    for (int r = 0; r < 16; ++r) p0[r] = fmaf(p0[r], C2, mnL);
#pragma unroll
    for (int r = 0; r < 16; ++r) p1[r] = fmaf(p1[r], C2, mnL);
#pragma unroll
    for (int r = 0; r < 16; ++r) p0[r] = __builtin_amdgcn_exp2f(p0[r]);
}
__device__ __forceinline__ void finishSM(f32x16& p0, f32x16& p1, float alpha, float& l_reg, bf16x8& pa0, bf16x8& pa1, bf16x8& pa2, bf16x8& pa3) {
#pragma unroll
    for (int r = 0; r < 16; ++r) p1[r] = __builtin_amdgcn_exp2f(p1[r]);
    float ps = 0;
#pragma unroll
    for (int r = 0; r < 16; ++r) ps += p0[r];
#pragma unroll
    for (int r = 0; r < 16; ++r) ps += p1[r];
    { auto rr = __builtin_amdgcn_permlane32_swap(__float_as_uint(ps), __float_as_uint(ps), false, false);
      ps = __uint_as_float(rr[0]) + __uint_as_float(rr[1]); }
    l_reg = l_reg * alpha + ps;
#define PK4(P, B_, OUT) do { unsigned a0 = cvt_pk_bf16(P[B_+0], P[B_+1]), a1 = cvt_pk_bf16(P[B_+2], P[B_+3]);                          \
        unsigned b0 = cvt_pk_bf16(P[B_+4], P[B_+5]), b1 = cvt_pk_bf16(P[B_+6], P[B_+7]);                                             \
        auto r0 = __builtin_amdgcn_permlane32_swap(a0, b0, false, false); auto r1 = __builtin_amdgcn_permlane32_swap(a1, b1, false, false); \
        v4u w = {r0[0], r1[0], r0[1], r1[1]}; OUT = *reinterpret_cast<bf16x8*>(&w); } while (0)
    PK4(p0, 0, pa0); PK4(p0, 8, pa1); PK4(p1, 0, pa2); PK4(p1, 8, pa3);
#undef PK4
}
template <int KB>
__device__ __forceinline__ void qkt(f32x16& p0, f32x16& p1, const char* K_lds, int r32, int hi, const bf16x8* qr) {
    p0 = f32x16{}; p1 = f32x16{};
    const char* kb[4];
#pragma unroll
    for (int dd = 0; dd < 4; ++dd) kb[dd] = K_lds + KB * SHM_K + KSWZ(r32, (dd * 16 + hi * 8) * 2);
#pragma unroll
    for (int d0 = 0; d0 < 8; ++d0) { const char* a = kb[d0 & 3] + (d0 >> 2) * 128;
        bf16x8 b0 = *reinterpret_cast<const bf16x8*>(a);
        bf16x8 b1 = *reinterpret_cast<const bf16x8*>(a + 32 * 256);
        p0 = __builtin_amdgcn_mfma_f32_32x32x16_bf16(b0, qr[d0], p0, 0, 0, 0);
        p1 = __builtin_amdgcn_mfma_f32_32x32x16_bf16(b1, qr[d0], p1, 0, 0, 0); }
}
template <int VB>
__device__ __forceinline__ void pv_tile(f32x16* o, int vb0, bf16x8 pa0, bf16x8 pa1, bf16x8 pa2, bf16x8 pa3) {
#define TRRD(dst, off) asm volatile("ds_read_b64_tr_b16 %0, %1 offset:%2" : "=&v"(dst) : "v"(vb0), "i"(off) : "memory")
#define PV_RD(d0, X) do { constexpr int b_ = VB * SHM_V + v_rd_off(d0, 0, 0); \
        TRRD(X##l0, b_); TRRD(X##h0, b_ + 2048); TRRD(X##l1, b_ + 4096); TRRD(X##h1, b_ + 6144); TRRD(X##l2, b_ + 8192); TRRD(X##h2, b_ + 10240); TRRD(X##l3, b_ + 12288); TRRD(X##h3, b_ + 14336); } while (0)
#define PV_MM(d0, X) do { \
        o[d0] = __builtin_amdgcn_mfma_f32_32x32x16_bf16(pa0, (bf16x8){X##l0[0], X##l0[1], X##l0[2], X##l0[3], X##h0[0], X##h0[1], X##h0[2], X##h0[3]}, o[d0], 0, 0, 0);   \
        o[d0] = __builtin_amdgcn_mfma_f32_32x32x16_bf16(pa1, (bf16x8){X##l1[0], X##l1[1], X##l1[2], X##l1[3], X##h1[0], X##h1[1], X##h1[2], X##h1[3]}, o[d0], 0, 0, 0);   \
        o[d0] = __builtin_amdgcn_mfma_f32_32x32x16_bf16(pa2, (bf16x8){X##l2[0], X##l2[1], X##l2[2], X##l2[3], X##h2[0], X##h2[1], X##h2[2], X##h2[3]}, o[d0], 0, 0, 0);   \
        o[d0] = __builtin_amdgcn_mfma_f32_32x32x16_bf16(pa3, (bf16x8){X##l3[0], X##l3[1], X##l3[2], X##l3[3], X##h3[0], X##h3[1], X##h3[2], X##h3[3]}, o[d0], 0, 0, 0); } while (0)
#define PV_WAIT(n) do { asm volatile("s_waitcnt lgkmcnt(" #n ")" ::: "memory"); SBAR(); } while (0)
    { s16x4 al0, al1, al2, al3, ah0, ah1, ah2, ah3, bl0, bl1, bl2, bl3, bh0, bh1, bh2, bh3;
      PV_RD(0, a); PV_RD(1, b);
      PV_WAIT(8); PV_MM(0, a); SBAR(); PV_RD(2, a);
      PV_WAIT(8); PV_MM(1, b); SBAR(); PV_RD(3, b);
      PV_WAIT(8); PV_MM(2, a);
      PV_WAIT(0); PV_MM(3, b); }
#undef PV_RD
#undef PV_MM
#undef PV_WAIT
#undef TRRD
}
struct BlockRef { const bf16* Q; const bf16* K; const bf16* V; bf16* O; const float* KM; int P0; };
struct Seam { bf16x8 qr[8]; bf16x8 st_v0, st_v1, st_k0, st_k1; };
#define ROW(p, k0, rr) ((p) + (size_t)((k0) + (rr)) * TS + sc)
#define VMW() asm volatile("s_waitcnt vmcnt(0)" ::: "memory")
#define VMWN(n) asm volatile("s_waitcnt vmcnt(%0)" :: "i"(n) : "memory")
#define SLOAD_H(Kp, Vp, k0) do { S.st_v0 = load8(ROW(Vp, k0, sr)); S.st_v1 = load8(ROW(Vp, k0, 32 + sr));              \
                         S.st_k0 = load8(ROW(Kp, k0, sr)); S.st_k1 = load8(ROW(Kp, k0, 32 + sr)); } while (0)
#define SWRITE_HK(bf) do { *(bf16x8*)(K_lds + (bf) * SHM_K + kws) = S.st_k0; *(bf16x8*)(K_lds + (bf) * SHM_K + kws + 32 * 256) = S.st_k1; } while (0)
#define SWRITE_HV(bf) do { *(bf16x8*)(V_lds + (bf) * SHM_V + vst0) = S.st_v0; *(bf16x8*)(V_lds + (bf) * SHM_V + vst1) = S.st_v1; } while (0)
#define SWRITE_H(bf) do { SWRITE_HV(bf); SWRITE_HK(bf); } while (0)
__device__ __forceinline__ void moba_prime(const BlockRef& cur, char* lds, Seam& S) {
    const int tid = threadIdx.x, wid = __builtin_amdgcn_readfirstlane(tid >> 6), lane = tid & 63, r32 = lane & 31, hi = lane >> 5;
    const int sr = tid >> 4, sc = (tid & 15) * 8, kws = KSWZ(sr, sc * 2); char* K_lds = lds + 2 * SHM_V;
#pragma unroll
    for (int d0 = 0; d0 < 8; ++d0) S.qr[d0] = load8(cur.Q + (size_t)(wid * QBLK + r32) * TS + d0 * 16 + hi * 8);
    SLOAD_H(cur.K, cur.V, 0); VMW(); SWRITE_HK(0);
    __syncthreads();
}
__device__ __forceinline__ void moba_block(const BlockRef& cur, const BlockRef& nxt, char* lds, Seam& S) {
    const int tid = threadIdx.x, wid = __builtin_amdgcn_readfirstlane(tid >> 6), lane = tid & 63, r32 = lane & 31, hi = lane >> 5;
    const int NT = cur.P0 / KVBLK + QB / KVBLK;
    const int qlo = cur.P0 + wid * QBLK, qm = qlo + r32 - 4 * hi;
    char* V_lds = lds; char* K_lds = lds + 2 * SHM_V;
    float* ws = (float*)(lds + 2 * SHM_V + 2 * SHM_K) + wid * 64; float* li_l = ws, * al_l = ws + 32;
    int sel = 0xff; const int qb = cur.P0 >> 8;
    if (qb > 3) {
        float g[7];
#pragma unroll
        for (int j = 0; j < 7; ++j) { float s = -__builtin_inff();
            asm volatile("" ::: "memory");
            if (j < qb) { int hoff = hi * 8; asm volatile("" : "+v"(hoff)); const float* km = cur.KM + j * HD + hoff; s = 0.f;
#pragma unroll
                for (int d0 = 0; d0 < 8; ++d0) { const f32x4 k0 = *(const f32x4*)(km + d0 * 16), k1 = *(const f32x4*)(km + d0 * 16 + 4); const bf16x8 qv = S.qr[d0];
                    s += bf2f((unsigned short)qv[0]) * k0[0] + bf2f((unsigned short)qv[1]) * k0[1] + bf2f((unsigned short)qv[2]) * k0[2] + bf2f((unsigned short)qv[3]) * k0[3]
                       + bf2f((unsigned short)qv[4]) * k1[0] + bf2f((unsigned short)qv[5]) * k1[1] + bf2f((unsigned short)qv[6]) * k1[2] + bf2f((unsigned short)qv[7]) * k1[3]; }
                auto rr = __builtin_amdgcn_permlane32_swap(__float_as_uint(s), __float_as_uint(s), false, false); s = __uint_as_float(rr[0]) + __uint_as_float(rr[1]); }
            g[j] = s; }
        sel = 0;
#pragma unroll
        for (int j = 0; j < 7; ++j) { int rank = 0;
#pragma unroll
            for (int k = 0; k < 7; ++k) if (k != j) rank += (g[k] > g[j] || (g[k] == g[j] && k < j)) ? 1 : 0;
            if (j < qb && rank < 3) sel |= 1 << j; }
        sel |= 1 << qb;
    }
    float m_reg = -1e30f, l_reg = 0; f32x16 o[4] = {};
    const int sr = tid >> 4, sc = (tid & 15) * 8, vst0 = v_st(sr, sc), vst1 = v_st(32 + sr, sc), kws = KSWZ(sr, sc * 2);
    const int vb0 = (int)(uintptr_t)V_lds + v_rd_base(lane);
    const bf16* Kh = cur.K; const bf16* Vh = cur.V;
#define RESC(a) do { if (__any((a) < 1.f)) { if (hi == 0) al_l[r32] = (a); asm volatile("s_waitcnt lgkmcnt(0)" ::: "memory");              \
                     for (int d_ = 0; d_ < 4; ++d_) for (int r = 0; r < 16; ++r) o[d_][r] *= al_l[crow(r, hi)]; } } while (0)
#define KBASE(t) ((t) * KVBLK)
#define MASKT(P0_, P1_, t) do { const int kb_ = KBASE(t); if (kb_ + KVBLK - 1 > qlo) mask_tile(P0_, P1_, qm - kb_); \
        dropT = (kb_ < cur.P0) && ((sel >> (kb_ >> 8)) & 1) == 0; } while (0)
    constexpr int NQL = 8;
#define SEAM_K0() do { VMWN(NQL); SWRITE_HK(0); SBAR(); } while (0)
    f32x16 pA0, pA1, pB0, pB1; float mnA, mnB, alA, alB; bf16x8 pa0, pa1, pa2, pa3; bool dropT = false;
    SWRITE_HV(0); SBAR();
    if (NT > 1) SLOAD_H(Kh, Vh, KBASE(1));
    SBAR(); qkt<0>(pA0, pA1, K_lds, r32, hi, S.qr);
    MASKT(pA0, pA1, 0); partialSM(pA0, pA1, m_reg, mnA, alA, dropT);
    if (NT > 1) { VMW(); SWRITE_H(1); }
    __syncthreads();
#define HALF_STEP(PX0, PX1, mnX, alX, PY0, PY1, alY, t, KB, VB, SB) do {                                                      \
        SBAR(); qkt<KB>(PX0, PX1, K_lds, r32, hi, S.qr);                                                                      \
        finishSM(PY0, PY1, alY, l_reg, pa0, pa1, pa2, pa3); SBAR();                                                           \
        if ((t) + 1 < NT) { SLOAD_H(Kh, Vh, KBASE((t) + 1)); SBAR(); }                                                        \
        pv_tile<VB>(o, vb0, pa0, pa1, pa2, pa3); MASKT(PX0, PX1, (t)); partialSM(PX0, PX1, m_reg, mnX, alX, dropT);            \
        __syncthreads();                                                                                                      \
        if ((t) + 1 < NT) { VMW(); SWRITE_H(SB); }                                                                            \
        RESC(alX); __syncthreads(); } while (0)
    for (int t = 1; t + 1 < NT; t += 2) {
        HALF_STEP(pB0, pB1, mnB, alB, pA0, pA1, alA, t, 1, 0, 0);
        HALF_STEP(pA0, pA1, mnA, alA, pB0, pB1, alB, t + 1, 0, 1, 1);
    }
    SBAR(); qkt<1>(pB0, pB1, K_lds, r32, hi, S.qr); SBAR();
    SLOAD_H(nxt.K, nxt.V, 0); SBAR();
#pragma unroll
    for (int d0 = 0; d0 < 8; ++d0) S.qr[d0] = load8(nxt.Q + (size_t)(wid * QBLK + r32) * TS + d0 * 16 + hi * 8);
    SBAR();
    finishSM(pA0, pA1, alA, l_reg, pa0, pa1, pa2, pa3); SBAR();
    pv_tile<0>(o, vb0, pa0, pa1, pa2, pa3);
    MASKT(pB0, pB1, NT - 1); partialSM(pB0, pB1, m_reg, mnB, alB, dropT); __syncthreads(); RESC(alB);
    finishSM(pB0, pB1, alB, l_reg, pa0, pa1, pa2, pa3); SBAR(); pv_tile<1>(o, vb0, pa0, pa1, pa2, pa3);
    SBAR(); SEAM_K0();
    if (hi == 0) li_l[r32] = l_reg; asm volatile("s_waitcnt lgkmcnt(0)" ::: "memory");
    float rli[16];
#pragma unroll
    for (int r = 0; r < 16; ++r) rli[r] = __builtin_amdgcn_rcpf(li_l[crow(r, hi)]);
    bf16* Ow = cur.O + (size_t)(wid * QBLK) * TS;
#pragma unroll
    for (int r = 0; r < 16; ++r) { const int orow = crow(r, hi);
#pragma unroll
        for (int d0 = 0; d0 < 4; ++d0) { const float v = o[d0][r] * rli[r];
            const float vn = __shfl_xor(v, 1);
            if ((r32 & 1) == 0) *(unsigned*)(Ow + (size_t)orow * TS + d0 * 32 + r32) = cvt_pk_bf16(v, vn); } }
    __syncthreads();
#undef RESC
#undef KBASE
#undef MASKT
#undef SEAM_K0
#undef HALF_STEP
}
#undef ROW
#undef VMW
#undef VMWN
#undef SLOAD_H
#undef SWRITE_HK
#undef SWRITE_HV
#undef SWRITE_H
}

#define XB_TMO      128
#define XB_XCNT(j)  (256  + 64 * (j))
#define XB_XSUB(j)  (1280 + 64 * (j))
#define XB_XGEN(j)  (2304 + 64 * (j))
#define XB_TOP      3328
#define XB_TOPGEN   3392
#define XCD_BAR_WORDS 3456
#define XB_SPIN_CAP (1u << 18)
__device__ __forceinline__ unsigned xb_ld(unsigned* p)              { return __hip_atomic_load(p, __ATOMIC_RELAXED, __HIP_MEMORY_SCOPE_AGENT); }
__device__ __forceinline__ unsigned xb_add(unsigned* p, unsigned v) { return __hip_atomic_fetch_add(p, v, __ATOMIC_RELAXED, __HIP_MEMORY_SCOPE_AGENT); }
__device__ __forceinline__ unsigned xb_xcc_id() { return (unsigned)__builtin_amdgcn_s_getreg((3 << 11) | 20) & 0xFu; }
#define XB_SPIN(cond, bar) do { unsigned _sp = 0; while (cond) { __builtin_amdgcn_s_sleep(1); \
    if ((++_sp & 255u) == 0u) { if (xb_ld(&(bar)[XB_TMO])) break; if (_sp > XB_SPIN_CAP) { atomicAdd(&(bar)[XB_TMO], 1u); break; } } } } while (0)
struct XcdBarrier { unsigned* bar; unsigned x; volatile LAS unsigned* st; };
__device__ __forceinline__ XcdBarrier xcd_barrier_post(unsigned* bar, volatile LAS unsigned* st) {
    XcdBarrier b; b.bar = bar; b.x = xb_xcc_id(); b.st = st;
    if (threadIdx.x == 0) (void)xb_add(&bar[XB_XCNT(b.x)], 1u);
    return b;
}
__device__ __forceinline__ void xcd_barrier_complete(unsigned* bar, unsigned x, unsigned& nloc, unsigned& nx) {
    const unsigned G = gridDim.x * gridDim.y * gridDim.z;
    unsigned sum, cnt, mine, sp = 0u;
    for (;;) {
        sum = 0u; cnt = 0u;
#pragma unroll 1
        for (unsigned j = 0; j < 16; ++j) { const unsigned c = xb_ld(&bar[XB_XCNT(j)]); sum += c; cnt += (c > 0u) ? 1u : 0u; }
        if (sum == G) break;
        __builtin_amdgcn_s_sleep(1);
        if ((++sp & 255u) == 0u) { if (xb_ld(&bar[XB_TMO])) break; if (sp > XB_SPIN_CAP) { atomicAdd(&bar[XB_TMO], 1u); break; } }
    }
    mine = xb_ld(&bar[XB_XCNT(x)]);
    nloc = mine > 0u ? mine : 1u; nx = cnt > 0u ? cnt : 1u;
}
__device__ __forceinline__ void xcd_barrier(const XcdBarrier& b) {
    asm volatile("s_waitcnt vmcnt(0)" ::: "memory");
    __syncthreads();
    if (threadIdx.x == 0) {
        unsigned* bar = b.bar;
        __builtin_amdgcn_s_waitcnt(0);
        unsigned nloc = b.st[0], nx = b.st[1];
        if (nloc == 0u) { xcd_barrier_complete(bar, b.x, nloc, nx); b.st[0] = nloc; b.st[1] = nx; }
        const unsigned old = xb_add(&bar[XB_XSUB(b.x)], 1u);
        const unsigned gen = old / nloc;
        if (old + 1u == (gen + 1u) * nloc) {
            __builtin_amdgcn_fence(__ATOMIC_RELEASE, "agent");
            asm volatile("s_waitcnt vmcnt(0)" ::: "memory");
            const unsigned og = xb_add(&bar[XB_TOP], 1u);
            const unsigned tg = og / nx;
            if (og + 1u == (tg + 1u) * nx) xb_add(&bar[XB_TOPGEN], 1u);
            else XB_SPIN(xb_ld(&bar[XB_TOPGEN]) == tg, bar);
            __builtin_amdgcn_fence(__ATOMIC_ACQUIRE, "agent");
            xb_add(&bar[XB_XGEN(b.x)], 1u);
            asm volatile("s_waitcnt vmcnt(0)" ::: "memory");
        } else {
            XB_SPIN(xb_ld(&bar[XB_XGEN(b.x)]) == gen, bar);
            __builtin_amdgcn_fence(__ATOMIC_ACQUIRE, "agent");
            asm volatile("s_waitcnt vmcnt(0)" ::: "memory");
        }
    }
    __syncthreads();
}

struct Frame {
    LAS unsigned char* lds; volatile LAS unsigned* MISC; unsigned* ctl;
    int tid, lane, wave, vcu, G, bx, lo, hi;
    unsigned char* ws;
};
struct Args { const void* in[24]; float* out; unsigned char* ws; int ph_lo, ph_hi; };
typedef const __attribute__((address_space(4))) Args* KArgs;
__device__ __forceinline__ KArgs kargs() { KArgs p = (KArgs)__builtin_amdgcn_kernarg_segment_ptr(); asm volatile("" : "+s"(p)); return p; }
__device__ __forceinline__ void refresh(Frame& F) {
    KArgs k = kargs();
    int t = threadIdx.x; asm volatile("" : "+v"(t)); F.tid = t; F.lane = t & 63; F.wave = __builtin_amdgcn_readfirstlane(t >> 6);
    int g = gridDim.x, bx = blockIdx.x; asm volatile("" : "+s"(g), "+s"(bx)); F.G = g; F.bx = bx; F.vcu = (g % 8 == 0) ? (bx % 8) * (g / 8) + bx / 8 : bx;
    F.ws = k->ws; F.ctl = (unsigned*)(F.ws + WS_CTL); F.lo = k->ph_lo; F.hi = k->ph_hi;
    F.lds = (LAS unsigned char*)0; F.MISC = (volatile LAS unsigned*)(F.lds + MISC_OFF);
}
__device__ __forceinline__ XcdBarrier frame_bar(Frame& F) { XcdBarrier b; b.bar = F.ctl + CW_BAR; b.x = xb_xcc_id(); b.st = F.MISC + 8; return b; }
enum { I_X = 0, I_POS, I_NORMS, I_LAMRE, I_LAMIM, I_LOGDT, I_BRE, I_BIM, I_CRE, I_CIM, I_SD, I_WGLU, I_KVN, I_WKV, I_WQ, I_WO, I_FW1, I_FW3, I_FW2, I_ROUTER, I_RBIAS, I_MW1, I_MW3, I_MW2 };

__device__ __forceinline__ int rot32(int d) { return 8 * ((d & 15) >> 2) + 2 * (d & 3) + (d >> 4); }
constexpr int NKIND = 31;
struct WK { const float* W; const float* gain; unsigned char* dst; unsigned* colmax; float* psq; int ldw, K, N, mode, base, which, ot; };
__device__ __forceinline__ void wk_get(KArgs ap, unsigned char* ws, int kind, WK& k) {
    const auto& a = *ap; const float* norms = (const float*)a.in[I_NORMS]; k.gain = nullptr; k.colmax = nullptr; k.psq = nullptr; k.mode = 0; k.base = 0; k.which = 0; k.ot = 0; k.ldw = DM; k.K = DM; k.N = DM;
    if (kind == 0) { k.W = (const float*)a.in[I_WGLU]; k.ldw = 2 * DM; k.N = 2 * DM; k.dst = ws + WS_WGLU; k.mode = 3; }
    else if (kind == 1) { k.W = (const float*)a.in[I_WQ]; k.gain = norms + 4 * DM; k.mode = 2; k.ot = MK_QKV8; k.dst = MK_QKV8 ? ws + WS_WQQKV : ws + WS_WQKV; k.colmax = (unsigned*)(ws + WS_COLMAX_QKV); }
    else if (kind == 2) { k.W = (const float*)a.in[I_WKV]; k.ldw = 2 * DM; k.N = 2 * DM; k.gain = (const float*)a.in[I_KVN]; k.mode = 4; k.base = DM; k.ot = MK_QKV8; k.dst = MK_QKV8 ? ws + WS_WQQKV : ws + WS_WQKV; k.colmax = (unsigned*)(ws + WS_COLMAX_QKV); }
    else if (kind == 3) { k.W = (const float*)a.in[I_WO]; k.dst = ws + WS_WO; }
    else if (kind == 4 || kind == 5) { k.W = (const float*)a.in[kind == 4 ? I_FW1 : I_FW3]; k.ldw = FFD; k.N = FFD; k.gain = norms + 2 * DM; k.mode = 1; k.which = kind - 4; k.ot = 1; k.dst = ws + WS_WQF13; k.colmax = (unsigned*)(ws + WS_COLMAX_F); k.psq = (float*)(ws + WS_PSQD); }
    else if (kind == 6) { k.W = (const float*)a.in[I_FW2]; k.K = FFD; k.dst = ws + WS_WF2; if (MK_FFN2F8) { k.ot = 2; k.colmax = (unsigned*)(ws + WS_COLMAX_W2) + NE * DM; } }
    else if (kind < 23) { const int e = (kind - 7) & 7, wh = (kind - 7) >> 3; k.W = (const float*)a.in[wh ? I_MW3 : I_MW1] + (size_t)e * DM * FFE; k.ldw = FFE; k.N = FFE; k.gain = norms + 6 * DM; k.mode = 1; k.which = wh; k.ot = 1;
        k.dst = ws + WS_WQ13 + (size_t)e * 2 * FFE * DM; k.colmax = (unsigned*)(ws + WS_COLMAX) + e * 2 * FFE; k.psq = (float*)(ws + WS_PSQ) + e * 2 * FFE; }
    else { const int e = kind - 23; k.W = (const float*)a.in[I_MW2] + (size_t)e * FFE * DM; k.K = FFE; k.ot = 2; k.dst = ws + WS_W8M2 + (size_t)e * DM * FFE; k.colmax = (unsigned*)(ws + WS_COLMAX_W2) + e * DM; }
}
__device__ __forceinline__ int wk_drow(const WK& k, int n) {
    if (k.mode == 1) return (n >> 7) * 256 + k.which * 128 + (n & 127);
    if (k.mode == 3) { const int chn = n & 1023; return (chn >> 7) * 256 + (n >> 10) * 128 + (chn & 127); }
    if (k.mode == 2 || (k.mode == 4 && n < DM)) { const int d = n & 127; return k.base + (n & ~127) + (d < 32 ? rot32(d) : d); }
    return k.base + n;
}
__device__ __forceinline__ int wk_f8ex(float cm) { int ex = 0; if (cm > 0.f) { ex = 134 - (int)((__float_as_uint(cm) >> 23) & 0xffu); ex = ex < -60 ? -60 : (ex > 60 ? 60 : ex); } return ex; }
__device__ __forceinline__ unsigned q8(float x) { int q = (int)rintf(x); q = q < -127 ? -127 : (q > 127 ? 127 : q); return (unsigned)q & 0xffu; }
__device__ __forceinline__ unsigned q8x4(float a, float b, float c, float d, float f) {
    unsigned p = 0;
    p = __builtin_amdgcn_cvt_pk_u8_f32(rintf(fmaf(a, f, 128.0f)), 0, p); p = __builtin_amdgcn_cvt_pk_u8_f32(rintf(fmaf(b, f, 128.0f)), 1, p);
    p = __builtin_amdgcn_cvt_pk_u8_f32(rintf(fmaf(c, f, 128.0f)), 2, p); p = __builtin_amdgcn_cvt_pk_u8_f32(rintf(fmaf(d, f, 128.0f)), 3, p);
    return p ^ 0x80808080u;
}
__device__ __forceinline__ void wk_stats_item(const WK& k, int kb, int nb, int lane) {
    const int nc = nb * 256 + 4 * lane; float mx[4] = {0.f, 0.f, 0.f, 0.f}, sq[4] = {0.f, 0.f, 0.f, 0.f};
#pragma unroll 1
    for (int i0 = 0; i0 < 64; i0 += 16) { f32x4 v[16];
#pragma unroll
        for (int i = 0; i < 16; ++i) v[i] = *(const f32x4*)(k.W + (size_t)(kb * 64 + i0 + i) * k.ldw + nc);
#pragma unroll
        for (int i = 0; i < 16; ++i) { const float gs = k.gain ? k.gain[kb * 64 + i0 + i] : 1.0f;
#pragma unroll
            for (int c = 0; c < 4; ++c) { const float x = v[i][c] * gs; mx[c] = fmaxf(mx[c], fabsf(x)); sq[c] += x * x; } } }
#pragma unroll
    for (int c = 0; c < 4; ++c) { const int dr = wk_drow(k, nc + c); atomicMax(k.colmax + dr, __float_as_uint(mx[c])); if (k.psq) k.psq[(size_t)kb * (NE * 2 * FFE) + dr] = sq[c]; }
}
__device__ __forceinline__ void wk_item(const WK& k, int kb, int nb, int* sb8, LAS float* scr, int lane) {
    const int k0 = kb * 64, n0 = nb * 64;
    f32x4 v[16]; const int r4 = lane >> 4, c4 = (lane & 15) * 4;
#pragma unroll
    for (int i = 0; i < 16; ++i) v[i] = *(const f32x4*)(k.W + (size_t)(k0 + 4 * i + r4) * k.ldw + n0 + c4);
    const int k8 = lane & 3, nl = lane >> 2;
    int dr[4]; float qs[4];
#pragma unroll
    for (int st = 0; st < 4; ++st) { dr[st] = wk_drow(k, n0 + 16 * st + nl); qs[st] = 1.0f;
        if (k.ot == 1) { const float cm = __uint_as_float(k.colmax[dr[st]]); qs[st] = cm > 0.f ? 127.0f / cm : 0.f; }
        if (k.ot == 2) { const int ex = wk_f8ex(__uint_as_float(k.colmax[dr[st]])); qs[st] = __builtin_bit_cast(float, (unsigned)(127 + ex) << 23); if (kb == 0 && k8 == 0) sb8[dr[st]] = 127 - ex; } }
#pragma unroll
    for (int hf = 0; hf < 2; ++hf) {
#pragma unroll
        for (int i = 0; i < 8; ++i) { const int kk = 4 * i + r4; const float gs = k.gain ? k.gain[k0 + hf * 32 + kk] : 1.0f; LAS float* d = scr + kk * 65 + c4; const f32x4 x = v[hf * 8 + i];
            d[0] = x.x * gs; d[1] = x.y * gs; d[2] = x.z * gs; d[3] = x.w * gs; }
        LDS_WAIT(); asm volatile("" ::: "memory");
#pragma unroll
        for (int st = 0; st < 4; ++st) { const int n = 16 * st + nl; const LAS float* sp = scr + (8 * k8) * 65 + n; const float f = qs[st];
            if (k.ot == 0) { v4u o; o.x = cvt_pk_bf16(sp[0 * 65], sp[1 * 65]); o.y = cvt_pk_bf16(sp[2 * 65], sp[3 * 65]); o.z = cvt_pk_bf16(sp[4 * 65], sp[5 * 65]); o.w = cvt_pk_bf16(sp[6 * 65], sp[7 * 65]);
                *(v4u*)((bf16*)k.dst + (size_t)dr[st] * k.K + k0 + hf * 32 + 8 * k8) = o; }
            else { v2u o;
                if (k.ot == 1) { o.x = q8x4(sp[0 * 65], sp[1 * 65], sp[2 * 65], sp[3 * 65], f); o.y = q8x4(sp[4 * 65], sp[5 * 65], sp[6 * 65], sp[7 * 65], f); }
                else { int p0 = __builtin_amdgcn_cvt_pk_fp8_f32(sp[0 * 65] * f, sp[1 * 65] * f, 0, false); p0 = __builtin_amdgcn_cvt_pk_fp8_f32(sp[2 * 65] * f, sp[3 * 65] * f, p0, true);
                       int p1 = __builtin_amdgcn_cvt_pk_fp8_f32(sp[4 * 65] * f, sp[5 * 65] * f, 0, false); p1 = __builtin_amdgcn_cvt_pk_fp8_f32(sp[6 * 65] * f, sp[7 * 65] * f, p1, true); o.x = (unsigned)p0; o.y = (unsigned)p1; }
                *(v2u*)(k.dst + (size_t)dr[st] * k.K + k0 + hf * 32 + 8 * k8) = o; } }
        LDS_WAIT(); asm volatile("" ::: "memory");
    }
}
__device__ __forceinline__ void wk_shape(int kind, int& nkb, int& nn, bool& quant) {
    nkb = DM / 64; nn = DM; quant = false;
    if (kind == 0) nn = 2 * DM;
    else if (kind == 1) quant = MK_QKV8 != 0;
    else if (kind == 2) { nn = 2 * DM; quant = MK_QKV8 != 0; }
    else if (kind == 4 || kind == 5) { nn = FFD; quant = true; }
    else if (kind == 6) { nkb = FFD / 64; quant = MK_FFN2F8 != 0; }
    else if (kind >= 7 && kind < 23) { nn = FFE; quant = true; }
    else if (kind >= 23) { nkb = FFE / 64; quant = true; }
}
template <bool GAIN> __device__ __forceinline__ void wk_tile_stats(const WK& k, int kb, int r4, const f32x4 (&v)[16], float (&mx)[4], float (&sq)[4]) {
    const float* gp = GAIN ? k.gain + kb * 64 + 16 * r4 : nullptr; if (GAIN) asm volatile("" : "+v"(gp));
#pragma unroll
    for (int i = 0; i < 16; ++i) { const float gs = GAIN ? gp[i] : 1.0f;
#pragma unroll
        for (int c = 0; c < 4; ++c) { const float x = v[i][c] * gs; mx[c] = fmaxf(mx[c], fabsf(x)); sq[c] += x * x; } }
}
template <bool GAIN> __device__ __forceinline__ void wk_tile_out(const WK& k, int kb, int r4, const f32x4 (&v)[16], const int (&dr)[4], const float (&qs)[4]) {
    const float* gp = GAIN ? k.gain + kb * 64 + 16 * r4 : nullptr; if (GAIN) asm volatile("" : "+v"(gp));
    float g[16];
#pragma unroll
    for (int i = 0; i < 16; ++i) g[i] = GAIN ? gp[i] : 1.0f;
#pragma unroll
    for (int c = 0; c < 4; ++c) { const float f = qs[c]; v4u o;
        if (k.ot == 1) { o.x = q8x4(v[0][c] * g[0], v[1][c] * g[1], v[2][c] * g[2], v[3][c] * g[3], f); o.y = q8x4(v[4][c] * g[4], v[5][c] * g[5], v[6][c] * g[6], v[7][c] * g[7], f);
                         o.z = q8x4(v[8][c] * g[8], v[9][c] * g[9], v[10][c] * g[10], v[11][c] * g[11], f); o.w = q8x4(v[12][c] * g[12], v[13][c] * g[13], v[14][c] * g[14], v[15][c] * g[15], f); }
        else { unsigned w[4];
#pragma unroll
            for (int q = 0; q < 4; ++q) { int pw = __builtin_amdgcn_cvt_pk_fp8_f32(v[4 * q][c] * g[4 * q] * f, v[4 * q + 1][c] * g[4 * q + 1] * f, 0, false);
                pw = __builtin_amdgcn_cvt_pk_fp8_f32(v[4 * q + 2][c] * g[4 * q + 2] * f, v[4 * q + 3][c] * g[4 * q + 3] * f, pw, true); w[q] = (unsigned)pw; }
            o.x = w[0]; o.y = w[1]; o.z = w[2]; o.w = w[3]; }
        *(v4u*)(k.dst + (size_t)dr[c] * k.K + kb * 64 + 16 * r4) = o; }
}
#define SCHED_FENCE() __builtin_amdgcn_sched_barrier(0)
template <int TPW> __device__ __forceinline__ void wk_super(const WK& k, Frame& F, int sbslot, int nb) {
    LAS float* smax = (LAS float*)(F.lds + F.wave * 16384) + 2080; LAS float* ssq = smax + 64;
    const int lane = F.lane, r4 = lane >> 4, c4 = (lane & 15) * 4, tpw = TPW;
    const float* wbase = k.W + (size_t)(16 * r4) * k.ldw + nb * 64 + c4;
#define WK_LOAD(v, kb) do { const float* p_ = wbase + (size_t)((kb) * 64) * k.ldw; _Pragma("unroll") for (int i_ = 0; i_ < 16; ++i_) { v[i_] = *(const f32x4*)p_; p_ += k.ldw; asm volatile("" : "+v"(p_)); } } while (0)
    float mx[4] = {0.f, 0.f, 0.f, 0.f}, sq[4] = {0.f, 0.f, 0.f, 0.f};
    f32x4 va[16], vb[16];
    const int kbase = F.wave * tpw;
    if constexpr (TPW == 2) { WK_LOAD(va, kbase); WK_LOAD(vb, kbase + 1); wk_tile_stats<TPW == 2>(k, kbase, r4, va, mx, sq); wk_tile_stats<TPW == 2>(k, kbase + 1, r4, vb, mx, sq); }
    else {
        static_assert(TPW == 2 || TPW == 7, "tile schedule below is written for 7 tiles");
        WK_LOAD(va, kbase);
#pragma unroll 1
        for (int t = 0; t < 6; t += 2) { WK_LOAD(vb, kbase + t + 1); SCHED_FENCE(); wk_tile_stats<TPW == 2>(k, kbase + t, r4, va, mx, sq); SCHED_FENCE(); WK_LOAD(va, kbase + t + 2); SCHED_FENCE(); wk_tile_stats<TPW == 2>(k, kbase + t + 1, r4, vb, mx, sq); SCHED_FENCE(); }
        wk_tile_stats<TPW == 2>(k, kbase + 6, r4, va, mx, sq); }
#pragma unroll
    for (int c = 0; c < 4; ++c) { mx[c] = fmaxf(mx[c], __shfl_xor(mx[c], 16)); mx[c] = fmaxf(mx[c], __shfl_xor(mx[c], 32)); sq[c] += __shfl_xor(sq[c], 16); sq[c] += __shfl_xor(sq[c], 32); }
    if (lane < 16) {
#pragma unroll
        for (int c = 0; c < 4; ++c) { smax[c4 + c] = mx[c]; ssq[c4 + c] = sq[c]; } }
    __syncthreads();
    int dr[4]; float qs[4];
#pragma unroll
    for (int c = 0; c < 4; ++c) { const int n = c4 + c; float cm = 0.f;
#pragma unroll
        for (int w = 0; w < NWAVES; ++w) cm = fmaxf(cm, ((const LAS float*)(F.lds + w * 16384))[2080 + n]);
        dr[c] = wk_drow(k, nb * 64 + n); qs[c] = 1.0f;
        if (k.ot == 1) qs[c] = cm > 0.f ? 127.0f / cm : 0.f;
        if (k.ot == 2) { const int ex = wk_f8ex(cm); qs[c] = __builtin_bit_cast(float, (unsigned)(127 + ex) << 23); } }
    if (F.tid < 64) { const int n = F.tid; float cm = 0.f, ss = 0.f;
#pragma unroll
        for (int w = 0; w < NWAVES; ++w) { cm = fmaxf(cm, ((const LAS float*)(F.lds + w * 16384))[2080 + n]); ss += ((const LAS float*)(F.lds + w * 16384))[2144 + n]; }
        const int d = wk_drow(k, nb * 64 + n); k.colmax[d] = __float_as_uint(cm); if (k.psq) k.psq[d] = ss;
        if (k.ot == 2) ((int*)(F.ws + WS_SB8))[sbslot * DM + d] = 127 - wk_f8ex(cm); }
    if constexpr (TPW == 2) { wk_tile_out<TPW == 2>(k, kbase, r4, va, dr, qs); wk_tile_out<TPW == 2>(k, kbase + 1, r4, vb, dr, qs); }
    else {
        wk_tile_out<TPW == 2>(k, kbase + 6, r4, va, dr, qs); SCHED_FENCE();
        WK_LOAD(va, kbase + 4); SCHED_FENCE(); wk_tile_out<TPW == 2>(k, kbase + 5, r4, vb, dr, qs); SCHED_FENCE();
#pragma unroll 1
        for (int t = 4; t >= 2; t -= 2) { WK_LOAD(vb, kbase + t - 1); SCHED_FENCE(); wk_tile_out<TPW == 2>(k, kbase + t, r4, va, dr, qs); SCHED_FENCE(); WK_LOAD(va, kbase + t - 2); SCHED_FENCE(); wk_tile_out<TPW == 2>(k, kbase + t - 1, r4, vb, dr, qs); SCHED_FENCE(); }
        wk_tile_out<TPW == 2>(k, kbase, r4, va, dr, qs); }
#undef WK_LOAD
    __syncthreads();
}
__device__ __forceinline__ void wk_super_g(const WK& k, Frame& F, int sbslot, int nb) {
    LAS float* smax = (LAS float*)(F.lds + F.wave * 16384) + 2080; LAS float* ssq = smax + 64;
    const int lane = F.lane, r4 = lane >> 4, c4 = (lane & 15) * 4, nkb = k.K / 64;
    const float* wbase = k.W + (size_t)(16 * r4) * k.ldw + nb * 64 + c4;
#define WK_LOAD(v, kb) do { const float* p_ = wbase + (size_t)((kb) * 64) * k.ldw; _Pragma("unroll") for (int i_ = 0; i_ < 16; ++i_) { v[i_] = *(const f32x4*)p_; p_ += k.ldw; asm volatile("" : "+v"(p_)); } } while (0)
    float mx[4] = {0.f, 0.f, 0.f, 0.f}, sq[4] = {0.f, 0.f, 0.f, 0.f};
    f32x4 va[16];
#pragma unroll 1
    for (int kb = F.wave; kb < nkb; kb += NWAVES) { WK_LOAD(va, kb); wk_tile_stats<false>(k, kb, r4, va, mx, sq); }
#pragma unroll
    for (int c = 0; c < 4; ++c) { mx[c] = fmaxf(mx[c], __shfl_xor(mx[c], 16)); mx[c] = fmaxf(mx[c], __shfl_xor(mx[c], 32)); sq[c] += __shfl_xor(sq[c], 16); sq[c] += __shfl_xor(sq[c], 32); }
    if (lane < 16) {
#pragma unroll
        for (int c = 0; c < 4; ++c) { smax[c4 + c] = mx[c]; ssq[c4 + c] = sq[c]; } }
    __syncthreads();
    int dr[4]; float qs[4];
#pragma unroll
    for (int c = 0; c < 4; ++c) { const int n = c4 + c; float cm = 0.f;
#pragma unroll
        for (int w = 0; w < NWAVES; ++w) cm = fmaxf(cm, ((const LAS float*)(F.lds + w * 16384))[2080 + n]);
        dr[c] = wk_drow(k, nb * 64 + n); const int ex = wk_f8ex(cm); qs[c] = __builtin_bit_cast(float, (unsigned)(127 + ex) << 23); }
    if (F.tid < 64) { const int n = F.tid; float cm = 0.f;
#pragma unroll
        for (int w = 0; w < NWAVES; ++w) cm = fmaxf(cm, ((const LAS float*)(F.lds + w * 16384))[2080 + n]);
        const int d = wk_drow(k, nb * 64 + n); k.colmax[d] = __float_as_uint(cm); ((int*)(F.ws + WS_SB8))[sbslot * DM + d] = 127 - wk_f8ex(cm); }
#pragma unroll 1
    for (int kb = F.wave; kb < nkb; kb += NWAVES) { WK_LOAD(va, kb); wk_tile_out<false>(k, kb, r4, va, dr, qs); }
#undef WK_LOAD
    __syncthreads();
}
constexpr int WQ_TOTAL = NE * (DM / 64) + 2 * NE * (FFE / 64) + 2 * (FFD / 64) + (MK_QKV8 ? 3 * DM / 64 : 0) + (MK_FFN2F8 ? DM / 64 : 0);
__device__ __forceinline__ void wk_convert_super(KArgs ap, Frame& F) {
    volatile LAS unsigned* qw = F.MISC + 16;
    if (F.tid == 0) qw[0] = __hip_atomic_fetch_add(F.ctl + CW_WQ, 1u, __ATOMIC_RELAXED, __HIP_MEMORY_SCOPE_AGENT);
    __syncthreads();
    int it = __builtin_amdgcn_readfirstlane((int)qw[0]);
#pragma unroll 1
    while (it < WQ_TOTAL) {
        unsigned nxt = 0; if (F.tid == 0) nxt = __hip_atomic_fetch_add(F.ctl + CW_WQ, 1u, __ATOMIC_RELAXED, __HIP_MEMORY_SCOPE_AGENT);
        int kind = 6, rem = it, nkb = 16;
        if (!(MK_FFN2F8 && rem < DM / 64)) { if (MK_FFN2F8) rem -= DM / 64;
#pragma unroll 1
            for (kind = NKIND - 1;; --kind) { if (kind == 6) continue; int nn; bool quant; wk_shape(kind, nkb, nn, quant); const int cnt = quant ? nn / 64 : 0; if (rem < cnt) break; rem -= cnt; } }
        { WK k; wk_get(ap, F.ws, kind, k);
          if (kind == 6) wk_super_g(k, F, NE, rem); else if (nkb == 16) wk_super<2>(k, F, kind - 23, rem); else wk_super<7>(k, F, kind - 23, rem); }
        if (F.tid == 0) qw[0] = nxt;
        __syncthreads();
        it = __builtin_amdgcn_readfirstlane((int)qw[0]);
    }
}
__device__ __forceinline__ void wk_convert(KArgs ap, Frame& F, int pass) {
    LAS float* scr = (LAS float*)(F.lds + F.wave * 16384);
    const int gw = F.vcu * NWAVES + F.wave, NGW = F.G * NWAVES;
    int it = gw;
#pragma unroll 1
    for (int kind = 0; kind < NKIND; ++kind) { WK k; wk_get(ap, F.ws, kind, k);
        const bool quant = k.ot != 0;
        if (pass == 0 && quant) { if (MK_SUPER) continue; const int nkb = k.K / 64, nnb = k.N / 256, cnt = nkb * nnb;
            for (; it < cnt; it += NGW) wk_stats_item(k, it % nkb, it / nkb, F.lane);
            it -= cnt; }
        else if ((pass == 0) != quant) { const int nkb = k.K / 64, nnb = k.N / 64, cnt = nkb * nnb;
            int* sb8 = (int*)(F.ws + WS_SB8) + (kind >= 23 ? (kind - 23) * DM : 0);
            for (; it < cnt; it += NGW) wk_item(k, it / nnb, it % nnb, sb8, scr, F.lane);
            it -= cnt; }
    }
}
__device__ __forceinline__ void p0_s5_group(KArgs ap, Frame& F, int g, int qtr) {
    const auto& a = *ap;
    const float* lam_re = (const float*)a.in[I_LAMRE]; const float* lam_im = (const float*)a.in[I_LAMIM]; const float* log_dt = (const float*)a.in[I_LOGDT];
    const float* b_re = (const float*)a.in[I_BRE]; const float* b_im = (const float*)a.in[I_BIM]; const float* c_re = (const float*)a.in[I_CRE]; const float* c_im = (const float*)a.in[I_CIM];
    const float* g0 = (const float*)a.in[I_NORMS];
    LAS float* apr = (LAS float*)F.lds;
    LAS float* api = apr + 17 * 64;
    LAS float* bbr = api + 17 * 64;
    LAS float* bbi = bbr + 1024;
    LAS float* ccr = bbi + 1024;
    LAS float* cci = ccr + 1024;
    LAS float* ktab = cci + 1024;
    const float dt = expf(log_dt[g]);
    for (int idx = F.tid; idx < 17 * 64; idx += NWAVES * 64) { const int l = idx >> 6, p = idx & 63; const float zr = lam_re[g * 64 + p] * dt, zi = lam_im[g * 64 + p] * dt;
        const float mag = expf((float)l * zr); float sn, cs; sincosf((float)l * zi, &sn, &cs); apr[idx] = mag * cs; api[idx] = mag * sn; }
    for (int idx = F.tid; idx < 1024; idx += NWAVES * 64) { const int p = idx >> 4, j = idx & 15; const float lr = lam_re[g * 64 + p], li = lam_im[g * 64 + p]; const float zr = lr * dt, zi = li * dt;
        const float mag = expf(zr); float sn, cs; sincosf(zi, &sn, &cs); const float ar = mag * cs, ai = mag * sn, den = lr * lr + li * li;
        const float cfr = ((ar - 1.0f) * lr + ai * li) / den, cfi = (ai * lr - (ar - 1.0f) * li) / den;
        const float br = b_re[(size_t)(g * 64 + p) * 16 + j], bi = b_im[(size_t)(g * 64 + p) * 16 + j], gn = g0[g * 16 + j];
        bbr[idx] = (cfr * br - cfi * bi) * gn; bbi[idx] = (cfr * bi + cfi * br) * gn;
        ccr[idx] = c_re[(size_t)g * 1024 + idx]; cci[idx] = c_im[(size_t)g * 1024 + idx]; }
    __syncthreads();
    for (int idx0 = F.tid; idx0 < 1024; idx0 += NWAVES * 64) { const int l = idx0 >> 6, i = 4 * qtr + ((idx0 >> 4) & 3), j = idx0 & 15, idx = (l * 16 + i) * 16 + j; float s = 0.f;
        for (int p = 0; p < 64; ++p) { const float cr = ccr[i * 64 + p], ci = cci[i * 64 + p], ar = apr[l * 64 + p], ai = api[l * 64 + p]; const float car = cr * ar - ci * ai, cai = cr * ai + ci * ar; s += car * bbr[p * 16 + j] - cai * bbi[p * 16 + j]; }
        ktab[idx] = s; }
    __syncthreads();
    bf16* btc = (bf16*)(F.ws + WS_BTC) + (size_t)g * 256 * UAK; bf16* bta = (bf16*)(F.ws + WS_BTA) + (size_t)g * 256 * 256;
    for (int pc = F.tid; pc < 64 * 48; pc += NWAVES * 64) { const int nq = pc / 48, k8 = pc % 48, t = nq >> 2, i = 4 * qtr + (nq & 3), n = t * 16 + i; float v[8];
        if (k8 < 32) { const int s = k8 >> 1, j0 = (k8 & 1) * 8;
#pragma unroll
            for (int jj = 0; jj < 8; ++jj) v[jj] = (t >= s) ? ktab[((t - s) * 16 + i) * 16 + j0 + jj] : 0.f; }
        else { const int pb = (k8 - 32) * 8;
#pragma unroll
            for (int jj = 0; jj < 8; ++jj) { const int p = (pb + jj) & 63; const float cr = ccr[i * 64 + p], ci = cci[i * 64 + p], ar = apr[(t + 1) * 64 + p], ai = api[(t + 1) * 64 + p];
                v[jj] = (pb < 64) ? (cr * ar - ci * ai) : -(cr * ai + ci * ar); } }
        v4u o; o.x = pk2(v[0], v[1]); o.y = pk2(v[2], v[3]); o.z = pk2(v[4], v[5]); o.w = pk2(v[6], v[7]);
        *(v4u*)(btc + (size_t)n * UAK + k8 * 8) = o; }
    for (int pc = F.tid; pc < 64 * 32; pc += NWAVES * 64) { const int n = (pc >> 5) * 4 + qtr, k8 = pc & 31, s = k8 >> 1, j0 = (k8 & 1) * 8; float v[8];
        const int p = n & 63, l = 15 - s; const float ar = apr[l * 64 + p], ai = api[l * 64 + p];
#pragma unroll
        for (int jj = 0; jj < 8; ++jj) { const float br = bbr[p * 16 + j0 + jj], bi = bbi[p * 16 + j0 + jj]; v[jj] = (n < 64) ? (ar * br - ai * bi) : ((n < 128) ? (ar * bi + ai * br) : 0.f); }
        v4u o; o.x = pk2(v[0], v[1]); o.y = pk2(v[2], v[3]); o.z = pk2(v[4], v[5]); o.w = pk2(v[6], v[7]);
        *(v4u*)(bta + (size_t)n * 256 + k8 * 8) = o; }
    float* spar = (float*)(F.ws + WS_SPAR) + g * 128;
    if (qtr == 0 && F.tid < 64) { spar[F.tid] = apr[16 * 64 + F.tid]; spar[64 + F.tid] = api[16 * 64 + F.tid]; }
    __syncthreads();
}
__device__ __forceinline__ void p0_chunk_load(const float* x, Frame& F, int ch, f32x4 (&v)[2][4]) {
    const int b = ch >> 7, c = ch & 127;
#pragma unroll
    for (int rr = 0; rr < 2; ++rr) { const int tok = F.wave * 2 + rr; const f32x4* xr = (const f32x4*)(x + (size_t)(b * SEQ + c * CL + tok) * DM) + F.lane;
#pragma unroll
        for (int j = 0; j < 4; ++j) v[rr][j] = xr[64 * j]; }
}
__device__ __forceinline__ void p0_chunk_store(Frame& F, int ch, const f32x4 (&v)[2][4]) {
    const int b = ch >> 7, c = ch & 127; LAS unsigned short* tile = (LAS unsigned short*)F.lds;
#pragma unroll
    for (int rr = 0; rr < 2; ++rr) { const int tok = F.wave * 2 + rr; float s = 0.f;
#pragma unroll
        for (int j = 0; j < 4; ++j) s += (v[rr][j].x * v[rr][j].x + v[rr][j].y * v[rr][j].y) + (v[rr][j].z * v[rr][j].z + v[rr][j].w * v[rr][j].w);
        const float rstd = 1.0f / sqrtf(wave_sum(s) * (1.0f / DM) + NORM_EPS);
#pragma unroll
        for (int j = 0; j < 4; ++j) { v2u w; w.x = pk2(v[rr][j].x * rstd, v[rr][j].y * rstd); w.y = pk2(v[rr][j].z * rstd, v[rr][j].w * rstd); *(LAS v2u*)(tile + tok * 1032 + 4 * F.lane + 256 * j) = w; } }
    __syncthreads();
    bf16* ua = (bf16*)(F.ws + WS_UA);
#pragma unroll
    for (int it = 0; it < 4; ++it) { const int q = it * 512 + F.tid, g = q >> 5, piece = q & 31, tok = piece >> 1, half = piece & 1;
        const v4u w = *(const LAS v4u*)(tile + tok * 1032 + g * 16 + half * 8);
        *(v4u*)(ua + ((size_t)g * GROWS + b * NCH + c) * UAK + tok * 16 + half * 8) = w; }
    __syncthreads();
}
__device__ __forceinline__ void p0_prologue(KArgs ap, Frame& F) {
    const auto& a = *ap;
    const float* norms = (const float*)a.in[I_NORMS];
    for (int task = F.vcu; task < NG * 4; task += F.G) p0_s5_group(ap, F, task >> 2, task & 3);
    { const int gt = F.vcu * (NWAVES * 64) + F.tid, NT = F.G * NWAVES * 64; const int* pos = (const int*)a.in[I_POS]; float* rope = (float*)(F.ws + WS_ROPE);
      for (int idx = gt; idx < NTOK * 16; idx += NT) { const int n = idx >> 4, i = idx & 15; const float inv = 1.0f / powf(500000.0f, (float)i * (1.0f / 16.0f)); const float ang = (float)pos[n] * inv; float sn, cs; sincosf(ang, &sn, &cs); rope[(size_t)n * 32 + i] = cs; rope[(size_t)n * 32 + 16 + i] = sn; }
      const float* wr = (const float*)a.in[I_ROUTER]; float* wro = (float*)(F.ws + WS_WR);
      for (int idx = gt; idx < DM * NE; idx += NT) wro[idx] = wr[idx] * norms[(1 * 4 + 2) * DM + (idx >> 3)]; }
    { const float* x = (const float*)a.in[I_X]; f32x4 va[2][4], vb[2][4]; int ch = F.vcu;
      if (ch < BATCH * NCH) p0_chunk_load(x, F, ch, va);
#pragma unroll 1
      for (; ch < BATCH * NCH; ch += 2 * F.G) {
          const bool h1 = ch + F.G < BATCH * NCH, h2 = ch + 2 * F.G < BATCH * NCH;
          if (h1) p0_chunk_load(x, F, ch + F.G, vb);
          p0_chunk_store(F, ch, va);
          if (h2) p0_chunk_load(x, F, ch + 2 * F.G, va);
          if (h1) p0_chunk_store(F, ch + F.G, vb); } }
    wk_convert(ap, F, 0);
}
__device__ __forceinline__ void expert_act_scale(Frame& F) {
    if (F.vcu < NE + (MK_FFN2F8 ? 1 : 0)) { const int e = F.vcu; const bool dense = e == NE; const float* pq = dense ? (const float*)(F.ws + WS_PSQD) : (const float*)(F.ws + WS_PSQ) + e * 2 * FFE; float m1 = 0.f, m3 = 0.f;
        const int nrow = dense ? 2 * FFD : 2 * FFE;
        for (int i = F.tid; i < nrow; i += NWAVES * 64) { float ss = 0.f;
#pragma unroll
            for (int kc = 0; kc < (MK_SUPER ? 1 : DM / 64); ++kc) ss += pq[(size_t)kc * (NE * 2 * FFE) + i];
            const float v = sqrtf(ss); if ((i >> 7) & 1) m3 = fmaxf(m3, v); else m1 = fmaxf(m1, v); }
#pragma unroll
        for (int o = 1; o < 64; o <<= 1) { m1 = fmaxf(m1, __shfl_xor(m1, o)); m3 = fmaxf(m3, __shfl_xor(m3, o)); }
        LAS float* red = (LAS float*)(F.lds + 8192);
        if (F.lane == 0) { red[F.wave] = m1; red[8 + F.wave] = m3; }
        __syncthreads();
        if (F.tid == 0) { float a1 = 0.f, a3 = 0.f; for (int w = 0; w < NWAVES; ++w) { a1 = fmaxf(a1, red[w]); a3 = fmaxf(a3, red[8 + w]); }
            const float bound = 1.1f * 1024.0f * a1 * a3;
            const int ex = wk_f8ex(bound);
            __hip_atomic_store(F.ctl + CW_EA + e, (unsigned)(127 - ex), __ATOMIC_RELAXED, __HIP_MEMORY_SCOPE_AGENT); }
        __syncthreads(); }
}
__device__ __forceinline__ void s5_scan_local(Frame& F) {
    const float* spar = (const float*)(F.ws + WS_SPAR); const float* sloc = (const float*)(F.ws + WS_SLOC); bf16* ua = (bf16*)(F.ws + WS_UA);
    const int nunits = (NG * 8 - F.bx + F.G - 1) / F.G;
    for (int t = F.wave; t < 2 * nunits; t += NWAVES) { int pm, pn; pg8::tile_of((t >> 1) * F.G + F.bx, NG * 8, 1, pm, pn);
        const int g = pm >> 3, b = (pm & 7) * 2 + (t & 1), p = F.lane;
        const float ar = spar[g * 128 + p], ai = spar[g * 128 + 64 + p]; float sr = 0.f, si = 0.f;
        const size_t row0 = (size_t)g * GROWS + b * NCH;
        constexpr int SB = 16; float l0r[SB], l0i[SB], l1r[SB], l1i[SB];
#define S5_LD(R, I, c0) do { _Pragma("unroll") for (int j = 0; j < SB; ++j) { R[j] = sloc[(row0 + (c0) + j) * 128 + p]; I[j] = sloc[(row0 + (c0) + j) * 128 + 64 + p]; } } while (0)
#define S5_RUN(R, I, c0) do { _Pragma("unroll") for (int j = 0; j < SB; ++j) { ua[(row0 + (c0) + j) * UAK + 256 + p] = (bf16)f2bf(sr); ua[(row0 + (c0) + j) * UAK + 320 + p] = (bf16)f2bf(si); \
            const float nr = ar * sr - ai * si + R[j], ni = ar * si + ai * sr + I[j]; sr = nr; si = ni; } } while (0)
        S5_LD(l0r, l0i, 0);
#pragma unroll 1
        for (int c0 = 0; c0 < NCH; c0 += 2 * SB) {
            S5_LD(l1r, l1i, c0 + SB); __builtin_amdgcn_sched_barrier(0);
            S5_RUN(l0r, l0i, c0); __builtin_amdgcn_sched_barrier(0);
            if (c0 + 2 * SB < NCH) S5_LD(l0r, l0i, c0 + 2 * SB);
            __builtin_amdgcn_sched_barrier(0);
            S5_RUN(l1r, l1i, c0 + SB); __builtin_amdgcn_sched_barrier(0); }
#undef S5_LD
#undef S5_RUN
    }
}
template <bool ROUTE, bool SRC, bool QOUT>
__device__ __forceinline__ void resid_pass(Frame& F, const float* xin, const bf16* xhin, const bf16* mix, int nslots, const float* gain, bf16* xh, const float* rbias) {
    const float* rowss = (const float*)(F.ws + WS_ROWSS); float* rs = (float*)(F.ws + WS_RS);
    LAS int* l_e = (LAS int*)F.lds; LAS float* l_w = (LAS float*)(F.lds + 1024); LAS int* l_cnt = (LAS int*)(F.lds + 2048); LAS int* l_base = (LAS int*)(F.lds + 2048 + 64); LAS float* l_s = (LAS float*)(F.lds + 3072);
    for (int blk = F.vcu; blk < NTOK / 128; blk += F.G) {
        if (ROUTE) { if (F.tid < NE) l_cnt[F.tid] = 0; __syncthreads(); }
        for (int k = 0; k < 16; ++k) { const int row = blk * 128 + F.wave * 16 + k;
            const v4u m0 = *(const v4u*)(mix + (size_t)row * DM + 8 * F.lane), m1 = *(const v4u*)(mix + (size_t)row * DM + 512 + 8 * F.lane);
            float hn[16];
            if (SRC) { const v4u a0 = *(const v4u*)(xhin + (size_t)row * DM + 8 * F.lane), a1 = *(const v4u*)(xhin + (size_t)row * DM + 512 + 8 * F.lane); const float sc = rs[row];
                hn[0] = bf2f(a0.x & 0xffffu) * sc; hn[1] = bf2f(a0.x >> 16) * sc; hn[2] = bf2f(a0.y & 0xffffu) * sc; hn[3] = bf2f(a0.y >> 16) * sc; hn[4] = bf2f(a0.z & 0xffffu) * sc; hn[5] = bf2f(a0.z >> 16) * sc; hn[6] = bf2f(a0.w & 0xffffu) * sc; hn[7] = bf2f(a0.w >> 16) * sc;
                hn[8] = bf2f(a1.x & 0xffffu) * sc; hn[9] = bf2f(a1.x >> 16) * sc; hn[10] = bf2f(a1.y & 0xffffu) * sc; hn[11] = bf2f(a1.y >> 16) * sc; hn[12] = bf2f(a1.z & 0xffffu) * sc; hn[13] = bf2f(a1.z >> 16) * sc; hn[14] = bf2f(a1.w & 0xffffu) * sc; hn[15] = bf2f(a1.w >> 16) * sc; }
            else { const f32x4* hp = (const f32x4*)(xin + (size_t)row * DM); const f32x4 h0 = hp[2 * F.lane], h1 = hp[2 * F.lane + 1], h2 = hp[128 + 2 * F.lane], h3 = hp[128 + 2 * F.lane + 1];
#pragma unroll
                for (int j = 0; j < 4; ++j) { hn[j] = h0[j]; hn[4 + j] = h1[j]; hn[8 + j] = h2[j]; hn[12 + j] = h3[j]; } }
            const f32x4* gp = (const f32x4*)gain; const f32x4 g0 = gp[2 * F.lane], g1 = gp[2 * F.lane + 1], g2 = gp[128 + 2 * F.lane], g3 = gp[128 + 2 * F.lane + 1];
            const float ssm = wave_sum(F.lane < nslots ? rowss[(size_t)row * 32 + F.lane] : 0.f);
            const float rm = 1.0f / sqrtf(ssm * (1.0f / DM) + NORM_EPS);
            hn[0] += bf2f(m0.x & 0xffffu) * rm * g0[0]; hn[1] += bf2f(m0.x >> 16) * rm * g0[1]; hn[2] += bf2f(m0.y & 0xffffu) * rm * g0[2]; hn[3] += bf2f(m0.y >> 16) * rm * g0[3];
            hn[4] += bf2f(m0.z & 0xffffu) * rm * g1[0]; hn[5] += bf2f(m0.z >> 16) * rm * g1[1]; hn[6] += bf2f(m0.w & 0xffffu) * rm * g1[2]; hn[7] += bf2f(m0.w >> 16) * rm * g1[3];
            hn[8] += bf2f(m1.x & 0xffffu) * rm * g2[0]; hn[9] += bf2f(m1.x >> 16) * rm * g2[1]; hn[10] += bf2f(m1.y & 0xffffu) * rm * g2[2]; hn[11] += bf2f(m1.y >> 16) * rm * g2[3];
            hn[12] += bf2f(m1.z & 0xffffu) * rm * g3[0]; hn[13] += bf2f(m1.z >> 16) * rm * g3[1]; hn[14] += bf2f(m1.w & 0xffffu) * rm * g3[2]; hn[15] += bf2f(m1.w >> 16) * rm * g3[3];
            float s2 = 0.f;
#pragma unroll
            for (int j = 0; j < 16; ++j) s2 += hn[j] * hn[j];
            const float ms = wave_sum(s2) * (1.0f / DM) + NORM_EPS; const float rms = sqrtf(ms), rh = 1.0f / rms;
            if (F.lane == 0) rs[row] = rms;
            v4u w0, w1; w0.x = pk2(hn[0] * rh, hn[1] * rh); w0.y = pk2(hn[2] * rh, hn[3] * rh); w0.z = pk2(hn[4] * rh, hn[5] * rh); w0.w = pk2(hn[6] * rh, hn[7] * rh);
            w1.x = pk2(hn[8] * rh, hn[9] * rh); w1.y = pk2(hn[10] * rh, hn[11] * rh); w1.z = pk2(hn[12] * rh, hn[13] * rh); w1.w = pk2(hn[14] * rh, hn[15] * rh);
            *(v4u*)(xh + (size_t)row * DM + 8 * F.lane) = w0; *(v4u*)(xh + (size_t)row * DM + 512 + 8 * F.lane) = w1;
            if (QOUT) {
                { float am = 0.f;
#pragma unroll
                  for (int j = 0; j < 16; ++j) am = fmaxf(am, fabsf(hn[j]));
#pragma unroll
                  for (int o = 1; o < 64; o <<= 1) am = fmaxf(am, __shfl_xor(am, o));
                  am *= rh; const float inv = am > 0.f ? 127.0f / am : 0.f, qs = rh * inv;
                  v2u q0, q1;
                  q0.x = q8x4(hn[0], hn[1], hn[2], hn[3], qs); q0.y = q8x4(hn[4], hn[5], hn[6], hn[7], qs);
                  q1.x = q8x4(hn[8], hn[9], hn[10], hn[11], qs); q1.y = q8x4(hn[12], hn[13], hn[14], hn[15], qs);
                  unsigned char* xq = F.ws + WS_XQ3 + (size_t)row * DM; *(v2u*)(xq + 8 * F.lane) = q0; *(v2u*)(xq + 512 + 8 * F.lane) = q1;
                  if (F.lane == 0) { if (ROUTE) l_s[F.wave * 16 + k] = am * (1.0f / 127.0f); else ((float*)(F.ws + WS_RSC))[row] = am * (1.0f / 127.0f); } }
            }
            if (ROUTE) {
                const float* wr = (const float*)(F.ws + WS_WR); float lg[NE];
#pragma unroll
                for (int e = 0; e < NE; ++e) lg[e] = 0.f;
#pragma unroll
                for (int half = 0; half < 2; ++half)
#pragma unroll
                    for (int j = 0; j < 8; ++j) { const int cc = half * 512 + 8 * F.lane + j; const f32x4 wa = *(const f32x4*)(wr + cc * 8), wb = *(const f32x4*)(wr + cc * 8 + 4); const float xv = hn[half * 8 + j] * rh;
                        lg[0] += xv * wa[0]; lg[1] += xv * wa[1]; lg[2] += xv * wa[2]; lg[3] += xv * wa[3]; lg[4] += xv * wb[0]; lg[5] += xv * wb[1]; lg[6] += xv * wb[2]; lg[7] += xv * wb[3]; }
#pragma unroll
                for (int e = 0; e < NE; ++e) lg[e] = wave_sum(lg[e]) + rbias[e];
                int e0 = 0; float v0 = lg[0];
#pragma unroll
                for (int e = 1; e < NE; ++e) if (lg[e] > v0) { v0 = lg[e]; e0 = e; }
                int e1 = -1; float v1 = -__builtin_inff();
#pragma unroll
                for (int e = 0; e < NE; ++e) if (e != e0 && lg[e] > v1) { v1 = lg[e]; e1 = e; }
                const float w1s = 1.0f / (1.0f + __expf(v0 - v1)), w0s = 1.0f - w1s;
                if (F.lane == 0) { const int ai = (F.wave * 16 + k) * 2; l_e[ai] = e0; l_e[ai + 1] = e1; l_w[ai] = w0s; l_w[ai + 1] = w1s; }
            }
        }
        if (ROUTE) {
            __syncthreads();
            int* list = (int*)(F.ws + WS_LIST); int* slot = (int*)(F.ws + WS_SLOT); float* tokw = (float*)(F.ws + WS_TOKW);
            int e = 0, rank = 0;
            if (F.tid < 256) { e = l_e[F.tid]; rank = atomicAdd((int*)&l_cnt[e], 1); }
            __syncthreads();
            if (F.tid < NE) l_base[F.tid] = (int)__hip_atomic_fetch_add(F.ctl + CW_ECNT + 64 * F.tid, (unsigned)l_cnt[F.tid], __ATOMIC_RELAXED, __HIP_MEMORY_SCOPE_AGENT);
            __syncthreads();
            if (F.tid < 256) { const int pos = l_base[e] + rank, token = blk * 128 + (F.tid >> 1);
                if (pos < LCAP) { list[e * LCAP + pos] = token; ((float*)(F.ws + WS_RSC))[e * LCAP + pos] = l_s[F.tid >> 1]; }
                slot[token * 2 + (F.tid & 1)] = e * LCAP + pos; tokw[token * 2 + (F.tid & 1)] = l_w[F.tid]; }
            __syncthreads();
        }
    }
}
__device__ __forceinline__ void final_pass(Frame& F, float* out, const bf16* xh, const bf16* y, const float* gain) {
    const int gw = F.vcu * NWAVES + F.wave, NGW = F.G * NWAVES;
    etab_build(F.lds, F.ctl);
    const int* slot = (const int*)(F.ws + WS_SLOT); const float* tokw = (const float*)(F.ws + WS_TOKW);
    for (int row = gw; row < NTOK; row += NGW) {
        const int s0 = slot[row * 2], s1 = slot[row * 2 + 1]; const float w0 = tokw[row * 2], w1 = tokw[row * 2 + 1];
        const int e0 = (s0 >> 15) & 7, e1 = (s1 >> 15) & 7; const int ps0 = *(const LAS int*)(F.lds + ET_OFF + 32 + 4 * e0), ps1 = *(const LAS int*)(F.lds + ET_OFF + 32 + 4 * e1);
        const size_t r0 = (size_t)ps0 * 256 + (s0 & (LCAP - 1)), r1 = (size_t)ps1 * 256 + (s1 & (LCAP - 1));
        float f[16];
        if (r0 >= 65536 || r1 >= 65536) {
            const bf16* yp = (const bf16*)(F.ws + WS_YP);
#pragma unroll
            for (int j = 0; j < 16; ++j) f[j] = 0.f;
#pragma unroll 1
            for (int side = 0; side < 2; ++side) { const size_t r = side ? r1 : r0; const float w = side ? w1 : w0; const int nk = r >= 65536 ? KSPLIT : 1;
                for (int kc = 0; kc < nk; ++kc) { const bf16* src = r >= 65536 ? yp + ((size_t)(kc * LPMAX) * 256 + (r - 65536)) * DM : y + r * DM;
#pragma unroll
                    for (int half = 0; half < 2; ++half) { const v4u a = *(const v4u*)(src + half * 512 + 8 * F.lane);
                        f[half * 8 + 0] += w * bf2f(a.x & 0xffffu); f[half * 8 + 1] += w * bf2f(a.x >> 16); f[half * 8 + 2] += w * bf2f(a.y & 0xffffu); f[half * 8 + 3] += w * bf2f(a.y >> 16);
                        f[half * 8 + 4] += w * bf2f(a.z & 0xffffu); f[half * 8 + 5] += w * bf2f(a.z >> 16); f[half * 8 + 6] += w * bf2f(a.w & 0xffffu); f[half * 8 + 7] += w * bf2f(a.w >> 16); } } } }
        else
#pragma unroll
        for (int half = 0; half < 2; ++half) { const v4u a = *(const v4u*)(y + r0 * DM + half * 512 + 8 * F.lane), bq = *(const v4u*)(y + r1 * DM + half * 512 + 8 * F.lane);
            f[half * 8 + 0] = w0 * bf2f(a.x & 0xffffu) + w1 * bf2f(bq.x & 0xffffu); f[half * 8 + 1] = w0 * bf2f(a.x >> 16) + w1 * bf2f(bq.x >> 16);
            f[half * 8 + 2] = w0 * bf2f(a.y & 0xffffu) + w1 * bf2f(bq.y & 0xffffu); f[half * 8 + 3] = w0 * bf2f(a.y >> 16) + w1 * bf2f(bq.y >> 16);
            f[half * 8 + 4] = w0 * bf2f(a.z & 0xffffu) + w1 * bf2f(bq.z & 0xffffu); f[half * 8 + 5] = w0 * bf2f(a.z >> 16) + w1 * bf2f(bq.z >> 16);
            f[half * 8 + 6] = w0 * bf2f(a.w & 0xffffu) + w1 * bf2f(bq.w & 0xffffu); f[half * 8 + 7] = w0 * bf2f(a.w >> 16) + w1 * bf2f(bq.w >> 16); }
        float ss = 0.f;
#pragma unroll
        for (int j = 0; j < 16; ++j) ss += f[j] * f[j];
        const float rf = 1.0f / sqrtf(wave_sum(ss) * (1.0f / DM) + NORM_EPS);
        f32x4* hp = (f32x4*)(out + (size_t)row * DM); const f32x4* gp = (const f32x4*)gain; const float sc = ((const float*)(F.ws + WS_RS))[row];
#pragma unroll
        for (int half = 0; half < 2; ++half) { const v4u a = *(const v4u*)(xh + (size_t)row * DM + half * 512 + 8 * F.lane);
            const float hv[8] = {bf2f(a.x & 0xffffu), bf2f(a.x >> 16), bf2f(a.y & 0xffffu), bf2f(a.y >> 16), bf2f(a.z & 0xffffu), bf2f(a.z >> 16), bf2f(a.w & 0xffffu), bf2f(a.w >> 16)};
#pragma unroll
            for (int q = 0; q < 2; ++q) { const int idx = half * 128 + 2 * F.lane + q; f32x4 h; const f32x4 g = gp[idx];
#pragma unroll
                for (int j = 0; j < 4; ++j) h[j] = hv[q * 4 + j] * sc + f[half * 8 + q * 4 + j] * rf * g[j];
                hp[idx] = h; } }
    }
}

constexpr int N_PHASES = MK_F8 ? 14 : 20;
__global__ void __launch_bounds__(NWAVES * 64, 2) mk_fwd(Args args) {
    extern __shared__ __attribute__((aligned(16))) unsigned char lds_raw[];
    Frame F; refresh(F);
    for (int u = F.tid; u < (LDS_BYTES - LDSCTL_OFF) / 4; u += NWAVES * 64) ((LAS unsigned*)(F.lds + LDSCTL_OFF))[u] = 0u;
    __syncthreads();
    if (F.hi - F.lo > 1) (void)xcd_barrier_post(F.ctl + CW_BAR, F.MISC + 8);
#ifndef MK_ONLY
#define MK_ONLY -1
#endif
#define IN(k) ((MK_ONLY < 0 || (k) == MK_ONLY) && (refresh(F), F.lo <= (k) && (k) < F.hi))
#define SEAM(k) do { refresh(F); if (F.lo <= (k) && (k) + 1 < F.hi) xcd_barrier(frame_bar(F)); } while (0)
#define ws (F.ws)
#define cblk (F.bx)
    if (IN(0)) { p0_prologue(kargs(), F); } SEAM(0);
    if (IN(1)) {
        if (MK_SUPER) wk_convert_super(kargs(), F); else wk_convert(kargs(), F, 1);
        __syncthreads();
        { PlainSched S{(const char*)(ws + WS_UA), (const char*)(ws + WS_BTA), 256, UAK, 256, NG * 8, 1, F.G, cblk, 8, (size_t)256 * 256 * 2};
          EpiS5A E{(float*)(ws + WS_SLOC)};
          pg8::gemm_phase(F.lds, S, E); }
        __builtin_amdgcn_fence(__ATOMIC_ACQUIRE, "agent"); VM_WAIT(); __syncthreads();
        s5_scan_local(F);
        VM_WAIT(); __syncthreads(); __builtin_amdgcn_fence(__ATOMIC_ACQUIRE, "agent"); VM_WAIT(); __syncthreads();
        { KArgs ka = kargs(); PlainSched S{(const char*)(ws + WS_UA), (const char*)(ws + WS_BTC), UAK, UAK, UAK, NG * 8, 1, F.G, cblk, 8, (size_t)256 * UAK * 2};
          EpiS5C E{(const bf16*)(ws + WS_UA), (const float*)ka->in[I_SD], (const float*)ka->in[I_NORMS], (bf16*)(ws + WS_GBUF)};
          pg8::gemm_phase(F.lds, S, E); }
    } SEAM(1);
    if (IN(2)) {
        PlainSched S{(const char*)(ws + WS_GBUF), (const char*)(ws + WS_WGLU), DM, DM, DM, NTOK / 256, 8, F.G, cblk, 1 << 30, 0};
        EpiGated<0> E{(bf16*)(ws + WS_MIX0), DM, (float*)(ws + WS_ROWSS), 0};
        pg8::gemm_phase(F.lds, S, E);
    } SEAM(2);
    if (IN(3)) { KArgs ka = kargs(); resid_pass<false, false, true>(F, (const float*)ka->in[I_X], nullptr, (const bf16*)(ws + WS_MIX0), 32, (const float*)ka->in[I_NORMS] + 1 * DM, (bf16*)(ws + WS_XH1), nullptr);
        expert_act_scale(F); } SEAM(3);
    if (IN(4)) {
        const int sad = MK_FFN2F8 ? (int)__hip_atomic_load(F.ctl + CW_EA + NE, __ATOMIC_RELAXED, __HIP_MEMORY_SCOPE_AGENT) : 127;
        PlainSched S{(const char*)(ws + WS_XQ3), (const char*)(ws + WS_WQF13), DM / 2, DM / 2, DM / 2, NTOK / 256, 2 * FFD / 256, F.G, cblk, 1 << 30, 0, sad};
        EpiGatedI8<MK_FFN2F8 != 0> E{(bf16*)(ws + WS_ACTD), FFD, (const float*)(ws + WS_RSC), (const float*)(ws + WS_COLMAX_F), 0, nullptr};
        pg8::gemm_phase(F.lds, S, E);
    } SEAM(4);
    if (IN(5)) {
#if MK_FFN2F8
        const int sad = (int)__hip_atomic_load(F.ctl + CW_EA + NE, __ATOMIC_RELAXED, __HIP_MEMORY_SCOPE_AGENT);
        PlainSched S{(const char*)(ws + WS_ACTD), (const char*)(ws + WS_WF2), FFD / 2, FFD / 2, FFD / 2, NTOK / 256, DM / 256, F.G, cblk, 1 << 30, 0, sad, (const int*)(ws + WS_SB8) + NE * DM};
        EpiPlain<true, false, 2> E{(bf16*)(ws + WS_F0), DM, (float*)(ws + WS_ROWSS)};
#else
        PlainSched S{(const char*)(ws + WS_ACTD), (const char*)(ws + WS_WF2), FFD, FFD, FFD, NTOK / 256, DM / 256, F.G, cblk, 1 << 30, 0};
        EpiPlain<true, false> E{(bf16*)(ws + WS_F0), DM, (float*)(ws + WS_ROWSS)};
#endif
        pg8::gemm_phase(F.lds, S, E);
    } SEAM(5);
    if (IN(6)) { KArgs ka = kargs(); resid_pass<false, true, MK_QKV8 != 0>(F, nullptr, (const bf16*)(ws + WS_XH1), (const bf16*)(ws + WS_F0), 16, (const float*)ka->in[I_NORMS] + 3 * DM, (bf16*)(ws + WS_XH2), nullptr); } SEAM(6);
    if (IN(7)) {
#if MK_QKV8
        PlainSched S{(const char*)(ws + WS_XQ3), (const char*)(ws + WS_WQQKV), DM / 2, DM / 2, DM / 2, NTOK / 256, 12, F.G, cblk, 1 << 30, 0};
        EpiQKV<true> E{(bf16*)(ws + WS_Q), (const float*)(ws + WS_ROPE), (float*)(ws + WS_KMEAN), (const float*)(ws + WS_RSC), (const float*)(ws + WS_COLMAX_QKV)};
#else
        PlainSched S{(const char*)(ws + WS_XH2), (const char*)(ws + WS_WQKV), DM, DM, DM, NTOK / 256, 12, F.G, cblk, 1 << 30, 0};
        EpiQKV<false> E{(bf16*)(ws + WS_Q), (const float*)(ws + WS_ROPE), (float*)(ws + WS_KMEAN), nullptr, nullptr};
#endif
        pg8::gemm_phase(F.lds, S, E);
    } SEAM(7);
    if (IN(8)) {
        const bf16* Qb = (const bf16*)(ws + WS_Q); const bf16* Kb = (const bf16*)(ws + WS_K); const bf16* Vb = (const bf16*)(ws + WS_V); bf16* Ob = (bf16*)(ws + WS_O); const float* KM = (const float*)(ws + WS_KMEAN);
        const int nitems = (BATCH * NH * 4 - F.vcu + F.G - 1) / F.G, nblocks = 2 * nitems;
        attn::Seam Sm;
#define MK_REF(R, kk) do { const int it_ = F.vcu + ((kk) >> 1) * F.G, bh_ = it_ >> 2, x_ = it_ & 3, qb_ = ((kk) & 1) ? 7 - x_ : x_, b_ = bh_ >> 3, h_ = bh_ & 7; \
        const size_t base_ = (size_t)b_ * SEQ * DM + h_ * HD; R.Q = Qb + base_ + (size_t)qb_ * 256 * DM; R.K = Kb + base_; R.V = Vb + base_; R.O = Ob + base_ + (size_t)qb_ * 256 * DM; R.KM = KM + (size_t)bh_ * NBLK * HD; R.P0 = qb_ * 256; } while (0)
        if (nblocks > 0) {
            attn::BlockRef cur, nxt; MK_REF(cur, 0);
            attn::moba_prime(cur, (char*)lds_raw, Sm);
            for (int kb = 0; kb < nblocks; ++kb) { const int kn = kb + 1 < nblocks ? kb + 1 : kb; MK_REF(nxt, kn); attn::moba_block(cur, nxt, (char*)lds_raw, Sm); cur = nxt; }
        }
#undef MK_REF
    } SEAM(8);
    if (IN(9)) {
        PlainSched S{(const char*)(ws + WS_O), (const char*)(ws + WS_WO), DM, DM, DM, NTOK / 256, DM / 256, F.G, cblk, 1 << 30, 0};
        EpiPlain<true, false> E{(bf16*)(ws + WS_MIX1), DM, (float*)(ws + WS_ROWSS)};
        pg8::gemm_phase(F.lds, S, E);
    } SEAM(9);
    if (IN(10)) { KArgs ka = kargs(); resid_pass<true, true, true>(F, nullptr, (const bf16*)(ws + WS_XH2), (const bf16*)(ws + WS_MIX1), 16, (const float*)ka->in[I_NORMS] + (4 + 1) * DM, (bf16*)(ws + WS_XH3), (const float*)ka->in[I_RBIAS]); } SEAM(10);
#if MK_F8
    if (IN(11)) {
        etab_build(F.lds, F.ctl); int nM = et_ps(F.lds, NE); nM = nM > 264 ? 264 : nM;
        MoeSched1 S{(const char*)(ws + WS_XQ3), (const char*)(ws + WS_WQ13), (const int*)(ws + WS_LIST), DM / 2, DM / 2, nM, 2 * FFE / 256, F.G, cblk, 0, F.lds};
        EpiGatedI8<true> E{(bf16*)(ws + WS_ACTM), FFE, (const float*)(ws + WS_RSC), (const float*)(ws + WS_COLMAX), 2 * FFE, (unsigned char*)kargs()->out};
        pg8::gemm_phase(F.lds, S, E);
    } SEAM(11);
    if (IN(12)) {
        etab_build(F.lds, F.ctl); const int P = et_ps(F.lds, NE); const int nM = P > 256 ? 256 : P; int nLeft = P - 256; nLeft = nLeft < 0 ? 0 : (nLeft > LPMAX ? LPMAX : nLeft);
        { MoeSched2 S{(const char*)(ws + WS_ACTM), (const char*)kargs()->out, (const char*)(ws + WS_W8M2), (const int*)(ws + WS_SB8), FFE / 2, FFE / 2, FFE / 2, nM, DM / 256, F.G, cblk, 0, F.lds};
          EpiPlain<false, true, 2> E{(bf16*)(ws + WS_Y), DM, nullptr};
          pg8::gemm_phase(F.lds, S, E); }
        { MoeSched2K S{(const char*)(ws + WS_ACTM), (const char*)kargs()->out, (const char*)(ws + WS_W8M2), (const int*)(ws + WS_SB8), 256, FFE / 2, FFE / 2, nLeft, F.G, (F.G - 1) - cblk, F.lds};
          EpiPlain<false, true, 2> E{(bf16*)(ws + WS_YP), DM, nullptr};
          pg8::gemm_phase(F.lds, S, E); }
    } SEAM(12);
#else
#pragma unroll
    for (int q = 0; q < 4; ++q) {
        if (IN(11 + 2 * q)) {
            etab_build(F.lds, F.ctl); const int P = et_ps(F.lds, NE); const int p0 = 64 * q; int nM = (q < 3) ? 64 : P - 192; nM = nM > 72 ? 72 : nM; if (p0 + nM > P) nM = P - p0; if (nM < 0) nM = 0;
            MoeSched1 S{(const char*)(ws + WS_XQ3), (const char*)(ws + WS_WQ13), (const int*)(ws + WS_LIST), DM / 2, DM / 2, nM, 2 * FFE / 256, F.G, cblk, p0, F.lds};
            EpiGatedI8<false> E{(bf16*)(ws + WS_ACTM), FFE, (const float*)(ws + WS_RSC), (const float*)(ws + WS_COLMAX), 2 * FFE, nullptr};
            pg8::gemm_phase(F.lds, S, E);
        } SEAM(11 + 2 * q);
        if (IN(12 + 2 * q)) {
            etab_build(F.lds, F.ctl); const int P = et_ps(F.lds, NE); const int p0 = 64 * q; int nM = (q < 3) ? 64 : P - 192; nM = nM > 72 ? 72 : nM; if (p0 + nM > P) nM = P - p0; if (nM < 0) nM = 0;
            MoeSched2B S{(const char*)(ws + WS_ACTM), (const char*)(ws + WS_WM2), FFE, FFE, FFE, nM, DM / 256, F.G, cblk, p0, F.lds};
            EpiPlain<false, true, 0> E{(bf16*)(ws + WS_Y), DM, nullptr};
            pg8::gemm_phase(F.lds, S, E);
        } SEAM(12 + 2 * q);
    }
#endif
    if (IN(N_PHASES - 1)) { KArgs ka = kargs(); final_pass(F, ka->out, (const bf16*)(ws + WS_XH3), (const bf16*)(ws + WS_Y), (const float*)ka->in[I_NORMS] + (4 + 3) * DM); }
#undef IN
#undef SEAM
#undef ws
#undef cblk
}

extern "C" void kernel_launch(void* const* d_in, const int* in_sizes, int n_in, void* d_out, int out_size, void* d_ws, size_t ws_size, hipStream_t stream) {
    static int grid = 0;
    if (grid == 0) {
        if (n_in != 24 || in_sizes[0] != NTOK * DM || out_size != NTOK * DM || ws_size < WS_END) { fprintf(stderr, "kernel_launch: unexpected problem (n_in %d, in0 %d, out %d, ws %zu < %zu)\n", n_in, n_in > 0 ? in_sizes[0] : -1, out_size, ws_size, (size_t)WS_END); grid = -1; return; }
        int dev = 0, cus = 0, per_cu = 0;
        if (hipGetDevice(&dev) != hipSuccess || hipDeviceGetAttribute(&cus, hipDeviceAttributeMultiprocessorCount, dev) != hipSuccess) { grid = -1; return; }
        if (hipFuncSetAttribute((const void*)mk_fwd, hipFuncAttributeMaxDynamicSharedMemorySize, LDS_BYTES) != hipSuccess) { fprintf(stderr, "kernel_launch: hipFuncSetAttribute failed\n"); grid = -1; return; }
        if (hipOccupancyMaxActiveBlocksPerMultiprocessor(&per_cu, (const void*)mk_fwd, NWAVES * 64, LDS_BYTES) != hipSuccess || per_cu < 1) { fprintf(stderr, "kernel_launch: occupancy query says %d blocks per CU\n", per_cu); (void)hipGetLastError(); grid = -1; return; }
        grid = cus;
    }
    if (grid < 0) return;
    if (hipMemsetAsync((char*)d_ws + WS_CTL, 0, ZERO_BYTES, stream) != hipSuccess) return;
    Args a{};
    for (int i = 0; i < 24; ++i) a.in[i] = d_in[i];
    a.out = (float*)d_out; a.ws = (unsigned char*)d_ws;
#if MK_ONE_LAUNCH
    a.ph_lo = 0; a.ph_hi = N_PHASES;
    hipLaunchKernelGGL(mk_fwd, dim3(grid), dim3(NWAVES * 64), LDS_BYTES, stream, a);
#else
    for (int p = 0; p < N_PHASES; ++p) { a.ph_lo = p; a.ph_hi = p + 1; for (int r = 0; r < (((MK_DUP_MASK >> p) & 1u) ? 2 : 1); ++r) hipLaunchKernelGGL(mk_fwd, dim3(grid), dim3(NWAVES * 64), LDS_BYTES, stream, a); }
#endif
}
```

```cpp
#include <hip/hip_runtime.h>
#include <stdio.h>
#include <stdint.h>

#ifndef MK_ONE_LAUNCH
#define MK_ONE_LAUNCH 1
#endif
#ifndef MK_F8
#define MK_F8 1
#endif
#ifndef MK_QKV8
#define MK_QKV8 1
#endif
#ifndef MK_SUPER
#define MK_SUPER 1
#endif
#ifndef MK_FFN2F8
#define MK_FFN2F8 1
#endif
#ifndef MK_MOE_NMAJOR
#define MK_MOE_NMAJOR 1
#endif
#ifndef MK_DUP_MASK
#define MK_DUP_MASK 0u
#endif

#define GAS __attribute__((address_space(1)))
#define LAS __attribute__((address_space(3)))
typedef unsigned short bf16;
typedef unsigned v4u __attribute__((ext_vector_type(4)));
typedef unsigned v2u __attribute__((ext_vector_type(2)));
typedef float f32x2 __attribute__((ext_vector_type(2)));
typedef float f32x4 __attribute__((ext_vector_type(4)));
typedef float f32x16 __attribute__((ext_vector_type(16)));
typedef short bf16x8 __attribute__((ext_vector_type(8)));
typedef short s16x4 __attribute__((ext_vector_type(4)));
typedef int i32x4 __attribute__((ext_vector_type(4)));
typedef int i32x8 __attribute__((ext_vector_type(8)));

constexpr int BATCH = 16, SEQ = 2048, DM = 1024, NTOK = BATCH * SEQ;
constexpr int NG = 64, NP = 64, CL = 16, NCH = SEQ / CL, GROWS = BATCH * NCH, UAK = 384;
constexpr int NH = 8, HD = 128, MBLK = 256, NBLK = SEQ / MBLK;
constexpr int FFD = 2816, NE = 8, FFE = 3584, LCAP = 32768;
constexpr float NORM_EPS = 1e-6f;
constexpr int NWAVES = 8;
constexpr int KSPLIT = 7, LPMAX = 7;
constexpr int ASPLIT = 128;

constexpr size_t MiB = 1u << 20;
constexpr size_t WS_CTL = 0, WS_KMEAN = 1 * MiB, ZERO_BYTES = 2 * MiB;
constexpr size_t WS_ROPE = 2 * MiB, WS_ROWSS = 6 * MiB, WS_LIST = 10 * MiB, WS_SLOT = 11 * MiB, WS_TOKW = WS_SLOT + 256 * 1024, WS_WR = WS_TOKW + 256 * 1024, WS_SPAR = WS_WR + 64 * 1024;
constexpr size_t WS_WQ13 = 13 * MiB, WS_XQ3 = 69 * MiB, WS_RSC = 101 * MiB, WS_WM2 = 125 * MiB;
constexpr size_t WS_COLMAX_F = 1536 * 1024 + 57344 * 4, WS_COLMAX_QKV = WS_COLMAX_F + 5632 * 4, WS_COLMAX_W2 = WS_COLMAX_QKV + 3072 * 4;
constexpr size_t WS_ROWNORM = 12 * MiB + 256 * 1024, WS_SB8 = 12 * MiB + 512 * 1024;
constexpr size_t WS_W8M2 = 125 * MiB, WS_PSQ = 153 * MiB, WS_PSQD = 180 * MiB;
constexpr int CW_EA = 9216;
constexpr size_t WS_WQF13 = 102 * MiB, WS_WQQKV = 108 * MiB;
constexpr size_t WS_COLMAX = 1536 * 1024;
constexpr size_t WS_WGLU = 181 * MiB, WS_WQKV = 185 * MiB, WS_WO = 191 * MiB, WS_WF13 = 193 * MiB, WS_WF2 = 204 * MiB, WS_BTA = 210 * MiB, WS_BTC = 218 * MiB;
constexpr size_t WS_UA = 230 * MiB, WS_SLOC = 326 * MiB, WS_GBUF = 390 * MiB, WS_MIX0 = 454 * MiB;
constexpr size_t WS_XH1 = 210 * MiB, WS_ACTD = 274 * MiB, WS_F0 = 450 * MiB;
constexpr size_t WS_XH2 = 450 * MiB, WS_Q = 230 * MiB, WS_K = 294 * MiB, WS_V = 358 * MiB;
constexpr size_t WS_O = WS_Q;
constexpr size_t WS_RS = 12 * MiB;
constexpr size_t WS_MIX1 = 294 * MiB, WS_XH3 = 450 * MiB;
constexpr size_t WS_Y = 181 * MiB, WS_ACTM = 313 * MiB, WS_YP = 425 * MiB;
constexpr size_t WS_END = 518 * MiB;
constexpr int CW_TMO = 0, CW_BAR = 4096, CW_ECNT = 8192, CW_WQ = 9344;

constexpr int RING_BYTES = 131072, LDSCTL_OFF = RING_BYTES, MISC_OFF = LDSCTL_OFF + 320, IDX_OFF = RING_BYTES + 1024, SCL_OFF = RING_BYTES + 2048, UT_OFF = RING_BYTES + 8192, LDS_BYTES = 147456;

#define LDS_WAIT() asm volatile("s_waitcnt lgkmcnt(0)" ::: "memory")
#define VM_WAIT() asm volatile("s_waitcnt vmcnt(0)" ::: "memory")
__device__ __forceinline__ unsigned f2bf(float f) { unsigned u = __builtin_bit_cast(unsigned, f); return (u + 0x7fffu + ((u >> 16) & 1u)) >> 16; }
__device__ __forceinline__ unsigned pk2(float lo, float hi) { return f2bf(lo) | (f2bf(hi) << 16); }
__device__ __forceinline__ float bf2f(unsigned b) { return __builtin_bit_cast(float, b << 16); }
__device__ __forceinline__ unsigned cvt_pk_bf16(float lo, float hi) { unsigned r; asm volatile("v_cvt_pk_bf16_f32 %0, %1, %2" : "=v"(r) : "v"(lo), "v"(hi)); return r; }
__device__ __forceinline__ float wave_sum(float v) {
#pragma unroll
    for (int o = 1; o < 64; o <<= 1) v += __shfl_xor(v, o);
    return v;
}
__device__ __forceinline__ float fast_sigmoid(float x) { return __builtin_amdgcn_rcpf(1.0f + __builtin_amdgcn_exp2f(-1.4426950408889634f * x)); }

namespace pg8 {
constexpr int BM = 256, BK = 64, HALF = 128, HTB = HALF * BK * 2, NXCD = 8, WGM = 4;
__host__ __device__ __forceinline__ int lds_byte(int r, int c) { const int st = (r >> 4) * 2 + (c >> 5), rr = r & 15, cc = c & 31, ob = rr * 64 + cc * 2; return st * 1024 + (ob ^ (((ob >> 9) & 1) << 5)); }
__host__ __device__ __forceinline__ void stage_rc(int b, int& R, int& C) { const int st = b / 1024, sb = b % 1024, swz = sb ^ (((sb >> 9) & 1) << 5); R = (st >> 1) * 16 + swz / 64; C = (st & 1) * 32 + (swz % 64) / 2; }
__host__ __device__ __forceinline__ int perm32(int rho) { const int n = rho >> 4, i = rho & 15; return 8 * (i >> 2) + 4 * n + (i & 3); }

__device__ __forceinline__ void lane_rc(int i, int& R, int& C) { int t = threadIdx.x; asm volatile("" : "+v"(t)); stage_rc(t * 16 + i * 8192, R, C); }
struct GUnit { int pm, pn, e, aux, rs, sa; };
__device__ __forceinline__ void tile_of(int L, int nM, int nN, int& pm, int& pn) {
    const int nwg = nM * nN; int wgid = L;
    { const int q = nwg / NXCD, r = nwg % NXCD, xcd = wgid % NXCD, off = wgid / NXCD; wgid = (xcd < r ? xcd * (q + 1) : r * (q + 1) + (xcd - r) * q) + off; }
    const int nig = WGM * nN, gid = wgid / nig, fm = gid * WGM, gsz = (nM - fm) < WGM ? (nM - fm) : WGM;
    pm = fm + ((wgid % nig) % gsz); pn = (wgid % nig) / gsz;
}

template <int MM> struct AccSel { typedef f32x4 T; };
template <> struct AccSel<1> { typedef i32x4 T; };
#define V8LO(v) __builtin_shufflevector(v, v, 0, 1, 2, 3)
#define V8HI(v) __builtin_shufflevector(v, v, 4, 5, 6, 7)
template <int MM, class T> __device__ __forceinline__ void mma2(T& acc, const i32x8& b, const i32x8& a, int sb, int sa) {
    if constexpr (MM == 2) asm volatile("v_mfma_scale_f32_16x16x128_f8f6f4 %0, %1, %2, %0, %3, %4 op_sel_hi:[0,0,0]" : "+v"(acc) : "v"(b), "v"(a), "v"(sb), "v"(sa));
    else if constexpr (MM == 1) { acc = __builtin_amdgcn_mfma_i32_16x16x64_i8(V8LO(b), V8LO(a), acc, 0, 0, 0); acc = __builtin_amdgcn_mfma_i32_16x16x64_i8(V8HI(b), V8HI(a), acc, 0, 0, 0); }
    else { acc = __builtin_amdgcn_mfma_f32_16x16x32_bf16(__builtin_bit_cast(bf16x8, V8LO(b)), __builtin_bit_cast(bf16x8, V8LO(a)), acc, 0, 0, 0);
           acc = __builtin_amdgcn_mfma_f32_16x16x32_bf16(__builtin_bit_cast(bf16x8, V8HI(b)), __builtin_bit_cast(bf16x8, V8HI(a)), acc, 0, 0, 0); }
}
template <class Epi, class Sched>
__device__ __forceinline__ void gemm_phase(LAS unsigned char* lds, const Sched& S, const Epi& E) {
    int tid_ = threadIdx.x; asm volatile("" : "+v"(tid_));
    const int tid = tid_, wid = __builtin_amdgcn_readfirstlane(tid >> 6), lane = tid & 63, wr = wid >> 2, wc = wid & 3, fr = lane & 15, fq = lane >> 4;
    const int nt = S.K / BK;
    unsigned voffB[2];
#pragma unroll
    for (int i = 0; i < 2; ++i) { int R, C; stage_rc(tid * 16 + i * 8192, R, C); const int Rb = Epi::PERM ? ((R & ~31) + perm32(R & 31)) : R; voffB[i] = (unsigned)(Rb * S.ldb + C) * 2u; }
    const unsigned kstep = BK * 2u;
    const unsigned hstepB = (unsigned)HALF * S.ldb * 2u;
    const unsigned ldsw = (unsigned)wid * 1024u;
    const int aoff = lds_byte(wr * 64 + fr, fq * 8), boff = lds_byte(wc * 32 + fr, fq * 8);
#define PG8_SA(b, h) (((b) * 2 + (h)) * HTB)
#define PG8_SB(b, h) ((4 + (b) * 2 + (h)) * HTB)
#define PG8_STAGE_A(bufoff, abase, soff, voff) do { const char* _g = (abase) + (unsigned)__builtin_amdgcn_readfirstlane((int)(soff)); asm volatile("" : "+s"(_g)); _Pragma("unroll") for (int _i = 0; _i < 2; ++_i) \
        __builtin_amdgcn_global_load_lds((const unsigned*)(_g + (voff)[_i]), (LAS unsigned*)(lds + (bufoff) + ldsw + _i * 8192), 16, 0, 0); } while (0)
#define PG8_STAGE_B(bufoff, soff) do { const char* _g = S.Bbase + (unsigned)__builtin_amdgcn_readfirstlane((int)(soff)); asm volatile("" : "+s"(_g)); _Pragma("unroll") for (int _i = 0; _i < 2; ++_i) \
        __builtin_amdgcn_global_load_lds((const unsigned*)(_g + voffB[_i]), (LAS unsigned*)(lds + (bufoff) + ldsw + _i * 8192), 16, 0, 0); } while (0)
#define PG8_LDA(dst, b, h) do { _Pragma("unroll") for (int m = 0; m < 4; ++m) dst[m] = __builtin_shufflevector(*(const LAS i32x4*)(lds + PG8_SA(b, h) + aoff + m * 2048), *(const LAS i32x4*)(lds + PG8_SA(b, h) + aoff + m * 2048 + 1024), 0, 1, 2, 3, 4, 5, 6, 7); } while (0)
#define PG8_LDB(dst, b, h) do { _Pragma("unroll") for (int n = 0; n < 2; ++n) dst[n] = __builtin_shufflevector(*(const LAS i32x4*)(lds + PG8_SB(b, h) + boff + n * 2048), *(const LAS i32x4*)(lds + PG8_SB(b, h) + boff + n * 2048 + 1024), 0, 1, 2, 3, 4, 5, 6, 7); } while (0)
#define PG8_MMA(ai, bj, At, Bt) do { __builtin_amdgcn_s_setprio(1); _Pragma("unroll") for (int m = 0; m < 4; ++m) _Pragma("unroll") for (int n = 0; n < 2; ++n) \
        mma2<Epi::MM>(acc[ai][bj][m][n], Bt[n], At[m], fsb[bj][n], fsa); __builtin_amdgcn_s_setprio(0); } while (0)
#define PG8_WAIT_V(n) asm volatile("s_waitcnt vmcnt(" #n ")" ::: "memory")
#define PG8_WAIT_L(n) asm volatile("s_waitcnt lgkmcnt(" #n ")" ::: "memory")
#define PG8_BAR __builtin_amdgcn_s_barrier()
#define PG8_SCHED __builtin_amdgcn_sched_barrier(0)
    if (wid == 0) { GUnit u; const bool ok = S.next(lane, u); LAS int* tb = (LAS int*)(lds + UT_OFF) + lane * 8;
        tb[0] = ok ? u.pm : -1; tb[1] = u.pn; tb[2] = u.e; tb[3] = u.aux; tb[4] = u.rs; tb[5] = u.sa; tb[6] = ok ? (int)S.b_off(u) : 0; tb[7] = ok ? (int)S.a_tile(u) : 0; }
    asm volatile("s_waitcnt lgkmcnt(0)" ::: "memory"); __syncthreads();
#define PG8_UNIT(i, u, bo, ao, ok) do { const LAS int* tb_ = (const LAS int*)(lds + UT_OFF) + ((i) & 63) * 8; \
        u.pm = __builtin_amdgcn_readfirstlane(tb_[0]); u.pn = __builtin_amdgcn_readfirstlane(tb_[1]); u.e = __builtin_amdgcn_readfirstlane(tb_[2]); u.aux = __builtin_amdgcn_readfirstlane(tb_[3]); \
        u.rs = __builtin_amdgcn_readfirstlane(tb_[4]); u.sa = __builtin_amdgcn_readfirstlane(tb_[5]); bo = (unsigned)__builtin_amdgcn_readfirstlane(tb_[6]); ao = (unsigned)__builtin_amdgcn_readfirstlane(tb_[7]); \
        ok = (i) < 64 && u.pm >= 0; } while (0)
    GUnit cur, nxt; int ui = 0; unsigned cB, cA, nB, nA; bool ok0;
    PG8_UNIT(0, cur, cB, cA, ok0);
    if (!ok0) return;
    const char* cAp = S.a_base(cur); const char* nAp = cAp;
    typedef typename AccSel<Epi::MM>::T AccT;
    int fsa = 127, fsb[2][2] = {{127, 127}, {127, 127}};
    AccT acc[2][2][4][2];
#pragma unroll
    for (int a = 0; a < 2; ++a)
#pragma unroll
        for (int b = 0; b < 2; ++b)
#pragma unroll
            for (int m = 0; m < 4; ++m)
#pragma unroll
                for (int n = 0; n < 2; ++n) acc[a][b][m][n] = AccT{};
    i32x8 At[4], B0[2], B1[2];
    unsigned oC[2][2], oN[2][2];
    if constexpr (Sched::GATHER) { S.a_off_first(cur, oC);
#pragma unroll
        for (int h = 0; h < 2; ++h)
#pragma unroll
            for (int i = 0; i < 2; ++i) oN[h][i] = oC[h][i]; }
    else { GUnit z; z.pm = 0; z.pn = 0; z.e = 0; z.aux = 0; z.rs = 0; z.sa = 127; S.a_off_first(z, oC);
#pragma unroll
        for (int h = 0; h < 2; ++h)
#pragma unroll
            for (int i = 0; i < 2; ++i) oN[h][i] = oC[h][i]; }
    if constexpr (Epi::MM == 2) S.f8_scales(cur, wc, fr, fsa, fsb);
    if constexpr (Epi::LDSS) E.prefetch_scales(cur, 0, lds);
    PG8_STAGE_B(PG8_SB(0, 0), cB); PG8_STAGE_B(PG8_SB(0, 1), cB + hstepB); PG8_STAGE_A(PG8_SA(0, 0), cAp, cA, oC[0]); PG8_STAGE_A(PG8_SA(0, 1), cAp, cA, oC[1]);
    if (wr == 1) PG8_BAR;
    PG8_WAIT_V(2); PG8_BAR;
    PG8_STAGE_B(PG8_SB(1, 0), cB + kstep); PG8_STAGE_A(PG8_SA(1, 0), cAp, cA + kstep, oC[0]); PG8_STAGE_B(PG8_SB(1, 1), cB + hstepB + kstep);
    PG8_WAIT_V(6); PG8_BAR;
    for (;;) {
        bool has_next; PG8_UNIT(ui + 1, nxt, nB, nA, has_next);
        if (!has_next) { nB = cB; nA = cA; nAp = cAp; } else nAp = S.a_base(nxt);
        if (has_next) S.prefetch(nxt, lds);
        if constexpr (Epi::LDSS) { if (has_next) E.prefetch_scales(nxt, (ui + 1) % 3, lds); }
        for (int t = 0; t < nt; t += 2) {
            const bool last = (t == nt - 2);
            const unsigned a1 = cA + (unsigned)(t + 1) * kstep;
            const unsigned a2 = last ? nA : cA + (unsigned)(t + 2) * kstep, b2 = last ? nB : cB + (unsigned)(t + 2) * kstep;
            const unsigned a3 = a2 + kstep, b3 = b2 + kstep; const char* const ap2 = last ? nAp : cAp;
            if constexpr (Sched::GATHER) { if (last && has_next) S.a_off_next(nxt, oN, lds); }
            PG8_LDB(B0, 0, 0); PG8_LDB(B1, 0, 1); PG8_SCHED; PG8_LDA(At, 0, 0); PG8_STAGE_A(PG8_SA(1, 1), cAp, a1, oC[1]);
            PG8_WAIT_V(8); PG8_WAIT_L(0); PG8_BAR; PG8_MMA(0, 0, At, B0); PG8_MMA(0, 1, At, B1); PG8_BAR; PG8_SCHED;
            PG8_LDA(At, 0, 1); PG8_STAGE_B(PG8_SB(0, 0), b2); PG8_STAGE_B(PG8_SB(0, 1), b2 + hstepB); PG8_STAGE_A(PG8_SA(0, 0), ap2, a2, oN[0]);
            PG8_WAIT_V(8); PG8_WAIT_L(0); PG8_BAR; PG8_MMA(1, 0, At, B0); PG8_MMA(1, 1, At, B1); PG8_BAR; PG8_SCHED;
            PG8_LDB(B0, 1, 0); PG8_LDB(B1, 1, 1); PG8_SCHED; PG8_LDA(At, 1, 0); PG8_STAGE_A(PG8_SA(0, 1), ap2, a2, oN[1]);
            PG8_WAIT_V(8); PG8_WAIT_L(0); PG8_BAR; PG8_MMA(0, 0, At, B0); PG8_MMA(0, 1, At, B1); PG8_BAR; PG8_SCHED;
            PG8_LDA(At, 1, 1); PG8_STAGE_B(PG8_SB(1, 0), b3); PG8_STAGE_B(PG8_SB(1, 1), b3 + hstepB); PG8_STAGE_A(PG8_SA(1, 0), ap2, a3, oN[0]);
            PG8_WAIT_V(8); PG8_WAIT_L(0); PG8_BAR; PG8_MMA(1, 0, At, B0); PG8_MMA(1, 1, At, B1); PG8_BAR; PG8_SCHED;
        }
        if (wr == 0) PG8_BAR;
        if constexpr (Epi::MM == 2) asm volatile("s_nop 15\n\ts_nop 15" ::: "memory");
        if constexpr (Epi::LDSS) E(acc, cur, wr, wc, fr, fq, lds + SCL_OFF + (ui % 3) * 2048); else E(acc, cur, wr, wc, fr, fq);
        if (!has_next) break;
#pragma unroll
        for (int a = 0; a < 2; ++a)
#pragma unroll
            for (int b = 0; b < 2; ++b)
#pragma unroll
                for (int m = 0; m < 4; ++m)
#pragma unroll
                    for (int n = 0; n < 2; ++n) acc[a][b][m][n] = AccT{};
        cur = nxt; cB = nB; cA = nA; cAp = nAp; ++ui;
        if constexpr (Epi::MM == 2) S.f8_scales(cur, wc, fr, fsa, fsb);
        if constexpr (Sched::GATHER) {
#pragma unroll
        for (int h = 0; h < 2; ++h)
#pragma unroll
            for (int i = 0; i < 2; ++i) oC[h][i] = oN[h][i]; }
        if (wr == 1) PG8_BAR;
    }
    PG8_WAIT_V(0);
    PG8_BAR;
#undef PG8_UNIT
#undef PG8_SA
#undef PG8_SB
#undef PG8_STAGE_A
#undef PG8_STAGE_B
#undef PG8_LDA
#undef PG8_LDB
#undef PG8_MMA
#undef PG8_WAIT_V
#undef PG8_WAIT_L
#undef PG8_BAR
#undef PG8_SCHED
}
}

using pg8::GUnit;
struct PlainSched {
    static constexpr bool GATHER = false;
    __device__ __forceinline__ const char* a_base(const GUnit&) const { return Abase; }
    __device__ __forceinline__ unsigned a_tile(const GUnit& u) const { return (unsigned)(u.pm * 256 * lda) * 2u; }
    const char* Abase; const char* Bbase; int K, lda, ldb, nM, nN, G, c, pmdiv; size_t bstride; int sa = 127; const int* sb8 = nullptr;
    __device__ __forceinline__ bool next(int i, GUnit& u) const { const long L = (long)i * G + c; if (L >= (long)nM * nN) return false; pg8::tile_of((int)L, nM, nN, u.pm, u.pn); u.e = u.pm / pmdiv; u.aux = u.pm; u.rs = u.pm * 256; u.sa = sa; return true; }
    __device__ __forceinline__ void f8_scales(const GUnit& u, int wc, int fr, int& sa_, int (&sb)[2][2]) const { sa_ = u.sa;
#pragma unroll
        for (int bj = 0; bj < 2; ++bj)
#pragma unroll
            for (int n = 0; n < 2; ++n) sb[bj][n] = sb8[u.pn * 256 + bj * 128 + wc * 32 + pg8::perm32(n * 16 + fr)]; }
    __device__ __forceinline__ void a_off_first(const GUnit& u, unsigned (&off)[2][2]) const { int R[2], C[2]; pg8::lane_rc(0, R[0], C[0]); pg8::lane_rc(1, R[1], C[1]);
#pragma unroll
        for (int h = 0; h < 2; ++h)
#pragma unroll
            for (int i = 0; i < 2; ++i) off[h][i] = (unsigned)((u.pm * 256 + h * 128 + R[i]) * lda + C[i]) * 2u; }
    __device__ __forceinline__ void a_off_next(const GUnit& u, unsigned (&off)[2][2], LAS unsigned char*) const { a_off_first(u, off); }
    __device__ __forceinline__ void prefetch(const GUnit&, LAS unsigned char*) const {}
    __device__ __forceinline__ unsigned b_off(const GUnit& u) const { return (unsigned)((size_t)u.e * bstride + (size_t)u.pn * 256 * ldb * 2); }
};
constexpr int ET_OFF = RING_BYTES + 512;
__device__ __forceinline__ void etab_build(LAS unsigned char* lds, const unsigned* ctl) {
    if (threadIdx.x < 64) { const int l = threadIdx.x & 63; int v = 0;
        if (l < NE) { v = (int)__hip_atomic_load(ctl + CW_ECNT + 64 * l, __ATOMIC_RELAXED, __HIP_MEMORY_SCOPE_AGENT); v = v < 0 ? 0 : (v > LCAP ? LCAP : v); }
        else if (l < 2 * NE) v = (int)__hip_atomic_load(ctl + CW_EA + (l - NE), __ATOMIC_RELAXED, __HIP_MEMORY_SCOPE_AGENT);
        int np = (l < NE) ? ((v + 255) >> 8) : 0, ps = np;
#pragma unroll
        for (int o = 1; o < NE; o <<= 1) { const int t = __shfl_up(ps, o); if (l >= o) ps += t; }
        if (l < NE) { *(LAS int*)(lds + ET_OFF + 4 * l) = v; *(LAS int*)(lds + ET_OFF + 32 + 4 * l) = ps - np; if (l == NE - 1) *(LAS int*)(lds + ET_OFF + 32 + 4 * NE) = ps; }
        else if (l < 2 * NE) *(LAS int*)(lds + ET_OFF + 72 + 4 * (l - NE)) = v; }
    __syncthreads();
}
__device__ __forceinline__ int et_cnt(LAS unsigned char* lds, int e) { return __builtin_amdgcn_readfirstlane(*(const LAS int*)(lds + ET_OFF + 4 * e)); }
__device__ __forceinline__ int et_ps(LAS unsigned char* lds, int e) { return __builtin_amdgcn_readfirstlane(*(const LAS int*)(lds + ET_OFF + 32 + 4 * e)); }
__device__ __forceinline__ int et_sa(LAS unsigned char* lds, int e) { return __builtin_amdgcn_readfirstlane(*(const LAS int*)(lds + ET_OFF + 72 + 4 * e)); }
__device__ __forceinline__ int et_ps_l(LAS unsigned char* lds, int e) { return *(const LAS int*)(lds + ET_OFF + 32 + 4 * e); }
__device__ __forceinline__ int et_sa_l(LAS unsigned char* lds, int e) { return *(const LAS int*)(lds + ET_OFF + 72 + 4 * e); }
__device__ __forceinline__ int et_expert(LAS unsigned char* lds, int p) { int e = 0;
#pragma unroll
    for (int k = 1; k < NE; ++k) e += (p >= et_ps_l(lds, k)) ? 1 : 0;
    return e; }
struct MoeSched1 {
    static constexpr bool GATHER = true;
    __device__ __forceinline__ const char* a_base(const GUnit&) const { return Abase; }
    __device__ __forceinline__ unsigned a_tile(const GUnit&) const { return 0u; }
    const char* Abase; const char* Bbase; const int* list; int K, ldb, nM, nN, G, c, p0; LAS unsigned char* EL;
    __device__ __forceinline__ bool next(int i, GUnit& u) const { const long L = (long)i * G + c; if (L >= (long)nM * nN) return false; if (MK_MOE_NMAJOR) pg8::tile_of((int)L, nN, nM, u.pn, u.pm); else pg8::tile_of((int)L, nM, nN, u.pm, u.pn); u.aux = p0 + u.pm; u.e = et_expert(EL, u.aux); u.rs = u.e * LCAP + (u.aux - et_ps_l(EL, u.e)) * 256; u.sa = et_sa_l(EL, u.e); return true; }
    __device__ __forceinline__ void a_off_first(const GUnit& u, unsigned (&off)[2][2]) const { int R[2], C[2]; pg8::lane_rc(0, R[0], C[0]); pg8::lane_rc(1, R[1], C[1]);
        const int cn = et_cnt(EL, u.e), ps = et_ps(EL, u.e);
        const int lp = (u.aux - ps) * 256;
#pragma unroll
        for (int h = 0; h < 2; ++h)
#pragma unroll
            for (int i = 0; i < 2; ++i) { const int pos = lp + h * 128 + R[i]; int tok = list[u.e * LCAP + (pos < LCAP ? pos : 0)]; tok = (pos < cn) ? tok : 0; tok = ((unsigned)tok < (unsigned)NTOK) ? tok : 0; off[h][i] = (unsigned)(tok * K + C[i]) * 2u; } }
    __device__ __forceinline__ void prefetch(const GUnit& u, LAS unsigned char* lds) const {
        const int wid = __builtin_amdgcn_readfirstlane(threadIdx.x >> 6), lane = threadIdx.x & 63;
        if (wid < 4) { const int ps = et_ps(EL, u.e);
            const int pos = (u.aux - ps) * 256 + wid * 64 + lane;
            __builtin_amdgcn_global_load_lds((const unsigned*)(list + u.e * LCAP + (pos < LCAP ? pos : 0)), (LAS unsigned*)(lds + IDX_OFF + wid * 256), 4, 0, 0); } }
    __device__ __forceinline__ void a_off_next(const GUnit& u, unsigned (&off)[2][2], LAS unsigned char* lds) const { int R[2], C[2]; pg8::lane_rc(0, R[0], C[0]); pg8::lane_rc(1, R[1], C[1]);
        const int cn = et_cnt(EL, u.e), ps = et_ps(EL, u.e);
        const int lp = (u.aux - ps) * 256;
#pragma unroll
        for (int h = 0; h < 2; ++h)
#pragma unroll
            for (int i = 0; i < 2; ++i) { const int rr = h * 128 + R[i]; int tok = *(const LAS int*)(lds + IDX_OFF + rr * 4); tok = (lp + rr < cn) ? tok : 0; tok = ((unsigned)tok < (unsigned)NTOK) ? tok : 0; off[h][i] = (unsigned)(tok * K + C[i]) * 2u; } }
    __device__ __forceinline__ unsigned b_off(const GUnit& u) const { return (unsigned)((size_t)u.e * ((size_t)2 * FFE * DM) + (size_t)u.pn * 256 * ldb * 2); }
};
struct MoeSched2 {
    static constexpr bool GATHER = false;
    __device__ __forceinline__ const char* a_base(const GUnit& u) const { return u.pm < ASPLIT ? Abase : Abase2; }
    __device__ __forceinline__ unsigned a_tile(const GUnit& u) const { return (unsigned)((u.pm < ASPLIT ? u.pm : u.pm - ASPLIT) * 256 * lda) * 2u; }
    const char* Abase; const char* Abase2; const char* Bbase; const int* sb8; int K, lda, ldb, nM, nN, G, c, p0; LAS unsigned char* EL;
    __device__ __forceinline__ bool next(int i, GUnit& u) const { const long L = (long)i * G + c; if (L >= (long)nM * nN) return false; pg8::tile_of((int)L, nM, nN, u.pm, u.pn); u.aux = p0 + u.pm; u.e = et_expert(EL, u.aux); u.rs = 0; u.sa = et_sa_l(EL, u.e); return true; }
    __device__ __forceinline__ void a_off_first(const GUnit& u, unsigned (&off)[2][2]) const { int R[2], C[2]; pg8::lane_rc(0, R[0], C[0]); pg8::lane_rc(1, R[1], C[1]);
#pragma unroll
        for (int h = 0; h < 2; ++h)
#pragma unroll
            for (int i = 0; i < 2; ++i) off[h][i] = (unsigned)((u.pm * 256 + h * 128 + R[i]) * lda + C[i]) * 2u; }
    __device__ __forceinline__ void a_off_next(const GUnit& u, unsigned (&off)[2][2], LAS unsigned char*) const { a_off_first(u, off); }
    __device__ __forceinline__ void prefetch(const GUnit&, LAS unsigned char*) const {}
    __device__ __forceinline__ unsigned b_off(const GUnit& u) const { return (unsigned)((size_t)u.e * ((size_t)DM * FFE) + (size_t)u.pn * 256 * ldb * 2); }
    __device__ __forceinline__ void f8_scales(const GUnit& u, int wc, int fr, int& sa, int (&sb)[2][2]) const { sa = u.sa;
#pragma unroll
        for (int bj = 0; bj < 2; ++bj)
#pragma unroll
            for (int n = 0; n < 2; ++n) sb[bj][n] = sb8[u.e * DM + u.pn * 256 + bj * 128 + wc * 32 + pg8::perm32(n * 16 + fr)]; }
};

struct MoeSched2K {
    static constexpr bool GATHER = false;
    __device__ __forceinline__ const char* a_base(const GUnit& u) const { return u.pm < ASPLIT ? Abase : Abase2; }
    __device__ __forceinline__ unsigned a_tile(const GUnit& u) const { return (unsigned)((u.pm < ASPLIT ? u.pm : u.pm - ASPLIT) * 256 * lda) * 2u + (unsigned)u.rs * 512u; }
    const char* Abase; const char* Abase2; const char* Bbase; const int* sb8; int K, lda, ldb, nLeft, G, c; LAS unsigned char* EL;
    __device__ __forceinline__ bool next(int i, GUnit& u) const { const long L = (long)i * G + c; if (L >= (long)nLeft * 4 * KSPLIT) return false; const int kc = (int)(L % KSPLIT), t = (int)(L / KSPLIT), lp = t >> 2;
        u.pn = t & 3; u.pm = 256 + lp; u.rs = kc; u.aux = kc * LPMAX + lp; u.e = et_expert(EL, u.pm); u.sa = et_sa_l(EL, u.e); return true; }
    __device__ __forceinline__ void a_off_first(const GUnit& u, unsigned (&off)[2][2]) const { int R[2], C[2]; pg8::lane_rc(0, R[0], C[0]); pg8::lane_rc(1, R[1], C[1]);
#pragma unroll
        for (int h = 0; h < 2; ++h)
#pragma unroll
            for (int i = 0; i < 2; ++i) off[h][i] = (unsigned)((u.pm * 256 + h * 128 + R[i]) * lda + C[i]) * 2u; }
    __device__ __forceinline__ void a_off_next(const GUnit& u, unsigned (&off)[2][2], LAS unsigned char*) const { a_off_first(u, off); }
    __device__ __forceinline__ void prefetch(const GUnit&, LAS unsigned char*) const {}
    __device__ __forceinline__ unsigned b_off(const GUnit& u) const { return (unsigned)((size_t)u.e * ((size_t)DM * FFE) + (size_t)u.pn * 256 * ldb * 2) + (unsigned)u.rs * 512u; }
    __device__ __forceinline__ void f8_scales(const GUnit& u, int wc, int fr, int& sa, int (&sb)[2][2]) const { sa = u.sa;
#pragma unroll
        for (int bj = 0; bj < 2; ++bj)
#pragma unroll
            for (int n = 0; n < 2; ++n) sb[bj][n] = sb8[u.e * DM + u.pn * 256 + bj * 128 + wc * 32 + pg8::perm32(n * 16 + fr)]; }
};

struct MoeSched2B {
    static constexpr bool GATHER = false;
    __device__ __forceinline__ const char* a_base(const GUnit&) const { return Abase; }
    __device__ __forceinline__ unsigned a_tile(const GUnit& u) const { return (unsigned)(u.pm * 256 * lda) * 2u; }
    const char* Abase; const char* Bbase; int K, lda, ldb, nM, nN, G, c, p0; LAS unsigned char* EL;
    __device__ __forceinline__ bool next(int i, GUnit& u) const { const long L = (long)i * G + c; if (L >= (long)nM * nN) return false; pg8::tile_of((int)L, nM, nN, u.pm, u.pn); u.aux = p0 + u.pm; u.e = et_expert(EL, u.aux); u.rs = 0; u.sa = 127; return true; }
    __device__ __forceinline__ void a_off_first(const GUnit& u, unsigned (&off)[2][2]) const { int R[2], C[2]; pg8::lane_rc(0, R[0], C[0]); pg8::lane_rc(1, R[1], C[1]);
#pragma unroll
        for (int h = 0; h < 2; ++h)
#pragma unroll
            for (int i = 0; i < 2; ++i) off[h][i] = (unsigned)((u.pm * 256 + h * 128 + R[i]) * lda + C[i]) * 2u; }
    __device__ __forceinline__ void a_off_next(const GUnit& u, unsigned (&off)[2][2], LAS unsigned char*) const { a_off_first(u, off); }
    __device__ __forceinline__ void prefetch(const GUnit&, LAS unsigned char*) const {}
    __device__ __forceinline__ unsigned b_off(const GUnit& u) const { return (unsigned)((size_t)u.e * ((size_t)DM * FFE * 2) + (size_t)u.pn * 256 * ldb * 2); }
};

typedef const f32x4 (&AccRef)[2][2][4][2];
struct EpiS5A { static constexpr bool PERM = false, LDSS = false; static constexpr int MM = 0; float* sloc;
    __device__ __forceinline__ void operator()(AccRef acc, const GUnit& u, int wr, int wc, int fr, int fq) const {
        float* base = sloc + (size_t)(u.pm * 256 + wr * 64 + fr) * 128 + wc * 32 + 4 * fq;
#pragma unroll
        for (int ai = 0; ai < 2; ++ai)
#pragma unroll
            for (int m = 0; m < 4; ++m)
#pragma unroll
                for (int n = 0; n < 2; ++n) *(f32x4*)(base + (size_t)(ai * 128 + m * 16) * 128 + n * 16) = acc[ai][0][m][n]; } };
struct EpiS5C { static constexpr bool PERM = true, LDSS = false; static constexpr int MM = 0; const bf16* ua; const float* dsk; const float* g0; bf16* gbuf;
    __device__ __forceinline__ void operator()(AccRef acc, const GUnit& u, int wr, int wc, int fr, int fq) const {
        const int g = u.pm >> 3, i0 = 8 * (fq & 1);
        f32x4 d0 = *(const f32x4*)(dsk + g * 16 + i0) * *(const f32x4*)(g0 + g * 16 + i0), d1 = *(const f32x4*)(dsk + g * 16 + i0 + 4) * *(const f32x4*)(g0 + g * 16 + i0 + 4);
#pragma unroll
        for (int ai = 0; ai < 2; ++ai)
#pragma unroll
            for (int m = 0; m < 4; ++m) { const int r = ai * 128 + wr * 64 + m * 16 + fr, rowg = (u.pm & 7) * 256 + r, b = rowg >> 7, c = rowg & 127;
#pragma unroll
                for (int bj = 0; bj < 2; ++bj) { const int col = 128 * bj + 32 * wc + 8 * fq, t = col >> 4;
                    const v4u uu = *(const v4u*)(ua + (size_t)(u.pm * 256 + r) * UAK + col);
                    f32x4 y0 = acc[ai][bj][m][0], y1 = acc[ai][bj][m][1];
                    y0[0] += d0[0] * bf2f(uu.x & 0xffffu); y0[1] += d0[1] * bf2f(uu.x >> 16); y0[2] += d0[2] * bf2f(uu.y & 0xffffu); y0[3] += d0[3] * bf2f(uu.y >> 16);
                    y1[0] += d1[0] * bf2f(uu.z & 0xffffu); y1[1] += d1[1] * bf2f(uu.z >> 16); y1[2] += d1[2] * bf2f(uu.w & 0xffffu); y1[3] += d1[3] * bf2f(uu.w >> 16);
#pragma unroll
                    for (int k = 0; k < 4; ++k) { const float a = y0[k], bq = y1[k]; y0[k] = a * fast_sigmoid(1.5957691216f * (a + 0.044715f * a * a * a)); y1[k] = bq * fast_sigmoid(1.5957691216f * (bq + 0.044715f * bq * bq * bq)); }
                    v4u w; w.x = cvt_pk_bf16(y0[0], y0[1]); w.y = cvt_pk_bf16(y0[2], y0[3]); w.z = cvt_pk_bf16(y1[0], y1[1]); w.w = cvt_pk_bf16(y1[2], y1[3]);
                    *(v4u*)(gbuf + (size_t)(b * SEQ + c * CL + t) * DM + g * 16 + i0) = w; }
                asm volatile("" ::: "memory"); } } };
template <int MODE> struct EpiGated { static constexpr bool PERM = true, LDSS = false; static constexpr int MM = 0; bf16* out; int ldc; float* rowss; int rowsel;
    __device__ __forceinline__ void operator()(AccRef acc, const GUnit& u, int wr, int wc, int fr, int fq) const {
#pragma unroll
        for (int ai = 0; ai < 2; ++ai)
#pragma unroll
            for (int m = 0; m < 4; ++m) { const int row = u.pm * 256 + ai * 128 + wr * 64 + m * 16 + fr; float o[8]; float ss = 0.f;
#pragma unroll
                for (int n = 0; n < 2; ++n)
#pragma unroll
                    for (int k = 0; k < 4; ++k) { const float a = acc[ai][0][m][n][k], bq = acc[ai][1][m][n][k]; const float v = (MODE == 0) ? a * fast_sigmoid(bq) : a * fast_sigmoid(a) * bq; o[n * 4 + k] = v; ss += v * v; }
                v4u w; w.x = cvt_pk_bf16(o[0], o[1]); w.y = cvt_pk_bf16(o[2], o[3]); w.z = cvt_pk_bf16(o[4], o[5]); w.w = cvt_pk_bf16(o[6], o[7]);
                *(v4u*)(out + (size_t)row * ldc + u.pn * 128 + wc * 32 + fq * 8) = w;
                if (MODE == 0) { ss += __shfl_xor(ss, 16); ss += __shfl_xor(ss, 32); if (fq == 0) rowss[(size_t)row * 32 + u.pn * 4 + wc] = ss; } } } };
__device__ __forceinline__ void scales_to_lds(const float* rs256, const float* cm256, int buf, LAS unsigned char* lds) {
    const int wid = __builtin_amdgcn_readfirstlane(threadIdx.x >> 6), lane = threadIdx.x & 63;
    const float* src = (wid < 4) ? rs256 + wid * 64 + lane : cm256 + (wid - 4) * 64 + lane;
    __builtin_amdgcn_global_load_lds((const unsigned*)src, (LAS unsigned*)(lds + SCL_OFF + buf * 2048 + wid * 256), 4, 0, 0);
}
template <bool F8OUT> struct EpiGatedI8 { static constexpr bool PERM = true, LDSS = true; static constexpr int MM = 1; bf16* out; int ldc; const float* rowscale; const float* colmax; int cstride; unsigned char* out2;
    __device__ __forceinline__ void prefetch_scales(const GUnit& u, int buf, LAS unsigned char* lds) const { scales_to_lds(rowscale + u.rs, colmax + (size_t)u.e * cstride + u.pn * 256, buf, lds); }
    __device__ __forceinline__ void operator()(const i32x4 (&acc)[2][2][4][2], const GUnit& u, int wr, int wc, int fr, int fq, LAS unsigned char* tab) const {
        const LAS float* cm = (const LAS float*)(tab + 1024) + wc * 32 + 8 * fq; const float k127 = 1.0f / 127.0f;
        float fscale = 1.0f; if constexpr (F8OUT) fscale = __builtin_bit_cast(float, (unsigned)(254 - u.sa) << 23);
        const float L2E = 1.4426950408889634f, k1 = k127 * L2E, k3 = k127 * fscale * (1.0f / L2E);
        const f32x4 s1a = *(const LAS f32x4*)cm * k1, s1b = *(const LAS f32x4*)(cm + 4) * k1, s3a = *(const LAS f32x4*)(cm + 128) * k3, s3b = *(const LAS f32x4*)(cm + 132) * k3;
        const f32x2 c1[4] = {{s1a[0], s1a[1]}, {s1a[2], s1a[3]}, {s1b[0], s1b[1]}, {s1b[2], s1b[3]}}, c3[4] = {{s3a[0], s3a[1]}, {s3a[2], s3a[3]}, {s3b[0], s3b[1]}, {s3b[2], s3b[3]}};
        const LAS float* rsc = (const LAS float*)tab + wr * 64 + fr;
#pragma unroll
        for (int ai = 0; ai < 2; ++ai)
#pragma unroll
            for (int m = 0; m < 4; ++m) { const int r = ai * 128 + wr * 64 + m * 16 + fr; const float sA = rsc[ai * 128 + m * 16]; const f32x2 sAA = {sA, sA}; float o[8];
#pragma unroll
                for (int q = 0; q < 4; ++q) { const int n = q >> 1, k0 = (q & 1) * 2;
                    const f32x2 av = (f32x2){(float)acc[ai][0][m][n][k0], (float)acc[ai][0][m][n][k0 + 1]} * (c1[q] * sAA), bv = (f32x2){(float)acc[ai][1][m][n][k0], (float)acc[ai][1][m][n][k0 + 1]} * (c3[q] * sAA);
                    const f32x2 d = (f32x2){__builtin_amdgcn_exp2f(-av[0]), __builtin_amdgcn_exp2f(-av[1])} + (f32x2){1.0f, 1.0f};
                    const f32x2 ov = (av * bv) * (f32x2){__builtin_amdgcn_rcpf(d[0]), __builtin_amdgcn_rcpf(d[1])};
                    o[2 * q] = ov[0]; o[2 * q + 1] = ov[1]; }
                if constexpr (F8OUT) {
                    int p0 = __builtin_amdgcn_cvt_pk_fp8_f32(o[0], o[1], 0, false); p0 = __builtin_amdgcn_cvt_pk_fp8_f32(o[2], o[3], p0, true);
                    int p1 = __builtin_amdgcn_cvt_pk_fp8_f32(o[4], o[5], 0, false); p1 = __builtin_amdgcn_cvt_pk_fp8_f32(o[6], o[7], p1, true);
                    v2u w; w.x = (unsigned)p0; w.y = (unsigned)p1;
                    unsigned char* const ob = (u.pm < ASPLIT) ? (unsigned char*)out + (size_t)(u.pm * 256) * ldc : out2 + (size_t)((u.pm - ASPLIT) * 256) * ldc;
                    *(v2u*)(ob + (size_t)r * ldc + u.pn * 128 + wc * 32 + fq * 8) = w; }
                else {
                v4u w; w.x = cvt_pk_bf16(o[0], o[1]); w.y = cvt_pk_bf16(o[2], o[3]); w.z = cvt_pk_bf16(o[4], o[5]); w.w = cvt_pk_bf16(o[6], o[7]);
                *(v4u*)(out + (size_t)(u.pm * 256 + r) * ldc + u.pn * 128 + wc * 32 + fq * 8) = w; } } } };
template <bool SS, bool USEAUX, int MMODE = 0> struct EpiPlain { static constexpr bool PERM = true, LDSS = false; static constexpr int MM = MMODE; bf16* out; int ldc; float* rowss;
    __device__ __forceinline__ void operator()(AccRef acc, const GUnit& u, int wr, int wc, int fr, int fq) const {
        const int rb = (USEAUX ? u.aux : u.pm) * 256;
#pragma unroll
        for (int ai = 0; ai < 2; ++ai)
#pragma unroll
            for (int m = 0; m < 4; ++m) { const int row = rb + ai * 128 + wr * 64 + m * 16 + fr; float ss = 0.f;
#pragma unroll
                for (int bj = 0; bj < 2; ++bj) { const f32x4 v0 = acc[ai][bj][m][0], v1 = acc[ai][bj][m][1];
                    if (SS) ss += (v0[0] * v0[0] + v0[1] * v0[1]) + (v0[2] * v0[2] + v0[3] * v0[3]) + (v1[0] * v1[0] + v1[1] * v1[1]) + (v1[2] * v1[2] + v1[3] * v1[3]);
                    v4u w; w.x = cvt_pk_bf16(v0[0], v0[1]); w.y = cvt_pk_bf16(v0[2], v0[3]); w.z = cvt_pk_bf16(v1[0], v1[1]); w.w = cvt_pk_bf16(v1[2], v1[3]);
                    *(v4u*)(out + (size_t)row * ldc + u.pn * 256 + bj * 128 + wc * 32 + fq * 8) = w; }
                if (SS) { ss += __shfl_xor(ss, 16); ss += __shfl_xor(ss, 32); if (fq == 0) rowss[(size_t)row * 32 + u.pn * 4 + wc] = ss; } } } };
template <bool I8Q> struct EpiQKV { static constexpr bool PERM = true, LDSS = I8Q; static constexpr int MM = I8Q ? 1 : 0; bf16* qkv; const float* rope; float* kmean; const float* rowscale; const float* colmax;
    __device__ __forceinline__ void prefetch_scales(const GUnit& u, int buf, LAS unsigned char* lds) const { scales_to_lds(rowscale + u.rs, colmax + u.pn * 256, buf, lds); }
    template <class AccT> __device__ __forceinline__ void operator()(const AccT (&acc)[2][2][4][2], const GUnit& u, int wr, int wc, int fr, int fq, LAS unsigned char* tab = nullptr) const {
        const int sel = u.pn >> 2; bf16* const outb = qkv + (size_t)sel * (size_t)(32u << 20);
        const int colt = (u.pn & 3) * 256;
        f32x4 sb[2][2];
        if constexpr (I8Q) { const LAS float* cm = (const LAS float*)(tab + 1024) + wc * 32 + 8 * fq; const float k127 = 1.0f / 127.0f;
            sb[0][0] = *(const LAS f32x4*)cm * k127; sb[0][1] = *(const LAS f32x4*)(cm + 4) * k127; sb[1][0] = *(const LAS f32x4*)(cm + 128) * k127; sb[1][1] = *(const LAS f32x4*)(cm + 132) * k127; }
        float cs[2][2][4];
#pragma unroll
        for (int bj = 0; bj < 2; ++bj)
#pragma unroll
            for (int n = 0; n < 2; ++n)
#pragma unroll
                for (int kk = 0; kk < 4; ++kk) cs[bj][n][kk] = 0.f;
#pragma unroll
        for (int ai = 0; ai < 2; ++ai)
#pragma unroll
            for (int m = 0; m < 4; ++m) { const int rl = ai * 128 + wr * 64 + m * 16 + fr, row = u.pm * 256 + rl;
                float sA = 1.0f; if constexpr (I8Q) sA = ((const LAS float*)tab)[rl];
                f32x4 co = (f32x4){1.f, 1.f, 1.f, 1.f}, si = (f32x4){0.f, 0.f, 0.f, 0.f};
                if (sel < 2 && wc == 0) { co = *(const f32x4*)(rope + (size_t)row * 32 + 4 * fq); si = *(const f32x4*)(rope + (size_t)row * 32 + 16 + 4 * fq); }
#pragma unroll
                for (int bj = 0; bj < 2; ++bj) { f32x4 v0, v1;
                    if constexpr (I8Q) {
#pragma unroll
                        for (int kk = 0; kk < 4; ++kk) { v0[kk] = (float)acc[ai][bj][m][0][kk] * (sA * sb[bj][0][kk]); v1[kk] = (float)acc[ai][bj][m][1][kk] * (sA * sb[bj][1][kk]); } }
                    else {
#pragma unroll
                        for (int kk = 0; kk < 4; ++kk) { v0[kk] = acc[ai][bj][m][0][kk]; v1[kk] = acc[ai][bj][m][1][kk]; } }
                    if (sel < 2 && wc == 0) {
                        const float a0 = v0[0] * co[0] - v0[1] * si[0], a1 = v0[1] * co[0] + v0[0] * si[0], a2 = v0[2] * co[1] - v0[3] * si[1], a3 = v0[3] * co[1] + v0[2] * si[1];
                        const float b0 = v1[0] * co[2] - v1[1] * si[2], b1 = v1[1] * co[2] + v1[0] * si[2], b2 = v1[2] * co[3] - v1[3] * si[3], b3 = v1[3] * co[3] + v1[2] * si[3];
                        v0 = (f32x4){a0, a1, a2, a3}; v1 = (f32x4){b0, b1, b2, b3}; }
                    if (sel == 1) {
#pragma unroll
                        for (int kk = 0; kk < 4; ++kk) { cs[bj][0][kk] += v0[kk]; cs[bj][1][kk] += v1[kk]; } }
                    v4u w; w.x = cvt_pk_bf16(v0[0], v0[1]); w.y = cvt_pk_bf16(v0[2], v0[3]); w.z = cvt_pk_bf16(v1[0], v1[1]); w.w = cvt_pk_bf16(v1[2], v1[3]);
                    *(v4u*)(outb + (size_t)row * DM + colt + bj * 128 + wc * 32 + fq * 8) = w; } }
        if (sel == 1) {
            const int b = u.pm >> 3, blk = u.pm & 7;
#pragma unroll
            for (int bj = 0; bj < 2; ++bj)
#pragma unroll
                for (int n = 0; n < 2; ++n)
#pragma unroll
                    for (int kk = 0; kk < 4; ++kk) { float s = cs[bj][n][kk]; s += __shfl_xor(s, 1); s += __shfl_xor(s, 2); s += __shfl_xor(s, 4); s += __shfl_xor(s, 8);
                        if (fr == 0) { const int h = (u.pn & 3) * 2 + bj; atomicAdd(kmean + ((size_t)((b * NH + h) * NBLK + blk)) * HD + wc * 32 + fq * 8 + n * 4 + kk, s * (1.0f / 256.0f)); } } } } };

namespace attn {
constexpr int D = 128, TS = DM;
constexpr float SCALE = 0.08838834764831845f, THR = 8.f;
constexpr int NW = 8, QBLK = 32, KVBLK = 64, QB = NW * QBLK;
constexpr int SHM_V = KVBLK * D * 2, SHM_K = KVBLK * D * 2;
constexpr int ATT_LDS = 2 * SHM_V + 2 * SHM_K + NW * 64 * 4;
#define KSWZ(row, colB) ((row) * 256 + ((colB) ^ (((row) & 7) << 4)))
#define SBAR() __builtin_amdgcn_sched_barrier(0)
__device__ __forceinline__ int v_st(int k, int c) { const int kk = (k & ~0xC) | ((k & 4) << 1) | ((k & 8) >> 1); return ((kk >> 3) * 4 + (c >> 5)) * 512 + ((kk & 7) * 32 + (c & 31)) * 2; }
__device__ __forceinline__ int v_rd_base(int lane) { return ((lane & 3) << 3) | (((lane >> 2) & 3) << 6) | (((lane >> 4) & 1) << 5) | (((lane >> 5) & 1) << 8); }
constexpr int v_rd_off(int d0, int ks, int half) { return d0 * 512 + ks * 4096 + half * 2048; }
__device__ __forceinline__ int crow(int r, int hi) { return (r & 3) + 8 * (r >> 2) + 4 * hi; }
__device__ __forceinline__ bf16x8 load8(const bf16* p) { return *reinterpret_cast<const bf16x8*>(p); }
__device__ __forceinline__ void mask_tile(f32x16& p0, f32x16& p1, int dq) {
    const float NEG = -__builtin_inff();
#pragma unroll
    for (int r = 0; r < 16; ++r) { const int c = (r & 3) + 8 * (r >> 2); if (dq - c < 0) p0[r] = NEG; if (dq - c - 32 < 0) p1[r] = NEG; }
}
__device__ __forceinline__ void drop_tile(f32x16& p0, f32x16& p1, bool drop) {
    const float NEG = -__builtin_inff();
#pragma unroll
    for (int r = 0; r < 16; ++r) { p0[r] = drop ? NEG : p0[r]; p1[r] = drop ? NEG : p1[r]; }
}
__device__ __forceinline__ void partialSM(f32x16& p0, f32x16& p1, float& m_reg, float& mn, float& alpha, bool drop = false) {
    float pmax = p0[0];
#pragma unroll
    for (int r = 1; r < 16; ++r) pmax = fmaxf(pmax, p0[r]);
#pragma unroll
    for (int r = 0; r < 16; ++r) pmax = fmaxf(pmax, p1[r]);
    { auto rr = __builtin_amdgcn_permlane32_swap(__float_as_uint(pmax), __float_as_uint(pmax), false, false);
      pmax = fmaxf(__uint_as_float(rr[0]), __uint_as_float(rr[1])); }
    pmax = drop ? -__builtin_inff() : pmax;
    constexpr float C2 = 1.4426950408889634f * SCALE;
    if (__builtin_expect(__all((pmax - m_reg) * SCALE <= THR), 1)) { mn = m_reg; alpha = 1.f; }
    else { mn = fmaxf(m_reg, pmax); alpha = __builtin_amdgcn_exp2f((m_reg - mn) * C2); m_reg = mn; }
    const float mnL = drop ? -__builtin_inff() : -mn * C2;
#pragma unroll
    for (int r = 0; r < 16; ++r) p0[r] = fmaf(p0[r], C2, mnL);
#pragma unroll
    for (int r = 0; r < 16; ++r) p1[r] = fmaf(p1[r], C2, mnL);
#pragma unroll
    for (int r = 0; r < 16; ++r) p0[r] = __builtin_amdgcn_exp2f(p0[r]);
}
__device__ __forceinline__ void finishSM(f32x16& p0, f32x16& p1, float alpha, float& l_reg, bf16x8& pa0, bf16x8& pa1, bf16x8& pa2, bf16x8& pa3) {
#pragma unroll
    for (int r = 0; r < 16; ++r) p1[r] = __builtin_amdgcn_exp2f(p1[r]);
    float ps = 0;
#pragma unroll
    for (int r = 0; r < 16; ++r) ps += p0[r];
#pragma unroll
    for (int r = 0; r < 16; ++r) ps += p1[r];
    { auto rr = __builtin_amdgcn_permlane32_swap(__float_as_uint(ps), __float_as_uint(ps), false, false);
      ps = __uint_as_float(rr[0]) + __uint_as_float(rr[1]); }
    l_reg = l_reg * alpha + ps;
#define PK4(P, B_, OUT) do { unsigned a0 = cvt_pk_bf16(P[B_+0], P[B_+1]), a1 = cvt_pk_bf16(P[B_+2], P[B_+3]);                          \
        unsigned b0 = cvt_pk_bf16(P[B_+4], P[B_+5]), b1 = cvt_pk_bf16(P[B_+6], P[B_+7]);                                             \
        auto r0 = __builtin_amdgcn_permlane32_swap(a0, b0, false, false); auto r1 = __builtin_amdgcn_permlane32_swap(a1, b1, false, false); \
        v4u w = {r0[0], r1[0], r0[1], r1[1]}; OUT = *reinterpret_cast<bf16x8*>(&w); } while (0)
    PK4(p0, 0, pa0); PK4(p0, 8, pa1); PK4(p1, 0, pa2); PK4(p1, 8, pa3);
#undef PK4
}
template <int KB>
__device__ __forceinline__ void qkt(f32x16& p0, f32x16& p1, const char* K_lds, int r32, int hi, const bf16x8* qr) {
    p0 = f32x16{}; p1 = f32x16{};
    const char* kb[4];
#pragma unroll
    for (int dd = 0; dd < 4; ++dd) kb[dd] = K_lds + KB * SHM_K + KSWZ(r32, (dd * 16 + hi * 8) * 2);
#pragma unroll
    for (int d0 = 0; d0 < 8; ++d0) { const char* a = kb[d0 & 3] + (d0 >> 2) * 128;
        bf16x8 b0 = *reinterpret_cast<const bf16x8*>(a);
        bf16x8 b1 = *reinterpret_cast<const bf16x8*>(a + 32 * 256);
        p0 = __builtin_amdgcn_mfma_f32_32x32x16_bf16(b0, qr[d0], p0, 0, 0, 0);
        p1 = __builtin_amdgcn_mfma_f32_32x32x16_bf16(b1, qr[d0], p1, 0, 0, 0); }
}
template <int VB>
__device__ __forceinline__ void pv_tile(f32x16* o, int vb0, bf16x8 pa0, bf16x8 pa1, bf16x8 pa2, bf16x8 pa3) {
#define TRRD(dst, off) asm volatile("ds_read_b64_tr_b16 %0, %1 offset:%2" : "=&v"(dst) : "v"(vb0), "i"(off) : "memory")
#define PV_RD(d0, X) do { constexpr int b_ = VB * SHM_V + v_rd_off(d0, 0, 0); \
        TRRD(X##l0, b_); TRRD(X##h0, b_ + 2048); TRRD(X##l1, b_ + 4096); TRRD(X##h1, b_ + 6144); TRRD(X##l2, b_ + 8192); TRRD(X##h2, b_ + 10240); TRRD(X##l3, b_ + 12288); TRRD(X##h3, b_ + 14336); } while (0)
#define PV_MM(d0, X) do { \
        o[d0] = __builtin_amdgcn_mfma_f32_32x32x16_bf16(pa0, (bf16x8){X##l0[0], X##l0[1], X##l0[2], X##l0[3], X##h0[0], X##h0[1], X##h0[2], X##h0[3]}, o[d0], 0, 0, 0);   \
        o[d0] = __builtin_amdgcn_mfma_f32_32x32x16_bf16(pa1, (bf16x8){X##l1[0], X##l1[1], X##l1[2], X##l1[3], X##h1[0], X##h1[1], X##h1[2], X##h1[3]}, o[d0], 0, 0, 0);   \
        o[d0] = __builtin_amdgcn_mfma_f32_32x32x16_bf16(pa2, (bf16x8){X##l2[0], X##l2[1], X##l2[2], X##l2[3], X##h2[0], X##h2[1], X##h2[2], X##h2[3]}, o[d0], 0, 0, 0);   \
        o[d0] = __builtin_amdgcn_mfma_f32_32x32x16_bf16(pa3, (bf16x8){X##l3[0], X##l3[1], X##l3[2], X##l3[3], X##h3[0], X##h3[1], X##h3[2], X##h3[3]}, o[d0], 0, 0, 0); } while (0)
#define PV_WAIT(n) do { asm volatile("s_waitcnt lgkmcnt(" #n ")" ::: "memory"); SBAR(); } while (0)
    { s16x4 al0, al1, al2, al3, ah0, ah1, ah2, ah3, bl0, bl1, bl2, bl3, bh0, bh1, bh2, bh3;
      PV_RD(0, a); PV_RD(1, b);
      PV_WAIT(8); PV_MM(0, a); SBAR(); PV_RD(2, a);
      PV_WAIT(8); PV_MM(1, b); SBAR(); PV_RD(3, b);
      PV_WAIT(8); PV_MM(2, a);
      PV_WAIT(0); PV_MM(3, b); }
#undef PV_RD
#undef PV_MM
#undef PV_WAIT
#undef TRRD
}
struct BlockRef { const bf16* Q; const bf16* K; const bf16* V; bf16* O; const float* KM; int P0; };
struct Seam { bf16x8 qr[8]; bf16x8 st_v0, st_v1, st_k0, st_k1; };
#define ROW(p, k0, rr) ((p) + (size_t)((k0) + (rr)) * TS + sc)
#define VMW() asm volatile("s_waitcnt vmcnt(0)" ::: "memory")
#define VMWN(n) asm volatile("s_waitcnt vmcnt(%0)" :: "i"(n) : "memory")
#define SLOAD_H(Kp, Vp, k0) do { S.st_v0 = load8(ROW(Vp, k0, sr)); S.st_v1 = load8(ROW(Vp, k0, 32 + sr));              \
                         S.st_k0 = load8(ROW(Kp, k0, sr)); S.st_k1 = load8(ROW(Kp, k0, 32 + sr)); } while (0)
#define SWRITE_HK(bf) do { *(bf16x8*)(K_lds + (bf) * SHM_K + kws) = S.st_k0; *(bf16x8*)(K_lds + (bf) * SHM_K + kws + 32 * 256) = S.st_k1; } while (0)
#define SWRITE_HV(bf) do { *(bf16x8*)(V_lds + (bf) * SHM_V + vst0) = S.st_v0; *(bf16x8*)(V_lds + (bf) * SHM_V + vst1) = S.st_v1; } while (0)
#define SWRITE_H(bf) do { SWRITE_HV(bf); SWRITE_HK(bf); } while (0)
__device__ __forceinline__ void moba_prime(const BlockRef& cur, char* lds, Seam& S) {
    const int tid = threadIdx.x, wid = __builtin_amdgcn_readfirstlane(tid >> 6), lane = tid & 63, r32 = lane & 31, hi = lane >> 5;
    const int sr = tid >> 4, sc = (tid & 15) * 8, kws = KSWZ(sr, sc * 2); char* K_lds = lds + 2 * SHM_V;
#pragma unroll
    for (int d0 = 0; d0 < 8; ++d0) S.qr[d0] = load8(cur.Q + (size_t)(wid * QBLK + r32) * TS + d0 * 16 + hi * 8);
    SLOAD_H(cur.K, cur.V, 0); VMW(); SWRITE_HK(0);
    __syncthreads();
}
__device__ __forceinline__ void moba_block(const BlockRef& cur, const BlockRef& nxt, char* lds, Seam& S) {
    const int tid = threadIdx.x, wid = __builtin_amdgcn_readfirstlane(tid >> 6), lane = tid & 63, r32 = lane & 31, hi = lane >> 5;
    const int NT = cur.P0 / KVBLK + QB / KVBLK;
    const int qlo = cur.P0 + wid * QBLK, qm = qlo + r32 - 4 * hi;
    char* V_lds = lds; char* K_lds = lds + 2 * SHM_V;
    float* ws = (float*)(lds + 2 * SHM_V + 2 * SHM_K) + wid * 64; float* li_l = ws, * al_l = ws + 32;
    int sel = 0xff; const int qb = cur.P0 >> 8;
    if (qb > 3) {
        float g[7];
#pragma unroll
        for (int j = 0; j < 7; ++j) { float s = -__builtin_inff();
            asm volatile("" ::: "memory");
            if (j < qb) { int hoff = hi * 8; asm volatile("" : "+v"(hoff)); const float* km = cur.KM + j * HD + hoff; s = 0.f;
#pragma unroll
                for (int d0 = 0; d0 < 8; ++d0) { const f32x4 k0 = *(const f32x4*)(km + d0 * 16), k1 = *(const f32x4*)(km + d0 * 16 + 4); const bf16x8 qv = S.qr[d0];
                    s += bf2f((unsigned short)qv[0]) * k0[0] + bf2f((unsigned short)qv[1]) * k0[1] + bf2f((unsigned short)qv[2]) * k0[2] + bf2f((unsigned short)qv[3]) * k0[3]
                       + bf2f((unsigned short)qv[4]) * k1[0] + bf2f((unsigned short)qv[5]) * k1[1] + bf2f((unsigned short)qv[6]) * k1[2] + bf2f((unsigned short)qv[7]) * k1[3]; }
                auto rr = __builtin_amdgcn_permlane32_swap(__float_as_uint(s), __float_as_uint(s), false, false); s = __uint_as_float(rr[0]) + __uint_as_float(rr[1]); }
            g[j] = s; }
        sel = 0;
#pragma unroll
        for (int j = 0; j < 7; ++j) { int rank = 0;
#pragma unroll
            for (int k = 0; k < 7; ++k) if (k != j) rank += (g[k] > g[j] || (g[k] == g[j] && k < j)) ? 1 : 0;
            if (j < qb && rank < 3) sel |= 1 << j; }
        sel |= 1 << qb;
    }
    float m_reg = -1e30f, l_reg = 0; f32x16 o[4] = {};
    const int sr = tid >> 4, sc = (tid & 15) * 8, vst0 = v_st(sr, sc), vst1 = v_st(32 + sr, sc), kws = KSWZ(sr, sc * 2);
    const int vb0 = (int)(uintptr_t)V_lds + v_rd_base(lane);
    const bf16* Kh = cur.K; const bf16* Vh = cur.V;
#define RESC(a) do { if (__any((a) < 1.f)) { if (hi == 0) al_l[r32] = (a); asm volatile("s_waitcnt lgkmcnt(0)" ::: "memory");              \
                     for (int d_ = 0; d_ < 4; ++d_) for (int r = 0; r < 16; ++r) o[d_][r] *= al_l[crow(r, hi)]; } } while (0)
#define KBASE(t) ((t) * KVBLK)
#define MASKT(P0_, P1_, t) do { const int kb_ = KBASE(t); if (kb_ + KVBLK - 1 > qlo) mask_tile(P0_, P1_, qm - kb_); \
        dropT = (kb_ < cur.P0) && ((sel >> (kb_ >> 8)) & 1) == 0; } while (0)
    constexpr int NQL = 8;
#define SEAM_K0() do { VMWN(NQL); SWRITE_HK(0); SBAR(); } while (0)
    f32x16 pA0, pA1, pB0, pB1; float mnA, mnB, alA, alB; bf16x8 pa0, pa1, pa2, pa3; bool dropT = false;
    SWRITE_HV(0); SBAR();
    if (NT > 1) SLOAD_H(Kh, Vh, KBASE(1));
    SBAR(); qkt<0>(pA0, pA1, K_lds, r32, hi, S.qr);
    MASKT(pA0, pA1, 0); partialSM(pA0, pA1, m_reg, mnA, alA, dropT);
    if (NT > 1) { VMW(); SWRITE_H(1); }
    __syncthreads();
#define HALF_STEP(PX0, PX1, mnX, alX, PY0, PY1, alY, t, KB, VB, SB) do {                                                      \
        SBAR(); qkt<KB>(PX0, PX1, K_lds, r32, hi, S.qr);                                                                      \
        finishSM(PY0, PY1, alY, l_reg, pa0, pa1, pa2, pa3); SBAR();                                                           \
        if ((t) + 1 < NT) { SLOAD_H(Kh, Vh, KBASE((t) + 1)); SBAR(); }                                                        \
        pv_tile<VB>(o, vb0, pa0, pa1, pa2, pa3); MASKT(PX0, PX1, (t)); partialSM(PX0, PX1, m_reg, mnX, alX, dropT);            \
        __syncthreads();                                                                                                      \
        if ((t) + 1 < NT) { VMW(); SWRITE_H(SB); }                                                                            \
        RESC(alX); __syncthreads(); } while (0)
    for (int t = 1; t + 1 < NT; t += 2) {
        HALF_STEP(pB0, pB1, mnB, alB, pA0, pA1, alA, t, 1, 0, 0);
        HALF_STEP(pA0, pA1, mnA, alA, pB0, pB1, alB, t + 1, 0, 1, 1);
    }
    SBAR(); qkt<1>(pB0, pB1, K_lds, r32, hi, S.qr); SBAR();
    SLOAD_H(nxt.K, nxt.V, 0); SBAR();
#pragma unroll
    for (int d0 = 0; d0 < 8; ++d0) S.qr[d0] = load8(nxt.Q + (size_t)(wid * QBLK + r32) * TS + d0 * 16 + hi * 8);
    SBAR();
    finishSM(pA0, pA1, alA, l_reg, pa0, pa1, pa2, pa3); SBAR();
    pv_tile<0>(o, vb0, pa0, pa1, pa2, pa3);
    MASKT(pB0, pB1, NT - 1); partialSM(pB0, pB1, m_reg, mnB, alB, dropT); __syncthreads(); RESC(alB);
    finishSM(pB0, pB1, alB, l_reg, pa0, pa1, pa2, pa3); SBAR(); pv_tile<1>(o, vb0, pa0, pa1, pa2, pa3);
    SBAR(); SEAM_K0();
    if (hi == 0) li_l[r32] = l_reg; asm volatile("s_waitcnt lgkmcnt(0)" ::: "memory");
    float rli[16];
#pragma unroll
    for (int r = 0; r < 16; ++r) rli[r] = __builtin_amdgcn_rcpf(li_l[crow(r, hi)]);
    bf16* Ow = cur.O + (size_t)(wid * QBLK) * TS;
#pragma unroll
    for (int r = 0; r < 16; ++r) { const int orow = crow(r, hi);
#pragma unroll
        for (int d0 = 0; d0 < 4; ++d0) { const float v = o[d0][r] * rli[r];
            const float vn = __shfl_xor(v, 1);
            if ((r32 & 1) == 0) *(unsigned*)(Ow + (size_t)orow * TS + d0 * 32 + r32) = cvt_pk_bf16(v, vn); } }
    __syncthreads();
#undef RESC
#undef KBASE
#undef MASKT
#undef SEAM_K0
#undef HALF_STEP
}
#undef ROW
#undef VMW
#undef VMWN
#undef SLOAD_H
#undef SWRITE_HK
#undef SWRITE_HV
#undef SWRITE_H
}

#define XB_TMO      128
#define XB_XCNT(j)  (256  + 64 * (j))
#define XB_XSUB(j)  (1280 + 64 * (j))
#define XB_XGEN(j)  (2304 + 64 * (j))
#define XB_TOP      3328
#define XB_TOPGEN   3392
#define XCD_BAR_WORDS 3456
#define XB_SPIN_CAP (1u << 18)
__device__ __forceinline__ unsigned xb_ld(unsigned* p)              { return __hip_atomic_load(p, __ATOMIC_RELAXED, __HIP_MEMORY_SCOPE_AGENT); }
__device__ __forceinline__ unsigned xb_add(unsigned* p, unsigned v) { return __hip_atomic_fetch_add(p, v, __ATOMIC_RELAXED, __HIP_MEMORY_SCOPE_AGENT); }
__device__ __forceinline__ unsigned xb_xcc_id() { return (unsigned)__builtin_amdgcn_s_getreg((3 << 11) | 20) & 0xFu; }
#define XB_SPIN(cond, bar) do { unsigned _sp = 0; while (cond) { __builtin_amdgcn_s_sleep(1); \
    if ((++_sp & 255u) == 0u) { if (xb_ld(&(bar)[XB_TMO])) break; if (_sp > XB_SPIN_CAP) { atomicAdd(&(bar)[XB_TMO], 1u); break; } } } } while (0)
struct XcdBarrier { unsigned* bar; unsigned x; volatile LAS unsigned* st; };
__device__ __forceinline__ XcdBarrier xcd_barrier_post(unsigned* bar, volatile LAS unsigned* st) {
    XcdBarrier b; b.bar = bar; b.x = xb_xcc_id(); b.st = st;
    if (threadIdx.x == 0) (void)xb_add(&bar[XB_XCNT(b.x)], 1u);
    return b;
}
__device__ __forceinline__ void xcd_barrier_complete(unsigned* bar, unsigned x, unsigned& nloc, unsigned& nx) {
    const unsigned G = gridDim.x * gridDim.y * gridDim.z;
    unsigned sum, cnt, mine, sp = 0u;
    for (;;) {
        sum = 0u; cnt = 0u;
#pragma unroll 1
        for (unsigned j = 0; j < 16; ++j) { const unsigned c = xb_ld(&bar[XB_XCNT(j)]); sum += c; cnt += (c > 0u) ? 1u : 0u; }
        if (sum == G) break;
        __builtin_amdgcn_s_sleep(1);
        if ((++sp & 255u) == 0u) { if (xb_ld(&bar[XB_TMO])) break; if (sp > XB_SPIN_CAP) { atomicAdd(&bar[XB_TMO], 1u); break; } }
    }
    mine = xb_ld(&bar[XB_XCNT(x)]);
    nloc = mine > 0u ? mine : 1u; nx = cnt > 0u ? cnt : 1u;
}
__device__ __forceinline__ void xcd_barrier(const XcdBarrier& b) {
    asm volatile("s_waitcnt vmcnt(0)" ::: "memory");
    __syncthreads();
    if (threadIdx.x == 0) {
        unsigned* bar = b.bar;
        __builtin_amdgcn_s_waitcnt(0);
        unsigned nloc = b.st[0], nx = b.st[1];
        if (nloc == 0u) { xcd_barrier_complete(bar, b.x, nloc, nx); b.st[0] = nloc; b.st[1] = nx; }
        const unsigned old = xb_add(&bar[XB_XSUB(b.x)], 1u);
        const unsigned gen = old / nloc;
        if (old + 1u == (gen + 1u) * nloc) {
            __builtin_amdgcn_fence(__ATOMIC_RELEASE, "agent");
            asm volatile("s_waitcnt vmcnt(0)" ::: "memory");
            const unsigned og = xb_add(&bar[XB_TOP], 1u);
            const unsigned tg = og / nx;
            if (og + 1u == (tg + 1u) * nx) xb_add(&bar[XB_TOPGEN], 1u);
            else XB_SPIN(xb_ld(&bar[XB_TOPGEN]) == tg, bar);
            __builtin_amdgcn_fence(__ATOMIC_ACQUIRE, "agent");
            xb_add(&bar[XB_XGEN(b.x)], 1u);
            asm volatile("s_waitcnt vmcnt(0)" ::: "memory");
        } else {
            XB_SPIN(xb_ld(&bar[XB_XGEN(b.x)]) == gen, bar);
            __builtin_amdgcn_fence(__ATOMIC_ACQUIRE, "agent");
            asm volatile("s_waitcnt vmcnt(0)" ::: "memory");
        }
    }
    __syncthreads();
}

struct Frame {
    LAS unsigned char* lds; volatile LAS unsigned* MISC; unsigned* ctl;
    int tid, lane, wave, vcu, G, bx, lo, hi;
    unsigned char* ws;
};
struct Args { const void* in[24]; float* out; unsigned char* ws; int ph_lo, ph_hi; };
typedef const __attribute__((address_space(4))) Args* KArgs;
__device__ __forceinline__ KArgs kargs() { KArgs p = (KArgs)__builtin_amdgcn_kernarg_segment_ptr(); asm volatile("" : "+s"(p)); return p; }
__device__ __forceinline__ void refresh(Frame& F) {
    KArgs k = kargs();
    int t = threadIdx.x; asm volatile("" : "+v"(t)); F.tid = t; F.lane = t & 63; F.wave = __builtin_amdgcn_readfirstlane(t >> 6);
    int g = gridDim.x, bx = blockIdx.x; asm volatile("" : "+s"(g), "+s"(bx)); F.G = g; F.bx = bx; F.vcu = (g % 8 == 0) ? (bx % 8) * (g / 8) + bx / 8 : bx;
    F.ws = k->ws; F.ctl = (unsigned*)(F.ws + WS_CTL); F.lo = k->ph_lo; F.hi = k->ph_hi;
    F.lds = (LAS unsigned char*)0; F.MISC = (volatile LAS unsigned*)(F.lds + MISC_OFF);
}
__device__ __forceinline__ XcdBarrier frame_bar(Frame& F) { XcdBarrier b; b.bar = F.ctl + CW_BAR; b.x = xb_xcc_id(); b.st = F.MISC + 8; return b; }
enum { I_X = 0, I_POS, I_NORMS, I_LAMRE, I_LAMIM, I_LOGDT, I_BRE, I_BIM, I_CRE, I_CIM, I_SD, I_WGLU, I_KVN, I_WKV, I_WQ, I_WO, I_FW1, I_FW3, I_FW2, I_ROUTER, I_RBIAS, I_MW1, I_MW3, I_MW2 };

__device__ __forceinline__ int rot32(int d) { return 8 * ((d & 15) >> 2) + 2 * (d & 3) + (d >> 4); }
constexpr int NKIND = 31;
struct WK { const float* W; const float* gain; unsigned char* dst; unsigned* colmax; float* psq; int ldw, K, N, mode, base, which, ot; };
__device__ __forceinline__ void wk_get(KArgs ap, unsigned char* ws, int kind, WK& k) {
    const auto& a = *ap; const float* norms = (const float*)a.in[I_NORMS]; k.gain = nullptr; k.colmax = nullptr; k.psq = nullptr; k.mode = 0; k.base = 0; k.which = 0; k.ot = 0; k.ldw = DM; k.K = DM; k.N = DM;
    if (kind == 0) { k.W = (const float*)a.in[I_WGLU]; k.ldw = 2 * DM; k.N = 2 * DM; k.dst = ws + WS_WGLU; k.mode = 3; }
    else if (kind == 1) { k.W = (const float*)a.in[I_WQ]; k.gain = norms + 4 * DM; k.mode = 2; k.ot = MK_QKV8; k.dst = MK_QKV8 ? ws + WS_WQQKV : ws + WS_WQKV; k.colmax = (unsigned*)(ws + WS_COLMAX_QKV); }
    else if (kind == 2) { k.W = (const float*)a.in[I_WKV]; k.ldw = 2 * DM; k.N = 2 * DM; k.gain = (const float*)a.in[I_KVN]; k.mode = 4; k.base = DM; k.ot = MK_QKV8; k.dst = MK_QKV8 ? ws + WS_WQQKV : ws + WS_WQKV; k.colmax = (unsigned*)(ws + WS_COLMAX_QKV); }
    else if (kind == 3) { k.W = (const float*)a.in[I_WO]; k.dst = ws + WS_WO; }
    else if (kind == 4 || kind == 5) { k.W = (const float*)a.in[kind == 4 ? I_FW1 : I_FW3]; k.ldw = FFD; k.N = FFD; k.gain = norms + 2 * DM; k.mode = 1; k.which = kind - 4; k.ot = 1; k.dst = ws + WS_WQF13; k.colmax = (unsigned*)(ws + WS_COLMAX_F); k.psq = (float*)(ws + WS_PSQD); }
    else if (kind == 6) { k.W = (const float*)a.in[I_FW2]; k.K = FFD; k.dst = ws + WS_WF2; if (MK_FFN2F8) { k.ot = 2; k.colmax = (unsigned*)(ws + WS_COLMAX_W2) + NE * DM; } }
    else if (kind < 23) { const int e = (kind - 7) & 7, wh = (kind - 7) >> 3; k.W = (const float*)a.in[wh ? I_MW3 : I_MW1] + (size_t)e * DM * FFE; k.ldw = FFE; k.N = FFE; k.gain = norms + 6 * DM; k.mode = 1; k.which = wh; k.ot = 1;
        k.dst = ws + WS_WQ13 + (size_t)e * 2 * FFE * DM; k.colmax = (unsigned*)(ws + WS_COLMAX) + e * 2 * FFE; k.psq = (float*)(ws + WS_PSQ) + e * 2 * FFE; }
    else { const int e = kind - 23; k.W = (const float*)a.in[I_MW2] + (size_t)e * FFE * DM; k.K = FFE; k.ot = 2; k.dst = ws + WS_W8M2 + (size_t)e * DM * FFE; k.colmax = (unsigned*)(ws + WS_COLMAX_W2) + e * DM; }
}
__device__ __forceinline__ int wk_drow(const WK& k, int n) {
    if (k.mode == 1) return (n >> 7) * 256 + k.which * 128 + (n & 127);
    if (k.mode == 3) { const int chn = n & 1023; return (chn >> 7) * 256 + (n >> 10) * 128 + (chn & 127); }
    if (k.mode == 2 || (k.mode == 4 && n < DM)) { const int d = n & 127; return k.base + (n & ~127) + (d < 32 ? rot32(d) : d); }
    return k.base + n;
}
__device__ __forceinline__ int wk_f8ex(float cm) { int ex = 0; if (cm > 0.f) { ex = 134 - (int)((__float_as_uint(cm) >> 23) & 0xffu); ex = ex < -60 ? -60 : (ex > 60 ? 60 : ex); } return ex; }
__device__ __forceinline__ unsigned q8(float x) { int q = (int)rintf(x); q = q < -127 ? -127 : (q > 127 ? 127 : q); return (unsigned)q & 0xffu; }
__device__ __forceinline__ unsigned q8x4(float a, float b, float c, float d, float f) {
    unsigned p = 0;
    p = __builtin_amdgcn_cvt_pk_u8_f32(rintf(fmaf(a, f, 128.0f)), 0, p); p = __builtin_amdgcn_cvt_pk_u8_f32(rintf(fmaf(b, f, 128.0f)), 1, p);
    p = __builtin_amdgcn_cvt_pk_u8_f32(rintf(fmaf(c, f, 128.0f)), 2, p); p = __builtin_amdgcn_cvt_pk_u8_f32(rintf(fmaf(d, f, 128.0f)), 3, p);
    return p ^ 0x80808080u;
}
__device__ __forceinline__ void wk_stats_item(const WK& k, int kb, int nb, int lane) {
    const int nc = nb * 256 + 4 * lane; float mx[4] = {0.f, 0.f, 0.f, 0.f}, sq[4] = {0.f, 0.f, 0.f, 0.f};
#pragma unroll 1
    for (int i0 = 0; i0 < 64; i0 += 16) { f32x4 v[16];
#pragma unroll
        for (int i = 0; i < 16; ++i) v[i] = *(const f32x4*)(k.W + (size_t)(kb * 64 + i0 + i) * k.ldw + nc);
#pragma unroll
        for (int i = 0; i < 16; ++i) { const float gs = k.gain ? k.gain[kb * 64 + i0 + i] : 1.0f;
#pragma unroll
            for (int c = 0; c < 4; ++c) { const float x = v[i][c] * gs; mx[c] = fmaxf(mx[c], fabsf(x)); sq[c] += x * x; } } }
#pragma unroll
    for (int c = 0; c < 4; ++c) { const int dr = wk_drow(k, nc + c); atomicMax(k.colmax + dr, __float_as_uint(mx[c])); if (k.psq) k.psq[(size_t)kb * (NE * 2 * FFE) + dr] = sq[c]; }
}
__device__ __forceinline__ void wk_item(const WK& k, int kb, int nb, int* sb8, LAS float* scr, int lane) {
    const int k0 = kb * 64, n0 = nb * 64;
    f32x4 v[16]; const int r4 = lane >> 4, c4 = (lane & 15) * 4;
#pragma unroll
    for (int i = 0; i < 16; ++i) v[i] = *(const f32x4*)(k.W + (size_t)(k0 + 4 * i + r4) * k.ldw + n0 + c4);
    const int k8 = lane & 3, nl = lane >> 2;
    int dr[4]; float qs[4];
#pragma unroll
    for (int st = 0; st < 4; ++st) { dr[st] = wk_drow(k, n0 + 16 * st + nl); qs[st] = 1.0f;
        if (k.ot == 1) { const float cm = __uint_as_float(k.colmax[dr[st]]); qs[st] = cm > 0.f ? 127.0f / cm : 0.f; }
        if (k.ot == 2) { const int ex = wk_f8ex(__uint_as_float(k.colmax[dr[st]])); qs[st] = __builtin_bit_cast(float, (unsigned)(127 + ex) << 23); if (kb == 0 && k8 == 0) sb8[dr[st]] = 127 - ex; } }
#pragma unroll
    for (int hf = 0; hf < 2; ++hf) {
#pragma unroll
        for (int i = 0; i < 8; ++i) { const int kk = 4 * i + r4; const float gs = k.gain ? k.gain[k0 + hf * 32 + kk] : 1.0f; LAS float* d = scr + kk * 65 + c4; const f32x4 x = v[hf * 8 + i];
            d[0] = x.x * gs; d[1] = x.y * gs; d[2] = x.z * gs; d[3] = x.w * gs; }
        LDS_WAIT(); asm volatile("" ::: "memory");
#pragma unroll
        for (int st = 0; st < 4; ++st) { const int n = 16 * st + nl; const LAS float* sp = scr + (8 * k8) * 65 + n; const float f = qs[st];
            if (k.ot == 0) { v4u o; o.x = cvt_pk_bf16(sp[0 * 65], sp[1 * 65]); o.y = cvt_pk_bf16(sp[2 * 65], sp[3 * 65]); o.z = cvt_pk_bf16(sp[4 * 65], sp[5 * 65]); o.w = cvt_pk_bf16(sp[6 * 65], sp[7 * 65]);
                *(v4u*)((bf16*)k.dst + (size_t)dr[st] * k.K + k0 + hf * 32 + 8 * k8) = o; }
            else { v2u o;
                if (k.ot == 1) { o.x = q8x4(sp[0 * 65], sp[1 * 65], sp[2 * 65], sp[3 * 65], f); o.y = q8x4(sp[4 * 65], sp[5 * 65], sp[6 * 65], sp[7 * 65], f); }
                else { int p0 = __builtin_amdgcn_cvt_pk_fp8_f32(sp[0 * 65] * f, sp[1 * 65] * f, 0, false); p0 = __builtin_amdgcn_cvt_pk_fp8_f32(sp[2 * 65] * f, sp[3 * 65] * f, p0, true);
                       int p1 = __builtin_amdgcn_cvt_pk_fp8_f32(sp[4 * 65] * f, sp[5 * 65] * f, 0, false); p1 = __builtin_amdgcn_cvt_pk_fp8_f32(sp[6 * 65] * f, sp[7 * 65] * f, p1, true); o.x = (unsigned)p0; o.y = (unsigned)p1; }
                *(v2u*)(k.dst + (size_t)dr[st] * k.K + k0 + hf * 32 + 8 * k8) = o; } }
        LDS_WAIT(); asm volatile("" ::: "memory");
    }
}
__device__ __forceinline__ void wk_shape(int kind, int& nkb, int& nn, bool& quant) {
    nkb = DM / 64; nn = DM; quant = false;
    if (kind == 0) nn = 2 * DM;
    else if (kind == 1) quant = MK_QKV8 != 0;
    else if (kind == 2) { nn = 2 * DM; quant = MK_QKV8 != 0; }
    else if (kind == 4 || kind == 5) { nn = FFD; quant = true; }
    else if (kind == 6) { nkb = FFD / 64; quant = MK_FFN2F8 != 0; }
    else if (kind >= 7 && kind < 23) { nn = FFE; quant = true; }
    else if (kind >= 23) { nkb = FFE / 64; quant = true; }
}
template <bool GAIN> __device__ __forceinline__ void wk_tile_stats(const WK& k, int kb, int r4, const f32x4 (&v)[16], float (&mx)[4], float (&sq)[4]) {
    const float* gp = GAIN ? k.gain + kb * 64 + 16 * r4 : nullptr; if (GAIN) asm volatile("" : "+v"(gp));
#pragma unroll
    for (int i = 0; i < 16; ++i) { const float gs = GAIN ? gp[i] : 1.0f;
#pragma unroll
        for (int c = 0; c < 4; ++c) { const float x = v[i][c] * gs; mx[c] = fmaxf(mx[c], fabsf(x)); sq[c] += x * x; } }
}
template <bool GAIN> __device__ __forceinline__ void wk_tile_out(const WK& k, int kb, int r4, const f32x4 (&v)[16], const int (&dr)[4], const float (&qs)[4]) {
    const float* gp = GAIN ? k.gain + kb * 64 + 16 * r4 : nullptr; if (GAIN) asm volatile("" : "+v"(gp));
    float g[16];
#pragma unroll
    for (int i = 0; i < 16; ++i) g[i] = GAIN ? gp[i] : 1.0f;
#pragma unroll
    for (int c = 0; c < 4; ++c) { const float f = qs[c]; v4u o;
        if (k.ot == 1) { o.x = q8x4(v[0][c] * g[0], v[1][c] * g[1], v[2][c] * g[2], v[3][c] * g[3], f); o.y = q8x4(v[4][c] * g[4], v[5][c] * g[5], v[6][c] * g[6], v[7][c] * g[7], f);
                         o.z = q8x4(v[8][c] * g[8], v[9][c] * g[9], v[10][c] * g[10], v[11][c] * g[11], f); o.w = q8x4(v[12][c] * g[12], v[13][c] * g[13], v[14][c] * g[14], v[15][c] * g[15], f); }
        else { unsigned w[4];
#pragma unroll
            for (int q = 0; q < 4; ++q) { int pw = __builtin_amdgcn_cvt_pk_fp8_f32(v[4 * q][c] * g[4 * q] * f, v[4 * q + 1][c] * g[4 * q + 1] * f, 0, false);
                pw = __builtin_amdgcn_cvt_pk_fp8_f32(v[4 * q + 2][c] * g[4 * q + 2] * f, v[4 * q + 3][c] * g[4 * q + 3] * f, pw, true); w[q] = (unsigned)pw; }
            o.x = w[0]; o.y = w[1]; o.z = w[2]; o.w = w[3]; }
        *(v4u*)(k.dst + (size_t)dr[c] * k.K + kb * 64 + 16 * r4) = o; }
}
#define SCHED_FENCE() __builtin_amdgcn_sched_barrier(0)
template <int TPW> __device__ __forceinline__ void wk_super(const WK& k, Frame& F, int sbslot, int nb) {
    LAS float* smax = (LAS float*)(F.lds + F.wave * 16384) + 2080; LAS float* ssq = smax + 64;
    const int lane = F.lane, r4 = lane >> 4, c4 = (lane & 15) * 4, tpw = TPW;
    const float* wbase = k.W + (size_t)(16 * r4) * k.ldw + nb * 64 + c4;
#define WK_LOAD(v, kb) do { const float* p_ = wbase + (size_t)((kb) * 64) * k.ldw; _Pragma("unroll") for (int i_ = 0; i_ < 16; ++i_) { v[i_] = *(const f32x4*)p_; p_ += k.ldw; asm volatile("" : "+v"(p_)); } } while (0)
    float mx[4] = {0.f, 0.f, 0.f, 0.f}, sq[4] = {0.f, 0.f, 0.f, 0.f};
    f32x4 va[16], vb[16];
    const int kbase = F.wave * tpw;
    if constexpr (TPW == 2) { WK_LOAD(va, kbase); WK_LOAD(vb, kbase + 1); wk_tile_stats<TPW == 2>(k, kbase, r4, va, mx, sq); wk_tile_stats<TPW == 2>(k, kbase + 1, r4, vb, mx, sq); }
    else {
        static_assert(TPW == 2 || TPW == 7, "tile schedule below is written for 7 tiles");
        WK_LOAD(va, kbase);
#pragma unroll 1
        for (int t = 0; t < 6; t += 2) { WK_LOAD(vb, kbase + t + 1); SCHED_FENCE(); wk_tile_stats<TPW == 2>(k, kbase + t, r4, va, mx, sq); SCHED_FENCE(); WK_LOAD(va, kbase + t + 2); SCHED_FENCE(); wk_tile_stats<TPW == 2>(k, kbase + t + 1, r4, vb, mx, sq); SCHED_FENCE(); }
        wk_tile_stats<TPW == 2>(k, kbase + 6, r4, va, mx, sq); }
#pragma unroll
    for (int c = 0; c < 4; ++c) { mx[c] = fmaxf(mx[c], __shfl_xor(mx[c], 16)); mx[c] = fmaxf(mx[c], __shfl_xor(mx[c], 32)); sq[c] += __shfl_xor(sq[c], 16); sq[c] += __shfl_xor(sq[c], 32); }
    if (lane < 16) {
#pragma unroll
        for (int c = 0; c < 4; ++c) { smax[c4 + c] = mx[c]; ssq[c4 + c] = sq[c]; } }
    __syncthreads();
    int dr[4]; float qs[4];
#pragma unroll
    for (int c = 0; c < 4; ++c) { const int n = c4 + c; float cm = 0.f;
#pragma unroll
        for (int w = 0; w < NWAVES; ++w) cm = fmaxf(cm, ((const LAS float*)(F.lds + w * 16384))[2080 + n]);
        dr[c] = wk_drow(k, nb * 64 + n); qs[c] = 1.0f;
        if (k.ot == 1) qs[c] = cm > 0.f ? 127.0f / cm : 0.f;
        if (k.ot == 2) { const int ex = wk_f8ex(cm); qs[c] = __builtin_bit_cast(float, (unsigned)(127 + ex) << 23); } }
    if (F.tid < 64) { const int n = F.tid; float cm = 0.f, ss = 0.f;
#pragma unroll
        for (int w = 0; w < NWAVES; ++w) { cm = fmaxf(cm, ((const LAS float*)(F.lds + w * 16384))[2080 + n]); ss += ((const LAS float*)(F.lds + w * 16384))[2144 + n]; }
        const int d = wk_drow(k, nb * 64 + n); k.colmax[d] = __float_as_uint(cm); if (k.psq) k.psq[d] = ss;
        if (k.ot == 2) ((int*)(F.ws + WS_SB8))[sbslot * DM + d] = 127 - wk_f8ex(cm); }
    if constexpr (TPW == 2) { wk_tile_out<TPW == 2>(k, kbase, r4, va, dr, qs); wk_tile_out<TPW == 2>(k, kbase + 1, r4, vb, dr, qs); }
    else {
        wk_tile_out<TPW == 2>(k, kbase + 6, r4, va, dr, qs); SCHED_FENCE();
        WK_LOAD(va, kbase + 4); SCHED_FENCE(); wk_tile_out<TPW == 2>(k, kbase + 5, r4, vb, dr, qs); SCHED_FENCE();
#pragma unroll 1
        for (int t = 4; t >= 2; t -= 2) { WK_LOAD(vb, kbase + t - 1); SCHED_FENCE(); wk_tile_out<TPW == 2>(k, kbase + t, r4, va, dr, qs); SCHED_FENCE(); WK_LOAD(va, kbase + t - 2); SCHED_FENCE(); wk_tile_out<TPW == 2>(k, kbase + t - 1, r4, vb, dr, qs); SCHED_FENCE(); }
        wk_tile_out<TPW == 2>(k, kbase, r4, va, dr, qs); }
#undef WK_LOAD
    __syncthreads();
}
__device__ __forceinline__ void wk_super_g(const WK& k, Frame& F, int sbslot, int nb) {
    LAS float* smax = (LAS float*)(F.lds + F.wave * 16384) + 2080; LAS float* ssq = smax + 64;
    const int lane = F.lane, r4 = lane >> 4, c4 = (lane & 15) * 4, nkb = k.K / 64;
    const float* wbase = k.W + (size_t)(16 * r4) * k.ldw + nb * 64 + c4;
#define WK_LOAD(v, kb) do { const float* p_ = wbase + (size_t)((kb) * 64) * k.ldw; _Pragma("unroll") for (int i_ = 0; i_ < 16; ++i_) { v[i_] = *(const f32x4*)p_; p_ += k.ldw; asm volatile("" : "+v"(p_)); } } while (0)
    float mx[4] = {0.f, 0.f, 0.f, 0.f}, sq[4] = {0.f, 0.f, 0.f, 0.f};
    f32x4 va[16];
#pragma unroll 1
    for (int kb = F.wave; kb < nkb; kb += NWAVES) { WK_LOAD(va, kb); wk_tile_stats<false>(k, kb, r4, va, mx, sq); }
#pragma unroll
    for (int c = 0; c < 4; ++c) { mx[c] = fmaxf(mx[c], __shfl_xor(mx[c], 16)); mx[c] = fmaxf(mx[c], __shfl_xor(mx[c], 32)); sq[c] += __shfl_xor(sq[c], 16); sq[c] += __shfl_xor(sq[c], 32); }
    if (lane < 16) {
#pragma unroll
        for (int c = 0; c < 4; ++c) { smax[c4 + c] = mx[c]; ssq[c4 + c] = sq[c]; } }
    __syncthreads();
    int dr[4]; float qs[4];
#pragma unroll
    for (int c = 0; c < 4; ++c) { const int n = c4 + c; float cm = 0.f;
#pragma unroll
        for (int w = 0; w < NWAVES; ++w) cm = fmaxf(cm, ((const LAS float*)(F.lds + w * 16384))[2080 + n]);
        dr[c] = wk_drow(k, nb * 64 + n); const int ex = wk_f8ex(cm); qs[c] = __builtin_bit_cast(float, (unsigned)(127 + ex) << 23); }
    if (F.tid < 64) { const int n = F.tid; float cm = 0.f;
#pragma unroll
        for (int w = 0; w < NWAVES; ++w) cm = fmaxf(cm, ((const LAS float*)(F.lds + w * 16384))[2080 + n]);
        const int d = wk_drow(k, nb * 64 + n); k.colmax[d] = __float_as_uint(cm); ((int*)(F.ws + WS_SB8))[sbslot * DM + d] = 127 - wk_f8ex(cm); }
#pragma unroll 1
    for (int kb = F.wave; kb < nkb; kb += NWAVES) { WK_LOAD(va, kb); wk_tile_out<false>(k, kb, r4, va, dr, qs); }
#undef WK_LOAD
    __syncthreads();
}
constexpr int WQ_TOTAL = NE * (DM / 64) + 2 * NE * (FFE / 64) + 2 * (FFD / 64) + (MK_QKV8 ? 3 * DM / 64 : 0) + (MK_FFN2F8 ? DM / 64 : 0);
__device__ __forceinline__ void wk_convert_super(KArgs ap, Frame& F) {
    volatile LAS unsigned* qw = F.MISC + 16;
    if (F.tid == 0) qw[0] = __hip_atomic_fetch_add(F.ctl + CW_WQ, 1u, __ATOMIC_RELAXED, __HIP_MEMORY_SCOPE_AGENT);
    __syncthreads();
    int it = __builtin_amdgcn_readfirstlane((int)qw[0]);
#pragma unroll 1
    while (it < WQ_TOTAL) {
        unsigned nxt = 0; if (F.tid == 0) nxt = __hip_atomic_fetch_add(F.ctl + CW_WQ, 1u, __ATOMIC_RELAXED, __HIP_MEMORY_SCOPE_AGENT);
        int kind = 6, rem = it, nkb = 16;
        if (!(MK_FFN2F8 && rem < DM / 64)) { if (MK_FFN2F8) rem -= DM / 64;
#pragma unroll 1
            for (kind = NKIND - 1;; --kind) { if (kind == 6) continue; int nn; bool quant; wk_shape(kind, nkb, nn, quant); const int cnt = quant ? nn / 64 : 0; if (rem < cnt) break; rem -= cnt; } }
        { WK k; wk_get(ap, F.ws, kind, k);
          if (kind == 6) wk_super_g(k, F, NE, rem); else if (nkb == 16) wk_super<2>(k, F, kind - 23, rem); else wk_super<7>(k, F, kind - 23, rem); }
        if (F.tid == 0) qw[0] = nxt;
        __syncthreads();
        it = __builtin_amdgcn_readfirstlane((int)qw[0]);
    }
}
__device__ __forceinline__ void wk_convert(KArgs ap, Frame& F, int pass) {
    LAS float* scr = (LAS float*)(F.lds + F.wave * 16384);
    const int gw = F.vcu * NWAVES + F.wave, NGW = F.G * NWAVES;
    int it = gw;
#pragma unroll 1
    for (int kind = 0; kind < NKIND; ++kind) { WK k; wk_get(ap, F.ws, kind, k);
        const bool quant = k.ot != 0;
        if (pass == 0 && quant) { if (MK_SUPER) continue; const int nkb = k.K / 64, nnb = k.N / 256, cnt = nkb * nnb;
            for (; it < cnt; it += NGW) wk_stats_item(k, it % nkb, it / nkb, F.lane);
            it -= cnt; }
        else if ((pass == 0) != quant) { const int nkb = k.K / 64, nnb = k.N / 64, cnt = nkb * nnb;
            int* sb8 = (int*)(F.ws + WS_SB8) + (kind >= 23 ? (kind - 23) * DM : 0);
            for (; it < cnt; it += NGW) wk_item(k, it / nnb, it % nnb, sb8, scr, F.lane);
            it -= cnt; }
    }
}
__device__ __forceinline__ void p0_s5_group(KArgs ap, Frame& F, int g, int qtr) {
    const auto& a = *ap;
    const float* lam_re = (const float*)a.in[I_LAMRE]; const float* lam_im = (const float*)a.in[I_LAMIM]; const float* log_dt = (const float*)a.in[I_LOGDT];
    const float* b_re = (const float*)a.in[I_BRE]; const float* b_im = (const float*)a.in[I_BIM]; const float* c_re = (const float*)a.in[I_CRE]; const float* c_im = (const float*)a.in[I_CIM];
    const float* g0 = (const float*)a.in[I_NORMS];
    LAS float* apr = (LAS float*)F.lds;
    LAS float* api = apr + 17 * 64;
    LAS float* bbr = api + 17 * 64;
    LAS float* bbi = bbr + 1024;
    LAS float* ccr = bbi + 1024;
    LAS float* cci = ccr + 1024;
    LAS float* ktab = cci + 1024;
    const float dt = expf(log_dt[g]);
    for (int idx = F.tid; idx < 17 * 64; idx += NWAVES * 64) { const int l = idx >> 6, p = idx & 63; const float zr = lam_re[g * 64 + p] * dt, zi = lam_im[g * 64 + p] * dt;
        const float mag = expf((float)l * zr); float sn, cs; sincosf((float)l * zi, &sn, &cs); apr[idx] = mag * cs; api[idx] = mag * sn; }
    for (int idx = F.tid; idx < 1024; idx += NWAVES * 64) { const int p = idx >> 4, j = idx & 15; const float lr = lam_re[g * 64 + p], li = lam_im[g * 64 + p]; const float zr = lr * dt, zi = li * dt;
        const float mag = expf(zr); float sn, cs; sincosf(zi, &sn, &cs); const float ar = mag * cs, ai = mag * sn, den = lr * lr + li * li;
        const float cfr = ((ar - 1.0f) * lr + ai * li) / den, cfi = (ai * lr - (ar - 1.0f) * li) / den;
        const float br = b_re[(size_t)(g * 64 + p) * 16 + j], bi = b_im[(size_t)(g * 64 + p) * 16 + j], gn = g0[g * 16 + j];
        bbr[idx] = (cfr * br - cfi * bi) * gn; bbi[idx] = (cfr * bi + cfi * br) * gn;
        ccr[idx] = c_re[(size_t)g * 1024 + idx]; cci[idx] = c_im[(size_t)g * 1024 + idx]; }
    __syncthreads();
    for (int idx0 = F.tid; idx0 < 1024; idx0 += NWAVES * 64) { const int l = idx0 >> 6, i = 4 * qtr + ((idx0 >> 4) & 3), j = idx0 & 15, idx = (l * 16 + i) * 16 + j; float s = 0.f;
        for (int p = 0; p < 64; ++p) { const float cr = ccr[i * 64 + p], ci = cci[i * 64 + p], ar = apr[l * 64 + p], ai = api[l * 64 + p]; const float car = cr * ar - ci * ai, cai = cr * ai + ci * ar; s += car * bbr[p * 16 + j] - cai * bbi[p * 16 + j]; }
        ktab[idx] = s; }
    __syncthreads();
    bf16* btc = (bf16*)(F.ws + WS_BTC) + (size_t)g * 256 * UAK; bf16* bta = (bf16*)(F.ws + WS_BTA) + (size_t)g * 256 * 256;
    for (int pc = F.tid; pc < 64 * 48; pc += NWAVES * 64) { const int nq = pc / 48, k8 = pc % 48, t = nq >> 2, i = 4 * qtr + (nq & 3), n = t * 16 + i; float v[8];
        if (k8 < 32) { const int s = k8 >> 1, j0 = (k8 & 1) * 8;
#pragma unroll
            for (int jj = 0; jj < 8; ++jj) v[jj] = (t >= s) ? ktab[((t - s) * 16 + i) * 16 + j0 + jj] : 0.f; }
        else { const int pb = (k8 - 32) * 8;
#pragma unroll
            for (int jj = 0; jj < 8; ++jj) { const int p = (pb + jj) & 63; const float cr = ccr[i * 64 + p], ci = cci[i * 64 + p], ar = apr[(t + 1) * 64 + p], ai = api[(t + 1) * 64 + p];
                v[jj] = (pb < 64) ? (cr * ar - ci * ai) : -(cr * ai + ci * ar); } }
        v4u o; o.x = pk2(v[0], v[1]); o.y = pk2(v[2], v[3]); o.z = pk2(v[4], v[5]); o.w = pk2(v[6], v[7]);
        *(v4u*)(btc + (size_t)n * UAK + k8 * 8) = o; }
    for (int pc = F.tid; pc < 64 * 32; pc += NWAVES * 64) { const int n = (pc >> 5) * 4 + qtr, k8 = pc & 31, s = k8 >> 1, j0 = (k8 & 1) * 8; float v[8];
        const int p = n & 63, l = 15 - s; const float ar = apr[l * 64 + p], ai = api[l * 64 + p];
#pragma unroll
        for (int jj = 0; jj < 8; ++jj) { const float br = bbr[p * 16 + j0 + jj], bi = bbi[p * 16 + j0 + jj]; v[jj] = (n < 64) ? (ar * br - ai * bi) : ((n < 128) ? (ar * bi + ai * br) : 0.f); }
        v4u o; o.x = pk2(v[0], v[1]); o.y = pk2(v[2], v[3]); o.z = pk2(v[4], v[5]); o.w = pk2(v[6], v[7]);
        *(v4u*)(bta + (size_t)n * 256 + k8 * 8) = o; }
    float* spar = (float*)(F.ws + WS_SPAR) + g * 128;
    if (qtr == 0 && F.tid < 64) { spar[F.tid] = apr[16 * 64 + F.tid]; spar[64 + F.tid] = api[16 * 64 + F.tid]; }
    __syncthreads();
}
__device__ __forceinline__ void p0_chunk_load(const float* x, Frame& F, int ch, f32x4 (&v)[2][4]) {
    const int b = ch >> 7, c = ch & 127;
#pragma unroll
    for (int rr = 0; rr < 2; ++rr) { const int tok = F.wave * 2 + rr; const f32x4* xr = (const f32x4*)(x + (size_t)(b * SEQ + c * CL + tok) * DM) + F.lane;
#pragma unroll
        for (int j = 0; j < 4; ++j) v[rr][j] = xr[64 * j]; }
}
__device__ __forceinline__ void p0_chunk_store(Frame& F, int ch, const f32x4 (&v)[2][4]) {
    const int b = ch >> 7, c = ch & 127; LAS unsigned short* tile = (LAS unsigned short*)F.lds;
#pragma unroll
    for (int rr = 0; rr < 2; ++rr) { const int tok = F.wave * 2 + rr; float s = 0.f;
#pragma unroll
        for (int j = 0; j < 4; ++j) s += (v[rr][j].x * v[rr][j].x + v[rr][j].y * v[rr][j].y) + (v[rr][j].z * v[rr][j].z + v[rr][j].w * v[rr][j].w);
        const float rstd = 1.0f / sqrtf(wave_sum(s) * (1.0f / DM) + NORM_EPS);
#pragma unroll
        for (int j = 0; j < 4; ++j) { v2u w; w.x = pk2(v[rr][j].x * rstd, v[rr][j].y * rstd); w.y = pk2(v[rr][j].z * rstd, v[rr][j].w * rstd); *(LAS v2u*)(tile + tok * 1032 + 4 * F.lane + 256 * j) = w; } }
    __syncthreads();
    bf16* ua = (bf16*)(F.ws + WS_UA);
#pragma unroll
    for (int it = 0; it < 4; ++it) { const int q = it * 512 + F.tid, g = q >> 5, piece = q & 31, tok = piece >> 1, half = piece & 1;
        const v4u w = *(const LAS v4u*)(tile + tok * 1032 + g * 16 + half * 8);
        *(v4u*)(ua + ((size_t)g * GROWS + b * NCH + c) * UAK + tok * 16 + half * 8) = w; }
    __syncthreads();
}
__device__ __forceinline__ void p0_prologue(KArgs ap, Frame& F) {
    const auto& a = *ap;
    const float* norms = (const float*)a.in[I_NORMS];
    for (int task = F.vcu; task < NG * 4; task += F.G) p0_s5_group(ap, F, task >> 2, task & 3);
    { const int gt = F.vcu * (NWAVES * 64) + F.tid, NT = F.G * NWAVES * 64; const int* pos = (const int*)a.in[I_POS]; float* rope = (float*)(F.ws + WS_ROPE);
      for (int idx = gt; idx < NTOK * 16; idx += NT) { const int n = idx >> 4, i = idx & 15; const float inv = 1.0f / powf(500000.0f, (float)i * (1.0f / 16.0f)); const float ang = (float)pos[n] * inv; float sn, cs; sincosf(ang, &sn, &cs); rope[(size_t)n * 32 + i] = cs; rope[(size_t)n * 32 + 16 + i] = sn; }
      const float* wr = (const float*)a.in[I_ROUTER]; float* wro = (float*)(F.ws + WS_WR);
      for (int idx = gt; idx < DM * NE; idx += NT) wro[idx] = wr[idx] * norms[(1 * 4 + 2) * DM + (idx >> 3)]; }
    { const float* x = (const float*)a.in[I_X]; f32x4 va[2][4], vb[2][4]; int ch = F.vcu;
      if (ch < BATCH * NCH) p0_chunk_load(x, F, ch, va);
#pragma unroll 1
      for (; ch < BATCH * NCH; ch += 2 * F.G) {
          const bool h1 = ch + F.G < BATCH * NCH, h2 = ch + 2 * F.G < BATCH * NCH;
          if (h1) p0_chunk_load(x, F, ch + F.G, vb);
          p0_chunk_store(F, ch, va);
          if (h2) p0_chunk_load(x, F, ch + 2 * F.G, va);
          if (h1) p0_chunk_store(F, ch + F.G, vb); } }
    wk_convert(ap, F, 0);
}
__device__ __forceinline__ void expert_act_scale(Frame& F) {
    if (F.vcu < NE + (MK_FFN2F8 ? 1 : 0)) { const int e = F.vcu; const bool dense = e == NE; const float* pq = dense ? (const float*)(F.ws + WS_PSQD) : (const float*)(F.ws + WS_PSQ) + e * 2 * FFE; float m1 = 0.f, m3 = 0.f;
        const int nrow = dense ? 2 * FFD : 2 * FFE;
        for (int i = F.tid; i < nrow; i += NWAVES * 64) { float ss = 0.f;
#pragma unroll
            for (int kc = 0; kc < (MK_SUPER ? 1 : DM / 64); ++kc) ss += pq[(size_t)kc * (NE * 2 * FFE) + i];
            const float v = sqrtf(ss); if ((i >> 7) & 1) m3 = fmaxf(m3, v); else m1 = fmaxf(m1, v); }
#pragma unroll
        for (int o = 1; o < 64; o <<= 1) { m1 = fmaxf(m1, __shfl_xor(m1, o)); m3 = fmaxf(m3, __shfl_xor(m3, o)); }
        LAS float* red = (LAS float*)(F.lds + 8192);
        if (F.lane == 0) { red[F.wave] = m1; red[8 + F.wave] = m3; }
        __syncthreads();
        if (F.tid == 0) { float a1 = 0.f, a3 = 0.f; for (int w = 0; w < NWAVES; ++w) { a1 = fmaxf(a1, red[w]); a3 = fmaxf(a3, red[8 + w]); }
            const float bound = 1.1f * 1024.0f * a1 * a3;
            const int ex = wk_f8ex(bound);
            __hip_atomic_store(F.ctl + CW_EA + e, (unsigned)(127 - ex), __ATOMIC_RELAXED, __HIP_MEMORY_SCOPE_AGENT); }
        __syncthreads(); }
}
__device__ __forceinline__ void s5_scan_local(Frame& F) {
    const float* spar = (const float*)(F.ws + WS_SPAR); const float* sloc = (const float*)(F.ws + WS_SLOC); bf16* ua = (bf16*)(F.ws + WS_UA);
    const int nunits = (NG * 8 - F.bx + F.G - 1) / F.G;
    for (int t = F.wave; t < 2 * nunits; t += NWAVES) { int pm, pn; pg8::tile_of((t >> 1) * F.G + F.bx, NG * 8, 1, pm, pn);
        const int g = pm >> 3, b = (pm & 7) * 2 + (t & 1), p = F.lane;
        const float ar = spar[g * 128 + p], ai = spar[g * 128 + 64 + p]; float sr = 0.f, si = 0.f;
        const size_t row0 = (size_t)g * GROWS + b * NCH;
        constexpr int SB = 16; float l0r[SB], l0i[SB], l1r[SB], l1i[SB];
#define S5_LD(R, I, c0) do { _Pragma("unroll") for (int j = 0; j < SB; ++j) { R[j] = sloc[(row0 + (c0) + j) * 128 + p]; I[j] = sloc[(row0 + (c0) + j) * 128 + 64 + p]; } } while (0)
#define S5_RUN(R, I, c0) do { _Pragma("unroll") for (int j = 0; j < SB; ++j) { ua[(row0 + (c0) + j) * UAK + 256 + p] = (bf16)f2bf(sr); ua[(row0 + (c0) + j) * UAK + 320 + p] = (bf16)f2bf(si); \
            const float nr = ar * sr - ai * si + R[j], ni = ar * si + ai * sr + I[j]; sr = nr; si = ni; } } while (0)
        S5_LD(l0r, l0i, 0);
#pragma unroll 1
        for (int c0 = 0; c0 < NCH; c0 += 2 * SB) {
            S5_LD(l1r, l1i, c0 + SB); __builtin_amdgcn_sched_barrier(0);
            S5_RUN(l0r, l0i, c0); __builtin_amdgcn_sched_barrier(0);
            if (c0 + 2 * SB < NCH) S5_LD(l0r, l0i, c0 + 2 * SB);
            __builtin_amdgcn_sched_barrier(0);
            S5_RUN(l1r, l1i, c0 + SB); __builtin_amdgcn_sched_barrier(0); }
#undef S5_LD
#undef S5_RUN
    }
}
template <bool ROUTE, bool SRC, bool QOUT>
__device__ __forceinline__ void resid_pass(Frame& F, const float* xin, const bf16* xhin, const bf16* mix, int nslots, const float* gain, bf16* xh, const float* rbias) {
    const float* rowss = (const float*)(F.ws + WS_ROWSS); float* rs = (float*)(F.ws + WS_RS);
    LAS int* l_e = (LAS int*)F.lds; LAS float* l_w = (LAS float*)(F.lds + 1024); LAS int* l_cnt = (LAS int*)(F.lds + 2048); LAS int* l_base = (LAS int*)(F.lds + 2048 + 64); LAS float* l_s = (LAS float*)(F.lds + 3072);
    for (int blk = F.vcu; blk < NTOK / 128; blk += F.G) {
        if (ROUTE) { if (F.tid < NE) l_cnt[F.tid] = 0; __syncthreads(); }
        for (int k = 0; k < 16; ++k) { const int row = blk * 128 + F.wave * 16 + k;
            const v4u m0 = *(const v4u*)(mix + (size_t)row * DM + 8 * F.lane), m1 = *(const v4u*)(mix + (size_t)row * DM + 512 + 8 * F.lane);
            float hn[16];
            if (SRC) { const v4u a0 = *(const v4u*)(xhin + (size_t)row * DM + 8 * F.lane), a1 = *(const v4u*)(xhin + (size_t)row * DM + 512 + 8 * F.lane); const float sc = rs[row];
                hn[0] = bf2f(a0.x & 0xffffu) * sc; hn[1] = bf2f(a0.x >> 16) * sc; hn[2] = bf2f(a0.y & 0xffffu) * sc; hn[3] = bf2f(a0.y >> 16) * sc; hn[4] = bf2f(a0.z & 0xffffu) * sc; hn[5] = bf2f(a0.z >> 16) * sc; hn[6] = bf2f(a0.w & 0xffffu) * sc; hn[7] = bf2f(a0.w >> 16) * sc;
                hn[8] = bf2f(a1.x & 0xffffu) * sc; hn[9] = bf2f(a1.x >> 16) * sc; hn[10] = bf2f(a1.y & 0xffffu) * sc; hn[11] = bf2f(a1.y >> 16) * sc; hn[12] = bf2f(a1.z & 0xffffu) * sc; hn[13] = bf2f(a1.z >> 16) * sc; hn[14] = bf2f(a1.w & 0xffffu) * sc; hn[15] = bf2f(a1.w >> 16) * sc; }
            else { const f32x4* hp = (const f32x4*)(xin + (size_t)row * DM); const f32x4 h0 = hp[2 * F.lane], h1 = hp[2 * F.lane + 1], h2 = hp[128 + 2 * F.lane], h3 = hp[128 + 2 * F.lane + 1];
#pragma unroll
                for (int j = 0; j < 4; ++j) { hn[j] = h0[j]; hn[4 + j] = h1[j]; hn[8 + j] = h2[j]; hn[12 + j] = h3[j]; } }
            const f32x4* gp = (const f32x4*)gain; const f32x4 g0 = gp[2 * F.lane], g1 = gp[2 * F.lane + 1], g2 = gp[128 + 2 * F.lane], g3 = gp[128 + 2 * F.lane + 1];
            const float ssm = wave_sum(F.lane < nslots ? rowss[(size_t)row * 32 + F.lane] : 0.f);
            const float rm = 1.0f / sqrtf(ssm * (1.0f / DM) + NORM_EPS);
            hn[0] += bf2f(m0.x & 0xffffu) * rm * g0[0]; hn[1] += bf2f(m0.x >> 16) * rm * g0[1]; hn[2] += bf2f(m0.y & 0xffffu) * rm * g0[2]; hn[3] += bf2f(m0.y >> 16) * rm * g0[3];
            hn[4] += bf2f(m0.z & 0xffffu) * rm * g1[0]; hn[5] += bf2f(m0.z >> 16) * rm * g1[1]; hn[6] += bf2f(m0.w & 0xffffu) * rm * g1[2]; hn[7] += bf2f(m0.w >> 16) * rm * g1[3];
            hn[8] += bf2f(m1.x & 0xffffu) * rm * g2[0]; hn[9] += bf2f(m1.x >> 16) * rm * g2[1]; hn[10] += bf2f(m1.y & 0xffffu) * rm * g2[2]; hn[11] += bf2f(m1.y >> 16) * rm * g2[3];
            hn[12] += bf2f(m1.z & 0xffffu) * rm * g3[0]; hn[13] += bf2f(m1.z >> 16) * rm * g3[1]; hn[14] += bf2f(m1.w & 0xffffu) * rm * g3[2]; hn[15] += bf2f(m1.w >> 16) * rm * g3[3];
            float s2 = 0.f;
#pragma unroll
            for (int j = 0; j < 16; ++j) s2 += hn[j] * hn[j];
            const float ms = wave_sum(s2) * (1.0f / DM) + NORM_EPS; const float rms = sqrtf(ms), rh = 1.0f / rms;
            if (F.lane == 0) rs[row] = rms;
            v4u w0, w1; w0.x = pk2(hn[0] * rh, hn[1] * rh); w0.y = pk2(hn[2] * rh, hn[3] * rh); w0.z = pk2(hn[4] * rh, hn[5] * rh); w0.w = pk2(hn[6] * rh, hn[7] * rh);
            w1.x = pk2(hn[8] * rh, hn[9] * rh); w1.y = pk2(hn[10] * rh, hn[11] * rh); w1.z = pk2(hn[12] * rh, hn[13] * rh); w1.w = pk2(hn[14] * rh, hn[15] * rh);
            *(v4u*)(xh + (size_t)row * DM + 8 * F.lane) = w0; *(v4u*)(xh + (size_t)row * DM + 512 + 8 * F.lane) = w1;
            if (QOUT) {
                { float am = 0.f;
#pragma unroll
                  for (int j = 0; j < 16; ++j) am = fmaxf(am, fabsf(hn[j]));
#pragma unroll
                  for (int o = 1; o < 64; o <<= 1) am = fmaxf(am, __shfl_xor(am, o));
                  am *= rh; const float inv = am > 0.f ? 127.0f / am : 0.f, qs = rh * inv;
                  v2u q0, q1;
                  q0.x = q8x4(hn[0], hn[1], hn[2], hn[3], qs); q0.y = q8x4(hn[4], hn[5], hn[6], hn[7], qs);
                  q1.x = q8x4(hn[8], hn[9], hn[10], hn[11], qs); q1.y = q8x4(hn[12], hn[13], hn[14], hn[15], qs);
                  unsigned char* xq = F.ws + WS_XQ3 + (size_t)row * DM; *(v2u*)(xq + 8 * F.lane) = q0; *(v2u*)(xq + 512 + 8 * F.lane) = q1;
                  if (F.lane == 0) { if (ROUTE) l_s[F.wave * 16 + k] = am * (1.0f / 127.0f); else ((float*)(F.ws + WS_RSC))[row] = am * (1.0f / 127.0f); } }
            }
            if (ROUTE) {
                const float* wr = (const float*)(F.ws + WS_WR); float lg[NE];
#pragma unroll
                for (int e = 0; e < NE; ++e) lg[e] = 0.f;
#pragma unroll
                for (int half = 0; half < 2; ++half)
#pragma unroll
                    for (int j = 0; j < 8; ++j) { const int cc = half * 512 + 8 * F.lane + j; const f32x4 wa = *(const f32x4*)(wr + cc * 8), wb = *(const f32x4*)(wr + cc * 8 + 4); const float xv = hn[half * 8 + j] * rh;
                        lg[0] += xv * wa[0]; lg[1] += xv * wa[1]; lg[2] += xv * wa[2]; lg[3] += xv * wa[3]; lg[4] += xv * wb[0]; lg[5] += xv * wb[1]; lg[6] += xv * wb[2]; lg[7] += xv * wb[3]; }
#pragma unroll
                for (int e = 0; e < NE; ++e) lg[e] = wave_sum(lg[e]) + rbias[e];
                int e0 = 0; float v0 = lg[0];
#pragma unroll
                for (int e = 1; e < NE; ++e) if (lg[e] > v0) { v0 = lg[e]; e0 = e; }
                int e1 = -1; float v1 = -__builtin_inff();
#pragma unroll
                for (int e = 0; e < NE; ++e) if (e != e0 && lg[e] > v1) { v1 = lg[e]; e1 = e; }
                const float w1s = 1.0f / (1.0f + __expf(v0 - v1)), w0s = 1.0f - w1s;
                if (F.lane == 0) { const int ai = (F.wave * 16 + k) * 2; l_e[ai] = e0; l_e[ai + 1] = e1; l_w[ai] = w0s; l_w[ai + 1] = w1s; }
            }
        }
        if (ROUTE) {
            __syncthreads();
            int* list = (int*)(F.ws + WS_LIST); int* slot = (int*)(F.ws + WS_SLOT); float* tokw = (float*)(F.ws + WS_TOKW);
            int e = 0, rank = 0;
            if (F.tid < 256) { e = l_e[F.tid]; rank = atomicAdd((int*)&l_cnt[e], 1); }
            __syncthreads();
            if (F.tid < NE) l_base[F.tid] = (int)__hip_atomic_fetch_add(F.ctl + CW_ECNT + 64 * F.tid, (unsigned)l_cnt[F.tid], __ATOMIC_RELAXED, __HIP_MEMORY_SCOPE_AGENT);
            __syncthreads();
            if (F.tid < 256) { const int pos = l_base[e] + rank, token = blk * 128 + (F.tid >> 1);
                if (pos < LCAP) { list[e * LCAP + pos] = token; ((float*)(F.ws + WS_RSC))[e * LCAP + pos] = l_s[F.tid >> 1]; }
                slot[token * 2 + (F.tid & 1)] = e * LCAP + pos; tokw[token * 2 + (F.tid & 1)] = l_w[F.tid]; }
            __syncthreads();
        }
    }
}
__device__ __forceinline__ void final_pass(Frame& F, float* out, const bf16* xh, const bf16* y, const float* gain) {
    const int gw = F.vcu * NWAVES + F.wave, NGW = F.G * NWAVES;
    etab_build(F.lds, F.ctl);
    const int* slot = (const int*)(F.ws + WS_SLOT); const float* tokw = (const float*)(F.ws + WS_TOKW); const float* rsv = (const float*)(F.ws + WS_RS); const f32x4* gp = (const f32x4*)gain;
    if (gw >= NTOK) return;
#define FP_S1(row_, S, W) do { S = *(const v2u*)(slot + (size_t)(row_) * 2); W = *(const f32x2*)(tokw + (size_t)(row_) * 2); } while (0)
#define FP_S2(row_, S, R0, R1, YA, YB, XA, SC) do { const int e0_ = ((int)S.x >> 15) & 7, e1_ = ((int)S.y >> 15) & 7; const int ps0_ = *(const LAS int*)(F.lds + ET_OFF + 32 + 4 * e0_), ps1_ = *(const LAS int*)(F.lds + ET_OFF + 32 + 4 * e1_); \
        R0 = (size_t)ps0_ * 256 + (S.x & (LCAP - 1)); R1 = (size_t)ps1_ * 256 + (S.y & (LCAP - 1)); const bool fast_ = R0 < 65536 && R1 < 65536; const size_t q0_ = fast_ ? R0 : 0, q1_ = fast_ ? R1 : 0; \
        _Pragma("unroll") for (int half = 0; half < 2; ++half) { YA[half] = *(const v4u*)(y + q0_ * DM + half * 512 + 8 * F.lane); YB[half] = *(const v4u*)(y + q1_ * DM + half * 512 + 8 * F.lane); XA[half] = *(const v4u*)(xh + (size_t)(row_) * DM + half * 512 + 8 * F.lane); } \
        SC = rsv[row_]; } while (0)
    int row = gw, nrow = gw + NGW; v2u sc_ = {0u, 0u}, sn_ = {0u, 0u}; f32x2 wc_ = {0.f, 0.f}, wn_ = {0.f, 0.f};
    size_t r0c, r1c; v4u yac[2], ybc[2], xac[2]; float scc;
    FP_S1(row, sc_, wc_);
    FP_S2(row, sc_, r0c, r1c, yac, ybc, xac, scc);
    if (nrow < NTOK) FP_S1(nrow, sn_, wn_);
#pragma unroll 1
    for (;;) {
        const bool has_next = nrow < NTOK;
        size_t r0n = 0, r1n = 0; v4u yan[2] = {{0u, 0u, 0u, 0u}, {0u, 0u, 0u, 0u}}, ybn[2] = {{0u, 0u, 0u, 0u}, {0u, 0u, 0u, 0u}}, xan[2] = {{0u, 0u, 0u, 0u}, {0u, 0u, 0u, 0u}}; float scn = 0.f; v2u snn = {0u, 0u}; f32x2 wnn = {0.f, 0.f};
        if (has_next) { FP_S2(nrow, sn_, r0n, r1n, yan, ybn, xan, scn); const int nn = nrow + NGW; if (nn < NTOK) FP_S1(nn, snn, wnn); }
        __builtin_amdgcn_sched_barrier(0);
        const size_t r0 = r0c, r1 = r1c; const float w0 = wc_[0], w1 = wc_[1];
        float f[16];
        if (r0 >= 65536 || r1 >= 65536) {
            const bf16* yp = (const bf16*)(F.ws + WS_YP);
#pragma unroll
            for (int j = 0; j < 16; ++j) f[j] = 0.f;
#pragma unroll 1
            for (int side = 0; side < 2; ++side) { const size_t r = side ? r1 : r0; const float w = side ? w1 : w0; const int nk = r >= 65536 ? KSPLIT : 1;
                for (int kc = 0; kc < nk; ++kc) { const bf16* src = r >= 65536 ? yp + ((size_t)(kc * LPMAX) * 256 + (r - 65536)) * DM : y + r * DM;
#pragma unroll
                    for (int half = 0; half < 2; ++half) { const v4u a = *(const v4u*)(src + half * 512 + 8 * F.lane);
                        f[half * 8 + 0] += w * bf2f(a.x & 0xffffu); f[half * 8 + 1] += w * bf2f(a.x >> 16); f[half * 8 + 2] += w * bf2f(a.y & 0xffffu); f[half * 8 + 3] += w * bf2f(a.y >> 16);
                        f[half * 8 + 4] += w * bf2f(a.z & 0xffffu); f[half * 8 + 5] += w * bf2f(a.z >> 16); f[half * 8 + 6] += w * bf2f(a.w & 0xffffu); f[half * 8 + 7] += w * bf2f(a.w >> 16); } } } }
        else
#pragma unroll
        for (int half = 0; half < 2; ++half) { const v4u a = yac[half], bq = ybc[half];
            f[half * 8 + 0] = w0 * bf2f(a.x & 0xffffu) + w1 * bf2f(bq.x & 0xffffu); f[half * 8 + 1] = w0 * bf2f(a.x >> 16) + w1 * bf2f(bq.x >> 16);
            f[half * 8 + 2] = w0 * bf2f(a.y & 0xffffu) + w1 * bf2f(bq.y & 0xffffu); f[half * 8 + 3] = w0 * bf2f(a.y >> 16) + w1 * bf2f(bq.y >> 16);
            f[half * 8 + 4] = w0 * bf2f(a.z & 0xffffu) + w1 * bf2f(bq.z & 0xffffu); f[half * 8 + 5] = w0 * bf2f(a.z >> 16) + w1 * bf2f(bq.z >> 16);
            f[half * 8 + 6] = w0 * bf2f(a.w & 0xffffu) + w1 * bf2f(bq.w & 0xffffu); f[half * 8 + 7] = w0 * bf2f(a.w >> 16) + w1 * bf2f(bq.w >> 16); }
        float ss = 0.f;
#pragma unroll
        for (int j = 0; j < 16; ++j) ss += f[j] * f[j];
        const float rf = 1.0f / sqrtf(wave_sum(ss) * (1.0f / DM) + NORM_EPS);
        f32x4* hp = (f32x4*)(out + (size_t)row * DM); const float sc = scc;
#pragma unroll
        for (int half = 0; half < 2; ++half) { const v4u a = xac[half];
            const float hv[8] = {bf2f(a.x & 0xffffu), bf2f(a.x >> 16), bf2f(a.y & 0xffffu), bf2f(a.y >> 16), bf2f(a.z & 0xffffu), bf2f(a.z >> 16), bf2f(a.w & 0xffffu), bf2f(a.w >> 16)};
#pragma unroll
            for (int q = 0; q < 2; ++q) { const int idx = half * 128 + 2 * F.lane + q; f32x4 h; const f32x4 g = gp[idx];
#pragma unroll
                for (int j = 0; j < 4; ++j) h[j] = hv[q * 4 + j] * sc + f[half * 8 + q * 4 + j] * rf * g[j];
                hp[idx] = h; } }
        if (!has_next) break;
        row = nrow; nrow += NGW; wc_ = wn_; r0c = r0n; r1c = r1n; scc = scn; sn_ = snn; wn_ = wnn;
#pragma unroll
        for (int half = 0; half < 2; ++half) { yac[half] = yan[half]; ybc[half] = ybn[half]; xac[half] = xan[half]; }
    }
#undef FP_S1
#undef FP_S2
}

constexpr int N_PHASES = MK_F8 ? 14 : 20;
__global__ void __launch_bounds__(NWAVES * 64, 2) mk_fwd(Args args) {
    extern __shared__ __attribute__((aligned(16))) unsigned char lds_raw[];
    Frame F; refresh(F);
    for (int u = F.tid; u < (LDS_BYTES - LDSCTL_OFF) / 4; u += NWAVES * 64) ((LAS unsigned*)(F.lds + LDSCTL_OFF))[u] = 0u;
    __syncthreads();
    if (F.hi - F.lo > 1) (void)xcd_barrier_post(F.ctl + CW_BAR, F.MISC + 8);
#ifndef MK_ONLY
#define MK_ONLY -1
#endif
#define IN(k) ((MK_ONLY < 0 || (k) == MK_ONLY) && (refresh(F), F.lo <= (k) && (k) < F.hi))
#define SEAM(k) do { refresh(F); if (F.lo <= (k) && (k) + 1 < F.hi) xcd_barrier(frame_bar(F)); } while (0)
#define ws (F.ws)
#define cblk (F.bx)
    if (IN(0)) { p0_prologue(kargs(), F); } SEAM(0);
    if (IN(1)) {
        if (MK_SUPER) wk_convert_super(kargs(), F); else wk_convert(kargs(), F, 1);
        __syncthreads();
        { PlainSched S{(const char*)(ws + WS_UA), (const char*)(ws + WS_BTA), 256, UAK, 256, NG * 8, 1, F.G, cblk, 8, (size_t)256 * 256 * 2};
          EpiS5A E{(float*)(ws + WS_SLOC)};
          pg8::gemm_phase(F.lds, S, E); }
        __builtin_amdgcn_fence(__ATOMIC_ACQUIRE, "agent"); VM_WAIT(); __syncthreads();
        s5_scan_local(F);
        VM_WAIT(); __syncthreads(); __builtin_amdgcn_fence(__ATOMIC_ACQUIRE, "agent"); VM_WAIT(); __syncthreads();
        { KArgs ka = kargs(); PlainSched S{(const char*)(ws + WS_UA), (const char*)(ws + WS_BTC), UAK, UAK, UAK, NG * 8, 1, F.G, cblk, 8, (size_t)256 * UAK * 2};
          EpiS5C E{(const bf16*)(ws + WS_UA), (const float*)ka->in[I_SD], (const float*)ka->in[I_NORMS], (bf16*)(ws + WS_GBUF)};
          pg8::gemm_phase(F.lds, S, E); }
    } SEAM(1);
    if (IN(2)) {
        PlainSched S{(const char*)(ws + WS_GBUF), (const char*)(ws + WS_WGLU), DM, DM, DM, NTOK / 256, 8, F.G, cblk, 1 << 30, 0};
        EpiGated<0> E{(bf16*)(ws + WS_MIX0), DM, (float*)(ws + WS_ROWSS), 0};
        pg8::gemm_phase(F.lds, S, E);
    } SEAM(2);
    if (IN(3)) { KArgs ka = kargs(); resid_pass<false, false, true>(F, (const float*)ka->in[I_X], nullptr, (const bf16*)(ws + WS_MIX0), 32, (const float*)ka->in[I_NORMS] + 1 * DM, (bf16*)(ws + WS_XH1), nullptr);
        expert_act_scale(F); } SEAM(3);
    if (IN(4)) {
        const int sad = MK_FFN2F8 ? (int)__hip_atomic_load(F.ctl + CW_EA + NE, __ATOMIC_RELAXED, __HIP_MEMORY_SCOPE_AGENT) : 127;
        PlainSched S{(const char*)(ws + WS_XQ3), (const char*)(ws + WS_WQF13), DM / 2, DM / 2, DM / 2, NTOK / 256, 2 * FFD / 256, F.G, cblk, 1 << 30, 0, sad};
        EpiGatedI8<MK_FFN2F8 != 0> E{(bf16*)(ws + WS_ACTD), FFD, (const float*)(ws + WS_RSC), (const float*)(ws + WS_COLMAX_F), 0, nullptr};
        pg8::gemm_phase(F.lds, S, E);
    } SEAM(4);
    if (IN(5)) {
#if MK_FFN2F8
        const int sad = (int)__hip_atomic_load(F.ctl + CW_EA + NE, __ATOMIC_RELAXED, __HIP_MEMORY_SCOPE_AGENT);
        PlainSched S{(const char*)(ws + WS_ACTD), (const char*)(ws + WS_WF2), FFD / 2, FFD / 2, FFD / 2, NTOK / 256, DM / 256, F.G, cblk, 1 << 30, 0, sad, (const int*)(ws + WS_SB8) + NE * DM};
        EpiPlain<true, false, 2> E{(bf16*)(ws + WS_F0), DM, (float*)(ws + WS_ROWSS)};
#else
        PlainSched S{(const char*)(ws + WS_ACTD), (const char*)(ws + WS_WF2), FFD, FFD, FFD, NTOK / 256, DM / 256, F.G, cblk, 1 << 30, 0};
        EpiPlain<true, false> E{(bf16*)(ws + WS_F0), DM, (float*)(ws + WS_ROWSS)};
#endif
        pg8::gemm_phase(F.lds, S, E);
    } SEAM(5);
    if (IN(6)) { KArgs ka = kargs(); resid_pass<false, true, MK_QKV8 != 0>(F, nullptr, (const bf16*)(ws + WS_XH1), (const bf16*)(ws + WS_F0), 16, (const float*)ka->in[I_NORMS] + 3 * DM, (bf16*)(ws + WS_XH2), nullptr); } SEAM(6);
    if (IN(7)) {
#if MK_QKV8
        PlainSched S{(const char*)(ws + WS_XQ3), (const char*)(ws + WS_WQQKV), DM / 2, DM / 2, DM / 2, NTOK / 256, 12, F.G, cblk, 1 << 30, 0};
        EpiQKV<true> E{(bf16*)(ws + WS_Q), (const float*)(ws + WS_ROPE), (float*)(ws + WS_KMEAN), (const float*)(ws + WS_RSC), (const float*)(ws + WS_COLMAX_QKV)};
#else
        PlainSched S{(const char*)(ws + WS_XH2), (const char*)(ws + WS_WQKV), DM, DM, DM, NTOK / 256, 12, F.G, cblk, 1 << 30, 0};
        EpiQKV<false> E{(bf16*)(ws + WS_Q), (const float*)(ws + WS_ROPE), (float*)(ws + WS_KMEAN), nullptr, nullptr};
#endif
        pg8::gemm_phase(F.lds, S, E);
    } SEAM(7);
    if (IN(8)) {
        const bf16* Qb = (const bf16*)(ws + WS_Q); const bf16* Kb = (const bf16*)(ws + WS_K); const bf16* Vb = (const bf16*)(ws + WS_V); bf16* Ob = (bf16*)(ws + WS_O); const float* KM = (const float*)(ws + WS_KMEAN);
        const int nitems = (BATCH * NH * 4 - F.vcu + F.G - 1) / F.G, nblocks = 2 * nitems;
        attn::Seam Sm;
#define MK_REF(R, kk) do { const int it_ = F.vcu + ((kk) >> 1) * F.G, bh_ = it_ >> 2, x_ = it_ & 3, qb_ = ((kk) & 1) ? 7 - x_ : x_, b_ = bh_ >> 3, h_ = bh_ & 7; \
        const size_t base_ = (size_t)b_ * SEQ * DM + h_ * HD; R.Q = Qb + base_ + (size_t)qb_ * 256 * DM; R.K = Kb + base_; R.V = Vb + base_; R.O = Ob + base_ + (size_t)qb_ * 256 * DM; R.KM = KM + (size_t)bh_ * NBLK * HD; R.P0 = qb_ * 256; } while (0)
        if (nblocks > 0) {
            attn::BlockRef cur, nxt; MK_REF(cur, 0);
            attn::moba_prime(cur, (char*)lds_raw, Sm);
            for (int kb = 0; kb < nblocks; ++kb) { const int kn = kb + 1 < nblocks ? kb + 1 : kb; MK_REF(nxt, kn); attn::moba_block(cur, nxt, (char*)lds_raw, Sm); cur = nxt; }
        }
#undef MK_REF
    } SEAM(8);
    if (IN(9)) {
        PlainSched S{(const char*)(ws + WS_O), (const char*)(ws + WS_WO), DM, DM, DM, NTOK / 256, DM / 256, F.G, cblk, 1 << 30, 0};
        EpiPlain<true, false> E{(bf16*)(ws + WS_MIX1), DM, (float*)(ws + WS_ROWSS)};
        pg8::gemm_phase(F.lds, S, E);
    } SEAM(9);
    if (IN(10)) { KArgs ka = kargs(); resid_pass<true, true, true>(F, nullptr, (const bf16*)(ws + WS_XH2), (const bf16*)(ws + WS_MIX1), 16, (const float*)ka->in[I_NORMS] + (4 + 1) * DM, (bf16*)(ws + WS_XH3), (const float*)ka->in[I_RBIAS]); } SEAM(10);
#if MK_F8
    if (IN(11)) {
        etab_build(F.lds, F.ctl); int nM = et_ps(F.lds, NE); nM = nM > 264 ? 264 : nM;
        MoeSched1 S{(const char*)(ws + WS_XQ3), (const char*)(ws + WS_WQ13), (const int*)(ws + WS_LIST), DM / 2, DM / 2, nM, 2 * FFE / 256, F.G, cblk, 0, F.lds};
        EpiGatedI8<true> E{(bf16*)(ws + WS_ACTM), FFE, (const float*)(ws + WS_RSC), (const float*)(ws + WS_COLMAX), 2 * FFE, (unsigned char*)kargs()->out};
        pg8::gemm_phase(F.lds, S, E);
    } SEAM(11);
    if (IN(12)) {
        etab_build(F.lds, F.ctl); const int P = et_ps(F.lds, NE); const int nM = P > 256 ? 256 : P; int nLeft = P - 256; nLeft = nLeft < 0 ? 0 : (nLeft > LPMAX ? LPMAX : nLeft);
        { MoeSched2 S{(const char*)(ws + WS_ACTM), (const char*)kargs()->out, (const char*)(ws + WS_W8M2), (const int*)(ws + WS_SB8), FFE / 2, FFE / 2, FFE / 2, nM, DM / 256, F.G, cblk, 0, F.lds};
          EpiPlain<false, true, 2> E{(bf16*)(ws + WS_Y), DM, nullptr};
          pg8::gemm_phase(F.lds, S, E); }
        { MoeSched2K S{(const char*)(ws + WS_ACTM), (const char*)kargs()->out, (const char*)(ws + WS_W8M2), (const int*)(ws + WS_SB8), 256, FFE / 2, FFE / 2, nLeft, F.G, (F.G - 1) - cblk, F.lds};
          EpiPlain<false, true, 2> E{(bf16*)(ws + WS_YP), DM, nullptr};
          pg8::gemm_phase(F.lds, S, E); }
    } SEAM(12);
#else
#pragma unroll
    for (int q = 0; q < 4; ++q) {
        if (IN(11 + 2 * q)) {
            etab_build(F.lds, F.ctl); const int P = et_ps(F.lds, NE); const int p0 = 64 * q; int nM = (q < 3) ? 64 : P - 192; nM = nM > 72 ? 72 : nM; if (p0 + nM > P) nM = P - p0; if (nM < 0) nM = 0;
            MoeSched1 S{(const char*)(ws + WS_XQ3), (const char*)(ws + WS_WQ13), (const int*)(ws + WS_LIST), DM / 2, DM / 2, nM, 2 * FFE / 256, F.G, cblk, p0, F.lds};
            EpiGatedI8<false> E{(bf16*)(ws + WS_ACTM), FFE, (const float*)(ws + WS_RSC), (const float*)(ws + WS_COLMAX), 2 * FFE, nullptr};
            pg8::gemm_phase(F.lds, S, E);
        } SEAM(11 + 2 * q);
        if (IN(12 + 2 * q)) {
            etab_build(F.lds, F.ctl); const int P = et_ps(F.lds, NE); const int p0 = 64 * q; int nM = (q < 3) ? 64 : P - 192; nM = nM > 72 ? 72 : nM; if (p0 + nM > P) nM = P - p0; if (nM < 0) nM = 0;
            MoeSched2B S{(const char*)(ws + WS_ACTM), (const char*)(ws + WS_WM2), FFE, FFE, FFE, nM, DM / 256, F.G, cblk, p0, F.lds};
            EpiPlain<false, true, 0> E{(bf16*)(ws + WS_Y), DM, nullptr};
            pg8::gemm_phase(F.lds, S, E);
        } SEAM(12 + 2 * q);
    }
#endif
    if (IN(N_PHASES - 1)) { KArgs ka = kargs(); final_pass(F, ka->out, (const bf16*)(ws + WS_XH3), (const bf16*)(ws + WS_Y), (const float*)ka->in[I_NORMS] + (4 + 3) * DM); }
#undef IN
#undef SEAM
#undef ws
#undef cblk
}

extern "C" void kernel_launch(void* const* d_in, const int* in_sizes, int n_in, void* d_out, int out_size, void* d_ws, size_t ws_size, hipStream_t stream) {
    static int grid = 0;
    if (grid == 0) {
        if (n_in != 24 || in_sizes[0] != NTOK * DM || out_size != NTOK * DM || ws_size < WS_END) { fprintf(stderr, "kernel_launch: unexpected problem (n_in %d, in0 %d, out %d, ws %zu < %zu)\n", n_in, n_in > 0 ? in_sizes[0] : -1, out_size, ws_size, (size_t)WS_END); grid = -1; return; }
        int dev = 0, cus = 0, per_cu = 0;
        if (hipGetDevice(&dev) != hipSuccess || hipDeviceGetAttribute(&cus, hipDeviceAttributeMultiprocessorCount, dev) != hipSuccess) { grid = -1; return; }
        if (hipFuncSetAttribute((const void*)mk_fwd, hipFuncAttributeMaxDynamicSharedMemorySize, LDS_BYTES) != hipSuccess) { fprintf(stderr, "kernel_launch: hipFuncSetAttribute failed\n"); grid = -1; return; }
        if (hipOccupancyMaxActiveBlocksPerMultiprocessor(&per_cu, (const void*)mk_fwd, NWAVES * 64, LDS_BYTES) != hipSuccess || per_cu < 1) { fprintf(stderr, "kernel_launch: occupancy query says %d blocks per CU\n", per_cu); (void)hipGetLastError(); grid = -1; return; }
        grid = cus;
    }
    if (grid < 0) return;
    if (hipMemsetAsync((char*)d_ws + WS_CTL, 0, ZERO_BYTES, stream) != hipSuccess) return;
    Args a{};
    for (int i = 0; i < 24; ++i) a.in[i] = d_in[i];
    a.out = (float*)d_out; a.ws = (unsigned char*)d_ws;
#if MK_ONE_LAUNCH
    a.ph_lo = 0; a.ph_hi = N_PHASES;
    hipLaunchKernelGGL(mk_fwd, dim3(grid), dim3(NWAVES * 64), LDS_BYTES, stream, a);
#else
    for (int p = 0; p < N_PHASES; ++p) { a.ph_lo = p; a.ph_hi = p + 1; for (int r = 0; r < (((MK_DUP_MASK >> p) & 1u) ? 2 : 1); ++r) hipLaunchKernelGGL(mk_fwd, dim3(grid), dim3(NWAVES * 64), LDS_BYTES, stream, a); }
#endif
}
```

```cpp
#include <hip/hip_runtime.h>
#include <stdio.h>
#include <stdint.h>

#ifndef MK_ONE_LAUNCH
#define MK_ONE_LAUNCH 1
#endif
#ifndef MK_F8
#define MK_F8 1
#endif
#ifndef MK_QKV8
#define MK_QKV8 1
#endif
#ifndef MK_SUPER
#define MK_SUPER 1
#endif
#ifndef MK_FFN2F8
#define MK_FFN2F8 1
#endif
#ifndef MK_MOE_NMAJOR
#define MK_MOE_NMAJOR 1
#endif
#ifndef MK_DUP_MASK
#define MK_DUP_MASK 0u
#endif

#define GAS __attribute__((address_space(1)))
#define LAS __attribute__((address_space(3)))
typedef unsigned short bf16;
typedef unsigned v4u __attribute__((ext_vector_type(4)));
typedef unsigned v2u __attribute__((ext_vector_type(2)));
typedef float f32x2 __attribute__((ext_vector_type(2)));
typedef float f32x4 __attribute__((ext_vector_type(4)));
typedef float f32x16 __attribute__((ext_vector_type(16)));
typedef short bf16x8 __attribute__((ext_vector_type(8)));
typedef short s16x4 __attribute__((ext_vector_type(4)));
typedef int i32x4 __attribute__((ext_vector_type(4)));
typedef int i32x8 __attribute__((ext_vector_type(8)));

constexpr int BATCH = 16, SEQ = 2048, DM = 1024, NTOK = BATCH * SEQ;
constexpr int NG = 64, NP = 64, CL = 16, NCH = SEQ / CL, GROWS = BATCH * NCH, UAK = 384;
constexpr int NH = 8, HD = 128, MBLK = 256, NBLK = SEQ / MBLK;
constexpr int FFD = 2816, NE = 8, FFE = 3584, LCAP = 32768;
constexpr float NORM_EPS = 1e-6f;
constexpr int NWAVES = 8;
constexpr int KSPLIT = 7, LPMAX = 7;
constexpr int ASPLIT = 128;

constexpr size_t MiB = 1u << 20;
constexpr size_t WS_CTL = 0, WS_KMEAN = 1 * MiB, ZERO_BYTES = 2 * MiB;
constexpr size_t WS_ROPE = 2 * MiB, WS_ROWSS = 6 * MiB, WS_LIST = 10 * MiB, WS_SLOT = 11 * MiB, WS_TOKW = WS_SLOT + 256 * 1024, WS_WR = WS_TOKW + 256 * 1024, WS_SPAR = WS_WR + 64 * 1024;
constexpr size_t WS_WQ13 = 13 * MiB, WS_XQ3 = 69 * MiB, WS_RSC = 101 * MiB, WS_WM2 = 125 * MiB;
constexpr size_t WS_COLMAX_F = 1536 * 1024 + 57344 * 4, WS_COLMAX_QKV = WS_COLMAX_F + 5632 * 4, WS_COLMAX_W2 = WS_COLMAX_QKV + 3072 * 4;
constexpr size_t WS_ROWNORM = 12 * MiB + 256 * 1024, WS_SB8 = 12 * MiB + 512 * 1024;
constexpr size_t WS_W8M2 = 125 * MiB, WS_PSQ = 153 * MiB, WS_PSQD = 180 * MiB;
constexpr int CW_EA = 9216;
constexpr size_t WS_WQF13 = 102 * MiB, WS_WQQKV = 108 * MiB;
constexpr size_t WS_COLMAX = 1536 * 1024;
constexpr size_t WS_WGLU = 181 * MiB, WS_WQKV = 185 * MiB, WS_WO = 191 * MiB, WS_WF13 = 193 * MiB, WS_WF2 = 204 * MiB, WS_BTA = 210 * MiB, WS_BTC = 218 * MiB;
constexpr size_t WS_UA = 230 * MiB, WS_SLOC = 326 * MiB, WS_GBUF = 390 * MiB, WS_MIX0 = 454 * MiB;
constexpr size_t WS_XH1 = 210 * MiB, WS_ACTD = 274 * MiB, WS_F0 = 450 * MiB;
constexpr size_t WS_XH2 = 450 * MiB, WS_Q = 230 * MiB, WS_K = 294 * MiB, WS_V = 358 * MiB;
constexpr size_t WS_O = WS_Q;
constexpr size_t WS_RS = 12 * MiB;
constexpr size_t WS_MIX1 = 294 * MiB, WS_XH3 = 450 * MiB;
constexpr size_t WS_Y = 181 * MiB, WS_ACTM = 313 * MiB, WS_YP = 425 * MiB;
constexpr size_t WS_END = 518 * MiB;
constexpr int CW_TMO = 0, CW_BAR = 4096, CW_ECNT = 8192, CW_WQ = 9344;

constexpr int RING_BYTES = 131072, LDSCTL_OFF = RING_BYTES, MISC_OFF = LDSCTL_OFF + 320, IDX_OFF = RING_BYTES + 1024, SCL_OFF = RING_BYTES + 2048, UT_OFF = RING_BYTES + 8192, LDS_BYTES = 147456;

#define LDS_WAIT() asm volatile("s_waitcnt lgkmcnt(0)" ::: "memory")
#define VM_WAIT() asm volatile("s_waitcnt vmcnt(0)" ::: "memory")
__device__ __forceinline__ unsigned f2bf(float f) { unsigned u = __builtin_bit_cast(unsigned, f); return (u + 0x7fffu + ((u >> 16) & 1u)) >> 16; }
__device__ __forceinline__ unsigned pk2(float lo, float hi) { return f2bf(lo) | (f2bf(hi) << 16); }
__device__ __forceinline__ float bf2f(unsigned b) { return __builtin_bit_cast(float, b << 16); }
__device__ __forceinline__ unsigned cvt_pk_bf16(float lo, float hi) { unsigned r; asm volatile("v_cvt_pk_bf16_f32 %0, %1, %2" : "=v"(r) : "v"(lo), "v"(hi)); return r; }
__device__ __forceinline__ float wave_sum(float v) {
#pragma unroll
    for (int o = 1; o < 64; o <<= 1) v += __shfl_xor(v, o);
    return v;
}
__device__ __forceinline__ float fast_sigmoid(float x) { return __builtin_amdgcn_rcpf(1.0f + __builtin_amdgcn_exp2f(-1.4426950408889634f * x)); }

namespace pg8 {
constexpr int BM = 256, BK = 64, HALF = 128, HTB = HALF * BK * 2, NXCD = 8, WGM = 4;
__host__ __device__ __forceinline__ int lds_byte(int r, int c) { const int st = (r >> 4) * 2 + (c >> 5), rr = r & 15, cc = c & 31, ob = rr * 64 + cc * 2; return st * 1024 + (ob ^ (((ob >> 9) & 1) << 5)); }
__host__ __device__ __forceinline__ void stage_rc(int b, int& R, int& C) { const int st = b / 1024, sb = b % 1024, swz = sb ^ (((sb >> 9) & 1) << 5); R = (st >> 1) * 16 + swz / 64; C = (st & 1) * 32 + (swz % 64) / 2; }
__host__ __device__ __forceinline__ int perm32(int rho) { const int n = rho >> 4, i = rho & 15; return 8 * (i >> 2) + 4 * n + (i & 3); }

__device__ __forceinline__ void lane_rc(int i, int& R, int& C) { int t = threadIdx.x; asm volatile("" : "+v"(t)); stage_rc(t * 16 + i * 8192, R, C); }
struct GUnit { int pm, pn, e, aux, rs, sa; };
__device__ __forceinline__ void tile_of(int L, int nM, int nN, int& pm, int& pn) {
    const int nwg = nM * nN; int wgid = L;
    { const int q = nwg / NXCD, r = nwg % NXCD, xcd = wgid % NXCD, off = wgid / NXCD; wgid = (xcd < r ? xcd * (q + 1) : r * (q + 1) + (xcd - r) * q) + off; }
    const int nig = WGM * nN, gid = wgid / nig, fm = gid * WGM, gsz = (nM - fm) < WGM ? (nM - fm) : WGM;
    pm = fm + ((wgid % nig) % gsz); pn = (wgid % nig) / gsz;
}

template <int MM> struct AccSel { typedef f32x4 T; };
template <> struct AccSel<1> { typedef i32x4 T; };
#define V8LO(v) __builtin_shufflevector(v, v, 0, 1, 2, 3)
#define V8HI(v) __builtin_shufflevector(v, v, 4, 5, 6, 7)
template <int MM, class T> __device__ __forceinline__ void mma2(T& acc, const i32x8& b, const i32x8& a, int sb, int sa) {
    if constexpr (MM == 2) asm volatile("v_mfma_scale_f32_16x16x128_f8f6f4 %0, %1, %2, %0, %3, %4 op_sel_hi:[0,0,0]" : "+v"(acc) : "v"(b), "v"(a), "v"(sb), "v"(sa));
    else if constexpr (MM == 1) { acc = __builtin_amdgcn_mfma_i32_16x16x64_i8(V8LO(b), V8LO(a), acc, 0, 0, 0); acc = __builtin_amdgcn_mfma_i32_16x16x64_i8(V8HI(b), V8HI(a), acc, 0, 0, 0); }
    else { acc = __builtin_amdgcn_mfma_f32_16x16x32_bf16(__builtin_bit_cast(bf16x8, V8LO(b)), __builtin_bit_cast(bf16x8, V8LO(a)), acc, 0, 0, 0);
           acc = __builtin_amdgcn_mfma_f32_16x16x32_bf16(__builtin_bit_cast(bf16x8, V8HI(b)), __builtin_bit_cast(bf16x8, V8HI(a)), acc, 0, 0, 0); }
}
template <class Epi, class Sched>
__device__ __forceinline__ void gemm_phase(LAS unsigned char* lds, const Sched& S, const Epi& E) {
    int tid_ = threadIdx.x; asm volatile("" : "+v"(tid_));
    const int tid = tid_, wid = __builtin_amdgcn_readfirstlane(tid >> 6), lane = tid & 63, wr = wid >> 2, wc = wid & 3, fr = lane & 15, fq = lane >> 4;
    const int nt = S.K / BK;
    unsigned voffB[2];
#pragma unroll
    for (int i = 0; i < 2; ++i) { int R, C; stage_rc(tid * 16 + i * 8192, R, C); const int Rb = Epi::PERM ? ((R & ~31) + perm32(R & 31)) : R; voffB[i] = (unsigned)(Rb * S.ldb + C) * 2u; }
    const unsigned kstep = BK * 2u;
    const unsigned hstepB = (unsigned)HALF * S.ldb * 2u;
    const unsigned ldsw = (unsigned)wid * 1024u;
    const int aoff = lds_byte(wr * 64 + fr, fq * 8), boff = lds_byte(wc * 32 + fr, fq * 8);
#define PG8_SA(b, h) (((b) * 2 + (h)) * HTB)
#define PG8_SB(b, h) ((4 + (b) * 2 + (h)) * HTB)
#define PG8_STAGE_A(bufoff, abase, soff, voff) do { const char* _g = (abase) + (unsigned)__builtin_amdgcn_readfirstlane((int)(soff)); asm volatile("" : "+s"(_g)); _Pragma("unroll") for (int _i = 0; _i < 2; ++_i) \
        __builtin_amdgcn_global_load_lds((const unsigned*)(_g + (voff)[_i]), (LAS unsigned*)(lds + (bufoff) + ldsw + _i * 8192), 16, 0, 0); } while (0)
#define PG8_STAGE_B(bufoff, soff) do { const char* _g = S.Bbase + (unsigned)__builtin_amdgcn_readfirstlane((int)(soff)); asm volatile("" : "+s"(_g)); _Pragma("unroll") for (int _i = 0; _i < 2; ++_i) \
        __builtin_amdgcn_global_load_lds((const unsigned*)(_g + voffB[_i]), (LAS unsigned*)(lds + (bufoff) + ldsw + _i * 8192), 16, 0, 0); } while (0)
#define PG8_LDA(dst, b, h) do { _Pragma("unroll") for (int m = 0; m < 4; ++m) dst[m] = __builtin_shufflevector(*(const LAS i32x4*)(lds + PG8_SA(b, h) + aoff + m * 2048), *(const LAS i32x4*)(lds + PG8_SA(b, h) + aoff + m * 2048 + 1024), 0, 1, 2, 3, 4, 5, 6, 7); } while (0)
#define PG8_LDB(dst, b, h) do { _Pragma("unroll") for (int n = 0; n < 2; ++n) dst[n] = __builtin_shufflevector(*(const LAS i32x4*)(lds + PG8_SB(b, h) + boff + n * 2048), *(const LAS i32x4*)(lds + PG8_SB(b, h) + boff + n * 2048 + 1024), 0, 1, 2, 3, 4, 5, 6, 7); } while (0)
#define PG8_MMA(ai, bj, At, Bt) do { __builtin_amdgcn_s_setprio(1); _Pragma("unroll") for (int m = 0; m < 4; ++m) _Pragma("unroll") for (int n = 0; n < 2; ++n) \
        mma2<Epi::MM>(acc[ai][bj][m][n], Bt[n], At[m], fsb[bj][n], fsa); __builtin_amdgcn_s_setprio(0); } while (0)
#define PG8_WAIT_V(n) asm volatile("s_waitcnt vmcnt(" #n ")" ::: "memory")
#define PG8_WAIT_L(n) asm volatile("s_waitcnt lgkmcnt(" #n ")" ::: "memory")
#define PG8_BAR __builtin_amdgcn_s_barrier()
#define PG8_SCHED __builtin_amdgcn_sched_barrier(0)
    if (wid == 0) { GUnit u; const bool ok = S.next(lane, u); LAS int* tb = (LAS int*)(lds + UT_OFF) + lane * 8;
        tb[0] = ok ? u.pm : -1; tb[1] = u.pn; tb[2] = u.e; tb[3] = u.aux; tb[4] = u.rs; tb[5] = u.sa; tb[6] = ok ? (int)S.b_off(u) : 0; tb[7] = ok ? (int)S.a_tile(u) : 0; }
    asm volatile("s_waitcnt lgkmcnt(0)" ::: "memory"); __syncthreads();
#define PG8_UNIT(i, u, bo, ao, ok) do { const LAS int* tb_ = (const LAS int*)(lds + UT_OFF) + ((i) & 63) * 8; \
        u.pm = __builtin_amdgcn_readfirstlane(tb_[0]); u.pn = __builtin_amdgcn_readfirstlane(tb_[1]); u.e = __builtin_amdgcn_readfirstlane(tb_[2]); u.aux = __builtin_amdgcn_readfirstlane(tb_[3]); \
        u.rs = __builtin_amdgcn_readfirstlane(tb_[4]); u.sa = __builtin_amdgcn_readfirstlane(tb_[5]); bo = (unsigned)__builtin_amdgcn_readfirstlane(tb_[6]); ao = (unsigned)__builtin_amdgcn_readfirstlane(tb_[7]); \
        ok = (i) < 64 && u.pm >= 0; } while (0)
    GUnit cur, nxt; int ui = 0; unsigned cB, cA, nB, nA; bool ok0;
    PG8_UNIT(0, cur, cB, cA, ok0);
    if (!ok0) return;
    const char* cAp = S.a_base(cur); const char* nAp = cAp;
    typedef typename AccSel<Epi::MM>::T AccT;
    int fsa = 127, fsb[2][2] = {{127, 127}, {127, 127}};
    AccT acc[2][2][4][2];
#pragma unroll
    for (int a = 0; a < 2; ++a)
#pragma unroll
        for (int b = 0; b < 2; ++b)
#pragma unroll
            for (int m = 0; m < 4; ++m)
#pragma unroll
                for (int n = 0; n < 2; ++n) acc[a][b][m][n] = AccT{};
    i32x8 At[4], B0[2], B1[2];
    unsigned oC[2][2], oN[2][2];
    if constexpr (Sched::GATHER) { S.a_off_first(cur, oC);
#pragma unroll
        for (int h = 0; h < 2; ++h)
#pragma unroll
            for (int i = 0; i < 2; ++i) oN[h][i] = oC[h][i]; }
    else { GUnit z; z.pm = 0; z.pn = 0; z.e = 0; z.aux = 0; z.rs = 0; z.sa = 127; S.a_off_first(z, oC);
#pragma unroll
        for (int h = 0; h < 2; ++h)
#pragma unroll
            for (int i = 0; i < 2; ++i) oN[h][i] = oC[h][i]; }
    if constexpr (Epi::MM == 2) S.f8_scales(cur, wc, fr, fsa, fsb);
    if constexpr (Epi::LDSS) E.prefetch_scales(cur, 0, lds);
    PG8_STAGE_B(PG8_SB(0, 0), cB); PG8_STAGE_B(PG8_SB(0, 1), cB + hstepB); PG8_STAGE_A(PG8_SA(0, 0), cAp, cA, oC[0]); PG8_STAGE_A(PG8_SA(0, 1), cAp, cA, oC[1]);
    if (wr == 1) PG8_BAR;
    PG8_WAIT_V(2); PG8_BAR;
    PG8_STAGE_B(PG8_SB(1, 0), cB + kstep); PG8_STAGE_A(PG8_SA(1, 0), cAp, cA + kstep, oC[0]); PG8_STAGE_B(PG8_SB(1, 1), cB + hstepB + kstep);
    PG8_WAIT_V(6); PG8_BAR;
    for (;;) {
        bool has_next; PG8_UNIT(ui + 1, nxt, nB, nA, has_next);
        if (!has_next) { nB = cB; nA = cA; nAp = cAp; } else nAp = S.a_base(nxt);
        if (has_next) S.prefetch(nxt, lds);
        if constexpr (Epi::LDSS) { if (has_next) E.prefetch_scales(nxt, (ui + 1) % 3, lds); }
        for (int t = 0; t < nt; t += 2) {
            const bool last = (t == nt - 2);
            const unsigned a1 = cA + (unsigned)(t + 1) * kstep;
            const unsigned a2 = last ? nA : cA + (unsigned)(t + 2) * kstep, b2 = last ? nB : cB + (unsigned)(t + 2) * kstep;
            const unsigned a3 = a2 + kstep, b3 = b2 + kstep; const char* const ap2 = last ? nAp : cAp;
            if constexpr (Sched::GATHER) { if (last && has_next) S.a_off_next(nxt, oN, lds); }
            PG8_LDB(B0, 0, 0); PG8_LDB(B1, 0, 1); PG8_SCHED; PG8_LDA(At, 0, 0); PG8_STAGE_A(PG8_SA(1, 1), cAp, a1, oC[1]);
            PG8_WAIT_V(8); PG8_WAIT_L(0); PG8_BAR; PG8_MMA(0, 0, At, B0); PG8_MMA(0, 1, At, B1); PG8_BAR; PG8_SCHED;
            PG8_LDA(At, 0, 1); PG8_STAGE_B(PG8_SB(0, 0), b2); PG8_STAGE_B(PG8_SB(0, 1), b2 + hstepB); PG8_STAGE_A(PG8_SA(0, 0), ap2, a2, oN[0]);
            PG8_WAIT_V(8); PG8_WAIT_L(0); PG8_BAR; PG8_MMA(1, 0, At, B0); PG8_MMA(1, 1, At, B1); PG8_BAR; PG8_SCHED;
            PG8_LDB(B0, 1, 0); PG8_LDB(B1, 1, 1); PG8_SCHED; PG8_LDA(At, 1, 0); PG8_STAGE_A(PG8_SA(0, 1), ap2, a2, oN[1]);
            PG8_WAIT_V(8); PG8_WAIT_L(0); PG8_BAR; PG8_MMA(0, 0, At, B0); PG8_MMA(0, 1, At, B1); PG8_BAR; PG8_SCHED;
            PG8_LDA(At, 1, 1); PG8_STAGE_B(PG8_SB(1, 0), b3); PG8_STAGE_B(PG8_SB(1, 1), b3 + hstepB); PG8_STAGE_A(PG8_SA(1, 0), ap2, a3, oN[0]);
            PG8_WAIT_V(8); PG8_WAIT_L(0); PG8_BAR; PG8_MMA(1, 0, At, B0); PG8_MMA(1, 1, At, B1); PG8_BAR; PG8_SCHED;
        }
        if (wr == 0) PG8_BAR;
        if constexpr (Epi::MM == 2) asm volatile("s_nop 15\n\ts_nop 15" ::: "memory");
        if constexpr (Epi::LDSS) E(acc, cur, wr, wc, fr, fq, lds + SCL_OFF + (ui % 3) * 2048); else E(acc, cur, wr, wc, fr, fq);
        if (!has_next) break;
#pragma unroll
        for (int a = 0; a < 2; ++a)
#pragma unroll
            for (int b = 0; b < 2; ++b)
#pragma unroll
                for (int m = 0; m < 4; ++m)
#pragma unroll
                    for (int n = 0; n < 2; ++n) acc[a][b][m][n] = AccT{};
        cur = nxt; cB = nB; cA = nA; cAp = nAp; ++ui;
        if constexpr (Epi::MM == 2) S.f8_scales(cur, wc, fr, fsa, fsb);
        if constexpr (Sched::GATHER) {
#pragma unroll
        for (int h = 0; h < 2; ++h)
#pragma unroll
            for (int i = 0; i < 2; ++i) oC[h][i] = oN[h][i]; }
        if (wr == 1) PG8_BAR;
    }
    PG8_WAIT_V(0);
    PG8_BAR;
#undef PG8_UNIT
#undef PG8_SA
#undef PG8_SB
#undef PG8_STAGE_A
#undef PG8_STAGE_B
#undef PG8_LDA
#undef PG8_LDB
#undef PG8_MMA
#undef PG8_WAIT_V
#undef PG8_WAIT_L
#undef PG8_BAR
#undef PG8_SCHED
}
}

using pg8::GUnit;
struct PlainSched {
    static constexpr bool GATHER = false;
    __device__ __forceinline__ const char* a_base(const GUnit&) const { return Abase; }
    __device__ __forceinline__ unsigned a_tile(const GUnit& u) const { return (unsigned)(u.pm * 256 * lda) * 2u; }
    const char* Abase; const char* Bbase; int K, lda, ldb, nM, nN, G, c, pmdiv; size_t bstride; int sa = 127; const int* sb8 = nullptr;
    __device__ __forceinline__ bool next(int i, GUnit& u) const { const long L = (long)i * G + c; if (L >= (long)nM * nN) return false; pg8::tile_of((int)L, nM, nN, u.pm, u.pn); u.e = u.pm / pmdiv; u.aux = u.pm; u.rs = u.pm * 256; u.sa = sa; return true; }
    __device__ __forceinline__ void f8_scales(const GUnit& u, int wc, int fr, int& sa_, int (&sb)[2][2]) const { sa_ = u.sa;
#pragma unroll
        for (int bj = 0; bj < 2; ++bj)
#pragma unroll
            for (int n = 0; n < 2; ++n) sb[bj][n] = sb8[u.pn * 256 + bj * 128 + wc * 32 + pg8::perm32(n * 16 + fr)]; }
    __device__ __forceinline__ void a_off_first(const GUnit& u, unsigned (&off)[2][2]) const { int R[2], C[2]; pg8::lane_rc(0, R[0], C[0]); pg8::lane_rc(1, R[1], C[1]);
#pragma unroll
        for (int h = 0; h < 2; ++h)
#pragma unroll
            for (int i = 0; i < 2; ++i) off[h][i] = (unsigned)((u.pm * 256 + h * 128 + R[i]) * lda + C[i]) * 2u; }
    __device__ __forceinline__ void a_off_next(const GUnit& u, unsigned (&off)[2][2], LAS unsigned char*) const { a_off_first(u, off); }
    __device__ __forceinline__ void prefetch(const GUnit&, LAS unsigned char*) const {}
    __device__ __forceinline__ unsigned b_off(const GUnit& u) const { return (unsigned)((size_t)u.e * bstride + (size_t)u.pn * 256 * ldb * 2); }
};
constexpr int ET_OFF = RING_BYTES + 512;
__device__ __forceinline__ void etab_build(LAS unsigned char* lds, const unsigned* ctl) {
    if (threadIdx.x < 64) { const int l = threadIdx.x & 63; int v = 0;
        if (l < NE) { v = (int)__hip_atomic_load(ctl + CW_ECNT + 64 * l, __ATOMIC_RELAXED, __HIP_MEMORY_SCOPE_AGENT); v = v < 0 ? 0 : (v > LCAP ? LCAP : v); }
        else if (l < 2 * NE) v = (int)__hip_atomic_load(ctl + CW_EA + (l - NE), __ATOMIC_RELAXED, __HIP_MEMORY_SCOPE_AGENT);
        int np = (l < NE) ? ((v + 255) >> 8) : 0, ps = np;
#pragma unroll
        for (int o = 1; o < NE; o <<= 1) { const int t = __shfl_up(ps, o); if (l >= o) ps += t; }
        if (l < NE) { *(LAS int*)(lds + ET_OFF + 4 * l) = v; *(LAS int*)(lds + ET_OFF + 32 + 4 * l) = ps - np; if (l == NE - 1) *(LAS int*)(lds + ET_OFF + 32 + 4 * NE) = ps; }
        else if (l < 2 * NE) *(LAS int*)(lds + ET_OFF + 72 + 4 * (l - NE)) = v; }
    __syncthreads();
}
__device__ __forceinline__ int et_cnt(LAS unsigned char* lds, int e) { return __builtin_amdgcn_readfirstlane(*(const LAS int*)(lds + ET_OFF + 4 * e)); }
__device__ __forceinline__ int et_ps(LAS unsigned char* lds, int e) { return __builtin_amdgcn_readfirstlane(*(const LAS int*)(lds + ET_OFF + 32 + 4 * e)); }
__device__ __forceinline__ int et_sa(LAS unsigned char* lds, int e) { return __builtin_amdgcn_readfirstlane(*(const LAS int*)(lds + ET_OFF + 72 + 4 * e)); }
__device__ __forceinline__ int et_ps_l(LAS unsigned char* lds, int e) { return *(const LAS int*)(lds + ET_OFF + 32 + 4 * e); }
__device__ __forceinline__ int et_sa_l(LAS unsigned char* lds, int e) { return *(const LAS int*)(lds + ET_OFF + 72 + 4 * e); }
__device__ __forceinline__ int et_expert(LAS unsigned char* lds, int p) { int e = 0;
#pragma unroll
    for (int k = 1; k < NE; ++k) e += (p >= et_ps_l(lds, k)) ? 1 : 0;
    return e; }
struct MoeSched1 {
    static constexpr bool GATHER = true;
    __device__ __forceinline__ const char* a_base(const GUnit&) const { return Abase; }
    __device__ __forceinline__ unsigned a_tile(const GUnit&) const { return 0u; }
    const char* Abase; const char* Bbase; const int* list; int K, ldb, nM, nN, G, c, p0; LAS unsigned char* EL;
    __device__ __forceinline__ bool next(int i, GUnit& u) const { const long L = (long)i * G + c; if (L >= (long)nM * nN) return false; if (MK_MOE_NMAJOR) pg8::tile_of((int)L, nN, nM, u.pn, u.pm); else pg8::tile_of((int)L, nM, nN, u.pm, u.pn); u.aux = p0 + u.pm; u.e = et_expert(EL, u.aux); u.rs = u.e * LCAP + (u.aux - et_ps_l(EL, u.e)) * 256; u.sa = et_sa_l(EL, u.e); return true; }
    __device__ __forceinline__ void a_off_first(const GUnit& u, unsigned (&off)[2][2]) const { int R[2], C[2]; pg8::lane_rc(0, R[0], C[0]); pg8::lane_rc(1, R[1], C[1]);
        const int cn = et_cnt(EL, u.e), ps = et_ps(EL, u.e);
        const int lp = (u.aux - ps) * 256;
#pragma unroll
        for (int h = 0; h < 2; ++h)
#pragma unroll
            for (int i = 0; i < 2; ++i) { const int pos = lp + h * 128 + R[i]; int tok = list[u.e * LCAP + (pos < LCAP ? pos : 0)]; tok = (pos < cn) ? tok : 0; tok = ((unsigned)tok < (unsigned)NTOK) ? tok : 0; off[h][i] = (unsigned)(tok * K + C[i]) * 2u; } }
    __device__ __forceinline__ void prefetch(const GUnit& u, LAS unsigned char* lds) const {
        const int wid = __builtin_amdgcn_readfirstlane(threadIdx.x >> 6), lane = threadIdx.x & 63;
        if (wid < 4) { const int ps = et_ps(EL, u.e);
            const int pos = (u.aux - ps) * 256 + wid * 64 + lane;
            __builtin_amdgcn_global_load_lds((const unsigned*)(list + u.e * LCAP + (pos < LCAP ? pos : 0)), (LAS unsigned*)(lds + IDX_OFF + wid * 256), 4, 0, 0); } }
    __device__ __forceinline__ void a_off_next(const GUnit& u, unsigned (&off)[2][2], LAS unsigned char* lds) const { int R[2], C[2]; pg8::lane_rc(0, R[0], C[0]); pg8::lane_rc(1, R[1], C[1]);
        const int cn = et_cnt(EL, u.e), ps = et_ps(EL, u.e);
        const int lp = (u.aux - ps) * 256;
#pragma unroll
        for (int h = 0; h < 2; ++h)
#pragma unroll
            for (int i = 0; i < 2; ++i) { const int rr = h * 128 + R[i]; int tok = *(const LAS int*)(lds + IDX_OFF + rr * 4); tok = (lp + rr < cn) ? tok : 0; tok = ((unsigned)tok < (unsigned)NTOK) ? tok : 0; off[h][i] = (unsigned)(tok * K + C[i]) * 2u; } }
    __device__ __forceinline__ unsigned b_off(const GUnit& u) const { return (unsigned)((size_t)u.e * ((size_t)2 * FFE * DM) + (size_t)u.pn * 256 * ldb * 2); }
};
struct MoeSched2 {
    static constexpr bool GATHER = false;
    __device__ __forceinline__ const char* a_base(const GUnit& u) const { return u.pm < ASPLIT ? Abase : Abase2; }
    __device__ __forceinline__ unsigned a_tile(const GUnit& u) const { return (unsigned)((u.pm < ASPLIT ? u.pm : u.pm - ASPLIT) * 256 * lda) * 2u; }
    const char* Abase; const char* Abase2; const char* Bbase; const int* sb8; int K, lda, ldb, nM, nN, G, c, p0; LAS unsigned char* EL;
    __device__ __forceinline__ bool next(int i, GUnit& u) const { const long L = (long)i * G + c; if (L >= (long)nM * nN) return false; pg8::tile_of((int)L, nM, nN, u.pm, u.pn); u.aux = p0 + u.pm; u.e = et_expert(EL, u.aux); u.rs = 0; u.sa = et_sa_l(EL, u.e); return true; }
    __device__ __forceinline__ void a_off_first(const GUnit& u, unsigned (&off)[2][2]) const { int R[2], C[2]; pg8::lane_rc(0, R[0], C[0]); pg8::lane_rc(1, R[1], C[1]);
#pragma unroll
        for (int h = 0; h < 2; ++h)
#pragma unroll
            for (int i = 0; i < 2; ++i) off[h][i] = (unsigned)((u.pm * 256 + h * 128 + R[i]) * lda + C[i]) * 2u; }
    __device__ __forceinline__ void a_off_next(const GUnit& u, unsigned (&off)[2][2], LAS unsigned char*) const { a_off_first(u, off); }
    __device__ __forceinline__ void prefetch(const GUnit&, LAS unsigned char*) const {}
    __device__ __forceinline__ unsigned b_off(const GUnit& u) const { return (unsigned)((size_t)u.e * ((size_t)DM * FFE) + (size_t)u.pn * 256 * ldb * 2); }
    __device__ __forceinline__ void f8_scales(const GUnit& u, int wc, int fr, int& sa, int (&sb)[2][2]) const { sa = u.sa;
#pragma unroll
        for (int bj = 0; bj < 2; ++bj)
#pragma unroll
            for (int n = 0; n < 2; ++n) sb[bj][n] = sb8[u.e * DM + u.pn * 256 + bj * 128 + wc * 32 + pg8::perm32(n * 16 + fr)]; }
};

struct MoeSched2K {
    static constexpr bool GATHER = false;
    __device__ __forceinline__ const char* a_base(const GUnit& u) const { return u.pm < ASPLIT ? Abase : Abase2; }
    __device__ __forceinline__ unsigned a_tile(const GUnit& u) const { return (unsigned)((u.pm < ASPLIT ? u.pm : u.pm - ASPLIT) * 256 * lda) * 2u + (unsigned)u.rs * 512u; }
    const char* Abase; const char* Abase2; const char* Bbase; const int* sb8; int K, lda, ldb, nLeft, G, c; LAS unsigned char* EL;
    __device__ __forceinline__ bool next(int i, GUnit& u) const { const long L = (long)i * G + c; if (L >= (long)nLeft * 4 * KSPLIT) return false; const int kc = (int)(L % KSPLIT), t = (int)(L / KSPLIT), lp = t >> 2;
        u.pn = t & 3; u.pm = 256 + lp; u.rs = kc; u.aux = kc * LPMAX + lp; u.e = et_expert(EL, u.pm); u.sa = et_sa_l(EL, u.e); return true; }
    __device__ __forceinline__ void a_off_first(const GUnit& u, unsigned (&off)[2][2]) const { int R[2], C[2]; pg8::lane_rc(0, R[0], C[0]); pg8::lane_rc(1, R[1], C[1]);
#pragma unroll
        for (int h = 0; h < 2; ++h)
#pragma unroll
            for (int i = 0; i < 2; ++i) off[h][i] = (unsigned)((u.pm * 256 + h * 128 + R[i]) * lda + C[i]) * 2u; }
    __device__ __forceinline__ void a_off_next(const GUnit& u, unsigned (&off)[2][2], LAS unsigned char*) const { a_off_first(u, off); }
    __device__ __forceinline__ void prefetch(const GUnit&, LAS unsigned char*) const {}
    __device__ __forceinline__ unsigned b_off(const GUnit& u) const { return (unsigned)((size_t)u.e * ((size_t)DM * FFE) + (size_t)u.pn * 256 * ldb * 2) + (unsigned)u.rs * 512u; }
    __device__ __forceinline__ void f8_scales(const GUnit& u, int wc, int fr, int& sa, int (&sb)[2][2]) const { sa = u.sa;
#pragma unroll
        for (int bj = 0; bj < 2; ++bj)
#pragma unroll
            for (int n = 0; n < 2; ++n) sb[bj][n] = sb8[u.e * DM + u.pn * 256 + bj * 128 + wc * 32 + pg8::perm32(n * 16 + fr)]; }
};

struct MoeSched2B {
    static constexpr bool GATHER = false;
    __device__ __forceinline__ const char* a_base(const GUnit&) const { return Abase; }
    __device__ __forceinline__ unsigned a_tile(const GUnit& u) const { return (unsigned)(u.pm * 256 * lda) * 2u; }
    const char* Abase; const char* Bbase; int K, lda, ldb, nM, nN, G, c, p0; LAS unsigned char* EL;
    __device__ __forceinline__ bool next(int i, GUnit& u) const { const long L = (long)i * G + c; if (L >= (long)nM * nN) return false; pg8::tile_of((int)L, nM, nN, u.pm, u.pn); u.aux = p0 + u.pm; u.e = et_expert(EL, u.aux); u.rs = 0; u.sa = 127; return true; }
    __device__ __forceinline__ void a_off_first(const GUnit& u, unsigned (&off)[2][2]) const { int R[2], C[2]; pg8::lane_rc(0, R[0], C[0]); pg8::lane_rc(1, R[1], C[1]);
#pragma unroll
        for (int h = 0; h < 2; ++h)
#pragma unroll
            for (int i = 0; i < 2; ++i) off[h][i] = (unsigned)((u.pm * 256 + h * 128 + R[i]) * lda + C[i]) * 2u; }
    __device__ __forceinline__ void a_off_next(const GUnit& u, unsigned (&off)[2][2], LAS unsigned char*) const { a_off_first(u, off); }
    __device__ __forceinline__ void prefetch(const GUnit&, LAS unsigned char*) const {}
    __device__ __forceinline__ unsigned b_off(const GUnit& u) const { return (unsigned)((size_t)u.e * ((size_t)DM * FFE * 2) + (size_t)u.pn * 256 * ldb * 2); }
};

typedef const f32x4 (&AccRef)[2][2][4][2];
struct EpiS5A { static constexpr bool PERM = false, LDSS = false; static constexpr int MM = 0; float* sloc;
    __device__ __forceinline__ void operator()(AccRef acc, const GUnit& u, int wr, int wc, int fr, int fq) const {
        float* base = sloc + (size_t)(u.pm * 256 + wr * 64 + fr) * 128 + wc * 32 + 4 * fq;
#pragma unroll
        for (int ai = 0; ai < 2; ++ai)
#pragma unroll
            for (int m = 0; m < 4; ++m)
#pragma unroll
                for (int n = 0; n < 2; ++n) *(f32x4*)(base + (size_t)(ai * 128 + m * 16) * 128 + n * 16) = acc[ai][0][m][n]; } };
struct EpiS5C { static constexpr bool PERM = true, LDSS = false; static constexpr int MM = 0; const bf16* ua; const float* dsk; const float* g0; bf16* gbuf;
    __device__ __forceinline__ void operator()(AccRef acc, const GUnit& u, int wr, int wc, int fr, int fq) const {
        const int g = u.pm >> 3, i0 = 8 * (fq & 1);
        f32x4 d0 = *(const f32x4*)(dsk + g * 16 + i0) * *(const f32x4*)(g0 + g * 16 + i0), d1 = *(const f32x4*)(dsk + g * 16 + i0 + 4) * *(const f32x4*)(g0 + g * 16 + i0 + 4);
#pragma unroll
        for (int ai = 0; ai < 2; ++ai)
#pragma unroll
            for (int m = 0; m < 4; ++m) { const int r = ai * 128 + wr * 64 + m * 16 + fr, rowg = (u.pm & 7) * 256 + r, b = rowg >> 7, c = rowg & 127;
#pragma unroll
                for (int bj = 0; bj < 2; ++bj) { const int col = 128 * bj + 32 * wc + 8 * fq, t = col >> 4;
                    const v4u uu = *(const v4u*)(ua + (size_t)(u.pm * 256 + r) * UAK + col);
                    f32x4 y0 = acc[ai][bj][m][0], y1 = acc[ai][bj][m][1];
                    y0[0] += d0[0] * bf2f(uu.x & 0xffffu); y0[1] += d0[1] * bf2f(uu.x >> 16); y0[2] += d0[2] * bf2f(uu.y & 0xffffu); y0[3] += d0[3] * bf2f(uu.y >> 16);
                    y1[0] += d1[0] * bf2f(uu.z & 0xffffu); y1[1] += d1[1] * bf2f(uu.z >> 16); y1[2] += d1[2] * bf2f(uu.w & 0xffffu); y1[3] += d1[3] * bf2f(uu.w >> 16);
#pragma unroll
                    for (int k = 0; k < 4; ++k) { const float a = y0[k], bq = y1[k]; y0[k] = a * fast_sigmoid(1.5957691216f * (a + 0.044715f * a * a * a)); y1[k] = bq * fast_sigmoid(1.5957691216f * (bq + 0.044715f * bq * bq * bq)); }
                    v4u w; w.x = cvt_pk_bf16(y0[0], y0[1]); w.y = cvt_pk_bf16(y0[2], y0[3]); w.z = cvt_pk_bf16(y1[0], y1[1]); w.w = cvt_pk_bf16(y1[2], y1[3]);
                    *(v4u*)(gbuf + (size_t)(b * SEQ + c * CL + t) * DM + g * 16 + i0) = w; }
                asm volatile("" ::: "memory"); } } };
template <int MODE> struct EpiGated { static constexpr bool PERM = true, LDSS = false; static constexpr int MM = 0; bf16* out; int ldc; float* rowss; int rowsel;
    __device__ __forceinline__ void operator()(AccRef acc, const GUnit& u, int wr, int wc, int fr, int fq) const {
#pragma unroll
        for (int ai = 0; ai < 2; ++ai)
#pragma unroll
            for (int m = 0; m < 4; ++m) { const int row = u.pm * 256 + ai * 128 + wr * 64 + m * 16 + fr; float o[8]; float ss = 0.f;
#pragma unroll
                for (int n = 0; n < 2; ++n)
#pragma unroll
                    for (int k = 0; k < 4; ++k) { const float a = acc[ai][0][m][n][k], bq = acc[ai][1][m][n][k]; const float v = (MODE == 0) ? a * fast_sigmoid(bq) : a * fast_sigmoid(a) * bq; o[n * 4 + k] = v; ss += v * v; }
                v4u w; w.x = cvt_pk_bf16(o[0], o[1]); w.y = cvt_pk_bf16(o[2], o[3]); w.z = cvt_pk_bf16(o[4], o[5]); w.w = cvt_pk_bf16(o[6], o[7]);
                *(v4u*)(out + (size_t)row * ldc + u.pn * 128 + wc * 32 + fq * 8) = w;
                if (MODE == 0) { ss += __shfl_xor(ss, 16); ss += __shfl_xor(ss, 32); if (fq == 0) rowss[(size_t)row * 32 + u.pn * 4 + wc] = ss; } } } };
__device__ __forceinline__ void scales_to_lds(const float* rs256, const float* cm256, int buf, LAS unsigned char* lds) {
    const int wid = __builtin_amdgcn_readfirstlane(threadIdx.x >> 6), lane = threadIdx.x & 63;
    const float* src = (wid < 4) ? rs256 + wid * 64 + lane : cm256 + (wid - 4) * 64 + lane;
    __builtin_amdgcn_global_load_lds((const unsigned*)src, (LAS unsigned*)(lds + SCL_OFF + buf * 2048 + wid * 256), 4, 0, 0);
}
template <bool F8OUT> struct EpiGatedI8 { static constexpr bool PERM = true, LDSS = true; static constexpr int MM = 1; bf16* out; int ldc; const float* rowscale; const float* colmax; int cstride; unsigned char* out2;
    __device__ __forceinline__ void prefetch_scales(const GUnit& u, int buf, LAS unsigned char* lds) const { scales_to_lds(rowscale + u.rs, colmax + (size_t)u.e * cstride + u.pn * 256, buf, lds); }
    __device__ __forceinline__ void operator()(const i32x4 (&acc)[2][2][4][2], const GUnit& u, int wr, int wc, int fr, int fq, LAS unsigned char* tab) const {
        const LAS float* cm = (const LAS float*)(tab + 1024) + wc * 32 + 8 * fq; const float k127 = 1.0f / 127.0f;
        float fscale = 1.0f; if constexpr (F8OUT) fscale = __builtin_bit_cast(float, (unsigned)(254 - u.sa) << 23);
        const float L2E = 1.4426950408889634f, k1 = k127 * L2E, k3 = k127 * fscale * (1.0f / L2E);
        const f32x4 s1a = *(const LAS f32x4*)cm * k1, s1b = *(const LAS f32x4*)(cm + 4) * k1, s3a = *(const LAS f32x4*)(cm + 128) * k3, s3b = *(const LAS f32x4*)(cm + 132) * k3;
        const f32x2 c1[4] = {{s1a[0], s1a[1]}, {s1a[2], s1a[3]}, {s1b[0], s1b[1]}, {s1b[2], s1b[3]}}, c3[4] = {{s3a[0], s3a[1]}, {s3a[2], s3a[3]}, {s3b[0], s3b[1]}, {s3b[2], s3b[3]}};
        const LAS float* rsc = (const LAS float*)tab + wr * 64 + fr;
#pragma unroll
        for (int ai = 0; ai < 2; ++ai)
#pragma unroll
            for (int m = 0; m < 4; ++m) { const int r = ai * 128 + wr * 64 + m * 16 + fr; const float sA = rsc[ai * 128 + m * 16]; const f32x2 sAA = {sA, sA}; float o[8];
#pragma unroll
                for (int q = 0; q < 4; ++q) { const int n = q >> 1, k0 = (q & 1) * 2;
                    const f32x2 av = (f32x2){(float)acc[ai][0][m][n][k0], (float)acc[ai][0][m][n][k0 + 1]} * (c1[q] * sAA), bv = (f32x2){(float)acc[ai][1][m][n][k0], (float)acc[ai][1][m][n][k0 + 1]} * (c3[q] * sAA);
                    const f32x2 d = (f32x2){__builtin_amdgcn_exp2f(-av[0]), __builtin_amdgcn_exp2f(-av[1])} + (f32x2){1.0f, 1.0f};
                    const f32x2 ov = (av * bv) * (f32x2){__builtin_amdgcn_rcpf(d[0]), __builtin_amdgcn_rcpf(d[1])};
                    o[2 * q] = ov[0]; o[2 * q + 1] = ov[1]; }
                if constexpr (F8OUT) {
                    int p0 = __builtin_amdgcn_cvt_pk_fp8_f32(o[0], o[1], 0, false); p0 = __builtin_amdgcn_cvt_pk_fp8_f32(o[2], o[3], p0, true);
                    int p1 = __builtin_amdgcn_cvt_pk_fp8_f32(o[4], o[5], 0, false); p1 = __builtin_amdgcn_cvt_pk_fp8_f32(o[6], o[7], p1, true);
                    v2u w; w.x = (unsigned)p0; w.y = (unsigned)p1;
                    unsigned char* const ob = (u.pm < ASPLIT) ? (unsigned char*)out + (size_t)(u.pm * 256) * ldc : out2 + (size_t)((u.pm - ASPLIT) * 256) * ldc;
                    *(v2u*)(ob + (size_t)r * ldc + u.pn * 128 + wc * 32 + fq * 8) = w; }
                else {
                v4u w; w.x = cvt_pk_bf16(o[0], o[1]); w.y = cvt_pk_bf16(o[2], o[3]); w.z = cvt_pk_bf16(o[4], o[5]); w.w = cvt_pk_bf16(o[6], o[7]);
                *(v4u*)(out + (size_t)(u.pm * 256 + r) * ldc + u.pn * 128 + wc * 32 + fq * 8) = w; } } } };
template <bool SS, bool USEAUX, int MMODE = 0> struct EpiPlain { static constexpr bool PERM = true, LDSS = false; static constexpr int MM = MMODE; bf16* out; int ldc; float* rowss;
    __device__ __forceinline__ void operator()(AccRef acc, const GUnit& u, int wr, int wc, int fr, int fq) const {
        const int rb = (USEAUX ? u.aux : u.pm) * 256;
#pragma unroll
        for (int ai = 0; ai < 2; ++ai)
#pragma unroll
            for (int m = 0; m < 4; ++m) { const int row = rb + ai * 128 + wr * 64 + m * 16 + fr; float ss = 0.f;
#pragma unroll
                for (int bj = 0; bj < 2; ++bj) { const f32x4 v0 = acc[ai][bj][m][0], v1 = acc[ai][bj][m][1];
                    if (SS) ss += (v0[0] * v0[0] + v0[1] * v0[1]) + (v0[2] * v0[2] + v0[3] * v0[3]) + (v1[0] * v1[0] + v1[1] * v1[1]) + (v1[2] * v1[2] + v1[3] * v1[3]);
                    v4u w; w.x = cvt_pk_bf16(v0[0], v0[1]); w.y = cvt_pk_bf16(v0[2], v0[3]); w.z = cvt_pk_bf16(v1[0], v1[1]); w.w = cvt_pk_bf16(v1[2], v1[3]);
                    *(v4u*)(out + (size_t)row * ldc + u.pn * 256 + bj * 128 + wc * 32 + fq * 8) = w; }
                if (SS) { ss += __shfl_xor(ss, 16); ss += __shfl_xor(ss, 32); if (fq == 0) rowss[(size_t)row * 32 + u.pn * 4 + wc] = ss; } } } };
template <bool I8Q> struct EpiQKV { static constexpr bool PERM = true, LDSS = I8Q; static constexpr int MM = I8Q ? 1 : 0; bf16* qkv; const float* rope; float* kmean; const float* rowscale; const float* colmax;
    __device__ __forceinline__ void prefetch_scales(const GUnit& u, int buf, LAS unsigned char* lds) const { scales_to_lds(rowscale + u.rs, colmax + u.pn * 256, buf, lds); }
    template <class AccT> __device__ __forceinline__ void operator()(const AccT (&acc)[2][2][4][2], const GUnit& u, int wr, int wc, int fr, int fq, LAS unsigned char* tab = nullptr) const {
        const int sel = u.pn >> 2; bf16* const outb = qkv + (size_t)sel * (size_t)(32u << 20);
        const int colt = (u.pn & 3) * 256;
        f32x4 sb[2][2];
        if constexpr (I8Q) { const LAS float* cm = (const LAS float*)(tab + 1024) + wc * 32 + 8 * fq; const float k127 = 1.0f / 127.0f;
            sb[0][0] = *(const LAS f32x4*)cm * k127; sb[0][1] = *(const LAS f32x4*)(cm + 4) * k127; sb[1][0] = *(const LAS f32x4*)(cm + 128) * k127; sb[1][1] = *(const LAS f32x4*)(cm + 132) * k127; }
        float cs[2][2][4];
#pragma unroll
        for (int bj = 0; bj < 2; ++bj)
#pragma unroll
            for (int n = 0; n < 2; ++n)
#pragma unroll
                for (int kk = 0; kk < 4; ++kk) cs[bj][n][kk] = 0.f;
#pragma unroll
        for (int ai = 0; ai < 2; ++ai)
#pragma unroll
            for (int m = 0; m < 4; ++m) { const int rl = ai * 128 + wr * 64 + m * 16 + fr, row = u.pm * 256 + rl;
                float sA = 1.0f; if constexpr (I8Q) sA = ((const LAS float*)tab)[rl];
                f32x4 co = (f32x4){1.f, 1.f, 1.f, 1.f}, si = (f32x4){0.f, 0.f, 0.f, 0.f};
                if (sel < 2 && wc == 0) { co = *(const f32x4*)(rope + (size_t)row * 32 + 4 * fq); si = *(const f32x4*)(rope + (size_t)row * 32 + 16 + 4 * fq); }
#pragma unroll
                for (int bj = 0; bj < 2; ++bj) { f32x4 v0, v1;
                    if constexpr (I8Q) {
#pragma unroll
                        for (int kk = 0; kk < 4; ++kk) { v0[kk] = (float)acc[ai][bj][m][0][kk] * (sA * sb[bj][0][kk]); v1[kk] = (float)acc[ai][bj][m][1][kk] * (sA * sb[bj][1][kk]); } }
                    else {
#pragma unroll
                        for (int kk = 0; kk < 4; ++kk) { v0[kk] = acc[ai][bj][m][0][kk]; v1[kk] = acc[ai][bj][m][1][kk]; } }
                    if (sel < 2 && wc == 0) {
                        const float a0 = v0[0] * co[0] - v0[1] * si[0], a1 = v0[1] * co[0] + v0[0] * si[0], a2 = v0[2] * co[1] - v0[3] * si[1], a3 = v0[3] * co[1] + v0[2] * si[1];
                        const float b0 = v1[0] * co[2] - v1[1] * si[2], b1 = v1[1] * co[2] + v1[0] * si[2], b2 = v1[2] * co[3] - v1[3] * si[3], b3 = v1[3] * co[3] + v1[2] * si[3];
                        v0 = (f32x4){a0, a1, a2, a3}; v1 = (f32x4){b0, b1, b2, b3}; }
                    if (sel == 1) {
#pragma unroll
                        for (int kk = 0; kk < 4; ++kk) { cs[bj][0][kk] += v0[kk]; cs[bj][1][kk] += v1[kk]; } }
                    v4u w; w.x = cvt_pk_bf16(v0[0], v0[1]); w.y = cvt_pk_bf16(v0[2], v0[3]); w.z = cvt_pk_bf16(v1[0], v1[1]); w.w = cvt_pk_bf16(v1[2], v1[3]);
                    *(v4u*)(outb + (size_t)row * DM + colt + bj * 128 + wc * 32 + fq * 8) = w; } }
        if (sel == 1) {
            const int b = u.pm >> 3, blk = u.pm & 7;
#pragma unroll
            for (int bj = 0; bj < 2; ++bj)
#pragma unroll
                for (int n = 0; n < 2; ++n)
#pragma unroll
                    for (int kk = 0; kk < 4; ++kk) { float s = cs[bj][n][kk]; s += __shfl_xor(s, 1); s += __shfl_xor(s, 2); s += __shfl_xor(s, 4); s += __shfl_xor(s, 8);
                        if (fr == 0) { const int h = (u.pn & 3) * 2 + bj; atomicAdd(kmean + ((size_t)((b * NH + h) * NBLK + blk)) * HD + wc * 32 + fq * 8 + n * 4 + kk, s * (1.0f / 256.0f)); } } } } };

namespace attn {
constexpr int D = 128, TS = DM;
constexpr float SCALE = 0.08838834764831845f, THR = 8.f;
constexpr int NW = 8, QBLK = 32, KVBLK = 64, QB = NW * QBLK;
constexpr int SHM_V = KVBLK * D * 2, SHM_K = KVBLK * D * 2;
constexpr int ATT_LDS = 2 * SHM_V + 2 * SHM_K + NW * 64 * 4;
#define KSWZ(row, colB) ((row) * 256 + ((colB) ^ (((row) & 7) << 4)))
#define SBAR() __builtin_amdgcn_sched_barrier(0)
__device__ __forceinline__ int v_st(int k, int c) { const int kk = (k & ~0xC) | ((k & 4) << 1) | ((k & 8) >> 1); return ((kk >> 3) * 4 + (c >> 5)) * 512 + ((kk & 7) * 32 + (c & 31)) * 2; }
__device__ __forceinline__ int v_rd_base(int lane) { return ((lane & 3) << 3) | (((lane >> 2) & 3) << 6) | (((lane >> 4) & 1) << 5) | (((lane >> 5) & 1) << 8); }
constexpr int v_rd_off(int d0, int ks, int half) { return d0 * 512 + ks * 4096 + half * 2048; }
__device__ __forceinline__ int crow(int r, int hi) { return (r & 3) + 8 * (r >> 2) + 4 * hi; }
__device__ __forceinline__ bf16x8 load8(const bf16* p) { return *reinterpret_cast<const bf16x8*>(p); }
__device__ __forceinline__ void mask_tile(f32x16& p0, f32x16& p1, int dq) {
    const float NEG = -__builtin_inff();
#pragma unroll
    for (int r = 0; r < 16; ++r) { const int c = (r & 3) + 8 * (r >> 2); if (dq - c < 0) p0[r] = NEG; if (dq - c - 32 < 0) p1[r] = NEG; }
}
__device__ __forceinline__ void drop_tile(f32x16& p0, f32x16& p1, bool drop) {
    const float NEG = -__builtin_inff();
#pragma unroll
    for (int r = 0; r < 16; ++r) { p0[r] = drop ? NEG : p0[r]; p1[r] = drop ? NEG : p1[r]; }
}
__device__ __forceinline__ void partialSM(f32x16& p0, f32x16& p1, float& m_reg, float& mn, float& alpha, bool drop = false) {
    float pmax = p0[0];
#pragma unroll
    for (int r = 1; r < 16; ++r) pmax = fmaxf(pmax, p0[r]);
#pragma unroll
    for (int r = 0; r < 16; ++r) pmax = fmaxf(pmax, p1[r]);
    { auto rr = __builtin_amdgcn_permlane32_swap(__float_as_uint(pmax), __float_as_uint(pmax), false, false);
      pmax = fmaxf(__uint_as_float(rr[0]), __uint_as_float(rr[1])); }
    pmax = drop ? -__builtin_inff() : pmax;
    constexpr float C2 = 1.4426950408889634f * SCALE;
    if (__builtin_expect(__all((pmax - m_reg) * SCALE <= THR), 1)) { mn = m_reg; alpha = 1.f; }
    else { mn = fmaxf(m_reg, pmax); alpha = __builtin_amdgcn_exp2f((m_reg - mn) * C2); m_reg = mn; }
    const float mnL = drop ? -__builtin_inff() : -mn * C2;
#pragma unroll
    for (int r = 0; r < 16; ++r) p0[r] = fmaf(p0[r], C2, mnL);
#pragma unroll
    for (int r = 0; r < 16; ++r) p1[r] = fmaf(p1[r], C2, mnL);
#pragma unroll
    for (int r = 0; r < 16; ++r) p0[r] = __builtin_amdgcn_exp2f(p0[r]);
}
__device__ __forceinline__ void finishSM(f32x16& p0, f32x16& p1, float alpha, float& l_reg, bf16x8& pa0, bf16x8& pa1, bf16x8& pa2, bf16x8& pa3) {
#pragma unroll
    for (int r = 0; r < 16; ++r) p1[r] = __builtin_amdgcn_exp2f(p1[r]);
    float ps = 0;
#pragma unroll
    for (int r = 0; r < 16; ++r) ps += p0[r];
#pragma unroll
    for (int r = 0; r < 16; ++r) ps += p1[r];
    { auto rr = __builtin_amdgcn_permlane32_swap(__float_as_uint(ps), __float_as_uint(ps), false, false);
      ps = __uint_as_float(rr[0]) + __uint_as_float(rr[1]); }
    l_reg = l_reg * alpha + ps;
#define PK4(P, B_, OUT) do { unsigned a0 = cvt_pk_bf16(P[B_+0], P[B_+1]), a1 = cvt_pk_bf16(P[B_+2], P[B_+3]);                          \
        unsigned b0 = cvt_pk_bf16(P[B_+4], P[B_+5]), b1 = cvt_pk_bf16(P[B_+6], P[B_+7]);                                             \
        auto r0 = __builtin_amdgcn_permlane32_swap(a0, b0, false, false); auto r1 = __builtin_amdgcn_permlane32_swap(a1, b1, false, false); \
        v4u w = {r0[0], r1[0], r0[1], r1[1]}; OUT = *reinterpret_cast<bf16x8*>(&w); } while (0)
    PK4(p0, 0, pa0); PK4(p0, 8, pa1); PK4(p1, 0, pa2); PK4(p1, 8, pa3);
#undef PK4
}
template <int KB>
__device__ __forceinline__ void qkt(f32x16& p0, f32x16& p1, const char* K_lds, int r32, int hi, const bf16x8* qr) {
    p0 = f32x16{}; p1 = f32x16{};
    const char* kb[4];
#pragma unroll
    for (int dd = 0; dd < 4; ++dd) kb[dd] = K_lds + KB * SHM_K + KSWZ(r32, (dd * 16 + hi * 8) * 2);
#pragma unroll
    for (int d0 = 0; d0 < 8; ++d0) { const char* a = kb[d0 & 3] + (d0 >> 2) * 128;
        bf16x8 b0 = *reinterpret_cast<const bf16x8*>(a);
        bf16x8 b1 = *reinterpret_cast<const bf16x8*>(a + 32 * 256);
        p0 = __builtin_amdgcn_mfma_f32_32x32x16_bf16(b0, qr[d0], p0, 0, 0, 0);
        p1 = __builtin_amdgcn_mfma_f32_32x32x16_bf16(b1, qr[d0], p1, 0, 0, 0); }
}
template <int VB>
__device__ __forceinline__ void pv_tile(f32x16* o, int vb0, bf16x8 pa0, bf16x8 pa1, bf16x8 pa2, bf16x8 pa3) {
#define TRRD(dst, off) asm volatile("ds_read_b64_tr_b16 %0, %1 offset:%2" : "=&v"(dst) : "v"(vb0), "i"(off) : "memory")
#define PV_RD(d0, X) do { constexpr int b_ = VB * SHM_V + v_rd_off(d0, 0, 0); \
        TRRD(X##l0, b_); TRRD(X##h0, b_ + 2048); TRRD(X##l1, b_ + 4096); TRRD(X##h1, b_ + 6144); TRRD(X##l2, b_ + 8192); TRRD(X##h2, b_ + 10240); TRRD(X##l3, b_ + 12288); TRRD(X##h3, b_ + 14336); } while (0)
#define PV_MM(d0, X) do { \
        o[d0] = __builtin_amdgcn_mfma_f32_32x32x16_bf16(pa0, (bf16x8){X##l0[0], X##l0[1], X##l0[2], X##l0[3], X##h0[0], X##h0[1], X##h0[2], X##h0[3]}, o[d0], 0, 0, 0);   \
        o[d0] = __builtin_amdgcn_mfma_f32_32x32x16_bf16(pa1, (bf16x8){X##l1[0], X##l1[1], X##l1[2], X##l1[3], X##h1[0], X##h1[1], X##h1[2], X##h1[3]}, o[d0], 0, 0, 0);   \
        o[d0] = __builtin_amdgcn_mfma_f32_32x32x16_bf16(pa2, (bf16x8){X##l2[0], X##l2[1], X##l2[2], X##l2[3], X##h2[0], X##h2[1], X##h2[2], X##h2[3]}, o[d0], 0, 0, 0);   \
        o[d0] = __builtin_amdgcn_mfma_f32_32x32x16_bf16(pa3, (bf16x8){X##l3[0], X##l3[1], X##l3[2], X##l3[3], X##h3[0], X##h3[1], X##h3[2], X##h3[3]}, o[d0], 0, 0, 0); } while (0)
#define PV_WAIT(n) do { asm volatile("s_waitcnt lgkmcnt(" #n ")" ::: "memory"); SBAR(); } while (0)
    { s16x4 al0, al1, al2, al3, ah0, ah1, ah2, ah3, bl0, bl1, bl2, bl3, bh0, bh1, bh2, bh3;
      PV_RD(0, a); PV_RD(1, b);
      PV_WAIT(8); PV_MM(0, a); SBAR(); PV_RD(2, a);
      PV_WAIT(8); PV_MM(1, b); SBAR(); PV_RD(3, b);
      PV_WAIT(8); PV_MM(2, a);
      PV_WAIT(0); PV_MM(3, b); }
#undef PV_RD
#undef PV_MM
#undef PV_WAIT
#undef TRRD
}
struct BlockRef { const bf16* Q; const bf16* K; const bf16* V; bf16* O; const float* KM; int P0; };
struct Seam { bf16x8 qr[8]; bf16x8 st_v0, st_v1, st_k0, st_k1; };
#define ROW(p, k0, rr) ((p) + (size_t)((k0) + (rr)) * TS + sc)
#define VMW() asm volatile("s_waitcnt vmcnt(0)" ::: "memory")
#define VMWN(n) asm volatile("s_waitcnt vmcnt(%0)" :: "i"(n) : "memory")
#define SLOAD_H(Kp, Vp, k0) do { S.st_v0 = load8(ROW(Vp, k0, sr)); S.st_v1 = load8(ROW(Vp, k0, 32 + sr));              \
                         S.st_k0 = load8(ROW(Kp, k0, sr)); S.st_k1 = load8(ROW(Kp, k0, 32 + sr)); } while (0)
#define SWRITE_HK(bf) do { *(bf16x8*)(K_lds + (bf) * SHM_K + kws) = S.st_k0; *(bf16x8*)(K_lds + (bf) * SHM_K + kws + 32 * 256) = S.st_k1; } while (0)
#define SWRITE_HV(bf) do { *(bf16x8*)(V_lds + (bf) * SHM_V + vst0) = S.st_v0; *(bf16x8*)(V_lds + (bf) * SHM_V + vst1) = S.st_v1; } while (0)
#define SWRITE_H(bf) do { SWRITE_HV(bf); SWRITE_HK(bf); } while (0)
__device__ __forceinline__ void moba_prime(const BlockRef& cur, char* lds, Seam& S) {
    const int tid = threadIdx.x, wid = __builtin_amdgcn_readfirstlane(tid >> 6), lane = tid & 63, r32 = lane & 31, hi = lane >> 5;
    const int sr = tid >> 4, sc = (tid & 15) * 8, kws = KSWZ(sr, sc * 2); char* K_lds = lds + 2 * SHM_V;
#pragma unroll
    for (int d0 = 0; d0 < 8; ++d0) S.qr[d0] = load8(cur.Q + (size_t)(wid * QBLK + r32) * TS + d0 * 16 + hi * 8);
    SLOAD_H(cur.K, cur.V, 0); VMW(); SWRITE_HK(0);
    __syncthreads();
}
__device__ __forceinline__ void moba_block(const BlockRef& cur, const BlockRef& nxt, char* lds, Seam& S) {
    const int tid = threadIdx.x, wid = __builtin_amdgcn_readfirstlane(tid >> 6), lane = tid & 63, r32 = lane & 31, hi = lane >> 5;
    const int NT = cur.P0 / KVBLK + QB / KVBLK;
    const int qlo = cur.P0 + wid * QBLK, qm = qlo + r32 - 4 * hi;
    char* V_lds = lds; char* K_lds = lds + 2 * SHM_V;
    float* ws = (float*)(lds + 2 * SHM_V + 2 * SHM_K) + wid * 64; float* li_l = ws, * al_l = ws + 32;
    int sel = 0xff; const int qb = cur.P0 >> 8;
    if (qb > 3) {
        float g[7];
#pragma unroll
        for (int j = 0; j < 7; ++j) { float s = -__builtin_inff();
            asm volatile("" ::: "memory");
            if (j < qb) { int hoff = hi * 8; asm volatile("" : "+v"(hoff)); const float* km = cur.KM + j * HD + hoff; s = 0.f;
#pragma unroll
                for (int d0 = 0; d0 < 8; ++d0) { const f32x4 k0 = *(const f32x4*)(km + d0 * 16), k1 = *(const f32x4*)(km + d0 * 16 + 4); const bf16x8 qv = S.qr[d0];
                    s += bf2f((unsigned short)qv[0]) * k0[0] + bf2f((unsigned short)qv[1]) * k0[1] + bf2f((unsigned short)qv[2]) * k0[2] + bf2f((unsigned short)qv[3]) * k0[3]
                       + bf2f((unsigned short)qv[4]) * k1[0] + bf2f((unsigned short)qv[5]) * k1[1] + bf2f((unsigned short)qv[6]) * k1[2] + bf2f((unsigned short)qv[7]) * k1[3]; }
                auto rr = __builtin_amdgcn_permlane32_swap(__float_as_uint(s), __float_as_uint(s), false, false); s = __uint_as_float(rr[0]) + __uint_as_float(rr[1]); }
            g[j] = s; }
        sel = 0;
#pragma unroll
        for (int j = 0; j < 7; ++j) { int rank = 0;
#pragma unroll
            for (int k = 0; k < 7; ++k) if (k != j) rank += (g[k] > g[j] || (g[k] == g[j] && k < j)) ? 1 : 0;
            if (j < qb && rank < 3) sel |= 1 << j; }
        sel |= 1 << qb;
    }
    float m_reg = -1e30f, l_reg = 0; f32x16 o[4] = {};
    const int sr = tid >> 4, sc = (tid & 15) * 8, vst0 = v_st(sr, sc), vst1 = v_st(32 + sr, sc), kws = KSWZ(sr, sc * 2);
    const int vb0 = (int)(uintptr_t)V_lds + v_rd_base(lane);
    const bf16* Kh = cur.K; const bf16* Vh = cur.V;
#define RESC(a) do { if (__any((a) < 1.f)) { if (hi == 0) al_l[r32] = (a); asm volatile("s_waitcnt lgkmcnt(0)" ::: "memory");              \
                     for (int d_ = 0; d_ < 4; ++d_) for (int r = 0; r < 16; ++r) o[d_][r] *= al_l[crow(r, hi)]; } } while (0)
#define KBASE(t) ((t) * KVBLK)
#define MASKT(P0_, P1_, t) do { const int kb_ = KBASE(t); if (kb_ + KVBLK - 1 > qlo) mask_tile(P0_, P1_, qm - kb_); \
        dropT = (kb_ < cur.P0) && ((sel >> (kb_ >> 8)) & 1) == 0; } while (0)
    constexpr int NQL = 8;
#define SEAM_K0() do { VMWN(NQL); SWRITE_HK(0); SBAR(); } while (0)
    f32x16 pA0, pA1, pB0, pB1; float mnA, mnB, alA, alB; bf16x8 pa0, pa1, pa2, pa3; bool dropT = false;
    SWRITE_HV(0); SBAR();
    if (NT > 1) SLOAD_H(Kh, Vh, KBASE(1));
    SBAR(); qkt<0>(pA0, pA1, K_lds, r32, hi, S.qr);
    MASKT(pA0, pA1, 0); partialSM(pA0, pA1, m_reg, mnA, alA, dropT);
    if (NT > 1) { VMW(); SWRITE_H(1); }
    __syncthreads();
#define HALF_STEP(PX0, PX1, mnX, alX, PY0, PY1, alY, t, KB, VB, SB) do {                                                      \
        SBAR(); qkt<KB>(PX0, PX1, K_lds, r32, hi, S.qr);                                                                      \
        finishSM(PY0, PY1, alY, l_reg, pa0, pa1, pa2, pa3); SBAR();                                                           \
        if ((t) + 1 < NT) { SLOAD_H(Kh, Vh, KBASE((t) + 1)); SBAR(); }                                                        \
        pv_tile<VB>(o, vb0, pa0, pa1, pa2, pa3); MASKT(PX0, PX1, (t)); partialSM(PX0, PX1, m_reg, mnX, alX, dropT);            \
        __syncthreads();                                                                                                      \
        if ((t) + 1 < NT) { VMW(); SWRITE_H(SB); }                                                                            \
        RESC(alX); __syncthreads(); } while (0)
    for (int t = 1; t + 1 < NT; t += 2) {
        HALF_STEP(pB0, pB1, mnB, alB, pA0, pA1, alA, t, 1, 0, 0);
        HALF_STEP(pA0, pA1, mnA, alA, pB0, pB1, alB, t + 1, 0, 1, 1);
    }
    SBAR(); qkt<1>(pB0, pB1, K_lds, r32, hi, S.qr); SBAR();
    SLOAD_H(nxt.K, nxt.V, 0); SBAR();
#pragma unroll
    for (int d0 = 0; d0 < 8; ++d0) S.qr[d0] = load8(nxt.Q + (size_t)(wid * QBLK + r32) * TS + d0 * 16 + hi * 8);
    SBAR();
    finishSM(pA0, pA1, alA, l_reg, pa0, pa1, pa2, pa3); SBAR();
    pv_tile<0>(o, vb0, pa0, pa1, pa2, pa3);
    MASKT(pB0, pB1, NT - 1); partialSM(pB0, pB1, m_reg, mnB, alB, dropT); __syncthreads(); RESC(alB);
    finishSM(pB0, pB1, alB, l_reg, pa0, pa1, pa2, pa3); SBAR(); pv_tile<1>(o, vb0, pa0, pa1, pa2, pa3);
    SBAR(); SEAM_K0();
    if (hi == 0) li_l[r32] = l_reg; asm volatile("s_waitcnt lgkmcnt(0)" ::: "memory");
    float rli[16];
#pragma unroll
    for (int r = 0; r < 16; ++r) rli[r] = __builtin_amdgcn_rcpf(li_l[crow(r, hi)]);
    bf16* Ow = cur.O + (size_t)(wid * QBLK) * TS;
#pragma unroll
    for (int r = 0; r < 16; ++r) { const int orow = crow(r, hi);
#pragma unroll
        for (int d0 = 0; d0 < 4; ++d0) { const float v = o[d0][r] * rli[r];
            const float vn = __shfl_xor(v, 1);
            if ((r32 & 1) == 0) *(unsigned*)(Ow + (size_t)orow * TS + d0 * 32 + r32) = cvt_pk_bf16(v, vn); } }
    __syncthreads();
#undef RESC
#undef KBASE
#undef MASKT
#undef SEAM_K0
#undef HALF_STEP
}
#undef ROW
#undef VMW
#undef VMWN
#undef SLOAD_H
#undef SWRITE_HK
#undef SWRITE_HV
#undef SWRITE_H
}

#define XB_TMO      128
#define XB_XCNT(j)  (256  + 64 * (j))
#define XB_XSUB(j)  (1280 + 64 * (j))
#define XB_XGEN(j)  (2304 + 64 * (j))
#define XB_TOP      3328
#define XB_TOPGEN   3392
#define XCD_BAR_WORDS 3456
#define XB_SPIN_CAP (1u << 18)
__device__ __forceinline__ unsigned xb_ld(unsigned* p)              { return __hip_atomic_load(p, __ATOMIC_RELAXED, __HIP_MEMORY_SCOPE_AGENT); }
__device__ __forceinline__ unsigned xb_add(unsigned* p, unsigned v) { return __hip_atomic_fetch_add(p, v, __ATOMIC_RELAXED, __HIP_MEMORY_SCOPE_AGENT); }
__device__ __forceinline__ unsigned xb_xcc_id() { return (unsigned)__builtin_amdgcn_s_getreg((3 << 11) | 20) & 0xFu; }
#define XB_SPIN(cond, bar) do { unsigned _sp = 0; while (cond) { __builtin_amdgcn_s_sleep(1); \
    if ((++_sp & 255u) == 0u) { if (xb_ld(&(bar)[XB_TMO])) break; if (_sp > XB_SPIN_CAP) { atomicAdd(&(bar)[XB_TMO], 1u); break; } } } } while (0)
struct XcdBarrier { unsigned* bar; unsigned x; volatile LAS unsigned* st; };
__device__ __forceinline__ XcdBarrier xcd_barrier_post(unsigned* bar, volatile LAS unsigned* st) {
    XcdBarrier b; b.bar = bar; b.x = xb_xcc_id(); b.st = st;
    if (threadIdx.x == 0) (void)xb_add(&bar[XB_XCNT(b.x)], 1u);
    return b;
}
__device__ __forceinline__ void xcd_barrier_complete(unsigned* bar, unsigned x, unsigned& nloc, unsigned& nx) {
    const unsigned G = gridDim.x * gridDim.y * gridDim.z;
    unsigned sum, cnt, mine, sp = 0u;
    for (;;) {
        sum = 0u; cnt = 0u;
#pragma unroll 1
        for (unsigned j = 0; j < 16; ++j) { const unsigned c = xb_ld(&bar[XB_XCNT(j)]); sum += c; cnt += (c > 0u) ? 1u : 0u; }
        if (sum == G) break;
        __builtin_amdgcn_s_sleep(1);
        if ((++sp & 255u) == 0u) { if (xb_ld(&bar[XB_TMO])) break; if (sp > XB_SPIN_CAP) { atomicAdd(&bar[XB_TMO], 1u); break; } }
    }
    mine = xb_ld(&bar[XB_XCNT(x)]);
    nloc = mine > 0u ? mine : 1u; nx = cnt > 0u ? cnt : 1u;
}
__device__ __forceinline__ void xcd_barrier(const XcdBarrier& b) {
    asm volatile("s_waitcnt vmcnt(0)" ::: "memory");
    __syncthreads();
    if (threadIdx.x == 0) {
        unsigned* bar = b.bar;
        __builtin_amdgcn_s_waitcnt(0);
        unsigned nloc = b.st[0], nx = b.st[1];
        if (nloc == 0u) { xcd_barrier_complete(bar, b.x, nloc, nx); b.st[0] = nloc; b.st[1] = nx; }
        const unsigned old = xb_add(&bar[XB_XSUB(b.x)], 1u);
        const unsigned gen = old / nloc;
        if (old + 1u == (gen + 1u) * nloc) {
            __builtin_amdgcn_fence(__ATOMIC_RELEASE, "agent");
            asm volatile("s_waitcnt vmcnt(0)" ::: "memory");
            const unsigned og = xb_add(&bar[XB_TOP], 1u);
            const unsigned tg = og / nx;
            if (og + 1u == (tg + 1u) * nx) xb_add(&bar[XB_TOPGEN], 1u);
            else XB_SPIN(xb_ld(&bar[XB_TOPGEN]) == tg, bar);
            __builtin_amdgcn_fence(__ATOMIC_ACQUIRE, "agent");
            xb_add(&bar[XB_XGEN(b.x)], 1u);
            asm volatile("s_waitcnt vmcnt(0)" ::: "memory");
        } else {
            XB_SPIN(xb_ld(&bar[XB_XGEN(b.x)]) == gen, bar);
            __builtin_amdgcn_fence(__ATOMIC_ACQUIRE, "agent");
            asm volatile("s_waitcnt vmcnt(0)" ::: "memory");
        }
    }
    __syncthreads();
}

struct Frame {
    LAS unsigned char* lds; volatile LAS unsigned* MISC; unsigned* ctl;
    int tid, lane, wave, vcu, G, bx, lo, hi;
    unsigned char* ws;
};
struct Args { const void* in[24]; float* out; unsigned char* ws; int ph_lo, ph_hi; };
typedef const __attribute__((address_space(4))) Args* KArgs;
__device__ __forceinline__ KArgs kargs() { KArgs p = (KArgs)__builtin_amdgcn_kernarg_segment_ptr(); asm volatile("" : "+s"(p)); return p; }
__device__ __forceinline__ void refresh(Frame& F) {
    KArgs k = kargs();
    int t = threadIdx.x; asm volatile("" : "+v"(t)); F.tid = t; F.lane = t & 63; F.wave = __builtin_amdgcn_readfirstlane(t >> 6);
    int g = gridDim.x, bx = blockIdx.x; asm volatile("" : "+s"(g), "+s"(bx)); F.G = g; F.bx = bx; F.vcu = (g % 8 == 0) ? (bx % 8) * (g / 8) + bx / 8 : bx;
    F.ws = k->ws; F.ctl = (unsigned*)(F.ws + WS_CTL); F.lo = k->ph_lo; F.hi = k->ph_hi;
    F.lds = (LAS unsigned char*)0; F.MISC = (volatile LAS unsigned*)(F.lds + MISC_OFF);
}
__device__ __forceinline__ XcdBarrier frame_bar(Frame& F) { XcdBarrier b; b.bar = F.ctl + CW_BAR; b.x = xb_xcc_id(); b.st = F.MISC + 8; return b; }
enum { I_X = 0, I_POS, I_NORMS, I_LAMRE, I_LAMIM, I_LOGDT, I_BRE, I_BIM, I_CRE, I_CIM, I_SD, I_WGLU, I_KVN, I_WKV, I_WQ, I_WO, I_FW1, I_FW3, I_FW2, I_ROUTER, I_RBIAS, I_MW1, I_MW3, I_MW2 };

__device__ __forceinline__ int rot32(int d) { return 8 * ((d & 15) >> 2) + 2 * (d & 3) + (d >> 4); }
constexpr int NKIND = 31;
struct WK { const float* W; const float* gain; unsigned char* dst; unsigned* colmax; float* psq; int ldw, K, N, mode, base, which, ot; };
__device__ __forceinline__ void wk_get(KArgs ap, unsigned char* ws, int kind, WK& k) {
    const auto& a = *ap; const float* norms = (const float*)a.in[I_NORMS]; k.gain = nullptr; k.colmax = nullptr; k.psq = nullptr; k.mode = 0; k.base = 0; k.which = 0; k.ot = 0; k.ldw = DM; k.K = DM; k.N = DM;
    if (kind == 0) { k.W = (const float*)a.in[I_WGLU]; k.ldw = 2 * DM; k.N = 2 * DM; k.dst = ws + WS_WGLU; k.mode = 3; }
    else if (kind == 1) { k.W = (const float*)a.in[I_WQ]; k.gain = norms + 4 * DM; k.mode = 2; k.ot = MK_QKV8; k.dst = MK_QKV8 ? ws + WS_WQQKV : ws + WS_WQKV; k.colmax = (unsigned*)(ws + WS_COLMAX_QKV); }
    else if (kind == 2) { k.W = (const float*)a.in[I_WKV]; k.ldw = 2 * DM; k.N = 2 * DM; k.gain = (const float*)a.in[I_KVN]; k.mode = 4; k.base = DM; k.ot = MK_QKV8; k.dst = MK_QKV8 ? ws + WS_WQQKV : ws + WS_WQKV; k.colmax = (unsigned*)(ws + WS_COLMAX_QKV); }
    else if (kind == 3) { k.W = (const float*)a.in[I_WO]; k.dst = ws + WS_WO; }
    else if (kind == 4 || kind == 5) { k.W = (const float*)a.in[kind == 4 ? I_FW1 : I_FW3]; k.ldw = FFD; k.N = FFD; k.gain = norms + 2 * DM; k.mode = 1; k.which = kind - 4; k.ot = 1; k.dst = ws + WS_WQF13; k.colmax = (unsigned*)(ws + WS_COLMAX_F); k.psq = (float*)(ws + WS_PSQD); }
    else if (kind == 6) { k.W = (const float*)a.in[I_FW2]; k.K = FFD; k.dst = ws + WS_WF2; if (MK_FFN2F8) { k.ot = 2; k.colmax = (unsigned*)(ws + WS_COLMAX_W2) + NE * DM; } }
    else if (kind < 23) { const int e = (kind - 7) & 7, wh = (kind - 7) >> 3; k.W = (const float*)a.in[wh ? I_MW3 : I_MW1] + (size_t)e * DM * FFE; k.ldw = FFE; k.N = FFE; k.gain = norms + 6 * DM; k.mode = 1; k.which = wh; k.ot = 1;
        k.dst = ws + WS_WQ13 + (size_t)e * 2 * FFE * DM; k.colmax = (unsigned*)(ws + WS_COLMAX) + e * 2 * FFE; k.psq = (float*)(ws + WS_PSQ) + e * 2 * FFE; }
    else { const int e = kind - 23; k.W = (const float*)a.in[I_MW2] + (size_t)e * FFE * DM; k.K = FFE; k.ot = 2; k.dst = ws + WS_W8M2 + (size_t)e * DM * FFE; k.colmax = (unsigned*)(ws + WS_COLMAX_W2) + e * DM; }
}
__device__ __forceinline__ int wk_drow(const WK& k, int n) {
    if (k.mode == 1) return (n >> 7) * 256 + k.which * 128 + (n & 127);
    if (k.mode == 3) { const int chn = n & 1023; return (chn >> 7) * 256 + (n >> 10) * 128 + (chn & 127); }
    if (k.mode == 2 || (k.mode == 4 && n < DM)) { const int d = n & 127; return k.base + (n & ~127) + (d < 32 ? rot32(d) : d); }
    return k.base + n;
}
__device__ __forceinline__ int wk_f8ex(float cm) { int ex = 0; if (cm > 0.f) { ex = 134 - (int)((__float_as_uint(cm) >> 23) & 0xffu); ex = ex < -60 ? -60 : (ex > 60 ? 60 : ex); } return ex; }
__device__ __forceinline__ unsigned q8(float x) { int q = (int)rintf(x); q = q < -127 ? -127 : (q > 127 ? 127 : q); return (unsigned)q & 0xffu; }
__device__ __forceinline__ unsigned q8x4(float a, float b, float c, float d, float f) {
    unsigned p = 0;
    p = __builtin_amdgcn_cvt_pk_u8_f32(rintf(fmaf(a, f, 128.0f)), 0, p); p = __builtin_amdgcn_cvt_pk_u8_f32(rintf(fmaf(b, f, 128.0f)), 1, p);
    p = __builtin_amdgcn_cvt_pk_u8_f32(rintf(fmaf(c, f, 128.0f)), 2, p); p = __builtin_amdgcn_cvt_pk_u8_f32(rintf(fmaf(d, f, 128.0f)), 3, p);
    return p ^ 0x80808080u;
}
__device__ __forceinline__ void wk_stats_item(const WK& k, int kb, int nb, int lane) {
    const int nc = nb * 256 + 4 * lane; float mx[4] = {0.f, 0.f, 0.f, 0.f}, sq[4] = {0.f, 0.f, 0.f, 0.f};
#pragma unroll 1
    for (int i0 = 0; i0 < 64; i0 += 16) { f32x4 v[16];
#pragma unroll
        for (int i = 0; i < 16; ++i) v[i] = *(const f32x4*)(k.W + (size_t)(kb * 64 + i0 + i) * k.ldw + nc);
#pragma unroll
        for (int i = 0; i < 16; ++i) { const float gs = k.gain ? k.gain[kb * 64 + i0 + i] : 1.0f;
#pragma unroll
            for (int c = 0; c < 4; ++c) { const float x = v[i][c] * gs; mx[c] = fmaxf(mx[c], fabsf(x)); sq[c] += x * x; } } }
#pragma unroll
    for (int c = 0; c < 4; ++c) { const int dr = wk_drow(k, nc + c); atomicMax(k.colmax + dr, __float_as_uint(mx[c])); if (k.psq) k.psq[(size_t)kb * (NE * 2 * FFE) + dr] = sq[c]; }
}
__device__ __forceinline__ void wk_item(const WK& k, int kb, int nb, int* sb8, LAS float* scr, int lane) {
    const int k0 = kb * 64, n0 = nb * 64;
    f32x4 v[16]; const int r4 = lane >> 4, c4 = (lane & 15) * 4;
#pragma unroll
    for (int i = 0; i < 16; ++i) v[i] = *(const f32x4*)(k.W + (size_t)(k0 + 4 * i + r4) * k.ldw + n0 + c4);
    const int k8 = lane & 3, nl = lane >> 2;
    int dr[4]; float qs[4];
#pragma unroll
    for (int st = 0; st < 4; ++st) { dr[st] = wk_drow(k, n0 + 16 * st + nl); qs[st] = 1.0f;
        if (k.ot == 1) { const float cm = __uint_as_float(k.colmax[dr[st]]); qs[st] = cm > 0.f ? 127.0f / cm : 0.f; }
        if (k.ot == 2) { const int ex = wk_f8ex(__uint_as_float(k.colmax[dr[st]])); qs[st] = __builtin_bit_cast(float, (unsigned)(127 + ex) << 23); if (kb == 0 && k8 == 0) sb8[dr[st]] = 127 - ex; } }
#pragma unroll
    for (int hf = 0; hf < 2; ++hf) {
#pragma unroll
        for (int i = 0; i < 8; ++i) { const int kk = 4 * i + r4; const float gs = k.gain ? k.gain[k0 + hf * 32 + kk] : 1.0f; LAS float* d = scr + kk * 65 + c4; const f32x4 x = v[hf * 8 + i];
            d[0] = x.x * gs; d[1] = x.y * gs; d[2] = x.z * gs; d[3] = x.w * gs; }
        LDS_WAIT(); asm volatile("" ::: "memory");
#pragma unroll
        for (int st = 0; st < 4; ++st) { const int n = 16 * st + nl; const LAS float* sp = scr + (8 * k8) * 65 + n; const float f = qs[st];
            if (k.ot == 0) { v4u o; o.x = cvt_pk_bf16(sp[0 * 65], sp[1 * 65]); o.y = cvt_pk_bf16(sp[2 * 65], sp[3 * 65]); o.z = cvt_pk_bf16(sp[4 * 65], sp[5 * 65]); o.w = cvt_pk_bf16(sp[6 * 65], sp[7 * 65]);
                *(v4u*)((bf16*)k.dst + (size_t)dr[st] * k.K + k0 + hf * 32 + 8 * k8) = o; }
            else { v2u o;
                if (k.ot == 1) { o.x = q8x4(sp[0 * 65], sp[1 * 65], sp[2 * 65], sp[3 * 65], f); o.y = q8x4(sp[4 * 65], sp[5 * 65], sp[6 * 65], sp[7 * 65], f); }
                else { int p0 = __builtin_amdgcn_cvt_pk_fp8_f32(sp[0 * 65] * f, sp[1 * 65] * f, 0, false); p0 = __builtin_amdgcn_cvt_pk_fp8_f32(sp[2 * 65] * f, sp[3 * 65] * f, p0, true);
                       int p1 = __builtin_amdgcn_cvt_pk_fp8_f32(sp[4 * 65] * f, sp[5 * 65] * f, 0, false); p1 = __builtin_amdgcn_cvt_pk_fp8_f32(sp[6 * 65] * f, sp[7 * 65] * f, p1, true); o.x = (unsigned)p0; o.y = (unsigned)p1; }
                *(v2u*)(k.dst + (size_t)dr[st] * k.K + k0 + hf * 32 + 8 * k8) = o; } }
        LDS_WAIT(); asm volatile("" ::: "memory");
    }
}
__device__ __forceinline__ void wk_shape(int kind, int& nkb, int& nn, bool& quant) {
    nkb = DM / 64; nn = DM; quant = false;
    if (kind == 0) nn = 2 * DM;
    else if (kind == 1) quant = MK_QKV8 != 0;
    else if (kind == 2) { nn = 2 * DM; quant = MK_QKV8 != 0; }
    else if (kind == 4 || kind == 5) { nn = FFD; quant = true; }
    else if (kind == 6) { nkb = FFD / 64; quant = MK_FFN2F8 != 0; }
    else if (kind >= 7 && kind < 23) { nn = FFE; quant = true; }
    else if (kind >= 23) { nkb = FFE / 64; quant = true; }
}
template <bool GAIN> __device__ __forceinline__ void wk_tile_stats(const WK& k, int kb, int r4, const f32x4 (&v)[16], float (&mx)[4], float (&sq)[4]) {
    const float* gp = GAIN ? k.gain + kb * 64 + 16 * r4 : nullptr; if (GAIN) asm volatile("" : "+v"(gp));
#pragma unroll
    for (int i = 0; i < 16; ++i) { const float gs = GAIN ? gp[i] : 1.0f;
#pragma unroll
        for (int c = 0; c < 4; ++c) { const float x = v[i][c] * gs; mx[c] = fmaxf(mx[c], fabsf(x)); sq[c] += x * x; } }
}
template <bool GAIN> __device__ __forceinline__ void wk_tile_out(const WK& k, int kb, int r4, const f32x4 (&v)[16], const int (&dr)[4], const float (&qs)[4]) {
    const float* gp = GAIN ? k.gain + kb * 64 + 16 * r4 : nullptr; if (GAIN) asm volatile("" : "+v"(gp));
    float g[16];
#pragma unroll
    for (int i = 0; i < 16; ++i) g[i] = GAIN ? gp[i] : 1.0f;
#pragma unroll
    for (int c = 0; c < 4; ++c) { const float f = qs[c]; v4u o;
        if (k.ot == 1) { o.x = q8x4(v[0][c] * g[0], v[1][c] * g[1], v[2][c] * g[2], v[3][c] * g[3], f); o.y = q8x4(v[4][c] * g[4], v[5][c] * g[5], v[6][c] * g[6], v[7][c] * g[7], f);
                         o.z = q8x4(v[8][c] * g[8], v[9][c] * g[9], v[10][c] * g[10], v[11][c] * g[11], f); o.w = q8x4(v[12][c] * g[12], v[13][c] * g[13], v[14][c] * g[14], v[15][c] * g[15], f); }
        else { unsigned w[4];
#pragma unroll
            for (int q = 0; q < 4; ++q) { int pw = __builtin_amdgcn_cvt_pk_fp8_f32(v[4 * q][c] * g[4 * q] * f, v[4 * q + 1][c] * g[4 * q + 1] * f, 0, false);
                pw = __builtin_amdgcn_cvt_pk_fp8_f32(v[4 * q + 2][c] * g[4 * q + 2] * f, v[4 * q + 3][c] * g[4 * q + 3] * f, pw, true); w[q] = (unsigned)pw; }
            o.x = w[0]; o.y = w[1]; o.z = w[2]; o.w = w[3]; }
        *(v4u*)(k.dst + (size_t)dr[c] * k.K + kb * 64 + 16 * r4) = o; }
}
#define SCHED_FENCE() __builtin_amdgcn_sched_barrier(0)
template <int TPW> __device__ __forceinline__ void wk_super(const WK& k, Frame& F, int sbslot, int nb) {
    LAS float* smax = (LAS float*)(F.lds + F.wave * 16384) + 2080; LAS float* ssq = smax + 64;
    const int lane = F.lane, r4 = lane >> 4, c4 = (lane & 15) * 4, tpw = TPW;
    const float* wbase = k.W + (size_t)(16 * r4) * k.ldw + nb * 64 + c4;
#define WK_LOAD(v, kb) do { const float* p_ = wbase + (size_t)((kb) * 64) * k.ldw; _Pragma("unroll") for (int i_ = 0; i_ < 16; ++i_) { v[i_] = *(const f32x4*)p_; p_ += k.ldw; asm volatile("" : "+v"(p_)); } } while (0)
    float mx[4] = {0.f, 0.f, 0.f, 0.f}, sq[4] = {0.f, 0.f, 0.f, 0.f};
    f32x4 va[16], vb[16];
    const int kbase = F.wave * tpw;
    if constexpr (TPW == 2) { WK_LOAD(va, kbase); WK_LOAD(vb, kbase + 1); wk_tile_stats<TPW == 2>(k, kbase, r4, va, mx, sq); wk_tile_stats<TPW == 2>(k, kbase + 1, r4, vb, mx, sq); }
    else {
        static_assert(TPW == 2 || TPW == 7, "tile schedule below is written for 7 tiles");
        WK_LOAD(va, kbase);
#pragma unroll 1
        for (int t = 0; t < 6; t += 2) { WK_LOAD(vb, kbase + t + 1); SCHED_FENCE(); wk_tile_stats<TPW == 2>(k, kbase + t, r4, va, mx, sq); SCHED_FENCE(); WK_LOAD(va, kbase + t + 2); SCHED_FENCE(); wk_tile_stats<TPW == 2>(k, kbase + t + 1, r4, vb, mx, sq); SCHED_FENCE(); }
        wk_tile_stats<TPW == 2>(k, kbase + 6, r4, va, mx, sq); }
#pragma unroll
    for (int c = 0; c < 4; ++c) { mx[c] = fmaxf(mx[c], __shfl_xor(mx[c], 16)); mx[c] = fmaxf(mx[c], __shfl_xor(mx[c], 32)); sq[c] += __shfl_xor(sq[c], 16); sq[c] += __shfl_xor(sq[c], 32); }
    if (lane < 16) {
#pragma unroll
        for (int c = 0; c < 4; ++c) { smax[c4 + c] = mx[c]; ssq[c4 + c] = sq[c]; } }
    __syncthreads();
    int dr[4]; float qs[4];
#pragma unroll
    for (int c = 0; c < 4; ++c) { const int n = c4 + c; float cm = 0.f;
#pragma unroll
        for (int w = 0; w < NWAVES; ++w) cm = fmaxf(cm, ((const LAS float*)(F.lds + w * 16384))[2080 + n]);
        dr[c] = wk_drow(k, nb * 64 + n); qs[c] = 1.0f;
        if (k.ot == 1) qs[c] = cm > 0.f ? 127.0f / cm : 0.f;
        if (k.ot == 2) { const int ex = wk_f8ex(cm); qs[c] = __builtin_bit_cast(float, (unsigned)(127 + ex) << 23); } }
    if (F.tid < 64) { const int n = F.tid; float cm = 0.f, ss = 0.f;
#pragma unroll
        for (int w = 0; w < NWAVES; ++w) { cm = fmaxf(cm, ((const LAS float*)(F.lds + w * 16384))[2080 + n]); ss += ((const LAS float*)(F.lds + w * 16384))[2144 + n]; }
        const int d = wk_drow(k, nb * 64 + n); k.colmax[d] = __float_as_uint(cm); if (k.psq) k.psq[d] = ss;
        if (k.ot == 2) ((int*)(F.ws + WS_SB8))[sbslot * DM + d] = 127 - wk_f8ex(cm); }
    if constexpr (TPW == 2) { wk_tile_out<TPW == 2>(k, kbase, r4, va, dr, qs); wk_tile_out<TPW == 2>(k, kbase + 1, r4, vb, dr, qs); }
    else {
        wk_tile_out<TPW == 2>(k, kbase + 6, r4, va, dr, qs); SCHED_FENCE();
        WK_LOAD(va, kbase + 4); SCHED_FENCE(); wk_tile_out<TPW == 2>(k, kbase + 5, r4, vb, dr, qs); SCHED_FENCE();
#pragma unroll 1
        for (int t = 4; t >= 2; t -= 2) { WK_LOAD(vb, kbase + t - 1); SCHED_FENCE(); wk_tile_out<TPW == 2>(k, kbase + t, r4, va, dr, qs); SCHED_FENCE(); WK_LOAD(va, kbase + t - 2); SCHED_FENCE(); wk_tile_out<TPW == 2>(k, kbase + t - 1, r4, vb, dr, qs); SCHED_FENCE(); }
        wk_tile_out<TPW == 2>(k, kbase, r4, va, dr, qs); }
#undef WK_LOAD
    __syncthreads();
}
__device__ __forceinline__ void wk_super_g(const WK& k, Frame& F, int sbslot, int nb) {
    LAS float* smax = (LAS float*)(F.lds + F.wave * 16384) + 2080; LAS float* ssq = smax + 64;
    const int lane = F.lane, r4 = lane >> 4, c4 = (lane & 15) * 4, nkb = k.K / 64;
    const float* wbase = k.W + (size_t)(16 * r4) * k.ldw + nb * 64 + c4;
#define WK_LOAD(v, kb) do { const float* p_ = wbase + (size_t)((kb) * 64) * k.ldw; _Pragma("unroll") for (int i_ = 0; i_ < 16; ++i_) { v[i_] = *(const f32x4*)p_; p_ += k.ldw; asm volatile("" : "+v"(p_)); } } while (0)
    float mx[4] = {0.f, 0.f, 0.f, 0.f}, sq[4] = {0.f, 0.f, 0.f, 0.f};
    f32x4 va[16];
#pragma unroll 1
    for (int kb = F.wave; kb < nkb; kb += NWAVES) { WK_LOAD(va, kb); wk_tile_stats<false>(k, kb, r4, va, mx, sq); }
#pragma unroll
    for (int c = 0; c < 4; ++c) { mx[c] = fmaxf(mx[c], __shfl_xor(mx[c], 16)); mx[c] = fmaxf(mx[c], __shfl_xor(mx[c], 32)); sq[c] += __shfl_xor(sq[c], 16); sq[c] += __shfl_xor(sq[c], 32); }
    if (lane < 16) {
#pragma unroll
        for (int c = 0; c < 4; ++c) { smax[c4 + c] = mx[c]; ssq[c4 + c] = sq[c]; } }
    __syncthreads();
    int dr[4]; float qs[4];
#pragma unroll
    for (int c = 0; c < 4; ++c) { const int n = c4 + c; float cm = 0.f;
#pragma unroll
        for (int w = 0; w < NWAVES; ++w) cm = fmaxf(cm, ((const LAS float*)(F.lds + w * 16384))[2080 + n]);
        dr[c] = wk_drow(k, nb * 64 + n); const int ex = wk_f8ex(cm); qs[c] = __builtin_bit_cast(float, (unsigned)(127 + ex) << 23); }
    if (F.tid < 64) { const int n = F.tid; float cm = 0.f;
#pragma unroll
        for (int w = 0; w < NWAVES; ++w) cm = fmaxf(cm, ((const LAS float*)(F.lds + w * 16384))[2080 + n]);
        const int d = wk_drow(k, nb * 64 + n); k.colmax[d] = __float_as_uint(cm); ((int*)(F.ws + WS_SB8))[sbslot * DM + d] = 127 - wk_f8ex(cm); }
#pragma unroll 1
    for (int kb = F.wave; kb < nkb; kb += NWAVES) { WK_LOAD(va, kb); wk_tile_out<false>(k, kb, r4, va, dr, qs); }
#undef WK_LOAD
    __syncthreads();
}
constexpr int WQ_TOTAL = NE * (DM / 64) + 2 * NE * (FFE / 64) + 2 * (FFD / 64) + (MK_QKV8 ? 3 * DM / 64 : 0) + (MK_FFN2F8 ? DM / 64 : 0);
__device__ __forceinline__ void wk_convert_super(KArgs ap, Frame& F) {
    volatile LAS unsigned* qw = F.MISC + 16;
    if (F.tid == 0) qw[0] = __hip_atomic_fetch_add(F.ctl + CW_WQ, 1u, __ATOMIC_RELAXED, __HIP_MEMORY_SCOPE_AGENT);
    __syncthreads();
    int it = __builtin_amdgcn_readfirstlane((int)qw[0]);
#pragma unroll 1
    while (it < WQ_TOTAL) {
        unsigned nxt = 0; if (F.tid == 0) nxt = __hip_atomic_fetch_add(F.ctl + CW_WQ, 1u, __ATOMIC_RELAXED, __HIP_MEMORY_SCOPE_AGENT);
        int kind = 6, rem = it, nkb = 16;
        if (!(MK_FFN2F8 && rem < DM / 64)) { if (MK_FFN2F8) rem -= DM / 64;
#pragma unroll 1
            for (kind = NKIND - 1;; --kind) { if (kind == 6) continue; int nn; bool quant; wk_shape(kind, nkb, nn, quant); const int cnt = quant ? nn / 64 : 0; if (rem < cnt) break; rem -= cnt; } }
        { WK k; wk_get(ap, F.ws, kind, k);
          if (kind == 6) wk_super_g(k, F, NE, rem); else if (nkb == 16) wk_super<2>(k, F, kind - 23, rem); else wk_super<7>(k, F, kind - 23, rem); }
        if (F.tid == 0) qw[0] = nxt;
        __syncthreads();
        it = __builtin_amdgcn_readfirstlane((int)qw[0]);
    }
}
__device__ __forceinline__ void wk_convert(KArgs ap, Frame& F, int pass) {
    LAS float* scr = (LAS float*)(F.lds + F.wave * 16384);
    const int gw = F.vcu * NWAVES + F.wave, NGW = F.G * NWAVES;
    int it = gw;
#pragma unroll 1
    for (int kind = 0; kind < NKIND; ++kind) { WK k; wk_get(ap, F.ws, kind, k);
        const bool quant = k.ot != 0;
        if (pass == 0 && quant) { if (MK_SUPER) continue; const int nkb = k.K / 64, nnb = k.N / 256, cnt = nkb * nnb;
            for (; it < cnt; it += NGW) wk_stats_item(k, it % nkb, it / nkb, F.lane);
            it -= cnt; }
        else if ((pass == 0) != quant) { const int nkb = k.K / 64, nnb = k.N / 64, cnt = nkb * nnb;
            int* sb8 = (int*)(F.ws + WS_SB8) + (kind >= 23 ? (kind - 23) * DM : 0);
            for (; it < cnt; it += NGW) wk_item(k, it / nnb, it % nnb, sb8, scr, F.lane);
            it -= cnt; }
    }
}
__device__ __forceinline__ void p0_s5_group(KArgs ap, Frame& F, int g, int qtr) {
    const auto& a = *ap;
    const float* lam_re = (const float*)a.in[I_LAMRE]; const float* lam_im = (const float*)a.in[I_LAMIM]; const float* log_dt = (const float*)a.in[I_LOGDT];
    const float* b_re = (const float*)a.in[I_BRE]; const float* b_im = (const float*)a.in[I_BIM]; const float* c_re = (const float*)a.in[I_CRE]; const float* c_im = (const float*)a.in[I_CIM];
    const float* g0 = (const float*)a.in[I_NORMS];
    LAS float* apr = (LAS float*)F.lds;
    LAS float* api = apr + 17 * 64;
    LAS float* bbr = api + 17 * 64;
    LAS float* bbi = bbr + 1024;
    LAS float* ccr = bbi + 1024;
    LAS float* cci = ccr + 1024;
    LAS float* ktab = cci + 1024;
    const float dt = expf(log_dt[g]);
    for (int idx = F.tid; idx < 17 * 64; idx += NWAVES * 64) { const int l = idx >> 6, p = idx & 63; const float zr = lam_re[g * 64 + p] * dt, zi = lam_im[g * 64 + p] * dt;
        const float mag = expf((float)l * zr); float sn, cs; sincosf((float)l * zi, &sn, &cs); apr[idx] = mag * cs; api[idx] = mag * sn; }
    for (int idx = F.tid; idx < 1024; idx += NWAVES * 64) { const int p = idx >> 4, j = idx & 15; const float lr = lam_re[g * 64 + p], li = lam_im[g * 64 + p]; const float zr = lr * dt, zi = li * dt;
        const float mag = expf(zr); float sn, cs; sincosf(zi, &sn, &cs); const float ar = mag * cs, ai = mag * sn, den = lr * lr + li * li;
        const float cfr = ((ar - 1.0f) * lr + ai * li) / den, cfi = (ai * lr - (ar - 1.0f) * li) / den;
        const float br = b_re[(size_t)(g * 64 + p) * 16 + j], bi = b_im[(size_t)(g * 64 + p) * 16 + j], gn = g0[g * 16 + j];
        bbr[idx] = (cfr * br - cfi * bi) * gn; bbi[idx] = (cfr * bi + cfi * br) * gn;
        ccr[idx] = c_re[(size_t)g * 1024 + idx]; cci[idx] = c_im[(size_t)g * 1024 + idx]; }
    __syncthreads();
    for (int idx0 = F.tid; idx0 < 1024; idx0 += NWAVES * 64) { const int l = idx0 >> 6, i = 4 * qtr + ((idx0 >> 4) & 3), j = idx0 & 15, idx = (l * 16 + i) * 16 + j; float s = 0.f;
        for (int p = 0; p < 64; ++p) { const float cr = ccr[i * 64 + p], ci = cci[i * 64 + p], ar = apr[l * 64 + p], ai = api[l * 64 + p]; const float car = cr * ar - ci * ai, cai = cr * ai + ci * ar; s += car * bbr[p * 16 + j] - cai * bbi[p * 16 + j]; }
        ktab[idx] = s; }
    __syncthreads();
    bf16* btc = (bf16*)(F.ws + WS_BTC) + (size_t)g * 256 * UAK; bf16* bta = (bf16*)(F.ws + WS_BTA) + (size_t)g * 256 * 256;
    for (int pc = F.tid; pc < 64 * 48; pc += NWAVES * 64) { const int nq = pc / 48, k8 = pc % 48, t = nq >> 2, i = 4 * qtr + (nq & 3), n = t * 16 + i; float v[8];
        if (k8 < 32) { const int s = k8 >> 1, j0 = (k8 & 1) * 8;
#pragma unroll
            for (int jj = 0; jj < 8; ++jj) v[jj] = (t >= s) ? ktab[((t - s) * 16 + i) * 16 + j0 + jj] : 0.f; }
        else { const int pb = (k8 - 32) * 8;
#pragma unroll
            for (int jj = 0; jj < 8; ++jj) { const int p = (pb + jj) & 63; const float cr = ccr[i * 64 + p], ci = cci[i * 64 + p], ar = apr[(t + 1) * 64 + p], ai = api[(t + 1) * 64 + p];
                v[jj] = (pb < 64) ? (cr * ar - ci * ai) : -(cr * ai + ci * ar); } }
        v4u o; o.x = pk2(v[0], v[1]); o.y = pk2(v[2], v[3]); o.z = pk2(v[4], v[5]); o.w = pk2(v[6], v[7]);
        *(v4u*)(btc + (size_t)n * UAK + k8 * 8) = o; }
    for (int pc = F.tid; pc < 64 * 32; pc += NWAVES * 64) { const int n = (pc >> 5) * 4 + qtr, k8 = pc & 31, s = k8 >> 1, j0 = (k8 & 1) * 8; float v[8];
        const int p = n & 63, l = 15 - s; const float ar = apr[l * 64 + p], ai = api[l * 64 + p];
#pragma unroll
        for (int jj = 0; jj < 8; ++jj) { const float br = bbr[p * 16 + j0 + jj], bi = bbi[p * 16 + j0 + jj]; v[jj] = (n < 64) ? (ar * br - ai * bi) : ((n < 128) ? (ar * bi + ai * br) : 0.f); }
        v4u o; o.x = pk2(v[0], v[1]); o.y = pk2(v[2], v[3]); o.z = pk2(v[4], v[5]); o.w = pk2(v[6], v[7]);
        *(v4u*)(bta + (size_t)n * 256 + k8 * 8) = o; }
    float* spar = (float*)(F.ws + WS_SPAR) + g * 128;
    if (qtr == 0 && F.tid < 64) { spar[F.tid] = apr[16 * 64 + F.tid]; spar[64 + F.tid] = api[16 * 64 + F.tid]; }
    __syncthreads();
}
__device__ __forceinline__ void p0_chunk_load(const float* x, Frame& F, int ch, f32x4 (&v)[2][4]) {
    const int b = ch >> 7, c = ch & 127;
#pragma unroll
    for (int rr = 0; rr < 2; ++rr) { const int tok = F.wave * 2 + rr; const f32x4* xr = (const f32x4*)(x + (size_t)(b * SEQ + c * CL + tok) * DM) + F.lane;
#pragma unroll
        for (int j = 0; j < 4; ++j) v[rr][j] = xr[64 * j]; }
}
__device__ __forceinline__ void p0_chunk_store(Frame& F, int ch, const f32x4 (&v)[2][4]) {
    const int b = ch >> 7, c = ch & 127; LAS unsigned short* tile = (LAS unsigned short*)F.lds;
#pragma unroll
    for (int rr = 0; rr < 2; ++rr) { const int tok = F.wave * 2 + rr; float s = 0.f;
#pragma unroll
        for (int j = 0; j < 4; ++j) s += (v[rr][j].x * v[rr][j].x + v[rr][j].y * v[rr][j].y) + (v[rr][j].z * v[rr][j].z + v[rr][j].w * v[rr][j].w);
        const float rstd = 1.0f / sqrtf(wave_sum(s) * (1.0f / DM) + NORM_EPS);
#pragma unroll
        for (int j = 0; j < 4; ++j) { v2u w; w.x = pk2(v[rr][j].x * rstd, v[rr][j].y * rstd); w.y = pk2(v[rr][j].z * rstd, v[rr][j].w * rstd); *(LAS v2u*)(tile + tok * 1032 + 4 * F.lane + 256 * j) = w; } }
    __syncthreads();
    bf16* ua = (bf16*)(F.ws + WS_UA);
#pragma unroll
    for (int it = 0; it < 4; ++it) { const int q = it * 512 + F.tid, g = q >> 5, piece = q & 31, tok = piece >> 1, half = piece & 1;
        const v4u w = *(const LAS v4u*)(tile + tok * 1032 + g * 16 + half * 8);
        *(v4u*)(ua + ((size_t)g * GROWS + b * NCH + c) * UAK + tok * 16 + half * 8) = w; }
    __syncthreads();
}
__device__ __forceinline__ void p0_prologue(KArgs ap, Frame& F) {
    const auto& a = *ap;
    const float* norms = (const float*)a.in[I_NORMS];
    for (int task = F.vcu; task < NG * 4; task += F.G) p0_s5_group(ap, F, task >> 2, task & 3);
    { const int gt = F.vcu * (NWAVES * 64) + F.tid, NT = F.G * NWAVES * 64; const int* pos = (const int*)a.in[I_POS]; float* rope = (float*)(F.ws + WS_ROPE);
      for (int idx = gt; idx < NTOK * 16; idx += NT) { const int n = idx >> 4, i = idx & 15; const float inv = 1.0f / powf(500000.0f, (float)i * (1.0f / 16.0f)); const float ang = (float)pos[n] * inv; float sn, cs; sincosf(ang, &sn, &cs); rope[(size_t)n * 32 + i] = cs; rope[(size_t)n * 32 + 16 + i] = sn; }
      const float* wr = (const float*)a.in[I_ROUTER]; float* wro = (float*)(F.ws + WS_WR);
      for (int idx = gt; idx < DM * NE; idx += NT) wro[idx] = wr[idx] * norms[(1 * 4 + 2) * DM + (idx >> 3)]; }
    { const float* x = (const float*)a.in[I_X]; f32x4 va[2][4], vb[2][4]; int ch = F.vcu;
      if (ch < BATCH * NCH) p0_chunk_load(x, F, ch, va);
#pragma unroll 1
      for (; ch < BATCH * NCH; ch += 2 * F.G) {
          const bool h1 = ch + F.G < BATCH * NCH, h2 = ch + 2 * F.G < BATCH * NCH;
          if (h1) p0_chunk_load(x, F, ch + F.G, vb);
          p0_chunk_store(F, ch, va);
          if (h2) p0_chunk_load(x, F, ch + 2 * F.G, va);
          if (h1) p0_chunk_store(F, ch + F.G, vb); } }
    wk_convert(ap, F, 0);
}
__device__ __forceinline__ void expert_act_scale(Frame& F) {
    if (F.vcu < NE + (MK_FFN2F8 ? 1 : 0)) { const int e = F.vcu; const bool dense = e == NE; const float* pq = dense ? (const float*)(F.ws + WS_PSQD) : (const float*)(F.ws + WS_PSQ) + e * 2 * FFE; float m1 = 0.f, m3 = 0.f;
        const int nrow = dense ? 2 * FFD : 2 * FFE;
        for (int i = F.tid; i < nrow; i += NWAVES * 64) { float ss = 0.f;
#pragma unroll
            for (int kc = 0; kc < (MK_SUPER ? 1 : DM / 64); ++kc) ss += pq[(size_t)kc * (NE * 2 * FFE) + i];
            const float v = sqrtf(ss); if ((i >> 7) & 1) m3 = fmaxf(m3, v); else m1 = fmaxf(m1, v); }
#pragma unroll
        for (int o = 1; o < 64; o <<= 1) { m1 = fmaxf(m1, __shfl_xor(m1, o)); m3 = fmaxf(m3, __shfl_xor(m3, o)); }
        LAS float* red = (LAS float*)(F.lds + 8192);
        if (F.lane == 0) { red[F.wave] = m1; red[8 + F.wave] = m3; }
        __syncthreads();
        if (F.tid == 0) { float a1 = 0.f, a3 = 0.f; for (int w = 0; w < NWAVES; ++w) { a1 = fmaxf(a1, red[w]); a3 = fmaxf(a3, red[8 + w]); }
            const float bound = 1.1f * 1024.0f * a1 * a3;
            const int ex = wk_f8ex(bound);
            __hip_atomic_store(F.ctl + CW_EA + e, (unsigned)(127 - ex), __ATOMIC_RELAXED, __HIP_MEMORY_SCOPE_AGENT); }
        __syncthreads(); }
}
__device__ __forceinline__ void s5_scan_local(Frame& F) {
    const float* spar = (const float*)(F.ws + WS_SPAR); const float* sloc = (const float*)(F.ws + WS_SLOC); bf16* ua = (bf16*)(F.ws + WS_UA);
    const int nunits = (NG * 8 - F.bx + F.G - 1) / F.G;
    for (int t = F.wave; t < 2 * nunits; t += NWAVES) { int pm, pn; pg8::tile_of((t >> 1) * F.G + F.bx, NG * 8, 1, pm, pn);
        const int g = pm >> 3, b = (pm & 7) * 2 + (t & 1), p = F.lane;
        const float ar = spar[g * 128 + p], ai = spar[g * 128 + 64 + p]; float sr = 0.f, si = 0.f;
        const size_t row0 = (size_t)g * GROWS + b * NCH;
        constexpr int SB = 16; float l0r[SB], l0i[SB], l1r[SB], l1i[SB];
#define S5_LD(R, I, c0) do { _Pragma("unroll") for (int j = 0; j < SB; ++j) { R[j] = sloc[(row0 + (c0) + j) * 128 + p]; I[j] = sloc[(row0 + (c0) + j) * 128 + 64 + p]; } } while (0)
#define S5_RUN(R, I, c0) do { _Pragma("unroll") for (int j = 0; j < SB; ++j) { ua[(row0 + (c0) + j) * UAK + 256 + p] = (bf16)f2bf(sr); ua[(row0 + (c0) + j) * UAK + 320 + p] = (bf16)f2bf(si); \
            const float nr = ar * sr - ai * si + R[j], ni = ar * si + ai * sr + I[j]; sr = nr; si = ni; } } while (0)
        S5_LD(l0r, l0i, 0);
#pragma unroll 1
        for (int c0 = 0; c0 < NCH; c0 += 2 * SB) {
            S5_LD(l1r, l1i, c0 + SB); __builtin_amdgcn_sched_barrier(0);
            S5_RUN(l0r, l0i, c0); __builtin_amdgcn_sched_barrier(0);
            if (c0 + 2 * SB < NCH) S5_LD(l0r, l0i, c0 + 2 * SB);
            __builtin_amdgcn_sched_barrier(0);
            S5_RUN(l1r, l1i, c0 + SB); __builtin_amdgcn_sched_barrier(0); }
#undef S5_LD
#undef S5_RUN
    }
}
struct RRow { v4u m0, m1, a0, a1; f32x4 h0, h1, h2, h3; float sc, ssq; };
template <bool SRC> __device__ __forceinline__ void rr_load(RRow& R, int lane, const float* xin, const bf16* xhin, const bf16* mix, const float* rowss, const float* rs, int row, int nslots) {
    R.m0 = *(const v4u*)(mix + (size_t)row * DM + 8 * lane); R.m1 = *(const v4u*)(mix + (size_t)row * DM + 512 + 8 * lane);
    if (SRC) { R.a0 = *(const v4u*)(xhin + (size_t)row * DM + 8 * lane); R.a1 = *(const v4u*)(xhin + (size_t)row * DM + 512 + 8 * lane); R.sc = rs[row]; }
    else { const f32x4* hp = (const f32x4*)(xin + (size_t)row * DM); R.h0 = hp[2 * lane]; R.h1 = hp[2 * lane + 1]; R.h2 = hp[128 + 2 * lane]; R.h3 = hp[128 + 2 * lane + 1]; }
    R.ssq = lane < nslots ? rowss[(size_t)row * 32 + lane] : 0.f;
}
template <bool ROUTE, bool SRC, bool QOUT>
__device__ __forceinline__ void resid_pass(Frame& F, const float* xin, const bf16* xhin, const bf16* mix, int nslots, const float* gain, bf16* xh, const float* rbias) {
    const float* rowss = (const float*)(F.ws + WS_ROWSS); float* rs = (float*)(F.ws + WS_RS);
    LAS int* l_e = (LAS int*)F.lds; LAS float* l_w = (LAS float*)(F.lds + 1024); LAS int* l_cnt = (LAS int*)(F.lds + 2048); LAS int* l_base = (LAS int*)(F.lds + 2048 + 64); LAS float* l_s = (LAS float*)(F.lds + 3072);
    for (int blk = F.vcu; blk < NTOK / 128; blk += F.G) {
        if (ROUTE) { if (F.tid < NE) l_cnt[F.tid] = 0; __syncthreads(); }
        RRow cur, nxt; rr_load<SRC>(cur, F.lane, xin, xhin, mix, rowss, rs, blk * 128 + F.wave * 16, nslots);
#pragma unroll 1
        for (int k = 0; k < 16; ++k) { const int row = blk * 128 + F.wave * 16 + k;
            nxt = cur; if (k + 1 < 16) rr_load<SRC>(nxt, F.lane, xin, xhin, mix, rowss, rs, row + 1, nslots);
            __builtin_amdgcn_sched_barrier(0);
            const v4u m0 = cur.m0, m1 = cur.m1;
            float hn[16];
            if (SRC) { const v4u a0 = cur.a0, a1 = cur.a1; const float sc = cur.sc;
                hn[0] = bf2f(a0.x & 0xffffu) * sc; hn[1] = bf2f(a0.x >> 16) * sc; hn[2] = bf2f(a0.y & 0xffffu) * sc; hn[3] = bf2f(a0.y >> 16) * sc; hn[4] = bf2f(a0.z & 0xffffu) * sc; hn[5] = bf2f(a0.z >> 16) * sc; hn[6] = bf2f(a0.w & 0xffffu) * sc; hn[7] = bf2f(a0.w >> 16) * sc;
                hn[8] = bf2f(a1.x & 0xffffu) * sc; hn[9] = bf2f(a1.x >> 16) * sc; hn[10] = bf2f(a1.y & 0xffffu) * sc; hn[11] = bf2f(a1.y >> 16) * sc; hn[12] = bf2f(a1.z & 0xffffu) * sc; hn[13] = bf2f(a1.z >> 16) * sc; hn[14] = bf2f(a1.w & 0xffffu) * sc; hn[15] = bf2f(a1.w >> 16) * sc; }
            else { const f32x4 h0 = cur.h0, h1 = cur.h1, h2 = cur.h2, h3 = cur.h3;
#pragma unroll
                for (int j = 0; j < 4; ++j) { hn[j] = h0[j]; hn[4 + j] = h1[j]; hn[8 + j] = h2[j]; hn[12 + j] = h3[j]; } }
            const f32x4* gp = (const f32x4*)gain; const f32x4 g0 = gp[2 * F.lane], g1 = gp[2 * F.lane + 1], g2 = gp[128 + 2 * F.lane], g3 = gp[128 + 2 * F.lane + 1];
            const float ssm = wave_sum(cur.ssq);
            const float rm = 1.0f / sqrtf(ssm * (1.0f / DM) + NORM_EPS);
            hn[0] += bf2f(m0.x & 0xffffu) * rm * g0[0]; hn[1] += bf2f(m0.x >> 16) * rm * g0[1]; hn[2] += bf2f(m0.y & 0xffffu) * rm * g0[2]; hn[3] += bf2f(m0.y >> 16) * rm * g0[3];
            hn[4] += bf2f(m0.z & 0xffffu) * rm * g1[0]; hn[5] += bf2f(m0.z >> 16) * rm * g1[1]; hn[6] += bf2f(m0.w & 0xffffu) * rm * g1[2]; hn[7] += bf2f(m0.w >> 16) * rm * g1[3];
            hn[8] += bf2f(m1.x & 0xffffu) * rm * g2[0]; hn[9] += bf2f(m1.x >> 16) * rm * g2[1]; hn[10] += bf2f(m1.y & 0xffffu) * rm * g2[2]; hn[11] += bf2f(m1.y >> 16) * rm * g2[3];
            hn[12] += bf2f(m1.z & 0xffffu) * rm * g3[0]; hn[13] += bf2f(m1.z >> 16) * rm * g3[1]; hn[14] += bf2f(m1.w & 0xffffu) * rm * g3[2]; hn[15] += bf2f(m1.w >> 16) * rm * g3[3];
            float s2 = 0.f;
#pragma unroll
            for (int j = 0; j < 16; ++j) s2 += hn[j] * hn[j];
            const float ms = wave_sum(s2) * (1.0f / DM) + NORM_EPS; const float rms = sqrtf(ms), rh = 1.0f / rms;
            if (F.lane == 0) rs[row] = rms;
            v4u w0, w1; w0.x = pk2(hn[0] * rh, hn[1] * rh); w0.y = pk2(hn[2] * rh, hn[3] * rh); w0.z = pk2(hn[4] * rh, hn[5] * rh); w0.w = pk2(hn[6] * rh, hn[7] * rh);
            w1.x = pk2(hn[8] * rh, hn[9] * rh); w1.y = pk2(hn[10] * rh, hn[11] * rh); w1.z = pk2(hn[12] * rh, hn[13] * rh); w1.w = pk2(hn[14] * rh, hn[15] * rh);
            *(v4u*)(xh + (size_t)row * DM + 8 * F.lane) = w0; *(v4u*)(xh + (size_t)row * DM + 512 + 8 * F.lane) = w1;
            if (QOUT) {
                { float am = 0.f;
#pragma unroll
                  for (int j = 0; j < 16; ++j) am = fmaxf(am, fabsf(hn[j]));
#pragma unroll
                  for (int o = 1; o < 64; o <<= 1) am = fmaxf(am, __shfl_xor(am, o));
                  am *= rh; const float inv = am > 0.f ? 127.0f / am : 0.f, qs = rh * inv;
                  v2u q0, q1;
                  q0.x = q8x4(hn[0], hn[1], hn[2], hn[3], qs); q0.y = q8x4(hn[4], hn[5], hn[6], hn[7], qs);
                  q1.x = q8x4(hn[8], hn[9], hn[10], hn[11], qs); q1.y = q8x4(hn[12], hn[13], hn[14], hn[15], qs);
                  unsigned char* xq = F.ws + WS_XQ3 + (size_t)row * DM; *(v2u*)(xq + 8 * F.lane) = q0; *(v2u*)(xq + 512 + 8 * F.lane) = q1;
                  if (F.lane == 0) { if (ROUTE) l_s[F.wave * 16 + k] = am * (1.0f / 127.0f); else ((float*)(F.ws + WS_RSC))[row] = am * (1.0f / 127.0f); } }
            }
            if (ROUTE) {
                const float* wr = (const float*)(F.ws + WS_WR); float lg[NE];
#pragma unroll
                for (int e = 0; e < NE; ++e) lg[e] = 0.f;
#pragma unroll
                for (int half = 0; half < 2; ++half)
#pragma unroll
                    for (int j = 0; j < 8; ++j) { const int cc = half * 512 + 8 * F.lane + j; const f32x4 wa = *(const f32x4*)(wr + cc * 8), wb = *(const f32x4*)(wr + cc * 8 + 4); const float xv = hn[half * 8 + j] * rh;
                        lg[0] += xv * wa[0]; lg[1] += xv * wa[1]; lg[2] += xv * wa[2]; lg[3] += xv * wa[3]; lg[4] += xv * wb[0]; lg[5] += xv * wb[1]; lg[6] += xv * wb[2]; lg[7] += xv * wb[3]; }
#pragma unroll
                for (int e = 0; e < NE; ++e) lg[e] = wave_sum(lg[e]) + rbias[e];
                int e0 = 0; float v0 = lg[0];
#pragma unroll
                for (int e = 1; e < NE; ++e) if (lg[e] > v0) { v0 = lg[e]; e0 = e; }
                int e1 = -1; float v1 = -__builtin_inff();
#pragma unroll
                for (int e = 0; e < NE; ++e) if (e != e0 && lg[e] > v1) { v1 = lg[e]; e1 = e; }
                const float w1s = 1.0f / (1.0f + __expf(v0 - v1)), w0s = 1.0f - w1s;
                if (F.lane == 0) { const int ai = (F.wave * 16 + k) * 2; l_e[ai] = e0; l_e[ai + 1] = e1; l_w[ai] = w0s; l_w[ai + 1] = w1s; }
            }
            cur = nxt;
        }
        if (ROUTE) {
            __syncthreads();
            int* list = (int*)(F.ws + WS_LIST); int* slot = (int*)(F.ws + WS_SLOT); float* tokw = (float*)(F.ws + WS_TOKW);
            int e = 0, rank = 0;
            if (F.tid < 256) { e = l_e[F.tid]; rank = atomicAdd((int*)&l_cnt[e], 1); }
            __syncthreads();
            if (F.tid < NE) l_base[F.tid] = (int)__hip_atomic_fetch_add(F.ctl + CW_ECNT + 64 * F.tid, (unsigned)l_cnt[F.tid], __ATOMIC_RELAXED, __HIP_MEMORY_SCOPE_AGENT);
            __syncthreads();
            if (F.tid < 256) { const int pos = l_base[e] + rank, token = blk * 128 + (F.tid >> 1);
                if (pos < LCAP) { list[e * LCAP + pos] = token; ((float*)(F.ws + WS_RSC))[e * LCAP + pos] = l_s[F.tid >> 1]; }
                slot[token * 2 + (F.tid & 1)] = e * LCAP + pos; tokw[token * 2 + (F.tid & 1)] = l_w[F.tid]; }
            __syncthreads();
        }
    }
}
__device__ __forceinline__ void final_pass(Frame& F, float* out, const bf16* xh, const bf16* y, const float* gain) {
    const int gw = F.vcu * NWAVES + F.wave, NGW = F.G * NWAVES;
    etab_build(F.lds, F.ctl);
    const int* slot = (const int*)(F.ws + WS_SLOT); const float* tokw = (const float*)(F.ws + WS_TOKW); const float* rsv = (const float*)(F.ws + WS_RS); const f32x4* gp = (const f32x4*)gain;
    if (gw >= NTOK) return;
#define FP_S1(row_, S, W) do { S = *(const v2u*)(slot + (size_t)(row_) * 2); W = *(const f32x2*)(tokw + (size_t)(row_) * 2); } while (0)
#define FP_S2(row_, S, R0, R1, YA, YB, XA, SC) do { const int e0_ = ((int)S.x >> 15) & 7, e1_ = ((int)S.y >> 15) & 7; const int ps0_ = *(const LAS int*)(F.lds + ET_OFF + 32 + 4 * e0_), ps1_ = *(const LAS int*)(F.lds + ET_OFF + 32 + 4 * e1_); \
        R0 = (size_t)ps0_ * 256 + (S.x & (LCAP - 1)); R1 = (size_t)ps1_ * 256 + (S.y & (LCAP - 1)); const bool fast_ = R0 < 65536 && R1 < 65536; const size_t q0_ = fast_ ? R0 : 0, q1_ = fast_ ? R1 : 0; \
        _Pragma("unroll") for (int half = 0; half < 2; ++half) { YA[half] = *(const v4u*)(y + q0_ * DM + half * 512 + 8 * F.lane); YB[half] = *(const v4u*)(y + q1_ * DM + half * 512 + 8 * F.lane); XA[half] = *(const v4u*)(xh + (size_t)(row_) * DM + half * 512 + 8 * F.lane); } \
        SC = rsv[row_]; } while (0)
    int row = gw, nrow = gw + NGW; v2u sc_ = {0u, 0u}, sn_ = {0u, 0u}; f32x2 wc_ = {0.f, 0.f}, wn_ = {0.f, 0.f};
    size_t r0c, r1c; v4u yac[2], ybc[2], xac[2]; float scc;
    FP_S1(row, sc_, wc_);
    FP_S2(row, sc_, r0c, r1c, yac, ybc, xac, scc);
    if (nrow < NTOK) FP_S1(nrow, sn_, wn_);
#pragma unroll 1
    for (;;) {
        const bool has_next = nrow < NTOK;
        size_t r0n = 0, r1n = 0; v4u yan[2] = {{0u, 0u, 0u, 0u}, {0u, 0u, 0u, 0u}}, ybn[2] = {{0u, 0u, 0u, 0u}, {0u, 0u, 0u, 0u}}, xan[2] = {{0u, 0u, 0u, 0u}, {0u, 0u, 0u, 0u}}; float scn = 0.f; v2u snn = {0u, 0u}; f32x2 wnn = {0.f, 0.f};
        if (has_next) { FP_S2(nrow, sn_, r0n, r1n, yan, ybn, xan, scn); const int nn = nrow + NGW; if (nn < NTOK) FP_S1(nn, snn, wnn); }
        __builtin_amdgcn_sched_barrier(0);
        const size_t r0 = r0c, r1 = r1c; const float w0 = wc_[0], w1 = wc_[1];
        float f[16];
        if (r0 >= 65536 || r1 >= 65536) {
            const bf16* yp = (const bf16*)(F.ws + WS_YP);
#pragma unroll
            for (int j = 0; j < 16; ++j) f[j] = 0.f;
#pragma unroll 1
            for (int side = 0; side < 2; ++side) { const size_t r = side ? r1 : r0; const float w = side ? w1 : w0; const int nk = r >= 65536 ? KSPLIT : 1;
                for (int kc = 0; kc < nk; ++kc) { const bf16* src = r >= 65536 ? yp + ((size_t)(kc * LPMAX) * 256 + (r - 65536)) * DM : y + r * DM;
#pragma unroll
                    for (int half = 0; half < 2; ++half) { const v4u a = *(const v4u*)(src + half * 512 + 8 * F.lane);
                        f[half * 8 + 0] += w * bf2f(a.x & 0xffffu); f[half * 8 + 1] += w * bf2f(a.x >> 16); f[half * 8 + 2] += w * bf2f(a.y & 0xffffu); f[half * 8 + 3] += w * bf2f(a.y >> 16);
                        f[half * 8 + 4] += w * bf2f(a.z & 0xffffu); f[half * 8 + 5] += w * bf2f(a.z >> 16); f[half * 8 + 6] += w * bf2f(a.w & 0xffffu); f[half * 8 + 7] += w * bf2f(a.w >> 16); } } } }
        else
#pragma unroll
        for (int half = 0; half < 2; ++half) { const v4u a = yac[half], bq = ybc[half];
            f[half * 8 + 0] = w0 * bf2f(a.x & 0xffffu) + w1 * bf2f(bq.x & 0xffffu); f[half * 8 + 1] = w0 * bf2f(a.x >> 16) + w1 * bf2f(bq.x >> 16);
            f[half * 8 + 2] = w0 * bf2f(a.y & 0xffffu) + w1 * bf2f(bq.y & 0xffffu); f[half * 8 + 3] = w0 * bf2f(a.y >> 16) + w1 * bf2f(bq.y >> 16);
            f[half * 8 + 4] = w0 * bf2f(a.z & 0xffffu) + w1 * bf2f(bq.z & 0xffffu); f[half * 8 + 5] = w0 * bf2f(a.z >> 16) + w1 * bf2f(bq.z >> 16);
            f[half * 8 + 6] = w0 * bf2f(a.w & 0xffffu) + w1 * bf2f(bq.w & 0xffffu); f[half * 8 + 7] = w0 * bf2f(a.w >> 16) + w1 * bf2f(bq.w >> 16); }
        float ss = 0.f;
#pragma unroll
        for (int j = 0; j < 16; ++j) ss += f[j] * f[j];
        const float rf = 1.0f / sqrtf(wave_sum(ss) * (1.0f / DM) + NORM_EPS);
        f32x4* hp = (f32x4*)(out + (size_t)row * DM); const float sc = scc;
#pragma unroll
        for (int half = 0; half < 2; ++half) { const v4u a = xac[half];
            const float hv[8] = {bf2f(a.x & 0xffffu), bf2f(a.x >> 16), bf2f(a.y & 0xffffu), bf2f(a.y >> 16), bf2f(a.z & 0xffffu), bf2f(a.z >> 16), bf2f(a.w & 0xffffu), bf2f(a.w >> 16)};
#pragma unroll
            for (int q = 0; q < 2; ++q) { const int idx = half * 128 + 2 * F.lane + q; f32x4 h; const f32x4 g = gp[idx];
#pragma unroll
                for (int j = 0; j < 4; ++j) h[j] = hv[q * 4 + j] * sc + f[half * 8 + q * 4 + j] * rf * g[j];
                hp[idx] = h; } }
        if (!has_next) break;
        row = nrow; nrow += NGW; wc_ = wn_; r0c = r0n; r1c = r1n; scc = scn; sn_ = snn; wn_ = wnn;
#pragma unroll
        for (int half = 0; half < 2; ++half) { yac[half] = yan[half]; ybc[half] = ybn[half]; xac[half] = xan[half]; }
    }
#undef FP_S1
#undef FP_S2
}

constexpr int N_PHASES = MK_F8 ? 14 : 20;
__global__ void __launch_bounds__(NWAVES * 64, 2) mk_fwd(Args args) {
    extern __shared__ __attribute__((aligned(16))) unsigned char lds_raw[];
    Frame F; refresh(F);
    for (int u = F.tid; u < (LDS_BYTES - LDSCTL_OFF) / 4; u += NWAVES * 64) ((LAS unsigned*)(F.lds + LDSCTL_OFF))[u] = 0u;
    __syncthreads();
    if (F.hi - F.lo > 1) (void)xcd_barrier_post(F.ctl + CW_BAR, F.MISC + 8);
#ifndef MK_ONLY
#define MK_ONLY -1
#endif
#define IN(k) ((MK_ONLY < 0 || (k) == MK_ONLY) && (refresh(F), F.lo <= (k) && (k) < F.hi))
#define SEAM(k) do { refresh(F); if (F.lo <= (k) && (k) + 1 < F.hi) xcd_barrier(frame_bar(F)); } while (0)
#define ws (F.ws)
#define cblk (F.bx)
    if (IN(0)) { p0_prologue(kargs(), F); } SEAM(0);
    if (IN(1)) {
        if (MK_SUPER) wk_convert_super(kargs(), F); else wk_convert(kargs(), F, 1);
        __syncthreads();
        { PlainSched S{(const char*)(ws + WS_UA), (const char*)(ws + WS_BTA), 256, UAK, 256, NG * 8, 1, F.G, cblk, 8, (size_t)256 * 256 * 2};
          EpiS5A E{(float*)(ws + WS_SLOC)};
          pg8::gemm_phase(F.lds, S, E); }
        __builtin_amdgcn_fence(__ATOMIC_ACQUIRE, "agent"); VM_WAIT(); __syncthreads();
        s5_scan_local(F);
        VM_WAIT(); __syncthreads(); __builtin_amdgcn_fence(__ATOMIC_ACQUIRE, "agent"); VM_WAIT(); __syncthreads();
        { KArgs ka = kargs(); PlainSched S{(const char*)(ws + WS_UA), (const char*)(ws + WS_BTC), UAK, UAK, UAK, NG * 8, 1, F.G, cblk, 8, (size_t)256 * UAK * 2};
          EpiS5C E{(const bf16*)(ws + WS_UA), (const float*)ka->in[I_SD], (const float*)ka->in[I_NORMS], (bf16*)(ws + WS_GBUF)};
          pg8::gemm_phase(F.lds, S, E); }
    } SEAM(1);
    if (IN(2)) {
        PlainSched S{(const char*)(ws + WS_GBUF), (const char*)(ws + WS_WGLU), DM, DM, DM, NTOK / 256, 8, F.G, cblk, 1 << 30, 0};
        EpiGated<0> E{(bf16*)(ws + WS_MIX0), DM, (float*)(ws + WS_ROWSS), 0};
        pg8::gemm_phase(F.lds, S, E);
    } SEAM(2);
    if (IN(3)) { KArgs ka = kargs(); resid_pass<false, false, true>(F, (const float*)ka->in[I_X], nullptr, (const bf16*)(ws + WS_MIX0), 32, (const float*)ka->in[I_NORMS] + 1 * DM, (bf16*)(ws + WS_XH1), nullptr);
        expert_act_scale(F); } SEAM(3);
    if (IN(4)) {
        const int sad = MK_FFN2F8 ? (int)__hip_atomic_load(F.ctl + CW_EA + NE, __ATOMIC_RELAXED, __HIP_MEMORY_SCOPE_AGENT) : 127;
        PlainSched S{(const char*)(ws + WS_XQ3), (const char*)(ws + WS_WQF13), DM / 2, DM / 2, DM / 2, NTOK / 256, 2 * FFD / 256, F.G, cblk, 1 << 30, 0, sad};
        EpiGatedI8<MK_FFN2F8 != 0> E{(bf16*)(ws + WS_ACTD), FFD, (const float*)(ws + WS_RSC), (const float*)(ws + WS_COLMAX_F), 0, nullptr};
        pg8::gemm_phase(F.lds, S, E);
    } SEAM(4);
    if (IN(5)) {
#if MK_FFN2F8
        const int sad = (int)__hip_atomic_load(F.ctl + CW_EA + NE, __ATOMIC_RELAXED, __HIP_MEMORY_SCOPE_AGENT);
        PlainSched S{(const char*)(ws + WS_ACTD), (const char*)(ws + WS_WF2), FFD / 2, FFD / 2, FFD / 2, NTOK / 256, DM / 256, F.G, cblk, 1 << 30, 0, sad, (const int*)(ws + WS_SB8) + NE * DM};
        EpiPlain<true, false, 2> E{(bf16*)(ws + WS_F0), DM, (float*)(ws + WS_ROWSS)};
#else
        PlainSched S{(const char*)(ws + WS_ACTD), (const char*)(ws + WS_WF2), FFD, FFD, FFD, NTOK / 256, DM / 256, F.G, cblk, 1 << 30, 0};
        EpiPlain<true, false> E{(bf16*)(ws + WS_F0), DM, (float*)(ws + WS_ROWSS)};
#endif
        pg8::gemm_phase(F.lds, S, E);
    } SEAM(5);
    if (IN(6)) { KArgs ka = kargs(); resid_pass<false, true, MK_QKV8 != 0>(F, nullptr, (const bf16*)(ws + WS_XH1), (const bf16*)(ws + WS_F0), 16, (const float*)ka->in[I_NORMS] + 3 * DM, (bf16*)(ws + WS_XH2), nullptr); } SEAM(6);
    if (IN(7)) {
#if MK_QKV8
        PlainSched S{(const char*)(ws + WS_XQ3), (const char*)(ws + WS_WQQKV), DM / 2, DM / 2, DM / 2, NTOK / 256, 12, F.G, cblk, 1 << 30, 0};
        EpiQKV<true> E{(bf16*)(ws + WS_Q), (const float*)(ws + WS_ROPE), (float*)(ws + WS_KMEAN), (const float*)(ws + WS_RSC), (const float*)(ws + WS_COLMAX_QKV)};
#else
        PlainSched S{(const char*)(ws + WS_XH2), (const char*)(ws + WS_WQKV), DM, DM, DM, NTOK / 256, 12, F.G, cblk, 1 << 30, 0};
        EpiQKV<false> E{(bf16*)(ws + WS_Q), (const float*)(ws + WS_ROPE), (float*)(ws + WS_KMEAN), nullptr, nullptr};
#endif
        pg8::gemm_phase(F.lds, S, E);
    } SEAM(7);
    if (IN(8)) {
        const bf16* Qb = (const bf16*)(ws + WS_Q); const bf16* Kb = (const bf16*)(ws + WS_K); const bf16* Vb = (const bf16*)(ws + WS_V); bf16* Ob = (bf16*)(ws + WS_O); const float* KM = (const float*)(ws + WS_KMEAN);
        const int nitems = (BATCH * NH * 4 - F.vcu + F.G - 1) / F.G, nblocks = 2 * nitems;
        attn::Seam Sm;
#define MK_REF(R, kk) do { const int it_ = F.vcu + ((kk) >> 1) * F.G, bh_ = it_ >> 2, x_ = it_ & 3, qb_ = ((kk) & 1) ? 7 - x_ : x_, b_ = bh_ >> 3, h_ = bh_ & 7; \
        const size_t base_ = (size_t)b_ * SEQ * DM + h_ * HD; R.Q = Qb + base_ + (size_t)qb_ * 256 * DM; R.K = Kb + base_; R.V = Vb + base_; R.O = Ob + base_ + (size_t)qb_ * 256 * DM; R.KM = KM + (size_t)bh_ * NBLK * HD; R.P0 = qb_ * 256; } while (0)
        if (nblocks > 0) {
            attn::BlockRef cur, nxt; MK_REF(cur, 0);
            attn::moba_prime(cur, (char*)lds_raw, Sm);
            for (int kb = 0; kb < nblocks; ++kb) { const int kn = kb + 1 < nblocks ? kb + 1 : kb; MK_REF(nxt, kn); attn::moba_block(cur, nxt, (char*)lds_raw, Sm); cur = nxt; }
        }
#undef MK_REF
    } SEAM(8);
    if (IN(9)) {
        PlainSched S{(const char*)(ws + WS_O), (const char*)(ws + WS_WO), DM, DM, DM, NTOK / 256, DM / 256, F.G, cblk, 1 << 30, 0};
        EpiPlain<true, false> E{(bf16*)(ws + WS_MIX1), DM, (float*)(ws + WS_ROWSS)};
        pg8::gemm_phase(F.lds, S, E);
    } SEAM(9);
    if (IN(10)) { KArgs ka = kargs(); resid_pass<true, true, true>(F, nullptr, (const bf16*)(ws + WS_XH2), (const bf16*)(ws + WS_MIX1), 16, (const float*)ka->in[I_NORMS] + (4 + 1) * DM, (bf16*)(ws + WS_XH3), (const float*)ka->in[I_RBIAS]); } SEAM(10);
#if MK_F8
    if (IN(11)) {
        etab_build(F.lds, F.ctl); int nM = et_ps(F.lds, NE); nM = nM > 264 ? 264 : nM;
        MoeSched1 S{(const char*)(ws + WS_XQ3), (const char*)(ws + WS_WQ13), (const int*)(ws + WS_LIST), DM / 2, DM / 2, nM, 2 * FFE / 256, F.G, cblk, 0, F.lds};
        EpiGatedI8<true> E{(bf16*)(ws + WS_ACTM), FFE, (const float*)(ws + WS_RSC), (const float*)(ws + WS_COLMAX), 2 * FFE, (unsigned char*)kargs()->out};
        pg8::gemm_phase(F.lds, S, E);
    } SEAM(11);
    if (IN(12)) {
        etab_build(F.lds, F.ctl); const int P = et_ps(F.lds, NE); const int nM = P > 256 ? 256 : P; int nLeft = P - 256; nLeft = nLeft < 0 ? 0 : (nLeft > LPMAX ? LPMAX : nLeft);
        { MoeSched2 S{(const char*)(ws + WS_ACTM), (const char*)kargs()->out, (const char*)(ws + WS_W8M2), (const int*)(ws + WS_SB8), FFE / 2, FFE / 2, FFE / 2, nM, DM / 256, F.G, cblk, 0, F.lds};
          EpiPlain<false, true, 2> E{(bf16*)(ws + WS_Y), DM, nullptr};
          pg8::gemm_phase(F.lds, S, E); }
        { MoeSched2K S{(const char*)(ws + WS_ACTM), (const char*)kargs()->out, (const char*)(ws + WS_W8M2), (const int*)(ws + WS_SB8), 256, FFE / 2, FFE / 2, nLeft, F.G, (F.G - 1) - cblk, F.lds};
          EpiPlain<false, true, 2> E{(bf16*)(ws + WS_YP), DM, nullptr};
          pg8::gemm_phase(F.lds, S, E); }
    } SEAM(12);
#else
#pragma unroll
    for (int q = 0; q < 4; ++q) {
        if (IN(11 + 2 * q)) {
            etab_build(F.lds, F.ctl); const int P = et_ps(F.lds, NE); const int p0 = 64 * q; int nM = (q < 3) ? 64 : P - 192; nM = nM > 72 ? 72 : nM; if (p0 + nM > P) nM = P - p0; if (nM < 0) nM = 0;
            MoeSched1 S{(const char*)(ws + WS_XQ3), (const char*)(ws + WS_WQ13), (const int*)(ws + WS_LIST), DM / 2, DM / 2, nM, 2 * FFE / 256, F.G, cblk, p0, F.lds};
            EpiGatedI8<false> E{(bf16*)(ws + WS_ACTM), FFE, (const float*)(ws + WS_RSC), (const float*)(ws + WS_COLMAX), 2 * FFE, nullptr};
            pg8::gemm_phase(F.lds, S, E);
        } SEAM(11 + 2 * q);
        if (IN(12 + 2 * q)) {
            etab_build(F.lds, F.ctl); const int P = et_ps(F.lds, NE); const int p0 = 64 * q; int nM = (q < 3) ? 64 : P - 192; nM = nM > 72 ? 72 : nM; if (p0 + nM > P) nM = P - p0; if (nM < 0) nM = 0;
            MoeSched2B S{(const char*)(ws + WS_ACTM), (const char*)(ws + WS_WM2), FFE, FFE, FFE, nM, DM / 256, F.G, cblk, p0, F.lds};
            EpiPlain<false, true, 0> E{(bf16*)(ws + WS_Y), DM, nullptr};
            pg8::gemm_phase(F.lds, S, E);
        } SEAM(12 + 2 * q);
    }
#endif
    if (IN(N_PHASES - 1)) { KArgs ka = kargs(); final_pass(F, ka->out, (const bf16*)(ws + WS_XH3), (const bf16*)(ws + WS_Y), (const float*)ka->in[I_NORMS] + (4 + 3) * DM); }
#undef IN
#undef SEAM
#undef ws
#undef cblk
}

extern "C" void kernel_launch(void* const* d_in, const int* in_sizes, int n_in, void* d_out, int out_size, void* d_ws, size_t ws_size, hipStream_t stream) {
    static int grid = 0;
    if (grid == 0) {
        if (n_in != 24 || in_sizes[0] != NTOK * DM || out_size != NTOK * DM || ws_size < WS_END) { fprintf(stderr, "kernel_launch: unexpected problem (n_in %d, in0 %d, out %d, ws %zu < %zu)\n", n_in, n_in > 0 ? in_sizes[0] : -1, out_size, ws_size, (size_t)WS_END); grid = -1; return; }
        int dev = 0, cus = 0, per_cu = 0;
        if (hipGetDevice(&dev) != hipSuccess || hipDeviceGetAttribute(&cus, hipDeviceAttributeMultiprocessorCount, dev) != hipSuccess) { grid = -1; return; }
        if (hipFuncSetAttribute((const void*)mk_fwd, hipFuncAttributeMaxDynamicSharedMemorySize, LDS_BYTES) != hipSuccess) { fprintf(stderr, "kernel_launch: hipFuncSetAttribute failed\n"); grid = -1; return; }
        if (hipOccupancyMaxActiveBlocksPerMultiprocessor(&per_cu, (const void*)mk_fwd, NWAVES * 64, LDS_BYTES) != hipSuccess || per_cu < 1) { fprintf(stderr, "kernel_launch: occupancy query says %d blocks per CU\n", per_cu); (void)hipGetLastError(); grid = -1; return; }
        grid = cus;
    }
    if (grid < 0) return;
    if (hipMemsetAsync((char*)d_ws + WS_CTL, 0, ZERO_BYTES, stream) != hipSuccess) return;
    Args a{};
    for (int i = 0; i < 24; ++i) a.in[i] = d_in[i];
    a.out = (float*)d_out; a.ws = (unsigned char*)d_ws;
#if MK_ONE_LAUNCH
    a.ph_lo = 0; a.ph_hi = N_PHASES;
    hipLaunchKernelGGL(mk_fwd, dim3(grid), dim3(NWAVES * 64), LDS_BYTES, stream, a);
#else
    for (int p = 0; p < N_PHASES; ++p) { a.ph_lo = p; a.ph_hi = p + 1; for (int r = 0; r < (((MK_DUP_MASK >> p) & 1u) ? 2 : 1); ++r) hipLaunchKernelGGL(mk_fwd, dim3(grid), dim3(NWAVES * 64), LDS_BYTES, stream, a); }
#endif
}
```

```cpp
#include <hip/hip_runtime.h>
#include <stdio.h>
#include <stdint.h>

#ifndef MK_ONE_LAUNCH
#define MK_ONE_LAUNCH 1
#endif
#ifndef MK_F8
#define MK_F8 1
#endif
#ifndef MK_QKV8
#define MK_QKV8 1
#endif
#ifndef MK_SUPER
#define MK_SUPER 1
#endif
#ifndef MK_FFN2F8
#define MK_FFN2F8 1
#endif
#ifndef MK_MOE_NMAJOR
#define MK_MOE_NMAJOR 1
#endif
#ifndef MK_DUP_MASK
#define MK_DUP_MASK 0u
#endif

#define GAS __attribute__((address_space(1)))
#define LAS __attribute__((address_space(3)))
typedef unsigned short bf16;
typedef unsigned v4u __attribute__((ext_vector_type(4)));
typedef unsigned v2u __attribute__((ext_vector_type(2)));
typedef float f32x2 __attribute__((ext_vector_type(2)));
typedef float f32x4 __attribute__((ext_vector_type(4)));
typedef float f32x16 __attribute__((ext_vector_type(16)));
typedef short bf16x8 __attribute__((ext_vector_type(8)));
typedef short s16x4 __attribute__((ext_vector_type(4)));
typedef int i32x4 __attribute__((ext_vector_type(4)));
typedef int i32x8 __attribute__((ext_vector_type(8)));

constexpr int BATCH = 16, SEQ = 2048, DM = 1024, NTOK = BATCH * SEQ;
constexpr int NG = 64, NP = 64, CL = 16, NCH = SEQ / CL, GROWS = BATCH * NCH, UAK = 384;
constexpr int NH = 8, HD = 128, MBLK = 256, NBLK = SEQ / MBLK;
constexpr int FFD = 2816, NE = 8, FFE = 3584, LCAP = 32768;
constexpr float NORM_EPS = 1e-6f;
constexpr int NWAVES = 8;
constexpr int KSPLIT = 7, LPMAX = 7;
constexpr int ASPLIT = 128;

constexpr size_t MiB = 1u << 20;
constexpr size_t WS_CTL = 0, WS_KMEAN = 1 * MiB, ZERO_BYTES = 2 * MiB;
constexpr size_t WS_ROPE = 2 * MiB, WS_ROWSS = 6 * MiB, WS_LIST = 10 * MiB, WS_SLOT = 11 * MiB, WS_TOKW = WS_SLOT + 256 * 1024, WS_WR = WS_TOKW + 256 * 1024, WS_SPAR = WS_WR + 64 * 1024;
constexpr size_t WS_WQ13 = 13 * MiB, WS_XQ3 = 69 * MiB, WS_RSC = 101 * MiB, WS_WM2 = 125 * MiB;
constexpr size_t WS_COLMAX_F = 1536 * 1024 + 57344 * 4, WS_COLMAX_QKV = WS_COLMAX_F + 5632 * 4, WS_COLMAX_W2 = WS_COLMAX_QKV + 3072 * 4;
constexpr size_t WS_ROWNORM = 12 * MiB + 256 * 1024, WS_SB8 = 12 * MiB + 512 * 1024;
constexpr size_t WS_W8M2 = 125 * MiB, WS_PSQ = 153 * MiB, WS_PSQD = 180 * MiB;
constexpr int CW_EA = 9216;
constexpr size_t WS_WQF13 = 102 * MiB, WS_WQQKV = 108 * MiB;
constexpr size_t WS_COLMAX = 1536 * 1024;
constexpr size_t WS_WGLU = 181 * MiB, WS_WQKV = 185 * MiB, WS_WO = 191 * MiB, WS_WF13 = 193 * MiB, WS_WF2 = 204 * MiB, WS_BTA = 210 * MiB, WS_BTC = 218 * MiB;
constexpr size_t WS_UA = 230 * MiB, WS_SLOC = 326 * MiB, WS_GBUF = 390 * MiB, WS_MIX0 = 454 * MiB;
constexpr size_t WS_XH1 = 210 * MiB, WS_ACTD = 274 * MiB, WS_F0 = 450 * MiB;
constexpr size_t WS_XH2 = 450 * MiB, WS_Q = 230 * MiB, WS_K = 294 * MiB, WS_V = 358 * MiB;
constexpr size_t WS_O = WS_Q;
constexpr size_t WS_RS = 12 * MiB;
constexpr size_t WS_MIX1 = 294 * MiB, WS_XH3 = 450 * MiB;
constexpr size_t WS_Y = 181 * MiB, WS_ACTM = 313 * MiB, WS_YP = 425 * MiB;
constexpr size_t WS_END = 518 * MiB;
constexpr int CW_TMO = 0, CW_BAR = 4096, CW_ECNT = 8192, CW_WQ = 9344;

constexpr int RING_BYTES = 131072, LDSCTL_OFF = RING_BYTES, MISC_OFF = LDSCTL_OFF + 320, IDX_OFF = RING_BYTES + 1024, SCL_OFF = RING_BYTES + 2048, UT_OFF = RING_BYTES + 8192, LDS_BYTES = 147456;

#define LDS_WAIT() asm volatile("s_waitcnt lgkmcnt(0)" ::: "memory")
#define VM_WAIT() asm volatile("s_waitcnt vmcnt(0)" ::: "memory")
__device__ __forceinline__ unsigned f2bf(float f) { unsigned u = __builtin_bit_cast(unsigned, f); return (u + 0x7fffu + ((u >> 16) & 1u)) >> 16; }
__device__ __forceinline__ unsigned pk2(float lo, float hi) { return f2bf(lo) | (f2bf(hi) << 16); }
__device__ __forceinline__ float bf2f(unsigned b) { return __builtin_bit_cast(float, b << 16); }
__device__ __forceinline__ unsigned cvt_pk_bf16(float lo, float hi) { unsigned r; asm volatile("v_cvt_pk_bf16_f32 %0, %1, %2" : "=v"(r) : "v"(lo), "v"(hi)); return r; }
__device__ __forceinline__ float wave_sum(float v) {
#pragma unroll
    for (int o = 1; o < 64; o <<= 1) v += __shfl_xor(v, o);
    return v;
}
__device__ __forceinline__ float fast_sigmoid(float x) { return __builtin_amdgcn_rcpf(1.0f + __builtin_amdgcn_exp2f(-1.4426950408889634f * x)); }

namespace pg8 {
constexpr int BM = 256, BK = 64, HALF = 128, HTB = HALF * BK * 2, NXCD = 8, WGM = 4;
__host__ __device__ __forceinline__ int lds_byte(int r, int c) { const int st = (r >> 4) * 2 + (c >> 5), rr = r & 15, cc = c & 31, ob = rr * 64 + cc * 2; return st * 1024 + (ob ^ (((ob >> 9) & 1) << 5)); }
__host__ __device__ __forceinline__ void stage_rc(int b, int& R, int& C) { const int st = b / 1024, sb = b % 1024, swz = sb ^ (((sb >> 9) & 1) << 5); R = (st >> 1) * 16 + swz / 64; C = (st & 1) * 32 + (swz % 64) / 2; }
__host__ __device__ __forceinline__ int perm32(int rho) { const int n = rho >> 4, i = rho & 15; return 8 * (i >> 2) + 4 * n + (i & 3); }

__device__ __forceinline__ void lane_rc(int i, int& R, int& C) { int t = threadIdx.x; asm volatile("" : "+v"(t)); stage_rc(t * 16 + i * 8192, R, C); }
struct GUnit { int pm, pn, e, aux, rs, sa; };
__device__ __forceinline__ void tile_of(int L, int nM, int nN, int& pm, int& pn) {
    const int nwg = nM * nN; int wgid = L;
    { const int q = nwg / NXCD, r = nwg % NXCD, xcd = wgid % NXCD, off = wgid / NXCD; wgid = (xcd < r ? xcd * (q + 1) : r * (q + 1) + (xcd - r) * q) + off; }
    const int nig = WGM * nN, gid = wgid / nig, fm = gid * WGM, gsz = (nM - fm) < WGM ? (nM - fm) : WGM;
    pm = fm + ((wgid % nig) % gsz); pn = (wgid % nig) / gsz;
}

template <int MM> struct AccSel { typedef f32x4 T; };
template <> struct AccSel<1> { typedef i32x4 T; };
#define V8LO(v) __builtin_shufflevector(v, v, 0, 1, 2, 3)
#define V8HI(v) __builtin_shufflevector(v, v, 4, 5, 6, 7)
template <int MM, class T> __device__ __forceinline__ void mma2(T& acc, const i32x8& b, const i32x8& a, int sb, int sa) {
    if constexpr (MM == 2) asm volatile("v_mfma_scale_f32_16x16x128_f8f6f4 %0, %1, %2, %0, %3, %4 op_sel_hi:[0,0,0]" : "+v"(acc) : "v"(b), "v"(a), "v"(sb), "v"(sa));
    else if constexpr (MM == 1) { acc = __builtin_amdgcn_mfma_i32_16x16x64_i8(V8LO(b), V8LO(a), acc, 0, 0, 0); acc = __builtin_amdgcn_mfma_i32_16x16x64_i8(V8HI(b), V8HI(a), acc, 0, 0, 0); }
    else { acc = __builtin_amdgcn_mfma_f32_16x16x32_bf16(__builtin_bit_cast(bf16x8, V8LO(b)), __builtin_bit_cast(bf16x8, V8LO(a)), acc, 0, 0, 0);
           acc = __builtin_amdgcn_mfma_f32_16x16x32_bf16(__builtin_bit_cast(bf16x8, V8HI(b)), __builtin_bit_cast(bf16x8, V8HI(a)), acc, 0, 0, 0); }
}
template <class Epi, class Sched>
__device__ __forceinline__ void gemm_phase(LAS unsigned char* lds, const Sched& S, const Epi& E) {
    int tid_ = threadIdx.x; asm volatile("" : "+v"(tid_));
    const int tid = tid_, wid = __builtin_amdgcn_readfirstlane(tid >> 6), lane = tid & 63, wr = wid >> 2, wc = wid & 3, fr = lane & 15, fq = lane >> 4;
    const int nt = S.K / BK;
    unsigned voffB[2];
#pragma unroll
    for (int i = 0; i < 2; ++i) { int R, C; stage_rc(tid * 16 + i * 8192, R, C); const int Rb = Epi::PERM ? ((R & ~31) + perm32(R & 31)) : R; voffB[i] = (unsigned)(Rb * S.ldb + C) * 2u; }
    const unsigned kstep = BK * 2u;
    const unsigned hstepB = (unsigned)HALF * S.ldb * 2u;
    const unsigned ldsw = (unsigned)wid * 1024u;
    const int aoff = lds_byte(wr * 64 + fr, fq * 8), boff = lds_byte(wc * 32 + fr, fq * 8);
#define PG8_SA(b, h) (((b) * 2 + (h)) * HTB)
#define PG8_SB(b, h) ((4 + (b) * 2 + (h)) * HTB)
#define PG8_STAGE_A(bufoff, abase, soff, voff) do { const char* _g = (abase) + (unsigned)__builtin_amdgcn_readfirstlane((int)(soff)); asm volatile("" : "+s"(_g)); _Pragma("unroll") for (int _i = 0; _i < 2; ++_i) \
        __builtin_amdgcn_global_load_lds((const unsigned*)(_g + (voff)[_i]), (LAS unsigned*)(lds + (bufoff) + ldsw + _i * 8192), 16, 0, 0); } while (0)
#define PG8_STAGE_B(bufoff, soff) do { const char* _g = S.Bbase + (unsigned)__builtin_amdgcn_readfirstlane((int)(soff)); asm volatile("" : "+s"(_g)); _Pragma("unroll") for (int _i = 0; _i < 2; ++_i) \
        __builtin_amdgcn_global_load_lds((const unsigned*)(_g + voffB[_i]), (LAS unsigned*)(lds + (bufoff) + ldsw + _i * 8192), 16, 0, 0); } while (0)
#define PG8_LDA(dst, b, h) do { _Pragma("unroll") for (int m = 0; m < 4; ++m) dst[m] = __builtin_shufflevector(*(const LAS i32x4*)(lds + PG8_SA(b, h) + aoff + m * 2048), *(const LAS i32x4*)(lds + PG8_SA(b, h) + aoff + m * 2048 + 1024), 0, 1, 2, 3, 4, 5, 6, 7); } while (0)
#define PG8_LDB(dst, b, h) do { _Pragma("unroll") for (int n = 0; n < 2; ++n) dst[n] = __builtin_shufflevector(*(const LAS i32x4*)(lds + PG8_SB(b, h) + boff + n * 2048), *(const LAS i32x4*)(lds + PG8_SB(b, h) + boff + n * 2048 + 1024), 0, 1, 2, 3, 4, 5, 6, 7); } while (0)
#define PG8_MMA(ai, bj, At, Bt) do { __builtin_amdgcn_s_setprio(1); _Pragma("unroll") for (int m = 0; m < 4; ++m) _Pragma("unroll") for (int n = 0; n < 2; ++n) \
        mma2<Epi::MM>(acc[ai][bj][m][n], Bt[n], At[m], fsb[bj][n], fsa); __builtin_amdgcn_s_setprio(0); } while (0)
#define PG8_WAIT_V(n) asm volatile("s_waitcnt vmcnt(" #n ")" ::: "memory")
#define PG8_WAIT_L(n) asm volatile("s_waitcnt lgkmcnt(" #n ")" ::: "memory")
#define PG8_BAR __builtin_amdgcn_s_barrier()
#define PG8_SCHED __builtin_amdgcn_sched_barrier(0)
    if (wid == 0) { GUnit u; const bool ok = S.next(lane, u); LAS int* tb = (LAS int*)(lds + UT_OFF) + lane * 8;
        tb[0] = ok ? u.pm : -1; tb[1] = u.pn; tb[2] = u.e; tb[3] = u.aux; tb[4] = u.rs; tb[5] = u.sa; tb[6] = ok ? (int)S.b_off(u) : 0; tb[7] = ok ? (int)S.a_tile(u) : 0; }
    asm volatile("s_waitcnt lgkmcnt(0)" ::: "memory"); __syncthreads();
#define PG8_UNIT(i, u, bo, ao, ok) do { const LAS int* tb_ = (const LAS int*)(lds + UT_OFF) + ((i) & 63) * 8; \
        u.pm = __builtin_amdgcn_readfirstlane(tb_[0]); u.pn = __builtin_amdgcn_readfirstlane(tb_[1]); u.e = __builtin_amdgcn_readfirstlane(tb_[2]); u.aux = __builtin_amdgcn_readfirstlane(tb_[3]); \
        u.rs = __builtin_amdgcn_readfirstlane(tb_[4]); u.sa = __builtin_amdgcn_readfirstlane(tb_[5]); bo = (unsigned)__builtin_amdgcn_readfirstlane(tb_[6]); ao = (unsigned)__builtin_amdgcn_readfirstlane(tb_[7]); \
        ok = (i) < 64 && u.pm >= 0; } while (0)
    GUnit cur, nxt; int ui = 0; unsigned cB, cA, nB, nA; bool ok0;
    PG8_UNIT(0, cur, cB, cA, ok0);
    if (!ok0) return;
    const char* cAp = S.a_base(cur); const char* nAp = cAp;
    typedef typename AccSel<Epi::MM>::T AccT;
    int fsa = 127, fsb[2][2] = {{127, 127}, {127, 127}};
    AccT acc[2][2][4][2];
#pragma unroll
    for (int a = 0; a < 2; ++a)
#pragma unroll
        for (int b = 0; b < 2; ++b)
#pragma unroll
            for (int m = 0; m < 4; ++m)
#pragma unroll
                for (int n = 0; n < 2; ++n) acc[a][b][m][n] = AccT{};
    i32x8 At[4], B0[2], B1[2];
    unsigned oC[2][2], oN[2][2];
    if constexpr (Sched::GATHER) { S.a_off_first(cur, oC);
#pragma unroll
        for (int h = 0; h < 2; ++h)
#pragma unroll
            for (int i = 0; i < 2; ++i) oN[h][i] = oC[h][i]; }
    else { GUnit z; z.pm = 0; z.pn = 0; z.e = 0; z.aux = 0; z.rs = 0; z.sa = 127; S.a_off_first(z, oC);
#pragma unroll
        for (int h = 0; h < 2; ++h)
#pragma unroll
            for (int i = 0; i < 2; ++i) oN[h][i] = oC[h][i]; }
    if constexpr (Epi::MM == 2) S.f8_scales(cur, wc, fr, fsa, fsb);
    if constexpr (Epi::LDSS) E.prefetch_scales(cur, 0, lds);
    PG8_STAGE_B(PG8_SB(0, 0), cB); PG8_STAGE_B(PG8_SB(0, 1), cB + hstepB); PG8_STAGE_A(PG8_SA(0, 0), cAp, cA, oC[0]); PG8_STAGE_A(PG8_SA(0, 1), cAp, cA, oC[1]);
    if (wr == 1) PG8_BAR;
    PG8_WAIT_V(2); PG8_BAR;
    PG8_STAGE_B(PG8_SB(1, 0), cB + kstep); PG8_STAGE_A(PG8_SA(1, 0), cAp, cA + kstep, oC[0]); PG8_STAGE_B(PG8_SB(1, 1), cB + hstepB + kstep);
    PG8_WAIT_V(6); PG8_BAR;
    for (;;) {
        bool has_next; PG8_UNIT(ui + 1, nxt, nB, nA, has_next);
        if (!has_next) { nB = cB; nA = cA; nAp = cAp; } else nAp = S.a_base(nxt);
        if (has_next) S.prefetch(nxt, lds);
        if constexpr (Epi::LDSS) { if (has_next) E.prefetch_scales(nxt, (ui + 1) % 3, lds); }
        for (int t = 0; t < nt; t += 2) {
            const bool last = (t == nt - 2);
            const unsigned a1 = cA + (unsigned)(t + 1) * kstep;
            const unsigned a2 = last ? nA : cA + (unsigned)(t + 2) * kstep, b2 = last ? nB : cB + (unsigned)(t + 2) * kstep;
            const unsigned a3 = a2 + kstep, b3 = b2 + kstep; const char* const ap2 = last ? nAp : cAp;
            if constexpr (Sched::GATHER) { if (last && has_next) S.a_off_next(nxt, oN, lds); }
            PG8_LDB(B0, 0, 0); PG8_LDB(B1, 0, 1); PG8_SCHED; PG8_LDA(At, 0, 0); PG8_STAGE_A(PG8_SA(1, 1), cAp, a1, oC[1]);
            PG8_WAIT_V(8); PG8_WAIT_L(0); PG8_BAR; PG8_MMA(0, 0, At, B0); PG8_MMA(0, 1, At, B1); PG8_BAR; PG8_SCHED;
            PG8_LDA(At, 0, 1); PG8_STAGE_B(PG8_SB(0, 0), b2); PG8_STAGE_B(PG8_SB(0, 1), b2 + hstepB); PG8_STAGE_A(PG8_SA(0, 0), ap2, a2, oN[0]);
            PG8_WAIT_V(8); PG8_WAIT_L(0); PG8_BAR; PG8_MMA(1, 0, At, B0); PG8_MMA(1, 1, At, B1); PG8_BAR; PG8_SCHED;
            PG8_LDB(B0, 1, 0); PG8_LDB(B1, 1, 1); PG8_SCHED; PG8_LDA(At, 1, 0); PG8_STAGE_A(PG8_SA(0, 1), ap2, a2, oN[1]);
            PG8_WAIT_V(8); PG8_WAIT_L(0); PG8_BAR; PG8_MMA(0, 0, At, B0); PG8_MMA(0, 1, At, B1); PG8_BAR; PG8_SCHED;
            PG8_LDA(At, 1, 1); PG8_STAGE_B(PG8_SB(1, 0), b3); PG8_STAGE_B(PG8_SB(1, 1), b3 + hstepB); PG8_STAGE_A(PG8_SA(1, 0), ap2, a3, oN[0]);
            PG8_WAIT_V(8); PG8_WAIT_L(0); PG8_BAR; PG8_MMA(1, 0, At, B0); PG8_MMA(1, 1, At, B1); PG8_BAR; PG8_SCHED;
        }
        if (wr == 0) PG8_BAR;
        if constexpr (Epi::MM == 2) asm volatile("s_nop 15\n\ts_nop 15" ::: "memory");
        if constexpr (Epi::LDSS) E(acc, cur, wr, wc, fr, fq, lds + SCL_OFF + (ui % 3) * 2048); else E(acc, cur, wr, wc, fr, fq);
        if (!has_next) break;
#pragma unroll
        for (int a = 0; a < 2; ++a)
#pragma unroll
            for (int b = 0; b < 2; ++b)
#pragma unroll
                for (int m = 0; m < 4; ++m)
#pragma unroll
                    for (int n = 0; n < 2; ++n) acc[a][b][m][n] = AccT{};
        cur = nxt; cB = nB; cA = nA; cAp = nAp; ++ui;
        if constexpr (Epi::MM == 2) S.f8_scales(cur, wc, fr, fsa, fsb);
        if constexpr (Sched::GATHER) {
#pragma unroll
        for (int h = 0; h < 2; ++h)
#pragma unroll
            for (int i = 0; i < 2; ++i) oC[h][i] = oN[h][i]; }
        if (wr == 1) PG8_BAR;
    }
    PG8_WAIT_V(0);
    PG8_BAR;
#undef PG8_UNIT
#undef PG8_SA
#undef PG8_SB
#undef PG8_STAGE_A
#undef PG8_STAGE_B
#undef PG8_LDA
#undef PG8_LDB
#undef PG8_MMA
#undef PG8_WAIT_V
#undef PG8_WAIT_L
#undef PG8_BAR
#undef PG8_SCHED
}
}

using pg8::GUnit;
struct PlainSched {
    static constexpr bool GATHER = false;
    __device__ __forceinline__ const char* a_base(const GUnit&) const { return Abase; }
    __device__ __forceinline__ unsigned a_tile(const GUnit& u) const { return (unsigned)(u.pm * 256 * lda) * 2u; }
    const char* Abase; const char* Bbase; int K, lda, ldb, nM, nN, G, c, pmdiv; size_t bstride; int sa = 127; const int* sb8 = nullptr;
    __device__ __forceinline__ bool next(int i, GUnit& u) const { const long L = (long)i * G + c; if (L >= (long)nM * nN) return false; pg8::tile_of((int)L, nM, nN, u.pm, u.pn); u.e = u.pm / pmdiv; u.aux = u.pm; u.rs = u.pm * 256; u.sa = sa; return true; }
    __device__ __forceinline__ void f8_scales(const GUnit& u, int wc, int fr, int& sa_, int (&sb)[2][2]) const { sa_ = u.sa;
#pragma unroll
        for (int bj = 0; bj < 2; ++bj)
#pragma unroll
            for (int n = 0; n < 2; ++n) sb[bj][n] = sb8[u.pn * 256 + bj * 128 + wc * 32 + pg8::perm32(n * 16 + fr)]; }
    __device__ __forceinline__ void a_off_first(const GUnit& u, unsigned (&off)[2][2]) const { int R[2], C[2]; pg8::lane_rc(0, R[0], C[0]); pg8::lane_rc(1, R[1], C[1]);
#pragma unroll
        for (int h = 0; h < 2; ++h)
#pragma unroll
            for (int i = 0; i < 2; ++i) off[h][i] = (unsigned)((u.pm * 256 + h * 128 + R[i]) * lda + C[i]) * 2u; }
    __device__ __forceinline__ void a_off_next(const GUnit& u, unsigned (&off)[2][2], LAS unsigned char*) const { a_off_first(u, off); }
    __device__ __forceinline__ void prefetch(const GUnit&, LAS unsigned char*) const {}
    __device__ __forceinline__ unsigned b_off(const GUnit& u) const { return (unsigned)((size_t)u.e * bstride + (size_t)u.pn * 256 * ldb * 2); }
};
constexpr int ET_OFF = RING_BYTES + 512;
__device__ __forceinline__ void etab_build(LAS unsigned char* lds, const unsigned* ctl) {
    if (threadIdx.x < 64) { const int l = threadIdx.x & 63; int v = 0;
        if (l < NE) { v = (int)__hip_atomic_load(ctl + CW_ECNT + 64 * l, __ATOMIC_RELAXED, __HIP_MEMORY_SCOPE_AGENT); v = v < 0 ? 0 : (v > LCAP ? LCAP : v); }
        else if (l < 2 * NE) v = (int)__hip_atomic_load(ctl + CW_EA + (l - NE), __ATOMIC_RELAXED, __HIP_MEMORY_SCOPE_AGENT);
        int np = (l < NE) ? ((v + 255) >> 8) : 0, ps = np;
#pragma unroll
        for (int o = 1; o < NE; o <<= 1) { const int t = __shfl_up(ps, o); if (l >= o) ps += t; }
        if (l < NE) { *(LAS int*)(lds + ET_OFF + 4 * l) = v; *(LAS int*)(lds + ET_OFF + 32 + 4 * l) = ps - np; if (l == NE - 1) *(LAS int*)(lds + ET_OFF + 32 + 4 * NE) = ps; }
        else if (l < 2 * NE) *(LAS int*)(lds + ET_OFF + 72 + 4 * (l - NE)) = v; }
    __syncthreads();
}
__device__ __forceinline__ int et_cnt(LAS unsigned char* lds, int e) { return __builtin_amdgcn_readfirstlane(*(const LAS int*)(lds + ET_OFF + 4 * e)); }
__device__ __forceinline__ int et_ps(LAS unsigned char* lds, int e) { return __builtin_amdgcn_readfirstlane(*(const LAS int*)(lds + ET_OFF + 32 + 4 * e)); }
__device__ __forceinline__ int et_sa(LAS unsigned char* lds, int e) { return __builtin_amdgcn_readfirstlane(*(const LAS int*)(lds + ET_OFF + 72 + 4 * e)); }
__device__ __forceinline__ int et_ps_l(LAS unsigned char* lds, int e) { return *(const LAS int*)(lds + ET_OFF + 32 + 4 * e); }
__device__ __forceinline__ int et_sa_l(LAS unsigned char* lds, int e) { return *(const LAS int*)(lds + ET_OFF + 72 + 4 * e); }
__device__ __forceinline__ int et_expert(LAS unsigned char* lds, int p) { int e = 0;
#pragma unroll
    for (int k = 1; k < NE; ++k) e += (p >= et_ps_l(lds, k)) ? 1 : 0;
    return e; }
struct MoeSched1 {
    static constexpr bool GATHER = true;
    __device__ __forceinline__ const char* a_base(const GUnit&) const { return Abase; }
    __device__ __forceinline__ unsigned a_tile(const GUnit&) const { return 0u; }
    const char* Abase; const char* Bbase; const int* list; int K, ldb, nM, nN, G, c, p0; LAS unsigned char* EL;
    __device__ __forceinline__ bool next(int i, GUnit& u) const { const long L = (long)i * G + c; if (L >= (long)nM * nN) return false; if (MK_MOE_NMAJOR) pg8::tile_of((int)L, nN, nM, u.pn, u.pm); else pg8::tile_of((int)L, nM, nN, u.pm, u.pn); u.aux = p0 + u.pm; u.e = et_expert(EL, u.aux); u.rs = u.e * LCAP + (u.aux - et_ps_l(EL, u.e)) * 256; u.sa = et_sa_l(EL, u.e); return true; }
    __device__ __forceinline__ void a_off_first(const GUnit& u, unsigned (&off)[2][2]) const { int R[2], C[2]; pg8::lane_rc(0, R[0], C[0]); pg8::lane_rc(1, R[1], C[1]);
        const int cn = et_cnt(EL, u.e), ps = et_ps(EL, u.e);
        const int lp = (u.aux - ps) * 256;
#pragma unroll
        for (int h = 0; h < 2; ++h)
#pragma unroll
            for (int i = 0; i < 2; ++i) { const int pos = lp + h * 128 + R[i]; int tok = list[u.e * LCAP + (pos < LCAP ? pos : 0)]; tok = (pos < cn) ? tok : 0; tok = ((unsigned)tok < (unsigned)NTOK) ? tok : 0; off[h][i] = (unsigned)(tok * K + C[i]) * 2u; } }
    __device__ __forceinline__ void prefetch(const GUnit& u, LAS unsigned char* lds) const {
        const int wid = __builtin_amdgcn_readfirstlane(threadIdx.x >> 6), lane = threadIdx.x & 63;
        if (wid < 4) { const int ps = et_ps(EL, u.e);
            const int pos = (u.aux - ps) * 256 + wid * 64 + lane;
            __builtin_amdgcn_global_load_lds((const unsigned*)(list + u.e * LCAP + (pos < LCAP ? pos : 0)), (LAS unsigned*)(lds + IDX_OFF + wid * 256), 4, 0, 0); } }
    __device__ __forceinline__ void a_off_next(const GUnit& u, unsigned (&off)[2][2], LAS unsigned char* lds) const { int R[2], C[2]; pg8::lane_rc(0, R[0], C[0]); pg8::lane_rc(1, R[1], C[1]);
        const int cn = et_cnt(EL, u.e), ps = et_ps(EL, u.e);
        const int lp = (u.aux - ps) * 256;
#pragma unroll
        for (int h = 0; h < 2; ++h)
#pragma unroll
            for (int i = 0; i < 2; ++i) { const int rr = h * 128 + R[i]; int tok = *(const LAS int*)(lds + IDX_OFF + rr * 4); tok = (lp + rr < cn) ? tok : 0; tok = ((unsigned)tok < (unsigned)NTOK) ? tok : 0; off[h][i] = (unsigned)(tok * K + C[i]) * 2u; } }
    __device__ __forceinline__ unsigned b_off(const GUnit& u) const { return (unsigned)((size_t)u.e * ((size_t)2 * FFE * DM) + (size_t)u.pn * 256 * ldb * 2); }
};
struct MoeSched2 {
    static constexpr bool GATHER = false;
    __device__ __forceinline__ const char* a_base(const GUnit& u) const { return u.pm < ASPLIT ? Abase : Abase2; }
    __device__ __forceinline__ unsigned a_tile(const GUnit& u) const { return (unsigned)((u.pm < ASPLIT ? u.pm : u.pm - ASPLIT) * 256 * lda) * 2u; }
    const char* Abase; const char* Abase2; const char* Bbase; const int* sb8; int K, lda, ldb, nM, nN, G, c, p0; LAS unsigned char* EL;
    __device__ __forceinline__ bool next(int i, GUnit& u) const { const long L = (long)i * G + c; if (L >= (long)nM * nN) return false; pg8::tile_of((int)L, nM, nN, u.pm, u.pn); u.aux = p0 + u.pm; u.e = et_expert(EL, u.aux); u.rs = 0; u.sa = et_sa_l(EL, u.e); return true; }
    __device__ __forceinline__ void a_off_first(const GUnit& u, unsigned (&off)[2][2]) const { int R[2], C[2]; pg8::lane_rc(0, R[0], C[0]); pg8::lane_rc(1, R[1], C[1]);
#pragma unroll
        for (int h = 0; h < 2; ++h)
#pragma unroll
            for (int i = 0; i < 2; ++i) off[h][i] = (unsigned)((u.pm * 256 + h * 128 + R[i]) * lda + C[i]) * 2u; }
    __device__ __forceinline__ void a_off_next(const GUnit& u, unsigned (&off)[2][2], LAS unsigned char*) const { a_off_first(u, off); }
    __device__ __forceinline__ void prefetch(const GUnit&, LAS unsigned char*) const {}
    __device__ __forceinline__ unsigned b_off(const GUnit& u) const { return (unsigned)((size_t)u.e * ((size_t)DM * FFE) + (size_t)u.pn * 256 * ldb * 2); }
    __device__ __forceinline__ void f8_scales(const GUnit& u, int wc, int fr, int& sa, int (&sb)[2][2]) const { sa = u.sa;
#pragma unroll
        for (int bj = 0; bj < 2; ++bj)
#pragma unroll
            for (int n = 0; n < 2; ++n) sb[bj][n] = sb8[u.e * DM + u.pn * 256 + bj * 128 + wc * 32 + pg8::perm32(n * 16 + fr)]; }
};

struct MoeSched2K {
    static constexpr bool GATHER = false;
    __device__ __forceinline__ const char* a_base(const GUnit& u) const { return u.pm < ASPLIT ? Abase : Abase2; }
    __device__ __forceinline__ unsigned a_tile(const GUnit& u) const { return (unsigned)((u.pm < ASPLIT ? u.pm : u.pm - ASPLIT) * 256 * lda) * 2u + (unsigned)u.rs * 512u; }
    const char* Abase; const char* Abase2; const char* Bbase; const int* sb8; int K, lda, ldb, nLeft, G, c; LAS unsigned char* EL;
    __device__ __forceinline__ bool next(int i, GUnit& u) const { const long L = (long)i * G + c; if (L >= (long)nLeft * 4 * KSPLIT) return false; const int kc = (int)(L % KSPLIT), t = (int)(L / KSPLIT), lp = t >> 2;
        u.pn = t & 3; u.pm = 256 + lp; u.rs = kc; u.aux = kc * LPMAX + lp; u.e = et_expert(EL, u.pm); u.sa = et_sa_l(EL, u.e); return true; }
    __device__ __forceinline__ void a_off_first(const GUnit& u, unsigned (&off)[2][2]) const { int R[2], C[2]; pg8::lane_rc(0, R[0], C[0]); pg8::lane_rc(1, R[1], C[1]);
#pragma unroll
        for (int h = 0; h < 2; ++h)
#pragma unroll
            for (int i = 0; i < 2; ++i) off[h][i] = (unsigned)((u.pm * 256 + h * 128 + R[i]) * lda + C[i]) * 2u; }
    __device__ __forceinline__ void a_off_next(const GUnit& u, unsigned (&off)[2][2], LAS unsigned char*) const { a_off_first(u, off); }
    __device__ __forceinline__ void prefetch(const GUnit&, LAS unsigned char*) const {}
    __device__ __forceinline__ unsigned b_off(const GUnit& u) const { return (unsigned)((size_t)u.e * ((size_t)DM * FFE) + (size_t)u.pn * 256 * ldb * 2) + (unsigned)u.rs * 512u; }
    __device__ __forceinline__ void f8_scales(const GUnit& u, int wc, int fr, int& sa, int (&sb)[2][2]) const { sa = u.sa;
#pragma unroll
        for (int bj = 0; bj < 2; ++bj)
#pragma unroll
            for (int n = 0; n < 2; ++n) sb[bj][n] = sb8[u.e * DM + u.pn * 256 + bj * 128 + wc * 32 + pg8::perm32(n * 16 + fr)]; }
};

struct MoeSched2B {
    static constexpr bool GATHER = false;
    __device__ __forceinline__ const char* a_base(const GUnit&) const { return Abase; }
    __device__ __forceinline__ unsigned a_tile(const GUnit& u) const { return (unsigned)(u.pm * 256 * lda) * 2u; }
    const char* Abase; const char* Bbase; int K, lda, ldb, nM, nN, G, c, p0; LAS unsigned char* EL;
    __device__ __forceinline__ bool next(int i, GUnit& u) const { const long L = (long)i * G + c; if (L >= (long)nM * nN) return false; pg8::tile_of((int)L, nM, nN, u.pm, u.pn); u.aux = p0 + u.pm; u.e = et_expert(EL, u.aux); u.rs = 0; u.sa = 127; return true; }
    __device__ __forceinline__ void a_off_first(const GUnit& u, unsigned (&off)[2][2]) const { int R[2], C[2]; pg8::lane_rc(0, R[0], C[0]); pg8::lane_rc(1, R[1], C[1]);
#pragma unroll
        for (int h = 0; h < 2; ++h)
#pragma unroll
            for (int i = 0; i < 2; ++i) off[h][i] = (unsigned)((u.pm * 256 + h * 128 + R[i]) * lda + C[i]) * 2u; }
    __device__ __forceinline__ void a_off_next(const GUnit& u, unsigned (&off)[2][2], LAS unsigned char*) const { a_off_first(u, off); }
    __device__ __forceinline__ void prefetch(const GUnit&, LAS unsigned char*) const {}
    __device__ __forceinline__ unsigned b_off(const GUnit& u) const { return (unsigned)((size_t)u.e * ((size_t)DM * FFE * 2) + (size_t)u.pn * 256 * ldb * 2); }
};

typedef const f32x4 (&AccRef)[2][2][4][2];
struct EpiS5A { static constexpr bool PERM = false, LDSS = false; static constexpr int MM = 0; float* sloc;
    __device__ __forceinline__ void operator()(AccRef acc, const GUnit& u, int wr, int wc, int fr, int fq) const {
        float* base = sloc + (size_t)(u.pm * 256 + wr * 64 + fr) * 128 + wc * 32 + 4 * fq;
#pragma unroll
        for (int ai = 0; ai < 2; ++ai)
#pragma unroll
            for (int m = 0; m < 4; ++m)
#pragma unroll
                for (int n = 0; n < 2; ++n) *(f32x4*)(base + (size_t)(ai * 128 + m * 16) * 128 + n * 16) = acc[ai][0][m][n]; } };
struct EpiS5C { static constexpr bool PERM = true, LDSS = false; static constexpr int MM = 0; const bf16* ua; const float* dsk; const float* g0; bf16* gbuf;
    __device__ __forceinline__ void operator()(AccRef acc, const GUnit& u, int wr, int wc, int fr, int fq) const {
        const int g = u.pm >> 3, i0 = 8 * (fq & 1);
        f32x4 d0 = *(const f32x4*)(dsk + g * 16 + i0) * *(const f32x4*)(g0 + g * 16 + i0), d1 = *(const f32x4*)(dsk + g * 16 + i0 + 4) * *(const f32x4*)(g0 + g * 16 + i0 + 4);
        const bf16* const up = ua + (size_t)(u.pm * 256 + wr * 64 + fr) * UAK + 32 * wc + 8 * fq;
#define S5C_LD(s_) (*(const v4u*)(up + (size_t)((((s_) >> 3) & 1) * 128 + (((s_) >> 1) & 3) * 16) * UAK + 128 * ((s_) & 1)))
        v4u un0 = S5C_LD(0), un1 = S5C_LD(1);
#pragma unroll
        for (int ai = 0; ai < 2; ++ai)
#pragma unroll
            for (int m = 0; m < 4; ++m) { const int r = ai * 128 + wr * 64 + m * 16 + fr, rowg = (u.pm & 7) * 256 + r, b = rowg >> 7, c = rowg & 127;
#pragma unroll
                for (int bj = 0; bj < 2; ++bj) { const int col = 128 * bj + 32 * wc + 8 * fq, t = col >> 4; const int st = (ai * 4 + m) * 2 + bj;
                    const v4u uu = un0; un0 = un1; if (st + 2 < 16) un1 = S5C_LD(st + 2);
                    f32x4 y0 = acc[ai][bj][m][0], y1 = acc[ai][bj][m][1];
                    y0[0] += d0[0] * bf2f(uu.x & 0xffffu); y0[1] += d0[1] * bf2f(uu.x >> 16); y0[2] += d0[2] * bf2f(uu.y & 0xffffu); y0[3] += d0[3] * bf2f(uu.y >> 16);
                    y1[0] += d1[0] * bf2f(uu.z & 0xffffu); y1[1] += d1[1] * bf2f(uu.z >> 16); y1[2] += d1[2] * bf2f(uu.w & 0xffffu); y1[3] += d1[3] * bf2f(uu.w >> 16);
#pragma unroll
                    for (int k = 0; k < 4; ++k) { const float a = y0[k], bq = y1[k]; y0[k] = a * fast_sigmoid(1.5957691216f * (a + 0.044715f * a * a * a)); y1[k] = bq * fast_sigmoid(1.5957691216f * (bq + 0.044715f * bq * bq * bq)); }
                    v4u w; w.x = cvt_pk_bf16(y0[0], y0[1]); w.y = cvt_pk_bf16(y0[2], y0[3]); w.z = cvt_pk_bf16(y1[0], y1[1]); w.w = cvt_pk_bf16(y1[2], y1[3]);
                    *(v4u*)(gbuf + (size_t)(b * SEQ + c * CL + t) * DM + g * 16 + i0) = w; }
                asm volatile("" ::: "memory"); }
#undef S5C_LD
    } };
template <int MODE> struct EpiGated { static constexpr bool PERM = true, LDSS = false; static constexpr int MM = 0; bf16* out; int ldc; float* rowss; int rowsel;
    __device__ __forceinline__ void operator()(AccRef acc, const GUnit& u, int wr, int wc, int fr, int fq) const {
#pragma unroll
        for (int ai = 0; ai < 2; ++ai)
#pragma unroll
            for (int m = 0; m < 4; ++m) { const int row = u.pm * 256 + ai * 128 + wr * 64 + m * 16 + fr; float o[8]; float ss = 0.f;
#pragma unroll
                for (int n = 0; n < 2; ++n)
#pragma unroll
                    for (int k = 0; k < 4; ++k) { const float a = acc[ai][0][m][n][k], bq = acc[ai][1][m][n][k]; const float v = (MODE == 0) ? a * fast_sigmoid(bq) : a * fast_sigmoid(a) * bq; o[n * 4 + k] = v; ss += v * v; }
                v4u w; w.x = cvt_pk_bf16(o[0], o[1]); w.y = cvt_pk_bf16(o[2], o[3]); w.z = cvt_pk_bf16(o[4], o[5]); w.w = cvt_pk_bf16(o[6], o[7]);
                *(v4u*)(out + (size_t)row * ldc + u.pn * 128 + wc * 32 + fq * 8) = w;
                if (MODE == 0) { ss += __shfl_xor(ss, 16); ss += __shfl_xor(ss, 32); if (fq == 0) rowss[(size_t)row * 32 + u.pn * 4 + wc] = ss; } } } };
__device__ __forceinline__ void scales_to_lds(const float* rs256, const float* cm256, int buf, LAS unsigned char* lds) {
    const int wid = __builtin_amdgcn_readfirstlane(threadIdx.x >> 6), lane = threadIdx.x & 63;
    const float* src = (wid < 4) ? rs256 + wid * 64 + lane : cm256 + (wid - 4) * 64 + lane;
    __builtin_amdgcn_global_load_lds((const unsigned*)src, (LAS unsigned*)(lds + SCL_OFF + buf * 2048 + wid * 256), 4, 0, 0);
}
template <bool F8OUT> struct EpiGatedI8 { static constexpr bool PERM = true, LDSS = true; static constexpr int MM = 1; bf16* out; int ldc; const float* rowscale; const float* colmax; int cstride; unsigned char* out2;
    __device__ __forceinline__ void prefetch_scales(const GUnit& u, int buf, LAS unsigned char* lds) const { scales_to_lds(rowscale + u.rs, colmax + (size_t)u.e * cstride + u.pn * 256, buf, lds); }
    __device__ __forceinline__ void operator()(const i32x4 (&acc)[2][2][4][2], const GUnit& u, int wr, int wc, int fr, int fq, LAS unsigned char* tab) const {
        const LAS float* cm = (const LAS float*)(tab + 1024) + wc * 32 + 8 * fq; const float k127 = 1.0f / 127.0f;
        float fscale = 1.0f; if constexpr (F8OUT) fscale = __builtin_bit_cast(float, (unsigned)(254 - u.sa) << 23);
        const float L2E = 1.4426950408889634f, k1 = k127 * L2E, k3 = k127 * fscale * (1.0f / L2E);
        const f32x4 s1a = *(const LAS f32x4*)cm * k1, s1b = *(const LAS f32x4*)(cm + 4) * k1, s3a = *(const LAS f32x4*)(cm + 128) * k3, s3b = *(const LAS f32x4*)(cm + 132) * k3;
        const f32x2 c1[4] = {{s1a[0], s1a[1]}, {s1a[2], s1a[3]}, {s1b[0], s1b[1]}, {s1b[2], s1b[3]}}, c3[4] = {{s3a[0], s3a[1]}, {s3a[2], s3a[3]}, {s3b[0], s3b[1]}, {s3b[2], s3b[3]}};
        const LAS float* rsc = (const LAS float*)tab + wr * 64 + fr;
#pragma unroll
        for (int ai = 0; ai < 2; ++ai)
#pragma unroll
            for (int m = 0; m < 4; ++m) { const int r = ai * 128 + wr * 64 + m * 16 + fr; const float sA = rsc[ai * 128 + m * 16]; const f32x2 sAA = {sA, sA}; float o[8];
#pragma unroll
                for (int q = 0; q < 4; ++q) { const int n = q >> 1, k0 = (q & 1) * 2;
                    const f32x2 av = (f32x2){(float)acc[ai][0][m][n][k0], (float)acc[ai][0][m][n][k0 + 1]} * (c1[q] * sAA), bv = (f32x2){(float)acc[ai][1][m][n][k0], (float)acc[ai][1][m][n][k0 + 1]} * (c3[q] * sAA);
                    const f32x2 d = (f32x2){__builtin_amdgcn_exp2f(-av[0]), __builtin_amdgcn_exp2f(-av[1])} + (f32x2){1.0f, 1.0f};
                    const f32x2 ov = (av * bv) * (f32x2){__builtin_amdgcn_rcpf(d[0]), __builtin_amdgcn_rcpf(d[1])};
                    o[2 * q] = ov[0]; o[2 * q + 1] = ov[1]; }
                if constexpr (F8OUT) {
                    int p0 = __builtin_amdgcn_cvt_pk_fp8_f32(o[0], o[1], 0, false); p0 = __builtin_amdgcn_cvt_pk_fp8_f32(o[2], o[3], p0, true);
                    int p1 = __builtin_amdgcn_cvt_pk_fp8_f32(o[4], o[5], 0, false); p1 = __builtin_amdgcn_cvt_pk_fp8_f32(o[6], o[7], p1, true);
                    v2u w; w.x = (unsigned)p0; w.y = (unsigned)p1;
                    unsigned char* const ob = (u.pm < ASPLIT) ? (unsigned char*)out + (size_t)(u.pm * 256) * ldc : out2 + (size_t)((u.pm - ASPLIT) * 256) * ldc;
                    *(v2u*)(ob + (size_t)r * ldc + u.pn * 128 + wc * 32 + fq * 8) = w; }
                else {
                v4u w; w.x = cvt_pk_bf16(o[0], o[1]); w.y = cvt_pk_bf16(o[2], o[3]); w.z = cvt_pk_bf16(o[4], o[5]); w.w = cvt_pk_bf16(o[6], o[7]);
                *(v4u*)(out + (size_t)(u.pm * 256 + r) * ldc + u.pn * 128 + wc * 32 + fq * 8) = w; } } } };
template <bool SS, bool USEAUX, int MMODE = 0> struct EpiPlain { static constexpr bool PERM = true, LDSS = false; static constexpr int MM = MMODE; bf16* out; int ldc; float* rowss;
    __device__ __forceinline__ void operator()(AccRef acc, const GUnit& u, int wr, int wc, int fr, int fq) const {
        const int rb = (USEAUX ? u.aux : u.pm) * 256;
#pragma unroll
        for (int ai = 0; ai < 2; ++ai)
#pragma unroll
            for (int m = 0; m < 4; ++m) { const int row = rb + ai * 128 + wr * 64 + m * 16 + fr; float ss = 0.f;
#pragma unroll
                for (int bj = 0; bj < 2; ++bj) { const f32x4 v0 = acc[ai][bj][m][0], v1 = acc[ai][bj][m][1];
                    if (SS) ss += (v0[0] * v0[0] + v0[1] * v0[1]) + (v0[2] * v0[2] + v0[3] * v0[3]) + (v1[0] * v1[0] + v1[1] * v1[1]) + (v1[2] * v1[2] + v1[3] * v1[3]);
                    v4u w; w.x = cvt_pk_bf16(v0[0], v0[1]); w.y = cvt_pk_bf16(v0[2], v0[3]); w.z = cvt_pk_bf16(v1[0], v1[1]); w.w = cvt_pk_bf16(v1[2], v1[3]);
                    *(v4u*)(out + (size_t)row * ldc + u.pn * 256 + bj * 128 + wc * 32 + fq * 8) = w; }
                if (SS) { ss += __shfl_xor(ss, 16); ss += __shfl_xor(ss, 32); if (fq == 0) rowss[(size_t)row * 32 + u.pn * 4 + wc] = ss; } } } };
template <bool I8Q> struct EpiQKV { static constexpr bool PERM = true, LDSS = I8Q; static constexpr int MM = I8Q ? 1 : 0; bf16* qkv; const float* rope; float* kmean; const float* rowscale; const float* colmax;
    __device__ __forceinline__ void prefetch_scales(const GUnit& u, int buf, LAS unsigned char* lds) const { scales_to_lds(rowscale + u.rs, colmax + u.pn * 256, buf, lds); }
    template <class AccT> __device__ __forceinline__ void operator()(const AccT (&acc)[2][2][4][2], const GUnit& u, int wr, int wc, int fr, int fq, LAS unsigned char* tab = nullptr) const {
        const int sel = u.pn >> 2; bf16* const outb = qkv + (size_t)sel * (size_t)(32u << 20);
        const int colt = (u.pn & 3) * 256;
        f32x4 sb[2][2];
        if constexpr (I8Q) { const LAS float* cm = (const LAS float*)(tab + 1024) + wc * 32 + 8 * fq; const float k127 = 1.0f / 127.0f;
            sb[0][0] = *(const LAS f32x4*)cm * k127; sb[0][1] = *(const LAS f32x4*)(cm + 4) * k127; sb[1][0] = *(const LAS f32x4*)(cm + 128) * k127; sb[1][1] = *(const LAS f32x4*)(cm + 132) * k127; }
        float cs[2][2][4];
#pragma unroll
        for (int bj = 0; bj < 2; ++bj)
#pragma unroll
            for (int n = 0; n < 2; ++n)
#pragma unroll
                for (int kk = 0; kk < 4; ++kk) cs[bj][n][kk] = 0.f;
        const bool rot = sel < 2 && wc == 0; const float* const rp = rope + (size_t)(u.pm * 256 + wr * 64 + fr) * 32 + 4 * fq;
        f32x4 co0 = (f32x4){1.f, 1.f, 1.f, 1.f}, si0 = (f32x4){0.f, 0.f, 0.f, 0.f}, co1 = co0, si1 = si0;
        if (rot) { co0 = *(const f32x4*)rp; si0 = *(const f32x4*)(rp + 16); co1 = *(const f32x4*)(rp + 16 * 32); si1 = *(const f32x4*)(rp + 16 * 32 + 16); }
#pragma unroll
        for (int ai = 0; ai < 2; ++ai)
#pragma unroll
            for (int m = 0; m < 4; ++m) { const int rl = ai * 128 + wr * 64 + m * 16 + fr, row = u.pm * 256 + rl;
                float sA = 1.0f; if constexpr (I8Q) sA = ((const LAS float*)tab)[rl];
                const f32x4 co = co0, si = si0; co0 = co1; si0 = si1;
                if (rot && ai * 4 + m + 2 < 8) { const int s2 = ai * 4 + m + 2; const float* q = rp + (size_t)((s2 >> 2) * 128 + (s2 & 3) * 16) * 32; co1 = *(const f32x4*)q; si1 = *(const f32x4*)(q + 16); }
#pragma unroll
                for (int bj = 0; bj < 2; ++bj) { f32x4 v0, v1;
                    if constexpr (I8Q) {
#pragma unroll
                        for (int kk = 0; kk < 4; ++kk) { v0[kk] = (float)acc[ai][bj][m][0][kk] * (sA * sb[bj][0][kk]); v1[kk] = (float)acc[ai][bj][m][1][kk] * (sA * sb[bj][1][kk]); } }
                    else {
#pragma unroll
                        for (int kk = 0; kk < 4; ++kk) { v0[kk] = acc[ai][bj][m][0][kk]; v1[kk] = acc[ai][bj][m][1][kk]; } }
                    if (sel < 2 && wc == 0) {
                        const float a0 = v0[0] * co[0] - v0[1] * si[0], a1 = v0[1] * co[0] + v0[0] * si[0], a2 = v0[2] * co[1] - v0[3] * si[1], a3 = v0[3] * co[1] + v0[2] * si[1];
                        const float b0 = v1[0] * co[2] - v1[1] * si[2], b1 = v1[1] * co[2] + v1[0] * si[2], b2 = v1[2] * co[3] - v1[3] * si[3], b3 = v1[3] * co[3] + v1[2] * si[3];
                        v0 = (f32x4){a0, a1, a2, a3}; v1 = (f32x4){b0, b1, b2, b3}; }
                    if (sel == 1) {
#pragma unroll
                        for (int kk = 0; kk < 4; ++kk) { cs[bj][0][kk] += v0[kk]; cs[bj][1][kk] += v1[kk]; } }
                    v4u w; w.x = cvt_pk_bf16(v0[0], v0[1]); w.y = cvt_pk_bf16(v0[2], v0[3]); w.z = cvt_pk_bf16(v1[0], v1[1]); w.w = cvt_pk_bf16(v1[2], v1[3]);
                    *(v4u*)(outb + (size_t)row * DM + colt + bj * 128 + wc * 32 + fq * 8) = w; } }
        if (sel == 1) {
            const int b = u.pm >> 3, blk = u.pm & 7;
#pragma unroll
            for (int bj = 0; bj < 2; ++bj)
#pragma unroll
                for (int n = 0; n < 2; ++n)
#pragma unroll
                    for (int kk = 0; kk < 4; ++kk) { float s = cs[bj][n][kk]; s += __shfl_xor(s, 1); s += __shfl_xor(s, 2); s += __shfl_xor(s, 4); s += __shfl_xor(s, 8);
                        if (fr == 0) { const int h = (u.pn & 3) * 2 + bj; atomicAdd(kmean + ((size_t)((b * NH + h) * NBLK + blk)) * HD + wc * 32 + fq * 8 + n * 4 + kk, s * (1.0f / 256.0f)); } } } } };

namespace attn {
constexpr int D = 128, TS = DM;
constexpr float SCALE = 0.08838834764831845f, THR = 8.f;
constexpr int NW = 8, QBLK = 32, KVBLK = 64, QB = NW * QBLK;
constexpr int SHM_V = KVBLK * D * 2, SHM_K = KVBLK * D * 2;
constexpr int ATT_LDS = 2 * SHM_V + 2 * SHM_K + NW * 64 * 4;
#define KSWZ(row, colB) ((row) * 256 + ((colB) ^ (((row) & 7) << 4)))
#define SBAR() __builtin_amdgcn_sched_barrier(0)
__device__ __forceinline__ int v_st(int k, int c) { const int kk = (k & ~0xC) | ((k & 4) << 1) | ((k & 8) >> 1); return ((kk >> 3) * 4 + (c >> 5)) * 512 + ((kk & 7) * 32 + (c & 31)) * 2; }
__device__ __forceinline__ int v_rd_base(int lane) { return ((lane & 3) << 3) | (((lane >> 2) & 3) << 6) | (((lane >> 4) & 1) << 5) | (((lane >> 5) & 1) << 8); }
constexpr int v_rd_off(int d0, int ks, int half) { return d0 * 512 + ks * 4096 + half * 2048; }
__device__ __forceinline__ int crow(int r, int hi) { return (r & 3) + 8 * (r >> 2) + 4 * hi; }
__device__ __forceinline__ bf16x8 load8(const bf16* p) { return *reinterpret_cast<const bf16x8*>(p); }
__device__ __forceinline__ void mask_tile(f32x16& p0, f32x16& p1, int dq) {
    const float NEG = -__builtin_inff();
#pragma unroll
    for (int r = 0; r < 16; ++r) { const int c = (r & 3) + 8 * (r >> 2); if (dq - c < 0) p0[r] = NEG; if (dq - c - 32 < 0) p1[r] = NEG; }
}
__device__ __forceinline__ void drop_tile(f32x16& p0, f32x16& p1, bool drop) {
    const float NEG = -__builtin_inff();
#pragma unroll
    for (int r = 0; r < 16; ++r) { p0[r] = drop ? NEG : p0[r]; p1[r] = drop ? NEG : p1[r]; }
}
__device__ __forceinline__ void partialSM(f32x16& p0, f32x16& p1, float& m_reg, float& mn, float& alpha, bool drop = false) {
    float pmax = p0[0];
#pragma unroll
    for (int r = 1; r < 16; ++r) pmax = fmaxf(pmax, p0[r]);
#pragma unroll
    for (int r = 0; r < 16; ++r) pmax = fmaxf(pmax, p1[r]);
    { auto rr = __builtin_amdgcn_permlane32_swap(__float_as_uint(pmax), __float_as_uint(pmax), false, false);
      pmax = fmaxf(__uint_as_float(rr[0]), __uint_as_float(rr[1])); }
    pmax = drop ? -__builtin_inff() : pmax;
    constexpr float C2 = 1.4426950408889634f * SCALE;
    if (__builtin_expect(__all((pmax - m_reg) * SCALE <= THR), 1)) { mn = m_reg; alpha = 1.f; }
    else { mn = fmaxf(m_reg, pmax); alpha = __builtin_amdgcn_exp2f((m_reg - mn) * C2); m_reg = mn; }
    const float mnL = drop ? -__builtin_inff() : -mn * C2;
#pragma unroll
    for (int r = 0; r < 16; ++r) p0[r] = fmaf(p0[r], C2, mnL);
#pragma unroll
    for (int r = 0; r < 16; ++r) p1[r] = fmaf(p1[r], C2, mnL);
#pragma unroll
    for (int r = 0; r < 16; ++r) p0[r] = __builtin_amdgcn_exp2f(p0[r]);
}
__device__ __forceinline__ void finishSM(f32x16& p0, f32x16& p1, float alpha, float& l_reg, bf16x8& pa0, bf16x8& pa1, bf16x8& pa2, bf16x8& pa3) {
#pragma unroll
    for (int r = 0; r < 16; ++r) p1[r] = __builtin_amdgcn_exp2f(p1[r]);
    float ps = 0;
#pragma unroll
    for (int r = 0; r < 16; ++r) ps += p0[r];
#pragma unroll
    for (int r = 0; r < 16; ++r) ps += p1[r];
    { auto rr = __builtin_amdgcn_permlane32_swap(__float_as_uint(ps), __float_as_uint(ps), false, false);
      ps = __uint_as_float(rr[0]) + __uint_as_float(rr[1]); }
    l_reg = l_reg * alpha + ps;
#define PK4(P, B_, OUT) do { unsigned a0 = cvt_pk_bf16(P[B_+0], P[B_+1]), a1 = cvt_pk_bf16(P[B_+2], P[B_+3]);                          \
        unsigned b0 = cvt_pk_bf16(P[B_+4], P[B_+5]), b1 = cvt_pk_bf16(P[B_+6], P[B_+7]);                                             \
        auto r0 = __builtin_amdgcn_permlane32_swap(a0, b0, false, false); auto r1 = __builtin_amdgcn_permlane32_swap(a1, b1, false, false); \
        v4u w = {r0[0], r1[0], r0[1], r1[1]}; OUT = *reinterpret_cast<bf16x8*>(&w); } while (0)
    PK4(p0, 0, pa0); PK4(p0, 8, pa1); PK4(p1, 0, pa2); PK4(p1, 8, pa3);
#undef PK4
}
template <int KB>
__device__ __forceinline__ void qkt(f32x16& p0, f32x16& p1, const char* K_lds, int r32, int hi, const bf16x8* qr) {
    p0 = f32x16{}; p1 = f32x16{};
    const char* kb[4];
#pragma unroll
    for (int dd = 0; dd < 4; ++dd) kb[dd] = K_lds + KB * SHM_K + KSWZ(r32, (dd * 16 + hi * 8) * 2);
#pragma unroll
    for (int d0 = 0; d0 < 8; ++d0) { const char* a = kb[d0 & 3] + (d0 >> 2) * 128;
        bf16x8 b0 = *reinterpret_cast<const bf16x8*>(a);
        bf16x8 b1 = *reinterpret_cast<const bf16x8*>(a + 32 * 256);
        p0 = __builtin_amdgcn_mfma_f32_32x32x16_bf16(b0, qr[d0], p0, 0, 0, 0);
        p1 = __builtin_amdgcn_mfma_f32_32x32x16_bf16(b1, qr[d0], p1, 0, 0, 0); }
}
template <int VB>
__device__ __forceinline__ void pv_tile(f32x16* o, int vb0, bf16x8 pa0, bf16x8 pa1, bf16x8 pa2, bf16x8 pa3) {
#define TRRD(dst, off) asm volatile("ds_read_b64_tr_b16 %0, %1 offset:%2" : "=&v"(dst) : "v"(vb0), "i"(off) : "memory")
#define PV_RD(d0, X) do { constexpr int b_ = VB * SHM_V + v_rd_off(d0, 0, 0); \
        TRRD(X##l0, b_); TRRD(X##h0, b_ + 2048); TRRD(X##l1, b_ + 4096); TRRD(X##h1, b_ + 6144); TRRD(X##l2, b_ + 8192); TRRD(X##h2, b_ + 10240); TRRD(X##l3, b_ + 12288); TRRD(X##h3, b_ + 14336); } while (0)
#define PV_MM(d0, X) do { \
        o[d0] = __builtin_amdgcn_mfma_f32_32x32x16_bf16(pa0, (bf16x8){X##l0[0], X##l0[1], X##l0[2], X##l0[3], X##h0[0], X##h0[1], X##h0[2], X##h0[3]}, o[d0], 0, 0, 0);   \
        o[d0] = __builtin_amdgcn_mfma_f32_32x32x16_bf16(pa1, (bf16x8){X##l1[0], X##l1[1], X##l1[2], X##l1[3], X##h1[0], X##h1[1], X##h1[2], X##h1[3]}, o[d0], 0, 0, 0);   \
        o[d0] = __builtin_amdgcn_mfma_f32_32x32x16_bf16(pa2, (bf16x8){X##l2[0], X##l2[1], X##l2[2], X##l2[3], X##h2[0], X##h2[1], X##h2[2], X##h2[3]}, o[d0], 0, 0, 0);   \
        o[d0] = __builtin_amdgcn_mfma_f32_32x32x16_bf16(pa3, (bf16x8){X##l3[0], X##l3[1], X##l3[2], X##l3[3], X##h3[0], X##h3[1], X##h3[2], X##h3[3]}, o[d0], 0, 0, 0); } while (0)
#define PV_WAIT(n) do { asm volatile("s_waitcnt lgkmcnt(" #n ")" ::: "memory"); SBAR(); } while (0)
    { s16x4 al0, al1, al2, al3, ah0, ah1, ah2, ah3, bl0, bl1, bl2, bl3, bh0, bh1, bh2, bh3;
      PV_RD(0, a); PV_RD(1, b);
      PV_WAIT(8); PV_MM(0, a); SBAR(); PV_RD(2, a);
      PV_WAIT(8); PV_MM(1, b); SBAR(); PV_RD(3, b);
      PV_WAIT(8); PV_MM(2, a);
      PV_WAIT(0); PV_MM(3, b); }
#undef PV_RD
#undef PV_MM
#undef PV_WAIT
#undef TRRD
}
struct BlockRef { const bf16* Q; const bf16* K; const bf16* V; bf16* O; const float* KM; int P0; };
struct Seam { bf16x8 qr[8]; bf16x8 st_v0, st_v1, st_k0, st_k1; };
#define ROW(p, k0, rr) ((p) + (size_t)((k0) + (rr)) * TS + sc)
#define VMW() asm volatile("s_waitcnt vmcnt(0)" ::: "memory")
#define VMWN(n) asm volatile("s_waitcnt vmcnt(%0)" :: "i"(n) : "memory")
#define SLOAD_H(Kp, Vp, k0) do { S.st_v0 = load8(ROW(Vp, k0, sr)); S.st_v1 = load8(ROW(Vp, k0, 32 + sr));              \
                         S.st_k0 = load8(ROW(Kp, k0, sr)); S.st_k1 = load8(ROW(Kp, k0, 32 + sr)); } while (0)
#define SWRITE_HK(bf) do { *(bf16x8*)(K_lds + (bf) * SHM_K + kws) = S.st_k0; *(bf16x8*)(K_lds + (bf) * SHM_K + kws + 32 * 256) = S.st_k1; } while (0)
#define SWRITE_HV(bf) do { *(bf16x8*)(V_lds + (bf) * SHM_V + vst0) = S.st_v0; *(bf16x8*)(V_lds + (bf) * SHM_V + vst1) = S.st_v1; } while (0)
#define SWRITE_H(bf) do { SWRITE_HV(bf); SWRITE_HK(bf); } while (0)
__device__ __forceinline__ void moba_prime(const BlockRef& cur, char* lds, Seam& S) {
    const int tid = threadIdx.x, wid = __builtin_amdgcn_readfirstlane(tid >> 6), lane = tid & 63, r32 = lane & 31, hi = lane >> 5;
    const int sr = tid >> 4, sc = (tid & 15) * 8, kws = KSWZ(sr, sc * 2); char* K_lds = lds + 2 * SHM_V;
#pragma unroll
    for (int d0 = 0; d0 < 8; ++d0) S.qr[d0] = load8(cur.Q + (size_t)(wid * QBLK + r32) * TS + d0 * 16 + hi * 8);
    SLOAD_H(cur.K, cur.V, 0); VMW(); SWRITE_HK(0);
    __syncthreads();
}
__device__ __forceinline__ void moba_block(const BlockRef& cur, const BlockRef& nxt, char* lds, Seam& S) {
    const int tid = threadIdx.x, wid = __builtin_amdgcn_readfirstlane(tid >> 6), lane = tid & 63, r32 = lane & 31, hi = lane >> 5;
    const int NT = cur.P0 / KVBLK + QB / KVBLK;
    const int qlo = cur.P0 + wid * QBLK, qm = qlo + r32 - 4 * hi;
    char* V_lds = lds; char* K_lds = lds + 2 * SHM_V;
    float* ws = (float*)(lds + 2 * SHM_V + 2 * SHM_K) + wid * 64; float* li_l = ws, * al_l = ws + 32;
    int sel = 0xff; const int qb = cur.P0 >> 8;
    if (qb > 3) {
        float g[7];
#pragma unroll
        for (int j = 0; j < 7; ++j) { float s = -__builtin_inff();
            asm volatile("" ::: "memory");
            if (j < qb) { int hoff = hi * 8; asm volatile("" : "+v"(hoff)); const float* km = cur.KM + j * HD + hoff; s = 0.f;
#pragma unroll
                for (int d0 = 0; d0 < 8; ++d0) { const f32x4 k0 = *(const f32x4*)(km + d0 * 16), k1 = *(const f32x4*)(km + d0 * 16 + 4); const bf16x8 qv = S.qr[d0];
                    s += bf2f((unsigned short)qv[0]) * k0[0] + bf2f((unsigned short)qv[1]) * k0[1] + bf2f((unsigned short)qv[2]) * k0[2] + bf2f((unsigned short)qv[3]) * k0[3]
                       + bf2f((unsigned short)qv[4]) * k1[0] + bf2f((unsigned short)qv[5]) * k1[1] + bf2f((unsigned short)qv[6]) * k1[2] + bf2f((unsigned short)qv[7]) * k1[3]; }
                auto rr = __builtin_amdgcn_permlane32_swap(__float_as_uint(s), __float_as_uint(s), false, false); s = __uint_as_float(rr[0]) + __uint_as_float(rr[1]); }
            g[j] = s; }
        sel = 0;
#pragma unroll
        for (int j = 0; j < 7; ++j) { int rank = 0;
#pragma unroll
            for (int k = 0; k < 7; ++k) if (k != j) rank += (g[k] > g[j] || (g[k] == g[j] && k < j)) ? 1 : 0;
            if (j < qb && rank < 3) sel |= 1 << j; }
        sel |= 1 << qb;
    }
    float m_reg = -1e30f, l_reg = 0; f32x16 o[4] = {};
    const int sr = tid >> 4, sc = (tid & 15) * 8, vst0 = v_st(sr, sc), vst1 = v_st(32 + sr, sc), kws = KSWZ(sr, sc * 2);
    const int vb0 = (int)(uintptr_t)V_lds + v_rd_base(lane);
    const bf16* Kh = cur.K; const bf16* Vh = cur.V;
#define RESC(a) do { if (__any((a) < 1.f)) { if (hi == 0) al_l[r32] = (a); asm volatile("s_waitcnt lgkmcnt(0)" ::: "memory");              \
                     for (int d_ = 0; d_ < 4; ++d_) for (int r = 0; r < 16; ++r) o[d_][r] *= al_l[crow(r, hi)]; } } while (0)
#define KBASE(t) ((t) * KVBLK)
#define MASKT(P0_, P1_, t) do { const int kb_ = KBASE(t); if (kb_ + KVBLK - 1 > qlo) mask_tile(P0_, P1_, qm - kb_); \
        dropT = (kb_ < cur.P0) && ((sel >> (kb_ >> 8)) & 1) == 0; } while (0)
    constexpr int NQL = 8;
#define SEAM_K0() do { VMWN(NQL); SWRITE_HK(0); SBAR(); } while (0)
    f32x16 pA0, pA1, pB0, pB1; float mnA, mnB, alA, alB; bf16x8 pa0, pa1, pa2, pa3; bool dropT = false;
    SWRITE_HV(0); SBAR();
    if (NT > 1) SLOAD_H(Kh, Vh, KBASE(1));
    SBAR(); qkt<0>(pA0, pA1, K_lds, r32, hi, S.qr);
    MASKT(pA0, pA1, 0); partialSM(pA0, pA1, m_reg, mnA, alA, dropT);
    if (NT > 1) { VMW(); SWRITE_H(1); }
    __syncthreads();
#define HALF_STEP(PX0, PX1, mnX, alX, PY0, PY1, alY, t, KB, VB, SB) do {                                                      \
        SBAR(); qkt<KB>(PX0, PX1, K_lds, r32, hi, S.qr);                                                                      \
        finishSM(PY0, PY1, alY, l_reg, pa0, pa1, pa2, pa3); SBAR();                                                           \
        if ((t) + 1 < NT) { SLOAD_H(Kh, Vh, KBASE((t) + 1)); SBAR(); }                                                        \
        pv_tile<VB>(o, vb0, pa0, pa1, pa2, pa3); MASKT(PX0, PX1, (t)); partialSM(PX0, PX1, m_reg, mnX, alX, dropT);            \
        __syncthreads();                                                                                                      \
        if ((t) + 1 < NT) { VMW(); SWRITE_H(SB); }                                                                            \
        RESC(alX); __syncthreads(); } while (0)
    for (int t = 1; t + 1 < NT; t += 2) {
        HALF_STEP(pB0, pB1, mnB, alB, pA0, pA1, alA, t, 1, 0, 0);
        HALF_STEP(pA0, pA1, mnA, alA, pB0, pB1, alB, t + 1, 0, 1, 1);
    }
    SBAR(); qkt<1>(pB0, pB1, K_lds, r32, hi, S.qr); SBAR();
    SLOAD_H(nxt.K, nxt.V, 0); SBAR();
#pragma unroll
    for (int d0 = 0; d0 < 8; ++d0) S.qr[d0] = load8(nxt.Q + (size_t)(wid * QBLK + r32) * TS + d0 * 16 + hi * 8);
    SBAR();
    finishSM(pA0, pA1, alA, l_reg, pa0, pa1, pa2, pa3); SBAR();
    pv_tile<0>(o, vb0, pa0, pa1, pa2, pa3);
    MASKT(pB0, pB1, NT - 1); partialSM(pB0, pB1, m_reg, mnB, alB, dropT); __syncthreads(); RESC(alB);
    finishSM(pB0, pB1, alB, l_reg, pa0, pa1, pa2, pa3); SBAR(); pv_tile<1>(o, vb0, pa0, pa1, pa2, pa3);
    SBAR(); SEAM_K0();
    if (hi == 0) li_l[r32] = l_reg; asm volatile("s_waitcnt lgkmcnt(0)" ::: "memory");
    float rli[16];
#pragma unroll
    for (int r = 0; r < 16; ++r) rli[r] = __builtin_amdgcn_rcpf(li_l[crow(r, hi)]);
    bf16* Ow = cur.O + (size_t)(wid * QBLK) * TS;
#pragma unroll
    for (int r = 0; r < 16; ++r) { const int orow = crow(r, hi);
#pragma unroll
        for (int d0 = 0; d0 < 4; ++d0) { const float v = o[d0][r] * rli[r];
            const float vn = __shfl_xor(v, 1);
            if ((r32 & 1) == 0) *(unsigned*)(Ow + (size_t)orow * TS + d0 * 32 + r32) = cvt_pk_bf16(v, vn); } }
    __syncthreads();
#undef RESC
#undef KBASE
#undef MASKT
#undef SEAM_K0
#undef HALF_STEP
}
#undef ROW
#undef VMW
#undef VMWN
#undef SLOAD_H
#undef SWRITE_HK
#undef SWRITE_HV
#undef SWRITE_H
}

#define XB_TMO      128
#define XB_XCNT(j)  (256  + 64 * (j))
#define XB_XSUB(j)  (1280 + 64 * (j))
#define XB_XGEN(j)  (2304 + 64 * (j))
#define XB_TOP      3328
#define XB_TOPGEN   3392
#define XCD_BAR_WORDS 3456
#define XB_SPIN_CAP (1u << 18)
__device__ __forceinline__ unsigned xb_ld(unsigned* p)              { return __hip_atomic_load(p, __ATOMIC_RELAXED, __HIP_MEMORY_SCOPE_AGENT); }
__device__ __forceinline__ unsigned xb_add(unsigned* p, unsigned v) { return __hip_atomic_fetch_add(p, v, __ATOMIC_RELAXED, __HIP_MEMORY_SCOPE_AGENT); }
__device__ __forceinline__ unsigned xb_xcc_id() { return (unsigned)__builtin_amdgcn_s_getreg((3 << 11) | 20) & 0xFu; }
#define XB_SPIN(cond, bar) do { unsigned _sp = 0; while (cond) { __builtin_amdgcn_s_sleep(1); \
    if ((++_sp & 255u) == 0u) { if (xb_ld(&(bar)[XB_TMO])) break; if (_sp > XB_SPIN_CAP) { atomicAdd(&(bar)[XB_TMO], 1u); break; } } } } while (0)
struct XcdBarrier { unsigned* bar; unsigned x; volatile LAS unsigned* st; };
__device__ __forceinline__ XcdBarrier xcd_barrier_post(unsigned* bar, volatile LAS unsigned* st) {
    XcdBarrier b; b.bar = bar; b.x = xb_xcc_id(); b.st = st;
    if (threadIdx.x == 0) (void)xb_add(&bar[XB_XCNT(b.x)], 1u);
    return b;
}
__device__ __forceinline__ void xcd_barrier_complete(unsigned* bar, unsigned x, unsigned& nloc, unsigned& nx) {
    const unsigned G = gridDim.x * gridDim.y * gridDim.z;
    unsigned sum, cnt, mine, sp = 0u;
    for (;;) {
        sum = 0u; cnt = 0u;
#pragma unroll 1
        for (unsigned j = 0; j < 16; ++j) { const unsigned c = xb_ld(&bar[XB_XCNT(j)]); sum += c; cnt += (c > 0u) ? 1u : 0u; }
        if (sum == G) break;
        __builtin_amdgcn_s_sleep(1);
        if ((++sp & 255u) == 0u) { if (xb_ld(&bar[XB_TMO])) break; if (sp > XB_SPIN_CAP) { atomicAdd(&bar[XB_TMO], 1u); break; } }
    }
    mine = xb_ld(&bar[XB_XCNT(x)]);
    nloc = mine > 0u ? mine : 1u; nx = cnt > 0u ? cnt : 1u;
}
__device__ __forceinline__ void xcd_barrier(const XcdBarrier& b) {
    asm volatile("s_waitcnt vmcnt(0)" ::: "memory");
    __syncthreads();
    if (threadIdx.x == 0) {
        unsigned* bar = b.bar;
        __builtin_amdgcn_s_waitcnt(0);
        unsigned nloc = b.st[0], nx = b.st[1];
        if (nloc == 0u) { xcd_barrier_complete(bar, b.x, nloc, nx); b.st[0] = nloc; b.st[1] = nx; }
        const unsigned old = xb_add(&bar[XB_XSUB(b.x)], 1u);
        const unsigned gen = old / nloc;
        if (old + 1u == (gen + 1u) * nloc) {
            __builtin_amdgcn_fence(__ATOMIC_RELEASE, "agent");
            asm volatile("s_waitcnt vmcnt(0)" ::: "memory");
            const unsigned og = xb_add(&bar[XB_TOP], 1u);
            const unsigned tg = og / nx;
            if (og + 1u == (tg + 1u) * nx) xb_add(&bar[XB_TOPGEN], 1u);
            else XB_SPIN(xb_ld(&bar[XB_TOPGEN]) == tg, bar);
            __builtin_amdgcn_fence(__ATOMIC_ACQUIRE, "agent");
            xb_add(&bar[XB_XGEN(b.x)], 1u);
            asm volatile("s_waitcnt vmcnt(0)" ::: "memory");
        } else {
            XB_SPIN(xb_ld(&bar[XB_XGEN(b.x)]) == gen, bar);
            __builtin_amdgcn_fence(__ATOMIC_ACQUIRE, "agent");
            asm volatile("s_waitcnt vmcnt(0)" ::: "memory");
        }
    }
    __syncthreads();
}

struct Frame {
    LAS unsigned char* lds; volatile LAS unsigned* MISC; unsigned* ctl;
    int tid, lane, wave, vcu, G, bx, lo, hi;
    unsigned char* ws;
};
struct Args { const void* in[24]; float* out; unsigned char* ws; int ph_lo, ph_hi; };
typedef const __attribute__((address_space(4))) Args* KArgs;
__device__ __forceinline__ KArgs kargs() { KArgs p = (KArgs)__builtin_amdgcn_kernarg_segment_ptr(); asm volatile("" : "+s"(p)); return p; }
__device__ __forceinline__ void refresh(Frame& F) {
    KArgs k = kargs();
    int t = threadIdx.x; asm volatile("" : "+v"(t)); F.tid = t; F.lane = t & 63; F.wave = __builtin_amdgcn_readfirstlane(t >> 6);
    int g = gridDim.x, bx = blockIdx.x; asm volatile("" : "+s"(g), "+s"(bx)); F.G = g; F.bx = bx; F.vcu = (g % 8 == 0) ? (bx % 8) * (g / 8) + bx / 8 : bx;
    F.ws = k->ws; F.ctl = (unsigned*)(F.ws + WS_CTL); F.lo = k->ph_lo; F.hi = k->ph_hi;
    F.lds = (LAS unsigned char*)0; F.MISC = (volatile LAS unsigned*)(F.lds + MISC_OFF);
}
__device__ __forceinline__ XcdBarrier frame_bar(Frame& F) { XcdBarrier b; b.bar = F.ctl + CW_BAR; b.x = xb_xcc_id(); b.st = F.MISC + 8; return b; }
enum { I_X = 0, I_POS, I_NORMS, I_LAMRE, I_LAMIM, I_LOGDT, I_BRE, I_BIM, I_CRE, I_CIM, I_SD, I_WGLU, I_KVN, I_WKV, I_WQ, I_WO, I_FW1, I_FW3, I_FW2, I_ROUTER, I_RBIAS, I_MW1, I_MW3, I_MW2 };

__device__ __forceinline__ int rot32(int d) { return 8 * ((d & 15) >> 2) + 2 * (d & 3) + (d >> 4); }
constexpr int NKIND = 31;
struct WK { const float* W; const float* gain; unsigned char* dst; unsigned* colmax; float* psq; int ldw, K, N, mode, base, which, ot; };
__device__ __forceinline__ void wk_get(KArgs ap, unsigned char* ws, int kind, WK& k) {
    const auto& a = *ap; const float* norms = (const float*)a.in[I_NORMS]; k.gain = nullptr; k.colmax = nullptr; k.psq = nullptr; k.mode = 0; k.base = 0; k.which = 0; k.ot = 0; k.ldw = DM; k.K = DM; k.N = DM;
    if (kind == 0) { k.W = (const float*)a.in[I_WGLU]; k.ldw = 2 * DM; k.N = 2 * DM; k.dst = ws + WS_WGLU; k.mode = 3; }
    else if (kind == 1) { k.W = (const float*)a.in[I_WQ]; k.gain = norms + 4 * DM; k.mode = 2; k.ot = MK_QKV8; k.dst = MK_QKV8 ? ws + WS_WQQKV : ws + WS_WQKV; k.colmax = (unsigned*)(ws + WS_COLMAX_QKV); }
    else if (kind == 2) { k.W = (const float*)a.in[I_WKV]; k.ldw = 2 * DM; k.N = 2 * DM; k.gain = (const float*)a.in[I_KVN]; k.mode = 4; k.base = DM; k.ot = MK_QKV8; k.dst = MK_QKV8 ? ws + WS_WQQKV : ws + WS_WQKV; k.colmax = (unsigned*)(ws + WS_COLMAX_QKV); }
    else if (kind == 3) { k.W = (const float*)a.in[I_WO]; k.dst = ws + WS_WO; }
    else if (kind == 4 || kind == 5) { k.W = (const float*)a.in[kind == 4 ? I_FW1 : I_FW3]; k.ldw = FFD; k.N = FFD; k.gain = norms + 2 * DM; k.mode = 1; k.which = kind - 4; k.ot = 1; k.dst = ws + WS_WQF13; k.colmax = (unsigned*)(ws + WS_COLMAX_F); k.psq = (float*)(ws + WS_PSQD); }
    else if (kind == 6) { k.W = (const float*)a.in[I_FW2]; k.K = FFD; k.dst = ws + WS_WF2; if (MK_FFN2F8) { k.ot = 2; k.colmax = (unsigned*)(ws + WS_COLMAX_W2) + NE * DM; } }
    else if (kind < 23) { const int e = (kind - 7) & 7, wh = (kind - 7) >> 3; k.W = (const float*)a.in[wh ? I_MW3 : I_MW1] + (size_t)e * DM * FFE; k.ldw = FFE; k.N = FFE; k.gain = norms + 6 * DM; k.mode = 1; k.which = wh; k.ot = 1;
        k.dst = ws + WS_WQ13 + (size_t)e * 2 * FFE * DM; k.colmax = (unsigned*)(ws + WS_COLMAX) + e * 2 * FFE; k.psq = (float*)(ws + WS_PSQ) + e * 2 * FFE; }
    else { const int e = kind - 23; k.W = (const float*)a.in[I_MW2] + (size_t)e * FFE * DM; k.K = FFE; k.ot = 2; k.dst = ws + WS_W8M2 + (size_t)e * DM * FFE; k.colmax = (unsigned*)(ws + WS_COLMAX_W2) + e * DM; }
}
__device__ __forceinline__ int wk_drow(const WK& k, int n) {
    if (k.mode == 1) return (n >> 7) * 256 + k.which * 128 + (n & 127);
    if (k.mode == 3) { const int chn = n & 1023; return (chn >> 7) * 256 + (n >> 10) * 128 + (chn & 127); }
    if (k.mode == 2 || (k.mode == 4 && n < DM)) { const int d = n & 127; return k.base + (n & ~127) + (d < 32 ? rot32(d) : d); }
    return k.base + n;
}
__device__ __forceinline__ int wk_f8ex(float cm) { int ex = 0; if (cm > 0.f) { ex = 134 - (int)((__float_as_uint(cm) >> 23) & 0xffu); ex = ex < -60 ? -60 : (ex > 60 ? 60 : ex); } return ex; }
__device__ __forceinline__ unsigned q8(float x) { int q = (int)rintf(x); q = q < -127 ? -127 : (q > 127 ? 127 : q); return (unsigned)q & 0xffu; }
__device__ __forceinline__ unsigned q8x4(float a, float b, float c, float d, float f) {
    unsigned p = 0;
    p = __builtin_amdgcn_cvt_pk_u8_f32(rintf(fmaf(a, f, 128.0f)), 0, p); p = __builtin_amdgcn_cvt_pk_u8_f32(rintf(fmaf(b, f, 128.0f)), 1, p);
    p = __builtin_amdgcn_cvt_pk_u8_f32(rintf(fmaf(c, f, 128.0f)), 2, p); p = __builtin_amdgcn_cvt_pk_u8_f32(rintf(fmaf(d, f, 128.0f)), 3, p);
    return p ^ 0x80808080u;
}
__device__ __forceinline__ void wk_stats_item(const WK& k, int kb, int nb, int lane) {
    const int nc = nb * 256 + 4 * lane; float mx[4] = {0.f, 0.f, 0.f, 0.f}, sq[4] = {0.f, 0.f, 0.f, 0.f};
#pragma unroll 1
    for (int i0 = 0; i0 < 64; i0 += 16) { f32x4 v[16];
#pragma unroll
        for (int i = 0; i < 16; ++i) v[i] = *(const f32x4*)(k.W + (size_t)(kb * 64 + i0 + i) * k.ldw + nc);
#pragma unroll
        for (int i = 0; i < 16; ++i) { const float gs = k.gain ? k.gain[kb * 64 + i0 + i] : 1.0f;
#pragma unroll
            for (int c = 0; c < 4; ++c) { const float x = v[i][c] * gs; mx[c] = fmaxf(mx[c], fabsf(x)); sq[c] += x * x; } } }
#pragma unroll
    for (int c = 0; c < 4; ++c) { const int dr = wk_drow(k, nc + c); atomicMax(k.colmax + dr, __float_as_uint(mx[c])); if (k.psq) k.psq[(size_t)kb * (NE * 2 * FFE) + dr] = sq[c]; }
}
__device__ __forceinline__ void wk_item(const WK& k, int kb, int nb, int* sb8, LAS float* scr, int lane) {
    const int k0 = kb * 64, n0 = nb * 64;
    f32x4 v[16]; const int r4 = lane >> 4, c4 = (lane & 15) * 4;
#pragma unroll
    for (int i = 0; i < 16; ++i) v[i] = *(const f32x4*)(k.W + (size_t)(k0 + 4 * i + r4) * k.ldw + n0 + c4);
    const int k8 = lane & 3, nl = lane >> 2;
    int dr[4]; float qs[4];
#pragma unroll
    for (int st = 0; st < 4; ++st) { dr[st] = wk_drow(k, n0 + 16 * st + nl); qs[st] = 1.0f;
        if (k.ot == 1) { const float cm = __uint_as_float(k.colmax[dr[st]]); qs[st] = cm > 0.f ? 127.0f / cm : 0.f; }
        if (k.ot == 2) { const int ex = wk_f8ex(__uint_as_float(k.colmax[dr[st]])); qs[st] = __builtin_bit_cast(float, (unsigned)(127 + ex) << 23); if (kb == 0 && k8 == 0) sb8[dr[st]] = 127 - ex; } }
#pragma unroll
    for (int hf = 0; hf < 2; ++hf) {
#pragma unroll
        for (int i = 0; i < 8; ++i) { const int kk = 4 * i + r4; const float gs = k.gain ? k.gain[k0 + hf * 32 + kk] : 1.0f; LAS float* d = scr + kk * 65 + c4; const f32x4 x = v[hf * 8 + i];
            d[0] = x.x * gs; d[1] = x.y * gs; d[2] = x.z * gs; d[3] = x.w * gs; }
        LDS_WAIT(); asm volatile("" ::: "memory");
#pragma unroll
        for (int st = 0; st < 4; ++st) { const int n = 16 * st + nl; const LAS float* sp = scr + (8 * k8) * 65 + n; const float f = qs[st];
            if (k.ot == 0) { v4u o; o.x = cvt_pk_bf16(sp[0 * 65], sp[1 * 65]); o.y = cvt_pk_bf16(sp[2 * 65], sp[3 * 65]); o.z = cvt_pk_bf16(sp[4 * 65], sp[5 * 65]); o.w = cvt_pk_bf16(sp[6 * 65], sp[7 * 65]);
                *(v4u*)((bf16*)k.dst + (size_t)dr[st] * k.K + k0 + hf * 32 + 8 * k8) = o; }
            else { v2u o;
                if (k.ot == 1) { o.x = q8x4(sp[0 * 65], sp[1 * 65], sp[2 * 65], sp[3 * 65], f); o.y = q8x4(sp[4 * 65], sp[5 * 65], sp[6 * 65], sp[7 * 65], f); }
                else { int p0 = __builtin_amdgcn_cvt_pk_fp8_f32(sp[0 * 65] * f, sp[1 * 65] * f, 0, false); p0 = __builtin_amdgcn_cvt_pk_fp8_f32(sp[2 * 65] * f, sp[3 * 65] * f, p0, true);
                       int p1 = __builtin_amdgcn_cvt_pk_fp8_f32(sp[4 * 65] * f, sp[5 * 65] * f, 0, false); p1 = __builtin_amdgcn_cvt_pk_fp8_f32(sp[6 * 65] * f, sp[7 * 65] * f, p1, true); o.x = (unsigned)p0; o.y = (unsigned)p1; }
                *(v2u*)(k.dst + (size_t)dr[st] * k.K + k0 + hf * 32 + 8 * k8) = o; } }
        LDS_WAIT(); asm volatile("" ::: "memory");
    }
}
__device__ __forceinline__ void wk_shape(int kind, int& nkb, int& nn, bool& quant) {
    nkb = DM / 64; nn = DM; quant = false;
    if (kind == 0) nn = 2 * DM;
    else if (kind == 1) quant = MK_QKV8 != 0;
    else if (kind == 2) { nn = 2 * DM; quant = MK_QKV8 != 0; }
    else if (kind == 4 || kind == 5) { nn = FFD; quant = true; }
    else if (kind == 6) { nkb = FFD / 64; quant = MK_FFN2F8 != 0; }
    else if (kind >= 7 && kind < 23) { nn = FFE; quant = true; }
    else if (kind >= 23) { nkb = FFE / 64; quant = true; }
}
template <bool GAIN> __device__ __forceinline__ void wk_tile_stats(const WK& k, int kb, int r4, const f32x4 (&v)[16], float (&mx)[4], float (&sq)[4]) {
    const float* gp = GAIN ? k.gain + kb * 64 + 16 * r4 : nullptr; if (GAIN) asm volatile("" : "+v"(gp));
#pragma unroll
    for (int i = 0; i < 16; ++i) { const float gs = GAIN ? gp[i] : 1.0f;
#pragma unroll
        for (int c = 0; c < 4; ++c) { const float x = v[i][c] * gs; mx[c] = fmaxf(mx[c], fabsf(x)); sq[c] += x * x; } }
}
template <bool GAIN> __device__ __forceinline__ void wk_tile_out(const WK& k, int kb, int r4, const f32x4 (&v)[16], const int (&dr)[4], const float (&qs)[4]) {
    const float* gp = GAIN ? k.gain + kb * 64 + 16 * r4 : nullptr; if (GAIN) asm volatile("" : "+v"(gp));
    float g[16];
#pragma unroll
    for (int i = 0; i < 16; ++i) g[i] = GAIN ? gp[i] : 1.0f;
#pragma unroll
    for (int c = 0; c < 4; ++c) { const float f = qs[c]; v4u o;
        if (k.ot == 1) { o.x = q8x4(v[0][c] * g[0], v[1][c] * g[1], v[2][c] * g[2], v[3][c] * g[3], f); o.y = q8x4(v[4][c] * g[4], v[5][c] * g[5], v[6][c] * g[6], v[7][c] * g[7], f);
                         o.z = q8x4(v[8][c] * g[8], v[9][c] * g[9], v[10][c] * g[10], v[11][c] * g[11], f); o.w = q8x4(v[12][c] * g[12], v[13][c] * g[13], v[14][c] * g[14], v[15][c] * g[15], f); }
        else { unsigned w[4];
#pragma unroll
            for (int q = 0; q < 4; ++q) { int pw = __builtin_amdgcn_cvt_pk_fp8_f32(v[4 * q][c] * g[4 * q] * f, v[4 * q + 1][c] * g[4 * q + 1] * f, 0, false);
                pw = __builtin_amdgcn_cvt_pk_fp8_f32(v[4 * q + 2][c] * g[4 * q + 2] * f, v[4 * q + 3][c] * g[4 * q + 3] * f, pw, true); w[q] = (unsigned)pw; }
            o.x = w[0]; o.y = w[1]; o.z = w[2]; o.w = w[3]; }
        *(v4u*)(k.dst + (size_t)dr[c] * k.K + kb * 64 + 16 * r4) = o; }
}
#define SCHED_FENCE() __builtin_amdgcn_sched_barrier(0)
template <int TPW> __device__ __forceinline__ void wk_super(const WK& k, Frame& F, int sbslot, int nb) {
    LAS float* smax = (LAS float*)(F.lds + F.wave * 16384) + 2080; LAS float* ssq = smax + 64;
    const int lane = F.lane, r4 = lane >> 4, c4 = (lane & 15) * 4, tpw = TPW;
    const float* wbase = k.W + (size_t)(16 * r4) * k.ldw + nb * 64 + c4;
#define WK_LOAD(v, kb) do { const float* p_ = wbase + (size_t)((kb) * 64) * k.ldw; _Pragma("unroll") for (int i_ = 0; i_ < 16; ++i_) { v[i_] = *(const f32x4*)p_; p_ += k.ldw; asm volatile("" : "+v"(p_)); } } while (0)
    float mx[4] = {0.f, 0.f, 0.f, 0.f}, sq[4] = {0.f, 0.f, 0.f, 0.f};
    f32x4 va[16], vb[16];
    const int kbase = F.wave * tpw;
    if constexpr (TPW == 2) { WK_LOAD(va, kbase); WK_LOAD(vb, kbase + 1); wk_tile_stats<TPW == 2>(k, kbase, r4, va, mx, sq); wk_tile_stats<TPW == 2>(k, kbase + 1, r4, vb, mx, sq); }
    else {
        static_assert(TPW == 2 || TPW == 7, "tile schedule below is written for 7 tiles");
        WK_LOAD(va, kbase);
#pragma unroll 1
        for (int t = 0; t < 6; t += 2) { WK_LOAD(vb, kbase + t + 1); SCHED_FENCE(); wk_tile_stats<TPW == 2>(k, kbase + t, r4, va, mx, sq); SCHED_FENCE(); WK_LOAD(va, kbase + t + 2); SCHED_FENCE(); wk_tile_stats<TPW == 2>(k, kbase + t + 1, r4, vb, mx, sq); SCHED_FENCE(); }
        wk_tile_stats<TPW == 2>(k, kbase + 6, r4, va, mx, sq); }
#pragma unroll
    for (int c = 0; c < 4; ++c) { mx[c] = fmaxf(mx[c], __shfl_xor(mx[c], 16)); mx[c] = fmaxf(mx[c], __shfl_xor(mx[c], 32)); sq[c] += __shfl_xor(sq[c], 16); sq[c] += __shfl_xor(sq[c], 32); }
    if (lane < 16) {
#pragma unroll
        for (int c = 0; c < 4; ++c) { smax[c4 + c] = mx[c]; ssq[c4 + c] = sq[c]; } }
    __syncthreads();
    int dr[4]; float qs[4];
#pragma unroll
    for (int c = 0; c < 4; ++c) { const int n = c4 + c; float cm = 0.f;
#pragma unroll
        for (int w = 0; w < NWAVES; ++w) cm = fmaxf(cm, ((const LAS float*)(F.lds + w * 16384))[2080 + n]);
        dr[c] = wk_drow(k, nb * 64 + n); qs[c] = 1.0f;
        if (k.ot == 1) qs[c] = cm > 0.f ? 127.0f / cm : 0.f;
        if (k.ot == 2) { const int ex = wk_f8ex(cm); qs[c] = __builtin_bit_cast(float, (unsigned)(127 + ex) << 23); } }
    if (F.tid < 64) { const int n = F.tid; float cm = 0.f, ss = 0.f;
#pragma unroll
        for (int w = 0; w < NWAVES; ++w) { cm = fmaxf(cm, ((const LAS float*)(F.lds + w * 16384))[2080 + n]); ss += ((const LAS float*)(F.lds + w * 16384))[2144 + n]; }
        const int d = wk_drow(k, nb * 64 + n); k.colmax[d] = __float_as_uint(cm); if (k.psq) k.psq[d] = ss;
        if (k.ot == 2) ((int*)(F.ws + WS_SB8))[sbslot * DM + d] = 127 - wk_f8ex(cm); }
    if constexpr (TPW == 2) { wk_tile_out<TPW == 2>(k, kbase, r4, va, dr, qs); wk_tile_out<TPW == 2>(k, kbase + 1, r4, vb, dr, qs); }
    else {
        wk_tile_out<TPW == 2>(k, kbase + 6, r4, va, dr, qs); SCHED_FENCE();
        WK_LOAD(va, kbase + 4); SCHED_FENCE(); wk_tile_out<TPW == 2>(k, kbase + 5, r4, vb, dr, qs); SCHED_FENCE();
#pragma unroll 1
        for (int t = 4; t >= 2; t -= 2) { WK_LOAD(vb, kbase + t - 1); SCHED_FENCE(); wk_tile_out<TPW == 2>(k, kbase + t, r4, va, dr, qs); SCHED_FENCE(); WK_LOAD(va, kbase + t - 2); SCHED_FENCE(); wk_tile_out<TPW == 2>(k, kbase + t - 1, r4, vb, dr, qs); SCHED_FENCE(); }
        wk_tile_out<TPW == 2>(k, kbase, r4, va, dr, qs); }
#undef WK_LOAD
    __syncthreads();
}
__device__ __forceinline__ void wk_super_g(const WK& k, Frame& F, int sbslot, int nb) {
    LAS float* smax = (LAS float*)(F.lds + F.wave * 16384) + 2080; LAS float* ssq = smax + 64;
    const int lane = F.lane, r4 = lane >> 4, c4 = (lane & 15) * 4, nkb = k.K / 64;
    const float* wbase = k.W + (size_t)(16 * r4) * k.ldw + nb * 64 + c4;
#define WK_LOAD(v, kb) do { const float* p_ = wbase + (size_t)((kb) * 64) * k.ldw; _Pragma("unroll") for (int i_ = 0; i_ < 16; ++i_) { v[i_] = *(const f32x4*)p_; p_ += k.ldw; asm volatile("" : "+v"(p_)); } } while (0)
    float mx[4] = {0.f, 0.f, 0.f, 0.f}, sq[4] = {0.f, 0.f, 0.f, 0.f};
    f32x4 va[16];
#pragma unroll 1
    for (int kb = F.wave; kb < nkb; kb += NWAVES) { WK_LOAD(va, kb); wk_tile_stats<false>(k, kb, r4, va, mx, sq); }
#pragma unroll
    for (int c = 0; c < 4; ++c) { mx[c] = fmaxf(mx[c], __shfl_xor(mx[c], 16)); mx[c] = fmaxf(mx[c], __shfl_xor(mx[c], 32)); sq[c] += __shfl_xor(sq[c], 16); sq[c] += __shfl_xor(sq[c], 32); }
    if (lane < 16) {
#pragma unroll
        for (int c = 0; c < 4; ++c) { smax[c4 + c] = mx[c]; ssq[c4 + c] = sq[c]; } }
    __syncthreads();
    int dr[4]; float qs[4];
#pragma unroll
    for (int c = 0; c < 4; ++c) { const int n = c4 + c; float cm = 0.f;
#pragma unroll
        for (int w = 0; w < NWAVES; ++w) cm = fmaxf(cm, ((const LAS float*)(F.lds + w * 16384))[2080 + n]);
        dr[c] = wk_drow(k, nb * 64 + n); const int ex = wk_f8ex(cm); qs[c] = __builtin_bit_cast(float, (unsigned)(127 + ex) << 23); }
    if (F.tid < 64) { const int n = F.tid; float cm = 0.f;
#pragma unroll
        for (int w = 0; w < NWAVES; ++w) cm = fmaxf(cm, ((const LAS float*)(F.lds + w * 16384))[2080 + n]);
        const int d = wk_drow(k, nb * 64 + n); k.colmax[d] = __float_as_uint(cm); ((int*)(F.ws + WS_SB8))[sbslot * DM + d] = 127 - wk_f8ex(cm); }
#pragma unroll 1
    for (int kb = F.wave; kb < nkb; kb += NWAVES) { WK_LOAD(va, kb); wk_tile_out<false>(k, kb, r4, va, dr, qs); }
#undef WK_LOAD
    __syncthreads();
}
constexpr int WQ_TOTAL = NE * (DM / 64) + 2 * NE * (FFE / 64) + 2 * (FFD / 64) + (MK_QKV8 ? 3 * DM / 64 : 0) + (MK_FFN2F8 ? DM / 64 : 0);
__device__ __forceinline__ void wk_convert_super(KArgs ap, Frame& F) {
    volatile LAS unsigned* qw = F.MISC + 16;
    if (F.tid == 0) qw[0] = __hip_atomic_fetch_add(F.ctl + CW_WQ, 1u, __ATOMIC_RELAXED, __HIP_MEMORY_SCOPE_AGENT);
    __syncthreads();
    int it = __builtin_amdgcn_readfirstlane((int)qw[0]);
#pragma unroll 1
    while (it < WQ_TOTAL) {
        unsigned nxt = 0; if (F.tid == 0) nxt = __hip_atomic_fetch_add(F.ctl + CW_WQ, 1u, __ATOMIC_RELAXED, __HIP_MEMORY_SCOPE_AGENT);
        int kind = 6, rem = it, nkb = 16;
        if (!(MK_FFN2F8 && rem < DM / 64)) { if (MK_FFN2F8) rem -= DM / 64;
#pragma unroll 1
            for (kind = NKIND - 1;; --kind) { if (kind == 6) continue; int nn; bool quant; wk_shape(kind, nkb, nn, quant); const int cnt = quant ? nn / 64 : 0; if (rem < cnt) break; rem -= cnt; } }
        { WK k; wk_get(ap, F.ws, kind, k);
          if (kind == 6) wk_super_g(k, F, NE, rem); else if (nkb == 16) wk_super<2>(k, F, kind - 23, rem); else wk_super<7>(k, F, kind - 23, rem); }
        if (F.tid == 0) qw[0] = nxt;
        __syncthreads();
        it = __builtin_amdgcn_readfirstlane((int)qw[0]);
    }
}
__device__ __forceinline__ void wk_convert(KArgs ap, Frame& F, int pass) {
    LAS float* scr = (LAS float*)(F.lds + F.wave * 16384);
    const int gw = F.vcu * NWAVES + F.wave, NGW = F.G * NWAVES;
    int it = gw;
#pragma unroll 1
    for (int kind = 0; kind < NKIND; ++kind) { WK k; wk_get(ap, F.ws, kind, k);
        const bool quant = k.ot != 0;
        if (pass == 0 && quant) { if (MK_SUPER) continue; const int nkb = k.K / 64, nnb = k.N / 256, cnt = nkb * nnb;
            for (; it < cnt; it += NGW) wk_stats_item(k, it % nkb, it / nkb, F.lane);
            it -= cnt; }
        else if ((pass == 0) != quant) { const int nkb = k.K / 64, nnb = k.N / 64, cnt = nkb * nnb;
            int* sb8 = (int*)(F.ws + WS_SB8) + (kind >= 23 ? (kind - 23) * DM : 0);
            for (; it < cnt; it += NGW) wk_item(k, it / nnb, it % nnb, sb8, scr, F.lane);
            it -= cnt; }
    }
}
__device__ __forceinline__ void p0_s5_group(KArgs ap, Frame& F, int g, int qtr) {
    const auto& a = *ap;
    const float* lam_re = (const float*)a.in[I_LAMRE]; const float* lam_im = (const float*)a.in[I_LAMIM]; const float* log_dt = (const float*)a.in[I_LOGDT];
    const float* b_re = (const float*)a.in[I_BRE]; const float* b_im = (const float*)a.in[I_BIM]; const float* c_re = (const float*)a.in[I_CRE]; const float* c_im = (const float*)a.in[I_CIM];
    const float* g0 = (const float*)a.in[I_NORMS];
    LAS float* apr = (LAS float*)F.lds;
    LAS float* api = apr + 17 * 64;
    LAS float* bbr = api + 17 * 64;
    LAS float* bbi = bbr + 1024;
    LAS float* ccr = bbi + 1024;
    LAS float* cci = ccr + 1024;
    LAS float* ktab = cci + 1024;
    const float dt = expf(log_dt[g]);
    for (int idx = F.tid; idx < 17 * 64; idx += NWAVES * 64) { const int l = idx >> 6, p = idx & 63; const float zr = lam_re[g * 64 + p] * dt, zi = lam_im[g * 64 + p] * dt;
        const float mag = expf((float)l * zr); float sn, cs; sincosf((float)l * zi, &sn, &cs); apr[idx] = mag * cs; api[idx] = mag * sn; }
    for (int idx = F.tid; idx < 1024; idx += NWAVES * 64) { const int p = idx >> 4, j = idx & 15; const float lr = lam_re[g * 64 + p], li = lam_im[g * 64 + p]; const float zr = lr * dt, zi = li * dt;
        const float mag = expf(zr); float sn, cs; sincosf(zi, &sn, &cs); const float ar = mag * cs, ai = mag * sn, den = lr * lr + li * li;
        const float cfr = ((ar - 1.0f) * lr + ai * li) / den, cfi = (ai * lr - (ar - 1.0f) * li) / den;
        const float br = b_re[(size_t)(g * 64 + p) * 16 + j], bi = b_im[(size_t)(g * 64 + p) * 16 + j], gn = g0[g * 16 + j];
        bbr[idx] = (cfr * br - cfi * bi) * gn; bbi[idx] = (cfr * bi + cfi * br) * gn;
        ccr[idx] = c_re[(size_t)g * 1024 + idx]; cci[idx] = c_im[(size_t)g * 1024 + idx]; }
    __syncthreads();
    for (int idx0 = F.tid; idx0 < 1024; idx0 += NWAVES * 64) { const int l = idx0 >> 6, i = 4 * qtr + ((idx0 >> 4) & 3), j = idx0 & 15, idx = (l * 16 + i) * 16 + j; float s = 0.f;
        for (int p = 0; p < 64; ++p) { const float cr = ccr[i * 64 + p], ci = cci[i * 64 + p], ar = apr[l * 64 + p], ai = api[l * 64 + p]; const float car = cr * ar - ci * ai, cai = cr * ai + ci * ar; s += car * bbr[p * 16 + j] - cai * bbi[p * 16 + j]; }
        ktab[idx] = s; }
    __syncthreads();
    bf16* btc = (bf16*)(F.ws + WS_BTC) + (size_t)g * 256 * UAK; bf16* bta = (bf16*)(F.ws + WS_BTA) + (size_t)g * 256 * 256;
    for (int pc = F.tid; pc < 64 * 48; pc += NWAVES * 64) { const int nq = pc / 48, k8 = pc % 48, t = nq >> 2, i = 4 * qtr + (nq & 3), n = t * 16 + i; float v[8];
        if (k8 < 32) { const int s = k8 >> 1, j0 = (k8 & 1) * 8;
#pragma unroll
            for (int jj = 0; jj < 8; ++jj) v[jj] = (t >= s) ? ktab[((t - s) * 16 + i) * 16 + j0 + jj] : 0.f; }
        else { const int pb = (k8 - 32) * 8;
#pragma unroll
            for (int jj = 0; jj < 8; ++jj) { const int p = (pb + jj) & 63; const float cr = ccr[i * 64 + p], ci = cci[i * 64 + p], ar = apr[(t + 1) * 64 + p], ai = api[(t + 1) * 64 + p];
                v[jj] = (pb < 64) ? (cr * ar - ci * ai) : -(cr * ai + ci * ar); } }
        v4u o; o.x = pk2(v[0], v[1]); o.y = pk2(v[2], v[3]); o.z = pk2(v[4], v[5]); o.w = pk2(v[6], v[7]);
        *(v4u*)(btc + (size_t)n * UAK + k8 * 8) = o; }
    for (int pc = F.tid; pc < 64 * 32; pc += NWAVES * 64) { const int n = (pc >> 5) * 4 + qtr, k8 = pc & 31, s = k8 >> 1, j0 = (k8 & 1) * 8; float v[8];
        const int p = n & 63, l = 15 - s; const float ar = apr[l * 64 + p], ai = api[l * 64 + p];
#pragma unroll
        for (int jj = 0; jj < 8; ++jj) { const float br = bbr[p * 16 + j0 + jj], bi = bbi[p * 16 + j0 + jj]; v[jj] = (n < 64) ? (ar * br - ai * bi) : ((n < 128) ? (ar * bi + ai * br) : 0.f); }
        v4u o; o.x = pk2(v[0], v[1]); o.y = pk2(v[2], v[3]); o.z = pk2(v[4], v[5]); o.w = pk2(v[6], v[7]);
        *(v4u*)(bta + (size_t)n * 256 + k8 * 8) = o; }
    float* spar = (float*)(F.ws + WS_SPAR) + g * 128;
    if (qtr == 0 && F.tid < 64) { spar[F.tid] = apr[16 * 64 + F.tid]; spar[64 + F.tid] = api[16 * 64 + F.tid]; }
    __syncthreads();
}
__device__ __forceinline__ void p0_chunk_load(const float* x, Frame& F, int ch, f32x4 (&v)[2][4]) {
    const int b = ch >> 7, c = ch & 127;
#pragma unroll
    for (int rr = 0; rr < 2; ++rr) { const int tok = F.wave * 2 + rr; const f32x4* xr = (const f32x4*)(x + (size_t)(b * SEQ + c * CL + tok) * DM) + F.lane;
#pragma unroll
        for (int j = 0; j < 4; ++j) v[rr][j] = xr[64 * j]; }
}
__device__ __forceinline__ void p0_chunk_store(Frame& F, int ch, const f32x4 (&v)[2][4]) {
    const int b = ch >> 7, c = ch & 127; LAS unsigned short* tile = (LAS unsigned short*)F.lds;
#pragma unroll
    for (int rr = 0; rr < 2; ++rr) { const int tok = F.wave * 2 + rr; float s = 0.f;
#pragma unroll
        for (int j = 0; j < 4; ++j) s += (v[rr][j].x * v[rr][j].x + v[rr][j].y * v[rr][j].y) + (v[rr][j].z * v[rr][j].z + v[rr][j].w * v[rr][j].w);
        const float rstd = 1.0f / sqrtf(wave_sum(s) * (1.0f / DM) + NORM_EPS);
#pragma unroll
        for (int j = 0; j < 4; ++j) { v2u w; w.x = pk2(v[rr][j].x * rstd, v[rr][j].y * rstd); w.y = pk2(v[rr][j].z * rstd, v[rr][j].w * rstd); *(LAS v2u*)(tile + tok * 1032 + 4 * F.lane + 256 * j) = w; } }
    __syncthreads();
    bf16* ua = (bf16*)(F.ws + WS_UA);
#pragma unroll
    for (int it = 0; it < 4; ++it) { const int q = it * 512 + F.tid, g = q >> 5, piece = q & 31, tok = piece >> 1, half = piece & 1;
        const v4u w = *(const LAS v4u*)(tile + tok * 1032 + g * 16 + half * 8);
        *(v4u*)(ua + ((size_t)g * GROWS + b * NCH + c) * UAK + tok * 16 + half * 8) = w; }
    __syncthreads();
}
__device__ __forceinline__ void p0_prologue(KArgs ap, Frame& F) {
    const auto& a = *ap;
    const float* norms = (const float*)a.in[I_NORMS];
    for (int task = F.vcu; task < NG * 4; task += F.G) p0_s5_group(ap, F, task >> 2, task & 3);
    { const int gt = F.vcu * (NWAVES * 64) + F.tid, NT = F.G * NWAVES * 64; const int* pos = (const int*)a.in[I_POS]; float* rope = (float*)(F.ws + WS_ROPE);
      for (int idx = gt; idx < NTOK * 16; idx += NT) { const int n = idx >> 4, i = idx & 15; const float inv = 1.0f / powf(500000.0f, (float)i * (1.0f / 16.0f)); const float ang = (float)pos[n] * inv; float sn, cs; sincosf(ang, &sn, &cs); rope[(size_t)n * 32 + i] = cs; rope[(size_t)n * 32 + 16 + i] = sn; }
      const float* wr = (const float*)a.in[I_ROUTER]; float* wro = (float*)(F.ws + WS_WR);
      for (int idx = gt; idx < DM * NE; idx += NT) wro[idx] = wr[idx] * norms[(1 * 4 + 2) * DM + (idx >> 3)]; }
    { const float* x = (const float*)a.in[I_X]; f32x4 va[2][4], vb[2][4]; int ch = F.vcu;
      if (ch < BATCH * NCH) p0_chunk_load(x, F, ch, va);
#pragma unroll 1
      for (; ch < BATCH * NCH; ch += 2 * F.G) {
          const bool h1 = ch + F.G < BATCH * NCH, h2 = ch + 2 * F.G < BATCH * NCH;
          if (h1) p0_chunk_load(x, F, ch + F.G, vb);
          p0_chunk_store(F, ch, va);
          if (h2) p0_chunk_load(x, F, ch + 2 * F.G, va);
          if (h1) p0_chunk_store(F, ch + F.G, vb); } }
    wk_convert(ap, F, 0);
}
__device__ __forceinline__ void expert_act_scale(Frame& F) {
    if (F.vcu < NE + (MK_FFN2F8 ? 1 : 0)) { const int e = F.vcu; const bool dense = e == NE; const float* pq = dense ? (const float*)(F.ws + WS_PSQD) : (const float*)(F.ws + WS_PSQ) + e * 2 * FFE; float m1 = 0.f, m3 = 0.f;
        const int nrow = dense ? 2 * FFD : 2 * FFE;
        for (int i = F.tid; i < nrow; i += NWAVES * 64) { float ss = 0.f;
#pragma unroll
            for (int kc = 0; kc < (MK_SUPER ? 1 : DM / 64); ++kc) ss += pq[(size_t)kc * (NE * 2 * FFE) + i];
            const float v = sqrtf(ss); if ((i >> 7) & 1) m3 = fmaxf(m3, v); else m1 = fmaxf(m1, v); }
#pragma unroll
        for (int o = 1; o < 64; o <<= 1) { m1 = fmaxf(m1, __shfl_xor(m1, o)); m3 = fmaxf(m3, __shfl_xor(m3, o)); }
        LAS float* red = (LAS float*)(F.lds + 8192);
        if (F.lane == 0) { red[F.wave] = m1; red[8 + F.wave] = m3; }
        __syncthreads();
        if (F.tid == 0) { float a1 = 0.f, a3 = 0.f; for (int w = 0; w < NWAVES; ++w) { a1 = fmaxf(a1, red[w]); a3 = fmaxf(a3, red[8 + w]); }
            const float bound = 1.1f * 1024.0f * a1 * a3;
            const int ex = wk_f8ex(bound);
            __hip_atomic_store(F.ctl + CW_EA + e, (unsigned)(127 - ex), __ATOMIC_RELAXED, __HIP_MEMORY_SCOPE_AGENT); }
        __syncthreads(); }
}
__device__ __forceinline__ void s5_scan_local(Frame& F) {
    const float* spar = (const float*)(F.ws + WS_SPAR); const float* sloc = (const float*)(F.ws + WS_SLOC); bf16* ua = (bf16*)(F.ws + WS_UA);
    const int nunits = (NG * 8 - F.bx + F.G - 1) / F.G;
    for (int t = F.wave; t < 2 * nunits; t += NWAVES) { int pm, pn; pg8::tile_of((t >> 1) * F.G + F.bx, NG * 8, 1, pm, pn);
        const int g = pm >> 3, b = (pm & 7) * 2 + (t & 1), p = F.lane;
        const float ar = spar[g * 128 + p], ai = spar[g * 128 + 64 + p]; float sr = 0.f, si = 0.f;
        const size_t row0 = (size_t)g * GROWS + b * NCH;
        constexpr int SB = 16; float l0r[SB], l0i[SB], l1r[SB], l1i[SB];
#define S5_LD(R, I, c0) do { _Pragma("unroll") for (int j = 0; j < SB; ++j) { R[j] = sloc[(row0 + (c0) + j) * 128 + p]; I[j] = sloc[(row0 + (c0) + j) * 128 + 64 + p]; } } while (0)
#define S5_RUN(R, I, c0) do { _Pragma("unroll") for (int j = 0; j < SB; ++j) { ua[(row0 + (c0) + j) * UAK + 256 + p] = (bf16)f2bf(sr); ua[(row0 + (c0) + j) * UAK + 320 + p] = (bf16)f2bf(si); \
            const float nr = ar * sr - ai * si + R[j], ni = ar * si + ai * sr + I[j]; sr = nr; si = ni; } } while (0)
        S5_LD(l0r, l0i, 0);
#pragma unroll 1
        for (int c0 = 0; c0 < NCH; c0 += 2 * SB) {
            S5_LD(l1r, l1i, c0 + SB); __builtin_amdgcn_sched_barrier(0);
            S5_RUN(l0r, l0i, c0); __builtin_amdgcn_sched_barrier(0);
            if (c0 + 2 * SB < NCH) S5_LD(l0r, l0i, c0 + 2 * SB);
            __builtin_amdgcn_sched_barrier(0);
            S5_RUN(l1r, l1i, c0 + SB); __builtin_amdgcn_sched_barrier(0); }
#undef S5_LD
#undef S5_RUN
    }
}
struct RRow { v4u m0, m1, a0, a1; f32x4 h0, h1, h2, h3; float sc, ssq; };
template <bool SRC> __device__ __forceinline__ void rr_load(RRow& R, int lane, const float* xin, const bf16* xhin, const bf16* mix, const float* rowss, const float* rs, int row, int nslots) {
    R.m0 = *(const v4u*)(mix + (size_t)row * DM + 8 * lane); R.m1 = *(const v4u*)(mix + (size_t)row * DM + 512 + 8 * lane);
    if (SRC) { R.a0 = *(const v4u*)(xhin + (size_t)row * DM + 8 * lane); R.a1 = *(const v4u*)(xhin + (size_t)row * DM + 512 + 8 * lane); R.sc = rs[row]; }
    else { const f32x4* hp = (const f32x4*)(xin + (size_t)row * DM); R.h0 = hp[2 * lane]; R.h1 = hp[2 * lane + 1]; R.h2 = hp[128 + 2 * lane]; R.h3 = hp[128 + 2 * lane + 1]; }
    R.ssq = lane < nslots ? rowss[(size_t)row * 32 + lane] : 0.f;
}
template <bool ROUTE, bool SRC, bool QOUT>
__device__ __forceinline__ void resid_pass(Frame& F, const float* xin, const bf16* xhin, const bf16* mix, int nslots, const float* gain, bf16* xh, const float* rbias) {
    const float* rowss = (const float*)(F.ws + WS_ROWSS); float* rs = (float*)(F.ws + WS_RS);
    LAS int* l_e = (LAS int*)F.lds; LAS float* l_w = (LAS float*)(F.lds + 1024); LAS int* l_cnt = (LAS int*)(F.lds + 2048); LAS int* l_base = (LAS int*)(F.lds + 2048 + 64); LAS float* l_s = (LAS float*)(F.lds + 3072);
    for (int blk = F.vcu; blk < NTOK / 128; blk += F.G) {
        if (ROUTE) { if (F.tid < NE) l_cnt[F.tid] = 0; __syncthreads(); }
        RRow cur, nxt; rr_load<SRC>(cur, F.lane, xin, xhin, mix, rowss, rs, blk * 128 + F.wave * 16, nslots);
#pragma unroll 1
        for (int k = 0; k < 16; ++k) { const int row = blk * 128 + F.wave * 16 + k;
            nxt = cur; if (k + 1 < 16) rr_load<SRC>(nxt, F.lane, xin, xhin, mix, rowss, rs, row + 1, nslots);
            __builtin_amdgcn_sched_barrier(0);
            const v4u m0 = cur.m0, m1 = cur.m1;
            float hn[16];
            if (SRC) { const v4u a0 = cur.a0, a1 = cur.a1; const float sc = cur.sc;
                hn[0] = bf2f(a0.x & 0xffffu) * sc; hn[1] = bf2f(a0.x >> 16) * sc; hn[2] = bf2f(a0.y & 0xffffu) * sc; hn[3] = bf2f(a0.y >> 16) * sc; hn[4] = bf2f(a0.z & 0xffffu) * sc; hn[5] = bf2f(a0.z >> 16) * sc; hn[6] = bf2f(a0.w & 0xffffu) * sc; hn[7] = bf2f(a0.w >> 16) * sc;
                hn[8] = bf2f(a1.x & 0xffffu) * sc; hn[9] = bf2f(a1.x >> 16) * sc; hn[10] = bf2f(a1.y & 0xffffu) * sc; hn[11] = bf2f(a1.y >> 16) * sc; hn[12] = bf2f(a1.z & 0xffffu) * sc; hn[13] = bf2f(a1.z >> 16) * sc; hn[14] = bf2f(a1.w & 0xffffu) * sc; hn[15] = bf2f(a1.w >> 16) * sc; }
            else { const f32x4 h0 = cur.h0, h1 = cur.h1, h2 = cur.h2, h3 = cur.h3;
#pragma unroll
                for (int j = 0; j < 4; ++j) { hn[j] = h0[j]; hn[4 + j] = h1[j]; hn[8 + j] = h2[j]; hn[12 + j] = h3[j]; } }
            const f32x4* gp = (const f32x4*)gain; const f32x4 g0 = gp[2 * F.lane], g1 = gp[2 * F.lane + 1], g2 = gp[128 + 2 * F.lane], g3 = gp[128 + 2 * F.lane + 1];
            const float ssm = wave_sum(cur.ssq);
            const float rm = 1.0f / sqrtf(ssm * (1.0f / DM) + NORM_EPS);
            hn[0] += bf2f(m0.x & 0xffffu) * rm * g0[0]; hn[1] += bf2f(m0.x >> 16) * rm * g0[1]; hn[2] += bf2f(m0.y & 0xffffu) * rm * g0[2]; hn[3] += bf2f(m0.y >> 16) * rm * g0[3];
            hn[4] += bf2f(m0.z & 0xffffu) * rm * g1[0]; hn[5] += bf2f(m0.z >> 16) * rm * g1[1]; hn[6] += bf2f(m0.w & 0xffffu) * rm * g1[2]; hn[7] += bf2f(m0.w >> 16) * rm * g1[3];
            hn[8] += bf2f(m1.x & 0xffffu) * rm * g2[0]; hn[9] += bf2f(m1.x >> 16) * rm * g2[1]; hn[10] += bf2f(m1.y & 0xffffu) * rm * g2[2]; hn[11] += bf2f(m1.y >> 16) * rm * g2[3];
            hn[12] += bf2f(m1.z & 0xffffu) * rm * g3[0]; hn[13] += bf2f(m1.z >> 16) * rm * g3[1]; hn[14] += bf2f(m1.w & 0xffffu) * rm * g3[2]; hn[15] += bf2f(m1.w >> 16) * rm * g3[3];
            float s2 = 0.f;
#pragma unroll
            for (int j = 0; j < 16; ++j) s2 += hn[j] * hn[j];
            const float ms = wave_sum(s2) * (1.0f / DM) + NORM_EPS; const float rms = sqrtf(ms), rh = 1.0f / rms;
            if (F.lane == 0) rs[row] = rms;
            v4u w0, w1; w0.x = pk2(hn[0] * rh, hn[1] * rh); w0.y = pk2(hn[2] * rh, hn[3] * rh); w0.z = pk2(hn[4] * rh, hn[5] * rh); w0.w = pk2(hn[6] * rh, hn[7] * rh);
            w1.x = pk2(hn[8] * rh, hn[9] * rh); w1.y = pk2(hn[10] * rh, hn[11] * rh); w1.z = pk2(hn[12] * rh, hn[13] * rh); w1.w = pk2(hn[14] * rh, hn[15] * rh);
            *(v4u*)(xh + (size_t)row * DM + 8 * F.lane) = w0; *(v4u*)(xh + (size_t)row * DM + 512 + 8 * F.lane) = w1;
            if (QOUT) {
                { float am = 0.f;
#pragma unroll
                  for (int j = 0; j < 16; ++j) am = fmaxf(am, fabsf(hn[j]));
#pragma unroll
                  for (int o = 1; o < 64; o <<= 1) am = fmaxf(am, __shfl_xor(am, o));
                  am *= rh; const float inv = am > 0.f ? 127.0f / am : 0.f, qs = rh * inv;
                  v2u q0, q1;
                  q0.x = q8x4(hn[0], hn[1], hn[2], hn[3], qs); q0.y = q8x4(hn[4], hn[5], hn[6], hn[7], qs);
                  q1.x = q8x4(hn[8], hn[9], hn[10], hn[11], qs); q1.y = q8x4(hn[12], hn[13], hn[14], hn[15], qs);
                  unsigned char* xq = F.ws + WS_XQ3 + (size_t)row * DM; *(v2u*)(xq + 8 * F.lane) = q0; *(v2u*)(xq + 512 + 8 * F.lane) = q1;
                  if (F.lane == 0) { if (ROUTE) l_s[F.wave * 16 + k] = am * (1.0f / 127.0f); else ((float*)(F.ws + WS_RSC))[row] = am * (1.0f / 127.0f); } }
            }
            if (ROUTE) {
                const float* wr = (const float*)(F.ws + WS_WR); float lg[NE];
#pragma unroll
                for (int e = 0; e < NE; ++e) lg[e] = 0.f;
#pragma unroll
                for (int half = 0; half < 2; ++half)
#pragma unroll
                    for (int j = 0; j < 8; ++j) { const int cc = half * 512 + 8 * F.lane + j; const f32x4 wa = *(const f32x4*)(wr + cc * 8), wb = *(const f32x4*)(wr + cc * 8 + 4); const float xv = hn[half * 8 + j] * rh;
                        lg[0] += xv * wa[0]; lg[1] += xv * wa[1]; lg[2] += xv * wa[2]; lg[3] += xv * wa[3]; lg[4] += xv * wb[0]; lg[5] += xv * wb[1]; lg[6] += xv * wb[2]; lg[7] += xv * wb[3]; }
#pragma unroll
                for (int e = 0; e < NE; ++e) lg[e] = wave_sum(lg[e]) + rbias[e];
                int e0 = 0; float v0 = lg[0];
#pragma unroll
                for (int e = 1; e < NE; ++e) if (lg[e] > v0) { v0 = lg[e]; e0 = e; }
                int e1 = -1; float v1 = -__builtin_inff();
#pragma unroll
                for (int e = 0; e < NE; ++e) if (e != e0 && lg[e] > v1) { v1 = lg[e]; e1 = e; }
                const float w1s = 1.0f / (1.0f + __expf(v0 - v1)), w0s = 1.0f - w1s;
                if (F.lane == 0) { const int ai = (F.wave * 16 + k) * 2; l_e[ai] = e0; l_e[ai + 1] = e1; l_w[ai] = w0s; l_w[ai + 1] = w1s; }
            }
            cur = nxt;
        }
        if (ROUTE) {
            __syncthreads();
            int* list = (int*)(F.ws + WS_LIST); int* slot = (int*)(F.ws + WS_SLOT); float* tokw = (float*)(F.ws + WS_TOKW);
            int e = 0, rank = 0;
            if (F.tid < 256) { e = l_e[F.tid]; rank = atomicAdd((int*)&l_cnt[e], 1); }
            __syncthreads();
            if (F.tid < NE) l_base[F.tid] = (int)__hip_atomic_fetch_add(F.ctl + CW_ECNT + 64 * F.tid, (unsigned)l_cnt[F.tid], __ATOMIC_RELAXED, __HIP_MEMORY_SCOPE_AGENT);
            __syncthreads();
            if (F.tid < 256) { const int pos = l_base[e] + rank, token = blk * 128 + (F.tid >> 1);
                if (pos < LCAP) { list[e * LCAP + pos] = token; ((float*)(F.ws + WS_RSC))[e * LCAP + pos] = l_s[F.tid >> 1]; }
                slot[token * 2 + (F.tid & 1)] = e * LCAP + pos; tokw[token * 2 + (F.tid & 1)] = l_w[F.tid]; }
            __syncthreads();
        }
    }
}
__device__ __forceinline__ void final_pass(Frame& F, float* out, const bf16* xh, const bf16* y, const float* gain) {
    const int gw = F.vcu * NWAVES + F.wave, NGW = F.G * NWAVES;
    etab_build(F.lds, F.ctl);
    const int* slot = (const int*)(F.ws + WS_SLOT); const float* tokw = (const float*)(F.ws + WS_TOKW); const float* rsv = (const float*)(F.ws + WS_RS); const f32x4* gp = (const f32x4*)gain;
    if (gw >= NTOK) return;
#define FP_S1(row_, S, W) do { S = *(const v2u*)(slot + (size_t)(row_) * 2); W = *(const f32x2*)(tokw + (size_t)(row_) * 2); } while (0)
#define FP_S2(row_, S, R0, R1, YA, YB, XA, SC) do { const int e0_ = ((int)S.x >> 15) & 7, e1_ = ((int)S.y >> 15) & 7; const int ps0_ = *(const LAS int*)(F.lds + ET_OFF + 32 + 4 * e0_), ps1_ = *(const LAS int*)(F.lds + ET_OFF + 32 + 4 * e1_); \
        R0 = (size_t)ps0_ * 256 + (S.x & (LCAP - 1)); R1 = (size_t)ps1_ * 256 + (S.y & (LCAP - 1)); const bool fast_ = R0 < 65536 && R1 < 65536; const size_t q0_ = fast_ ? R0 : 0, q1_ = fast_ ? R1 : 0; \
        _Pragma("unroll") for (int half = 0; half < 2; ++half) { YA[half] = *(const v4u*)(y + q0_ * DM + half * 512 + 8 * F.lane); YB[half] = *(const v4u*)(y + q1_ * DM + half * 512 + 8 * F.lane); XA[half] = *(const v4u*)(xh + (size_t)(row_) * DM + half * 512 + 8 * F.lane); } \
        SC = rsv[row_]; } while (0)
    int row = gw, nrow = gw + NGW; v2u sc_ = {0u, 0u}, sn_ = {0u, 0u}; f32x2 wc_ = {0.f, 0.f}, wn_ = {0.f, 0.f};
    size_t r0c, r1c; v4u yac[2], ybc[2], xac[2]; float scc;
    FP_S1(row, sc_, wc_);
    FP_S2(row, sc_, r0c, r1c, yac, ybc, xac, scc);
    if (nrow < NTOK) FP_S1(nrow, sn_, wn_);
#pragma unroll 1
    for (;;) {
        const bool has_next = nrow < NTOK;
        size_t r0n = 0, r1n = 0; v4u yan[2] = {{0u, 0u, 0u, 0u}, {0u, 0u, 0u, 0u}}, ybn[2] = {{0u, 0u, 0u, 0u}, {0u, 0u, 0u, 0u}}, xan[2] = {{0u, 0u, 0u, 0u}, {0u, 0u, 0u, 0u}}; float scn = 0.f; v2u snn = {0u, 0u}; f32x2 wnn = {0.f, 0.f};
        if (has_next) { FP_S2(nrow, sn_, r0n, r1n, yan, ybn, xan, scn); const int nn = nrow + NGW; if (nn < NTOK) FP_S1(nn, snn, wnn); }
        __builtin_amdgcn_sched_barrier(0);
        const size_t r0 = r0c, r1 = r1c; const float w0 = wc_[0], w1 = wc_[1];
        float f[16];
        if (r0 >= 65536 || r1 >= 65536) {
            const bf16* yp = (const bf16*)(F.ws + WS_YP);
#pragma unroll
            for (int j = 0; j < 16; ++j) f[j] = 0.f;
#pragma unroll 1
            for (int side = 0; side < 2; ++side) { const size_t r = side ? r1 : r0; const float w = side ? w1 : w0; const int nk = r >= 65536 ? KSPLIT : 1;
                for (int kc = 0; kc < nk; ++kc) { const bf16* src = r >= 65536 ? yp + ((size_t)(kc * LPMAX) * 256 + (r - 65536)) * DM : y + r * DM;
#pragma unroll
                    for (int half = 0; half < 2; ++half) { const v4u a = *(const v4u*)(src + half * 512 + 8 * F.lane);
                        f[half * 8 + 0] += w * bf2f(a.x & 0xffffu); f[half * 8 + 1] += w * bf2f(a.x >> 16); f[half * 8 + 2] += w * bf2f(a.y & 0xffffu); f[half * 8 + 3] += w * bf2f(a.y >> 16);
                        f[half * 8 + 4] += w * bf2f(a.z & 0xffffu); f[half * 8 + 5] += w * bf2f(a.z >> 16); f[half * 8 + 6] += w * bf2f(a.w & 0xffffu); f[half * 8 + 7] += w * bf2f(a.w >> 16); } } } }
        else
#pragma unroll
        for (int half = 0; half < 2; ++half) { const v4u a = yac[half], bq = ybc[half];
            f[half * 8 + 0] = w0 * bf2f(a.x & 0xffffu) + w1 * bf2f(bq.x & 0xffffu); f[half * 8 + 1] = w0 * bf2f(a.x >> 16) + w1 * bf2f(bq.x >> 16);
            f[half * 8 + 2] = w0 * bf2f(a.y & 0xffffu) + w1 * bf2f(bq.y & 0xffffu); f[half * 8 + 3] = w0 * bf2f(a.y >> 16) + w1 * bf2f(bq.y >> 16);
            f[half * 8 + 4] = w0 * bf2f(a.z & 0xffffu) + w1 * bf2f(bq.z & 0xffffu); f[half * 8 + 5] = w0 * bf2f(a.z >> 16) + w1 * bf2f(bq.z >> 16);
            f[half * 8 + 6] = w0 * bf2f(a.w & 0xffffu) + w1 * bf2f(bq.w & 0xffffu); f[half * 8 + 7] = w0 * bf2f(a.w >> 16) + w1 * bf2f(bq.w >> 16); }
        float ss = 0.f;
#pragma unroll
        for (int j = 0; j < 16; ++j) ss += f[j] * f[j];
        const float rf = 1.0f / sqrtf(wave_sum(ss) * (1.0f / DM) + NORM_EPS);
        f32x4* hp = (f32x4*)(out + (size_t)row * DM); const float sc = scc;
#pragma unroll
        for (int half = 0; half < 2; ++half) { const v4u a = xac[half];
            const float hv[8] = {bf2f(a.x & 0xffffu), bf2f(a.x >> 16), bf2f(a.y & 0xffffu), bf2f(a.y >> 16), bf2f(a.z & 0xffffu), bf2f(a.z >> 16), bf2f(a.w & 0xffffu), bf2f(a.w >> 16)};
#pragma unroll
            for (int q = 0; q < 2; ++q) { const int idx = half * 128 + 2 * F.lane + q; f32x4 h; const f32x4 g = gp[idx];
#pragma unroll
                for (int j = 0; j < 4; ++j) h[j] = hv[q * 4 + j] * sc + f[half * 8 + q * 4 + j] * rf * g[j];
                hp[idx] = h; } }
        if (!has_next) break;
        row = nrow; nrow += NGW; wc_ = wn_; r0c = r0n; r1c = r1n; scc = scn; sn_ = snn; wn_ = wnn;
#pragma unroll
        for (int half = 0; half < 2; ++half) { yac[half] = yan[half]; ybc[half] = ybn[half]; xac[half] = xan[half]; }
    }
#undef FP_S1
#undef FP_S2
}

constexpr int N_PHASES = MK_F8 ? 14 : 20;
__global__ void __launch_bounds__(NWAVES * 64, 2) mk_fwd(Args args) {
    extern __shared__ __attribute__((aligned(16))) unsigned char lds_raw[];
    Frame F; refresh(F);
    for (int u = F.tid; u < (LDS_BYTES - LDSCTL_OFF) / 4; u += NWAVES * 64) ((LAS unsigned*)(F.lds + LDSCTL_OFF))[u] = 0u;
    __syncthreads();
    if (F.hi - F.lo > 1) (void)xcd_barrier_post(F.ctl + CW_BAR, F.MISC + 8);
#ifndef MK_ONLY
#define MK_ONLY -1
#endif
#define IN(k) ((MK_ONLY < 0 || (k) == MK_ONLY) && (refresh(F), F.lo <= (k) && (k) < F.hi))
#define SEAM(k) do { refresh(F); if (F.lo <= (k) && (k) + 1 < F.hi) xcd_barrier(frame_bar(F)); } while (0)
#define ws (F.ws)
#define cblk (F.bx)
    if (IN(0)) { p0_prologue(kargs(), F); } SEAM(0);
    if (IN(1)) {
        if (MK_SUPER) wk_convert_super(kargs(), F); else wk_convert(kargs(), F, 1);
        __syncthreads();
        { PlainSched S{(const char*)(ws + WS_UA), (const char*)(ws + WS_BTA), 256, UAK, 256, NG * 8, 1, F.G, cblk, 8, (size_t)256 * 256 * 2};
          EpiS5A E{(float*)(ws + WS_SLOC)};
          pg8::gemm_phase(F.lds, S, E); }
        __builtin_amdgcn_fence(__ATOMIC_ACQUIRE, "agent"); VM_WAIT(); __syncthreads();
        s5_scan_local(F);
        VM_WAIT(); __syncthreads(); __builtin_amdgcn_fence(__ATOMIC_ACQUIRE, "agent"); VM_WAIT(); __syncthreads();
        { KArgs ka = kargs(); PlainSched S{(const char*)(ws + WS_UA), (const char*)(ws + WS_BTC), UAK, UAK, UAK, NG * 8, 1, F.G, cblk, 8, (size_t)256 * UAK * 2};
          EpiS5C E{(const bf16*)(ws + WS_UA), (const float*)ka->in[I_SD], (const float*)ka->in[I_NORMS], (bf16*)(ws + WS_GBUF)};
          pg8::gemm_phase(F.lds, S, E); }
    } SEAM(1);
    if (IN(2)) {
        PlainSched S{(const char*)(ws + WS_GBUF), (const char*)(ws + WS_WGLU), DM, DM, DM, NTOK / 256, 8, F.G, cblk, 1 << 30, 0};
        EpiGated<0> E{(bf16*)(ws + WS_MIX0), DM, (float*)(ws + WS_ROWSS), 0};
        pg8::gemm_phase(F.lds, S, E);
    } SEAM(2);
    if (IN(3)) { KArgs ka = kargs(); resid_pass<false, false, true>(F, (const float*)ka->in[I_X], nullptr, (const bf16*)(ws + WS_MIX0), 32, (const float*)ka->in[I_NORMS] + 1 * DM, (bf16*)(ws + WS_XH1), nullptr);
        expert_act_scale(F); } SEAM(3);
    if (IN(4)) {
        const int sad = MK_FFN2F8 ? (int)__hip_atomic_load(F.ctl + CW_EA + NE, __ATOMIC_RELAXED, __HIP_MEMORY_SCOPE_AGENT) : 127;
        PlainSched S{(const char*)(ws + WS_XQ3), (const char*)(ws + WS_WQF13), DM / 2, DM / 2, DM / 2, NTOK / 256, 2 * FFD / 256, F.G, cblk, 1 << 30, 0, sad};
        EpiGatedI8<MK_FFN2F8 != 0> E{(bf16*)(ws + WS_ACTD), FFD, (const float*)(ws + WS_RSC), (const float*)(ws + WS_COLMAX_F), 0, nullptr};
        pg8::gemm_phase(F.lds, S, E);
    } SEAM(4);
    if (IN(5)) {
#if MK_FFN2F8
        const int sad = (int)__hip_atomic_load(F.ctl + CW_EA + NE, __ATOMIC_RELAXED, __HIP_MEMORY_SCOPE_AGENT);
        PlainSched S{(const char*)(ws + WS_ACTD), (const char*)(ws + WS_WF2), FFD / 2, FFD / 2, FFD / 2, NTOK / 256, DM / 256, F.G, cblk, 1 << 30, 0, sad, (const int*)(ws + WS_SB8) + NE * DM};
        EpiPlain<true, false, 2> E{(bf16*)(ws + WS_F0), DM, (float*)(ws + WS_ROWSS)};
#else
        PlainSched S{(const char*)(ws + WS_ACTD), (const char*)(ws + WS_WF2), FFD, FFD, FFD, NTOK / 256, DM / 256, F.G, cblk, 1 << 30, 0};
        EpiPlain<true, false> E{(bf16*)(ws + WS_F0), DM, (float*)(ws + WS_ROWSS)};
#endif
        pg8::gemm_phase(F.lds, S, E);
    } SEAM(5);
    if (IN(6)) { KArgs ka = kargs(); resid_pass<false, true, MK_QKV8 != 0>(F, nullptr, (const bf16*)(ws + WS_XH1), (const bf16*)(ws + WS_F0), 16, (const float*)ka->in[I_NORMS] + 3 * DM, (bf16*)(ws + WS_XH2), nullptr); } SEAM(6);
    if (IN(7)) {
#if MK_QKV8
        PlainSched S{(const char*)(ws + WS_XQ3), (const char*)(ws + WS_WQQKV), DM / 2, DM / 2, DM / 2, NTOK / 256, 12, F.G, cblk, 1 << 30, 0};
        EpiQKV<true> E{(bf16*)(ws + WS_Q), (const float*)(ws + WS_ROPE), (float*)(ws + WS_KMEAN), (const float*)(ws + WS_RSC), (const float*)(ws + WS_COLMAX_QKV)};
#else
        PlainSched S{(const char*)(ws + WS_XH2), (const char*)(ws + WS_WQKV), DM, DM, DM, NTOK / 256, 12, F.G, cblk, 1 << 30, 0};
        EpiQKV<false> E{(bf16*)(ws + WS_Q), (const float*)(ws + WS_ROPE), (float*)(ws + WS_KMEAN), nullptr, nullptr};
#endif
        pg8::gemm_phase(F.lds, S, E);
    } SEAM(7);
    if (IN(8)) {
        const bf16* Qb = (const bf16*)(ws + WS_Q); const bf16* Kb = (const bf16*)(ws + WS_K); const bf16* Vb = (const bf16*)(ws + WS_V); bf16* Ob = (bf16*)(ws + WS_O); const float* KM = (const float*)(ws + WS_KMEAN);
        const int nitems = (BATCH * NH * 4 - F.vcu + F.G - 1) / F.G, nblocks = 2 * nitems;
        attn::Seam Sm;
#define MK_REF(R, kk) do { const int it_ = F.vcu + ((kk) >> 1) * F.G, bh_ = it_ >> 2, x_ = it_ & 3, qb_ = ((kk) & 1) ? 7 - x_ : x_, b_ = bh_ >> 3, h_ = bh_ & 7; \
        const size_t base_ = (size_t)b_ * SEQ * DM + h_ * HD; R.Q = Qb + base_ + (size_t)qb_ * 256 * DM; R.K = Kb + base_; R.V = Vb + base_; R.O = Ob + base_ + (size_t)qb_ * 256 * DM; R.KM = KM + (size_t)bh_ * NBLK * HD; R.P0 = qb_ * 256; } while (0)
        if (nblocks > 0) {
            attn::BlockRef cur, nxt; MK_REF(cur, 0);
            attn::moba_prime(cur, (char*)lds_raw, Sm);
            for (int kb = 0; kb < nblocks; ++kb) { const int kn = kb + 1 < nblocks ? kb + 1 : kb; MK_REF(nxt, kn); attn::moba_block(cur, nxt, (char*)lds_raw, Sm); cur = nxt; }
        }
#undef MK_REF
    } SEAM(8);
    if (IN(9)) {
        PlainSched S{(const char*)(ws + WS_O), (const char*)(ws + WS_WO), DM, DM, DM, NTOK / 256, DM / 256, F.G, cblk, 1 << 30, 0};
        EpiPlain<true, false> E{(bf16*)(ws + WS_MIX1), DM, (float*)(ws + WS_ROWSS)};
        pg8::gemm_phase(F.lds, S, E);
    } SEAM(9);
    if (IN(10)) { KArgs ka = kargs(); resid_pass<true, true, true>(F, nullptr, (const bf16*)(ws + WS_XH2), (const bf16*)(ws + WS_MIX1), 16, (const float*)ka->in[I_NORMS] + (4 + 1) * DM, (bf16*)(ws + WS_XH3), (const float*)ka->in[I_RBIAS]); } SEAM(10);
#if MK_F8
    if (IN(11)) {
        etab_build(F.lds, F.ctl); int nM = et_ps(F.lds, NE); nM = nM > 264 ? 264 : nM;
        MoeSched1 S{(const char*)(ws + WS_XQ3), (const char*)(ws + WS_WQ13), (const int*)(ws + WS_LIST), DM / 2, DM / 2, nM, 2 * FFE / 256, F.G, cblk, 0, F.lds};
        EpiGatedI8<true> E{(bf16*)(ws + WS_ACTM), FFE, (const float*)(ws + WS_RSC), (const float*)(ws + WS_COLMAX), 2 * FFE, (unsigned char*)kargs()->out};
        pg8::gemm_phase(F.lds, S, E);
    } SEAM(11);
    if (IN(12)) {
        etab_build(F.lds, F.ctl); const int P = et_ps(F.lds, NE); const int nM = P > 256 ? 256 : P; int nLeft = P - 256; nLeft = nLeft < 0 ? 0 : (nLeft > LPMAX ? LPMAX : nLeft);
        { MoeSched2 S{(const char*)(ws + WS_ACTM), (const char*)kargs()->out, (const char*)(ws + WS_W8M2), (const int*)(ws + WS_SB8), FFE / 2, FFE / 2, FFE / 2, nM, DM / 256, F.G, cblk, 0, F.lds};
          EpiPlain<false, true, 2> E{(bf16*)(ws + WS_Y), DM, nullptr};
          pg8::gemm_phase(F.lds, S, E); }
        { MoeSched2K S{(const char*)(ws + WS_ACTM), (const char*)kargs()->out, (const char*)(ws + WS_W8M2), (const int*)(ws + WS_SB8), 256, FFE / 2, FFE / 2, nLeft, F.G, (F.G - 1) - cblk, F.lds};
          EpiPlain<false, true, 2> E{(bf16*)(ws + WS_YP), DM, nullptr};
          pg8::gemm_phase(F.lds, S, E); }
    } SEAM(12);
#else
#pragma unroll
    for (int q = 0; q < 4; ++q) {
        if (IN(11 + 2 * q)) {
            etab_build(F.lds, F.ctl); const int P = et_ps(F.lds, NE); const int p0 = 64 * q; int nM = (q < 3) ? 64 : P - 192; nM = nM > 72 ? 72 : nM; if (p0 + nM > P) nM = P - p0; if (nM < 0) nM = 0;
            MoeSched1 S{(const char*)(ws + WS_XQ3), (const char*)(ws + WS_WQ13), (const int*)(ws + WS_LIST), DM / 2, DM / 2, nM, 2 * FFE / 256, F.G, cblk, p0, F.lds};
            EpiGatedI8<false> E{(bf16*)(ws + WS_ACTM), FFE, (const float*)(ws + WS_RSC), (const float*)(ws + WS_COLMAX), 2 * FFE, nullptr};
            pg8::gemm_phase(F.lds, S, E);
        } SEAM(11 + 2 * q);
        if (IN(12 + 2 * q)) {
            etab_build(F.lds, F.ctl); const int P = et_ps(F.lds, NE); const int p0 = 64 * q; int nM = (q < 3) ? 64 : P - 192; nM = nM > 72 ? 72 : nM; if (p0 + nM > P) nM = P - p0; if (nM < 0) nM = 0;
            MoeSched2B S{(const char*)(ws + WS_ACTM), (const char*)(ws + WS_WM2), FFE, FFE, FFE, nM, DM / 256, F.G, cblk, p0, F.lds};
            EpiPlain<false, true, 0> E{(bf16*)(ws + WS_Y), DM, nullptr};
            pg8::gemm_phase(F.lds, S, E);
        } SEAM(12 + 2 * q);
    }
#endif
    if (IN(N_PHASES - 1)) { KArgs ka = kargs(); final_pass(F, ka->out, (const bf16*)(ws + WS_XH3), (const bf16*)(ws + WS_Y), (const float*)ka->in[I_NORMS] + (4 + 3) * DM); }
#undef IN
#undef SEAM
#undef ws
#undef cblk
}

extern "C" void kernel_launch(void* const* d_in, const int* in_sizes, int n_in, void* d_out, int out_size, void* d_ws, size_t ws_size, hipStream_t stream) {
    static int grid = 0;
    if (grid == 0) {
        if (n_in != 24 || in_sizes[0] != NTOK * DM || out_size != NTOK * DM || ws_size < WS_END) { fprintf(stderr, "kernel_launch: unexpected problem (n_in %d, in0 %d, out %d, ws %zu < %zu)\n", n_in, n_in > 0 ? in_sizes[0] : -1, out_size, ws_size, (size_t)WS_END); grid = -1; return; }
        int dev = 0, cus = 0, per_cu = 0;
        if (hipGetDevice(&dev) != hipSuccess || hipDeviceGetAttribute(&cus, hipDeviceAttributeMultiprocessorCount, dev) != hipSuccess) { grid = -1; return; }
        if (hipFuncSetAttribute((const void*)mk_fwd, hipFuncAttributeMaxDynamicSharedMemorySize, LDS_BYTES) != hipSuccess) { fprintf(stderr, "kernel_launch: hipFuncSetAttribute failed\n"); grid = -1; return; }
        if (hipOccupancyMaxActiveBlocksPerMultiprocessor(&per_cu, (const void*)mk_fwd, NWAVES * 64, LDS_BYTES) != hipSuccess || per_cu < 1) { fprintf(stderr, "kernel_launch: occupancy query says %d blocks per CU\n", per_cu); (void)hipGetLastError(); grid = -1; return; }
        grid = cus;
    }
    if (grid < 0) return;
    if (hipMemsetAsync((char*)d_ws + WS_CTL, 0, ZERO_BYTES, stream) != hipSuccess) return;
    Args a{};
    for (int i = 0; i < 24; ++i) a.in[i] = d_in[i];
    a.out = (float*)d_out; a.ws = (unsigned char*)d_ws;
#if MK_ONE_LAUNCH
    a.ph_lo = 0; a.ph_hi = N_PHASES;
    hipLaunchKernelGGL(mk_fwd, dim3(grid), dim3(NWAVES * 64), LDS_BYTES, stream, a);
#else
    for (int p = 0; p < N_PHASES; ++p) { a.ph_lo = p; a.ph_hi = p + 1; for (int r = 0; r < (((MK_DUP_MASK >> p) & 1u) ? 2 : 1); ++r) hipLaunchKernelGGL(mk_fwd, dim3(grid), dim3(NWAVES * 64), LDS_BYTES, stream, a); }
#endif
}
```

```cpp
#include <hip/hip_runtime.h>
#include <stdio.h>
#include <stdint.h>

#ifndef MK_ONE_LAUNCH
#define MK_ONE_LAUNCH 1
#endif
#ifndef MK_F8
#define MK_F8 1
#endif
#ifndef MK_QKV8
#define MK_QKV8 1
#endif
#ifndef MK_SUPER
#define MK_SUPER 1
#endif
#ifndef MK_FFN2F8
#define MK_FFN2F8 1
#endif
#ifndef MK_MOE_NMAJOR
#define MK_MOE_NMAJOR 1
#endif
#ifndef MK_DUP_MASK
#define MK_DUP_MASK 0u
#endif

#define GAS __attribute__((address_space(1)))
#define LAS __attribute__((address_space(3)))
typedef unsigned short bf16;
typedef unsigned v4u __attribute__((ext_vector_type(4)));
typedef unsigned v2u __attribute__((ext_vector_type(2)));
typedef float f32x2 __attribute__((ext_vector_type(2)));
typedef float f32x4 __attribute__((ext_vector_type(4)));
typedef float f32x16 __attribute__((ext_vector_type(16)));
typedef short bf16x8 __attribute__((ext_vector_type(8)));
typedef short s16x4 __attribute__((ext_vector_type(4)));
typedef int i32x4 __attribute__((ext_vector_type(4)));
typedef int i32x8 __attribute__((ext_vector_type(8)));

constexpr int BATCH = 16, SEQ = 2048, DM = 1024, NTOK = BATCH * SEQ;
constexpr int NG = 64, NP = 64, CL = 16, NCH = SEQ / CL, GROWS = BATCH * NCH, UAK = 384;
constexpr int NH = 8, HD = 128, MBLK = 256, NBLK = SEQ / MBLK;
constexpr int FFD = 2816, NE = 8, FFE = 3584, LCAP = 32768;
constexpr float NORM_EPS = 1e-6f;
constexpr int NWAVES = 8;
constexpr int KSPLIT = 7, LPMAX = 7;
constexpr int ASPLIT = 128;

constexpr size_t MiB = 1u << 20;
constexpr size_t WS_CTL = 0, WS_KMEAN = 1 * MiB, ZERO_BYTES = 2 * MiB;
constexpr size_t WS_ROPE = 2 * MiB, WS_ROWSS = 6 * MiB, WS_LIST = 10 * MiB, WS_SLOT = 11 * MiB, WS_TOKW = WS_SLOT + 256 * 1024, WS_WR = WS_TOKW + 256 * 1024, WS_SPAR = WS_WR + 64 * 1024;
constexpr size_t WS_WQ13 = 13 * MiB, WS_XQ3 = 69 * MiB, WS_RSC = 101 * MiB, WS_WM2 = 125 * MiB;
constexpr size_t WS_COLMAX_F = 1536 * 1024 + 57344 * 4, WS_COLMAX_QKV = WS_COLMAX_F + 5632 * 4, WS_COLMAX_W2 = WS_COLMAX_QKV + 3072 * 4;
constexpr size_t WS_ROWNORM = 12 * MiB + 256 * 1024, WS_SB8 = 12 * MiB + 512 * 1024;
constexpr size_t WS_W8M2 = 125 * MiB, WS_PSQ = 153 * MiB, WS_PSQD = 180 * MiB;
constexpr int CW_EA = 9216;
constexpr size_t WS_WQF13 = 102 * MiB, WS_WQQKV = 108 * MiB;
constexpr size_t WS_COLMAX = 1536 * 1024;
constexpr size_t WS_WGLU = 181 * MiB, WS_WQKV = 185 * MiB, WS_WO = 191 * MiB, WS_WF13 = 193 * MiB, WS_WF2 = 204 * MiB, WS_BTA = 210 * MiB, WS_BTC = 218 * MiB;
constexpr size_t WS_UA = 230 * MiB, WS_SLOC = 326 * MiB, WS_GBUF = 390 * MiB, WS_MIX0 = 454 * MiB;
constexpr size_t WS_XH1 = 210 * MiB, WS_ACTD = 274 * MiB, WS_F0 = 450 * MiB;
constexpr size_t WS_XH2 = 450 * MiB, WS_Q = 230 * MiB, WS_K = 294 * MiB, WS_V = 358 * MiB;
constexpr size_t WS_O = WS_Q;
constexpr size_t WS_RS = 12 * MiB;
constexpr size_t WS_MIX1 = 294 * MiB, WS_XH3 = 450 * MiB;
constexpr size_t WS_Y = 181 * MiB, WS_ACTM = 313 * MiB, WS_YP = 425 * MiB;
constexpr size_t WS_END = 518 * MiB;
constexpr int CW_TMO = 0, CW_BAR = 4096, CW_ECNT = 8192, CW_WQ = 9344;

constexpr int RING_BYTES = 131072, LDSCTL_OFF = RING_BYTES, MISC_OFF = LDSCTL_OFF + 320, IDX_OFF = RING_BYTES + 1024, SCL_OFF = RING_BYTES + 2048, UT_OFF = RING_BYTES + 8192, LDS_BYTES = 147456;

#define LDS_WAIT() asm volatile("s_waitcnt lgkmcnt(0)" ::: "memory")
#define VM_WAIT() asm volatile("s_waitcnt vmcnt(0)" ::: "memory")
__device__ __forceinline__ unsigned f2bf(float f) { unsigned u = __builtin_bit_cast(unsigned, f); return (u + 0x7fffu + ((u >> 16) & 1u)) >> 16; }
__device__ __forceinline__ unsigned pk2(float lo, float hi) { return f2bf(lo) | (f2bf(hi) << 16); }
__device__ __forceinline__ float bf2f(unsigned b) { return __builtin_bit_cast(float, b << 16); }
__device__ __forceinline__ unsigned cvt_pk_bf16(float lo, float hi) { unsigned r; asm volatile("v_cvt_pk_bf16_f32 %0, %1, %2" : "=v"(r) : "v"(lo), "v"(hi)); return r; }
__device__ __forceinline__ float wave_sum(float v) {
#pragma unroll
    for (int o = 1; o < 64; o <<= 1) v += __shfl_xor(v, o);
    return v;
}
__device__ __forceinline__ float fast_sigmoid(float x) { return __builtin_amdgcn_rcpf(1.0f + __builtin_amdgcn_exp2f(-1.4426950408889634f * x)); }

namespace pg8 {
constexpr int BM = 256, BK = 64, HALF = 128, HTB = HALF * BK * 2, NXCD = 8, WGM = 4;
__host__ __device__ __forceinline__ int lds_byte(int r, int c) { const int st = (r >> 4) * 2 + (c >> 5), rr = r & 15, cc = c & 31, ob = rr * 64 + cc * 2; return st * 1024 + (ob ^ (((ob >> 9) & 1) << 5)); }
__host__ __device__ __forceinline__ void stage_rc(int b, int& R, int& C) { const int st = b / 1024, sb = b % 1024, swz = sb ^ (((sb >> 9) & 1) << 5); R = (st >> 1) * 16 + swz / 64; C = (st & 1) * 32 + (swz % 64) / 2; }
__host__ __device__ __forceinline__ int perm32(int rho) { const int n = rho >> 4, i = rho & 15; return 8 * (i >> 2) + 4 * n + (i & 3); }

__device__ __forceinline__ void lane_rc(int i, int& R, int& C) { int t = threadIdx.x; asm volatile("" : "+v"(t)); stage_rc(t * 16 + i * 8192, R, C); }
struct GUnit { int pm, pn, e, aux, rs, sa; };
__device__ __forceinline__ void tile_of(int L, int nM, int nN, int& pm, int& pn) {
    const int nwg = nM * nN; int wgid = L;
    { const int q = nwg / NXCD, r = nwg % NXCD, xcd = wgid % NXCD, off = wgid / NXCD; wgid = (xcd < r ? xcd * (q + 1) : r * (q + 1) + (xcd - r) * q) + off; }
    const int nig = WGM * nN, gid = wgid / nig, fm = gid * WGM, gsz = (nM - fm) < WGM ? (nM - fm) : WGM;
    pm = fm + ((wgid % nig) % gsz); pn = (wgid % nig) / gsz;
}

template <int MM> struct AccSel { typedef f32x4 T; };
template <> struct AccSel<1> { typedef i32x4 T; };
#define V8LO(v) __builtin_shufflevector(v, v, 0, 1, 2, 3)
#define V8HI(v) __builtin_shufflevector(v, v, 4, 5, 6, 7)
template <int MM, class T> __device__ __forceinline__ void mma2(T& acc, const i32x8& b, const i32x8& a, int sb, int sa) {
    if constexpr (MM == 2) asm volatile("v_mfma_scale_f32_16x16x128_f8f6f4 %0, %1, %2, %0, %3, %4 op_sel_hi:[0,0,0]" : "+v"(acc) : "v"(b), "v"(a), "v"(sb), "v"(sa));
    else if constexpr (MM == 1) { acc = __builtin_amdgcn_mfma_i32_16x16x64_i8(V8LO(b), V8LO(a), acc, 0, 0, 0); acc = __builtin_amdgcn_mfma_i32_16x16x64_i8(V8HI(b), V8HI(a), acc, 0, 0, 0); }
    else { acc = __builtin_amdgcn_mfma_f32_16x16x32_bf16(__builtin_bit_cast(bf16x8, V8LO(b)), __builtin_bit_cast(bf16x8, V8LO(a)), acc, 0, 0, 0);
           acc = __builtin_amdgcn_mfma_f32_16x16x32_bf16(__builtin_bit_cast(bf16x8, V8HI(b)), __builtin_bit_cast(bf16x8, V8HI(a)), acc, 0, 0, 0); }
}
template <class Epi, class Sched>
__device__ __forceinline__ void gemm_phase(LAS unsigned char* lds, const Sched& S, const Epi& E) {
    int tid_ = threadIdx.x; asm volatile("" : "+v"(tid_));
    const int tid = tid_, wid = __builtin_amdgcn_readfirstlane(tid >> 6), lane = tid & 63, wr = wid >> 2, wc = wid & 3, fr = lane & 15, fq = lane >> 4;
    const int nt = S.K / BK;
    unsigned voffB[2];
#pragma unroll
    for (int i = 0; i < 2; ++i) { int R, C; stage_rc(tid * 16 + i * 8192, R, C); const int Rb = Epi::PERM ? ((R & ~31) + perm32(R & 31)) : R; voffB[i] = (unsigned)(Rb * S.ldb + C) * 2u; }
    const unsigned kstep = BK * 2u;
    const unsigned hstepB = (unsigned)HALF * S.ldb * 2u;
    const unsigned ldsw = (unsigned)wid * 1024u;
    const int aoff = lds_byte(wr * 64 + fr, fq * 8), boff = lds_byte(wc * 32 + fr, fq * 8);
#define PG8_SA(b, h) (((b) * 2 + (h)) * HTB)
#define PG8_SB(b, h) ((4 + (b) * 2 + (h)) * HTB)
#define PG8_STAGE_A(bufoff, abase, soff, voff) do { const char* _g = (abase) + (unsigned)__builtin_amdgcn_readfirstlane((int)(soff)); asm volatile("" : "+s"(_g)); _Pragma("unroll") for (int _i = 0; _i < 2; ++_i) \
        __builtin_amdgcn_global_load_lds((const unsigned*)(_g + (voff)[_i]), (LAS unsigned*)(lds + (bufoff) + ldsw + _i * 8192), 16, 0, 0); } while (0)
#define PG8_STAGE_B(bufoff, soff) do { const char* _g = S.Bbase + (unsigned)__builtin_amdgcn_readfirstlane((int)(soff)); asm volatile("" : "+s"(_g)); _Pragma("unroll") for (int _i = 0; _i < 2; ++_i) \
        __builtin_amdgcn_global_load_lds((const unsigned*)(_g + voffB[_i]), (LAS unsigned*)(lds + (bufoff) + ldsw + _i * 8192), 16, 0, 0); } while (0)
#define PG8_LDA(dst, b, h) do { _Pragma("unroll") for (int m = 0; m < 4; ++m) dst[m] = __builtin_shufflevector(*(const LAS i32x4*)(lds + PG8_SA(b, h) + aoff + m * 2048), *(const LAS i32x4*)(lds + PG8_SA(b, h) + aoff + m * 2048 + 1024), 0, 1, 2, 3, 4, 5, 6, 7); } while (0)
#define PG8_LDB(dst, b, h) do { _Pragma("unroll") for (int n = 0; n < 2; ++n) dst[n] = __builtin_shufflevector(*(const LAS i32x4*)(lds + PG8_SB(b, h) + boff + n * 2048), *(const LAS i32x4*)(lds + PG8_SB(b, h) + boff + n * 2048 + 1024), 0, 1, 2, 3, 4, 5, 6, 7); } while (0)
#define PG8_MMA(ai, bj, At, Bt) do { __builtin_amdgcn_s_setprio(1); _Pragma("unroll") for (int m = 0; m < 4; ++m) _Pragma("unroll") for (int n = 0; n < 2; ++n) \
        mma2<Epi::MM>(acc[ai][bj][m][n], Bt[n], At[m], fsb[bj][n], fsa); __builtin_amdgcn_s_setprio(0); } while (0)
#define PG8_WAIT_V(n) asm volatile("s_waitcnt vmcnt(" #n ")" ::: "memory")
#define PG8_WAIT_L(n) asm volatile("s_waitcnt lgkmcnt(" #n ")" ::: "memory")
#define PG8_BAR __builtin_amdgcn_s_barrier()
#define PG8_SCHED __builtin_amdgcn_sched_barrier(0)
    if (wid == 0) { GUnit u; const bool ok = S.next(lane, u); LAS int* tb = (LAS int*)(lds + UT_OFF) + lane * 8;
        tb[0] = ok ? u.pm : -1; tb[1] = u.pn; tb[2] = u.e; tb[3] = u.aux; tb[4] = u.rs; tb[5] = u.sa; tb[6] = ok ? (int)S.b_off(u) : 0; tb[7] = ok ? (int)S.a_tile(u) : 0; }
    asm volatile("s_waitcnt lgkmcnt(0)" ::: "memory"); __syncthreads();
#define PG8_UNIT(i, u, bo, ao, ok) do { const LAS int* tb_ = (const LAS int*)(lds + UT_OFF) + ((i) & 63) * 8; \
        u.pm = __builtin_amdgcn_readfirstlane(tb_[0]); u.pn = __builtin_amdgcn_readfirstlane(tb_[1]); u.e = __builtin_amdgcn_readfirstlane(tb_[2]); u.aux = __builtin_amdgcn_readfirstlane(tb_[3]); \
        u.rs = __builtin_amdgcn_readfirstlane(tb_[4]); u.sa = __builtin_amdgcn_readfirstlane(tb_[5]); bo = (unsigned)__builtin_amdgcn_readfirstlane(tb_[6]); ao = (unsigned)__builtin_amdgcn_readfirstlane(tb_[7]); \
        ok = (i) < 64 && u.pm >= 0; } while (0)
    GUnit cur, nxt; int ui = 0; unsigned cB, cA, nB, nA; bool ok0;
    PG8_UNIT(0, cur, cB, cA, ok0);
    if (!ok0) return;
    const char* cAp = S.a_base(cur); const char* nAp = cAp;
    typedef typename AccSel<Epi::MM>::T AccT;
    int fsa = 127, fsb[2][2] = {{127, 127}, {127, 127}};
    AccT acc[2][2][4][2];
#pragma unroll
    for (int a = 0; a < 2; ++a)
#pragma unroll
        for (int b = 0; b < 2; ++b)
#pragma unroll
            for (int m = 0; m < 4; ++m)
#pragma unroll
                for (int n = 0; n < 2; ++n) acc[a][b][m][n] = AccT{};
    i32x8 At[4], B0[2], B1[2];
    unsigned oC[2][2], oN[2][2];
    if constexpr (Sched::GATHER) { S.a_off_first(cur, oC);
#pragma unroll
        for (int h = 0; h < 2; ++h)
#pragma unroll
            for (int i = 0; i < 2; ++i) oN[h][i] = oC[h][i]; }
    else { GUnit z; z.pm = 0; z.pn = 0; z.e = 0; z.aux = 0; z.rs = 0; z.sa = 127; S.a_off_first(z, oC);
#pragma unroll
        for (int h = 0; h < 2; ++h)
#pragma unroll
            for (int i = 0; i < 2; ++i) oN[h][i] = oC[h][i]; }
    if constexpr (Epi::MM == 2) S.f8_scales(cur, wc, fr, fsa, fsb);
    if constexpr (Epi::LDSS) E.prefetch_scales(cur, 0, lds);
    PG8_STAGE_B(PG8_SB(0, 0), cB); PG8_STAGE_B(PG8_SB(0, 1), cB + hstepB); PG8_STAGE_A(PG8_SA(0, 0), cAp, cA, oC[0]); PG8_STAGE_A(PG8_SA(0, 1), cAp, cA, oC[1]);
    if (wr == 1) PG8_BAR;
    PG8_WAIT_V(2); PG8_BAR;
    PG8_STAGE_B(PG8_SB(1, 0), cB + kstep); PG8_STAGE_A(PG8_SA(1, 0), cAp, cA + kstep, oC[0]); PG8_STAGE_B(PG8_SB(1, 1), cB + hstepB + kstep);
    PG8_WAIT_V(6); PG8_BAR;
    for (;;) {
        bool has_next; PG8_UNIT(ui + 1, nxt, nB, nA, has_next);
        if (!has_next) { nB = cB; nA = cA; nAp = cAp; } else nAp = S.a_base(nxt);
        if (has_next) S.prefetch(nxt, lds);
        if constexpr (Epi::LDSS) { if (has_next) E.prefetch_scales(nxt, (ui + 1) % 3, lds); }
        for (int t = 0; t < nt; t += 2) {
            const bool last = (t == nt - 2);
            const unsigned a1 = cA + (unsigned)(t + 1) * kstep;
            const unsigned a2 = last ? nA : cA + (unsigned)(t + 2) * kstep, b2 = last ? nB : cB + (unsigned)(t + 2) * kstep;
            const unsigned a3 = a2 + kstep, b3 = b2 + kstep; const char* const ap2 = last ? nAp : cAp;
            if constexpr (Sched::GATHER) { if (last && has_next) S.a_off_next(nxt, oN, lds); }
            PG8_LDB(B0, 0, 0); PG8_LDB(B1, 0, 1); PG8_SCHED; PG8_LDA(At, 0, 0); PG8_STAGE_A(PG8_SA(1, 1), cAp, a1, oC[1]);
            PG8_WAIT_V(8); PG8_WAIT_L(0); PG8_BAR; PG8_MMA(0, 0, At, B0); PG8_MMA(0, 1, At, B1); PG8_BAR; PG8_SCHED;
            PG8_LDA(At, 0, 1); PG8_STAGE_B(PG8_SB(0, 0), b2); PG8_STAGE_B(PG8_SB(0, 1), b2 + hstepB); PG8_STAGE_A(PG8_SA(0, 0), ap2, a2, oN[0]);
            PG8_WAIT_V(8); PG8_WAIT_L(0); PG8_BAR; PG8_MMA(1, 0, At, B0); PG8_MMA(1, 1, At, B1); PG8_BAR; PG8_SCHED;
            PG8_LDB(B0, 1, 0); PG8_LDB(B1, 1, 1); PG8_SCHED; PG8_LDA(At, 1, 0); PG8_STAGE_A(PG8_SA(0, 1), ap2, a2, oN[1]);
            PG8_WAIT_V(8); PG8_WAIT_L(0); PG8_BAR; PG8_MMA(0, 0, At, B0); PG8_MMA(0, 1, At, B1); PG8_BAR; PG8_SCHED;
            PG8_LDA(At, 1, 1); PG8_STAGE_B(PG8_SB(1, 0), b3); PG8_STAGE_B(PG8_SB(1, 1), b3 + hstepB); PG8_STAGE_A(PG8_SA(1, 0), ap2, a3, oN[0]);
            PG8_WAIT_V(8); PG8_WAIT_L(0); PG8_BAR; PG8_MMA(1, 0, At, B0); PG8_MMA(1, 1, At, B1); PG8_BAR; PG8_SCHED;
        }
        if (wr == 0) PG8_BAR;
        if constexpr (Epi::MM == 2) asm volatile("s_nop 15\n\ts_nop 15" ::: "memory");
        if constexpr (Epi::LDSS) E(acc, cur, wr, wc, fr, fq, lds + SCL_OFF + (ui % 3) * 2048); else E(acc, cur, wr, wc, fr, fq);
        if (!has_next) break;
#pragma unroll
        for (int a = 0; a < 2; ++a)
#pragma unroll
            for (int b = 0; b < 2; ++b)
#pragma unroll
                for (int m = 0; m < 4; ++m)
#pragma unroll
                    for (int n = 0; n < 2; ++n) acc[a][b][m][n] = AccT{};
        cur = nxt; cB = nB; cA = nA; cAp = nAp; ++ui;
        if constexpr (Epi::MM == 2) S.f8_scales(cur, wc, fr, fsa, fsb);
        if constexpr (Sched::GATHER) {
#pragma unroll
        for (int h = 0; h < 2; ++h)
#pragma unroll
            for (int i = 0; i < 2; ++i) oC[h][i] = oN[h][i]; }
        if (wr == 1) PG8_BAR;
    }
    PG8_WAIT_V(0);
    PG8_BAR;
#undef PG8_UNIT
#undef PG8_SA
#undef PG8_SB
#undef PG8_STAGE_A
#undef PG8_STAGE_B
#undef PG8_LDA
#undef PG8_LDB
#undef PG8_MMA
#undef PG8_WAIT_V
#undef PG8_WAIT_L
#undef PG8_BAR
#undef PG8_SCHED
}
}

using pg8::GUnit;
struct PlainSched {
    static constexpr bool GATHER = false;
    __device__ __forceinline__ const char* a_base(const GUnit&) const { return Abase; }
    __device__ __forceinline__ unsigned a_tile(const GUnit& u) const { return (unsigned)(u.pm * 256 * lda) * 2u; }
    const char* Abase; const char* Bbase; int K, lda, ldb, nM, nN, G, c, pmdiv; size_t bstride; int sa = 127; const int* sb8 = nullptr;
    __device__ __forceinline__ bool next(int i, GUnit& u) const { const long L = (long)i * G + c; if (L >= (long)nM * nN) return false; pg8::tile_of((int)L, nM, nN, u.pm, u.pn); u.e = u.pm / pmdiv; u.aux = u.pm; u.rs = u.pm * 256; u.sa = sa; return true; }
    __device__ __forceinline__ void f8_scales(const GUnit& u, int wc, int fr, int& sa_, int (&sb)[2][2]) const { sa_ = u.sa;
#pragma unroll
        for (int bj = 0; bj < 2; ++bj)
#pragma unroll
            for (int n = 0; n < 2; ++n) sb[bj][n] = sb8[u.pn * 256 + bj * 128 + wc * 32 + pg8::perm32(n * 16 + fr)]; }
    __device__ __forceinline__ void a_off_first(const GUnit& u, unsigned (&off)[2][2]) const { int R[2], C[2]; pg8::lane_rc(0, R[0], C[0]); pg8::lane_rc(1, R[1], C[1]);
#pragma unroll
        for (int h = 0; h < 2; ++h)
#pragma unroll
            for (int i = 0; i < 2; ++i) off[h][i] = (unsigned)((u.pm * 256 + h * 128 + R[i]) * lda + C[i]) * 2u; }
    __device__ __forceinline__ void a_off_next(const GUnit& u, unsigned (&off)[2][2], LAS unsigned char*) const { a_off_first(u, off); }
    __device__ __forceinline__ void prefetch(const GUnit&, LAS unsigned char*) const {}
    __device__ __forceinline__ unsigned b_off(const GUnit& u) const { return (unsigned)((size_t)u.e * bstride + (size_t)u.pn * 256 * ldb * 2); }
};
constexpr int ET_OFF = RING_BYTES + 512;
__device__ __forceinline__ void etab_build(LAS unsigned char* lds, const unsigned* ctl) {
    if (threadIdx.x < 64) { const int l = threadIdx.x & 63; int v = 0;
        if (l < NE) { v = (int)__hip_atomic_load(ctl + CW_ECNT + 64 * l, __ATOMIC_RELAXED, __HIP_MEMORY_SCOPE_AGENT); v = v < 0 ? 0 : (v > LCAP ? LCAP : v); }
        else if (l < 2 * NE) v = (int)__hip_atomic_load(ctl + CW_EA + (l - NE), __ATOMIC_RELAXED, __HIP_MEMORY_SCOPE_AGENT);
        int np = (l < NE) ? ((v + 255) >> 8) : 0, ps = np;
#pragma unroll
        for (int o = 1; o < NE; o <<= 1) { const int t = __shfl_up(ps, o); if (l >= o) ps += t; }
        if (l < NE) { *(LAS int*)(lds + ET_OFF + 4 * l) = v; *(LAS int*)(lds + ET_OFF + 32 + 4 * l) = ps - np; if (l == NE - 1) *(LAS int*)(lds + ET_OFF + 32 + 4 * NE) = ps; }
        else if (l < 2 * NE) *(LAS int*)(lds + ET_OFF + 72 + 4 * (l - NE)) = v; }
    __syncthreads();
}
__device__ __forceinline__ int et_cnt(LAS unsigned char* lds, int e) { return __builtin_amdgcn_readfirstlane(*(const LAS int*)(lds + ET_OFF + 4 * e)); }
__device__ __forceinline__ int et_ps(LAS unsigned char* lds, int e) { return __builtin_amdgcn_readfirstlane(*(const LAS int*)(lds + ET_OFF + 32 + 4 * e)); }
__device__ __forceinline__ int et_sa(LAS unsigned char* lds, int e) { return __builtin_amdgcn_readfirstlane(*(const LAS int*)(lds + ET_OFF + 72 + 4 * e)); }
__device__ __forceinline__ int et_ps_l(LAS unsigned char* lds, int e) { return *(const LAS int*)(lds + ET_OFF + 32 + 4 * e); }
__device__ __forceinline__ int et_sa_l(LAS unsigned char* lds, int e) { return *(const LAS int*)(lds + ET_OFF + 72 + 4 * e); }
__device__ __forceinline__ int et_expert(LAS unsigned char* lds, int p) { int e = 0;
#pragma unroll
    for (int k = 1; k < NE; ++k) e += (p >= et_ps_l(lds, k)) ? 1 : 0;
    return e; }
struct MoeSched1 {
    static constexpr bool GATHER = true;
    __device__ __forceinline__ const char* a_base(const GUnit&) const { return Abase; }
    __device__ __forceinline__ unsigned a_tile(const GUnit&) const { return 0u; }
    const char* Abase; const char* Bbase; const int* list; int K, ldb, nM, nN, G, c, p0; LAS unsigned char* EL;
    __device__ __forceinline__ bool next(int i, GUnit& u) const { const long L = (long)i * G + c; if (L >= (long)nM * nN) return false; if (MK_MOE_NMAJOR) pg8::tile_of((int)L, nN, nM, u.pn, u.pm); else pg8::tile_of((int)L, nM, nN, u.pm, u.pn); u.aux = p0 + u.pm; u.e = et_expert(EL, u.aux); u.rs = u.e * LCAP + (u.aux - et_ps_l(EL, u.e)) * 256; u.sa = et_sa_l(EL, u.e); return true; }
    __device__ __forceinline__ void a_off_first(const GUnit& u, unsigned (&off)[2][2]) const { int R[2], C[2]; pg8::lane_rc(0, R[0], C[0]); pg8::lane_rc(1, R[1], C[1]);
        const int cn = et_cnt(EL, u.e), ps = et_ps(EL, u.e);
        const int lp = (u.aux - ps) * 256;
#pragma unroll
        for (int h = 0; h < 2; ++h)
#pragma unroll
            for (int i = 0; i < 2; ++i) { const int pos = lp + h * 128 + R[i]; int tok = list[u.e * LCAP + (pos < LCAP ? pos : 0)]; tok = (pos < cn) ? tok : 0; tok = ((unsigned)tok < (unsigned)NTOK) ? tok : 0; off[h][i] = (unsigned)(tok * K + C[i]) * 2u; } }
    __device__ __forceinline__ void prefetch(const GUnit& u, LAS unsigned char* lds) const {
        const int wid = __builtin_amdgcn_readfirstlane(threadIdx.x >> 6), lane = threadIdx.x & 63;
        if (wid < 4) { const int ps = et_ps(EL, u.e);
            const int pos = (u.aux - ps) * 256 + wid * 64 + lane;
            __builtin_amdgcn_global_load_lds((const unsigned*)(list + u.e * LCAP + (pos < LCAP ? pos : 0)), (LAS unsigned*)(lds + IDX_OFF + wid * 256), 4, 0, 0); } }
    __device__ __forceinline__ void a_off_next(const GUnit& u, unsigned (&off)[2][2], LAS unsigned char* lds) const { int R[2], C[2]; pg8::lane_rc(0, R[0], C[0]); pg8::lane_rc(1, R[1], C[1]);
        const int cn = et_cnt(EL, u.e), ps = et_ps(EL, u.e);
        const int lp = (u.aux - ps) * 256;
#pragma unroll
        for (int h = 0; h < 2; ++h)
#pragma unroll
            for (int i = 0; i < 2; ++i) { const int rr = h * 128 + R[i]; int tok = *(const LAS int*)(lds + IDX_OFF + rr * 4); tok = (lp + rr < cn) ? tok : 0; tok = ((unsigned)tok < (unsigned)NTOK) ? tok : 0; off[h][i] = (unsigned)(tok * K + C[i]) * 2u; } }
    __device__ __forceinline__ unsigned b_off(const GUnit& u) const { return (unsigned)((size_t)u.e * ((size_t)2 * FFE * DM) + (size_t)u.pn * 256 * ldb * 2); }
};
struct MoeSched2 {
    static constexpr bool GATHER = false;
    __device__ __forceinline__ const char* a_base(const GUnit& u) const { return u.pm < ASPLIT ? Abase : Abase2; }
    __device__ __forceinline__ unsigned a_tile(const GUnit& u) const { return (unsigned)((u.pm < ASPLIT ? u.pm : u.pm - ASPLIT) * 256 * lda) * 2u; }
    const char* Abase; const char* Abase2; const char* Bbase; const int* sb8; int K, lda, ldb, nM, nN, G, c, p0; LAS unsigned char* EL;
    __device__ __forceinline__ bool next(int i, GUnit& u) const { const long L = (long)i * G + c; if (L >= (long)nM * nN) return false; pg8::tile_of((int)L, nM, nN, u.pm, u.pn); u.aux = p0 + u.pm; u.e = et_expert(EL, u.aux); u.rs = 0; u.sa = et_sa_l(EL, u.e); return true; }
    __device__ __forceinline__ void a_off_first(const GUnit& u, unsigned (&off)[2][2]) const { int R[2], C[2]; pg8::lane_rc(0, R[0], C[0]); pg8::lane_rc(1, R[1], C[1]);
#pragma unroll
        for (int h = 0; h < 2; ++h)
#pragma unroll
            for (int i = 0; i < 2; ++i) off[h][i] = (unsigned)((u.pm * 256 + h * 128 + R[i]) * lda + C[i]) * 2u; }
    __device__ __forceinline__ void a_off_next(const GUnit& u, unsigned (&off)[2][2], LAS unsigned char*) const { a_off_first(u, off); }
    __device__ __forceinline__ void prefetch(const GUnit&, LAS unsigned char*) const {}
    __device__ __forceinline__ unsigned b_off(const GUnit& u) const { return (unsigned)((size_t)u.e * ((size_t)DM * FFE) + (size_t)u.pn * 256 * ldb * 2); }
    __device__ __forceinline__ void f8_scales(const GUnit& u, int wc, int fr, int& sa, int (&sb)[2][2]) const { sa = u.sa;
#pragma unroll
        for (int bj = 0; bj < 2; ++bj)
#pragma unroll
            for (int n = 0; n < 2; ++n) sb[bj][n] = sb8[u.e * DM + u.pn * 256 + bj * 128 + wc * 32 + pg8::perm32(n * 16 + fr)]; }
};

struct MoeSched2K {
    static constexpr bool GATHER = false;
    __device__ __forceinline__ const char* a_base(const GUnit& u) const { return u.pm < ASPLIT ? Abase : Abase2; }
    __device__ __forceinline__ unsigned a_tile(const GUnit& u) const { return (unsigned)((u.pm < ASPLIT ? u.pm : u.pm - ASPLIT) * 256 * lda) * 2u + (unsigned)u.rs * 512u; }
    const char* Abase; const char* Abase2; const char* Bbase; const int* sb8; int K, lda, ldb, nLeft, G, c; LAS unsigned char* EL;
    __device__ __forceinline__ bool next(int i, GUnit& u) const { const long L = (long)i * G + c; if (L >= (long)nLeft * 4 * KSPLIT) return false; const int kc = (int)(L % KSPLIT), t = (int)(L / KSPLIT), lp = t >> 2;
        u.pn = t & 3; u.pm = 256 + lp; u.rs = kc; u.aux = kc * LPMAX + lp; u.e = et_expert(EL, u.pm); u.sa = et_sa_l(EL, u.e); return true; }
    __device__ __forceinline__ void a_off_first(const GUnit& u, unsigned (&off)[2][2]) const { int R[2], C[2]; pg8::lane_rc(0, R[0], C[0]); pg8::lane_rc(1, R[1], C[1]);
#pragma unroll
        for (int h = 0; h < 2; ++h)
#pragma unroll
            for (int i = 0; i < 2; ++i) off[h][i] = (unsigned)((u.pm * 256 + h * 128 + R[i]) * lda + C[i]) * 2u; }
    __device__ __forceinline__ void a_off_next(const GUnit& u, unsigned (&off)[2][2], LAS unsigned char*) const { a_off_first(u, off); }
    __device__ __forceinline__ void prefetch(const GUnit&, LAS unsigned char*) const {}
    __device__ __forceinline__ unsigned b_off(const GUnit& u) const { return (unsigned)((size_t)u.e * ((size_t)DM * FFE) + (size_t)u.pn * 256 * ldb * 2) + (unsigned)u.rs * 512u; }
    __device__ __forceinline__ void f8_scales(const GUnit& u, int wc, int fr, int& sa, int (&sb)[2][2]) const { sa = u.sa;
#pragma unroll
        for (int bj = 0; bj < 2; ++bj)
#pragma unroll
            for (int n = 0; n < 2; ++n) sb[bj][n] = sb8[u.e * DM + u.pn * 256 + bj * 128 + wc * 32 + pg8::perm32(n * 16 + fr)]; }
};

struct MoeSched2B {
    static constexpr bool GATHER = false;
    __device__ __forceinline__ const char* a_base(const GUnit&) const { return Abase; }
    __device__ __forceinline__ unsigned a_tile(const GUnit& u) const { return (unsigned)(u.pm * 256 * lda) * 2u; }
    const char* Abase; const char* Bbase; int K, lda, ldb, nM, nN, G, c, p0; LAS unsigned char* EL;
    __device__ __forceinline__ bool next(int i, GUnit& u) const { const long L = (long)i * G + c; if (L >= (long)nM * nN) return false; pg8::tile_of((int)L, nM, nN, u.pm, u.pn); u.aux = p0 + u.pm; u.e = et_expert(EL, u.aux); u.rs = 0; u.sa = 127; return true; }
    __device__ __forceinline__ void a_off_first(const GUnit& u, unsigned (&off)[2][2]) const { int R[2], C[2]; pg8::lane_rc(0, R[0], C[0]); pg8::lane_rc(1, R[1], C[1]);
#pragma unroll
        for (int h = 0; h < 2; ++h)
#pragma unroll
            for (int i = 0; i < 2; ++i) off[h][i] = (unsigned)((u.pm * 256 + h * 128 + R[i]) * lda + C[i]) * 2u; }
    __device__ __forceinline__ void a_off_next(const GUnit& u, unsigned (&off)[2][2], LAS unsigned char*) const { a_off_first(u, off); }
    __device__ __forceinline__ void prefetch(const GUnit&, LAS unsigned char*) const {}
    __device__ __forceinline__ unsigned b_off(const GUnit& u) const { return (unsigned)((size_t)u.e * ((size_t)DM * FFE * 2) + (size_t)u.pn * 256 * ldb * 2); }
};

typedef const f32x4 (&AccRef)[2][2][4][2];
struct EpiS5A { static constexpr bool PERM = false, LDSS = false; static constexpr int MM = 0; float* sloc;
    __device__ __forceinline__ void operator()(AccRef acc, const GUnit& u, int wr, int wc, int fr, int fq) const {
        float* base = sloc + (size_t)(u.pm * 256 + wr * 64 + fr) * 128 + wc * 32 + 4 * fq;
#pragma unroll
        for (int ai = 0; ai < 2; ++ai)
#pragma unroll
            for (int m = 0; m < 4; ++m)
#pragma unroll
                for (int n = 0; n < 2; ++n) *(f32x4*)(base + (size_t)(ai * 128 + m * 16) * 128 + n * 16) = acc[ai][0][m][n]; } };
struct EpiS5C { static constexpr bool PERM = true, LDSS = false; static constexpr int MM = 0; const bf16* ua; const float* dsk; const float* g0; bf16* gbuf;
    __device__ __forceinline__ void operator()(AccRef acc, const GUnit& u, int wr, int wc, int fr, int fq) const {
        const int g = u.pm >> 3, i0 = 8 * (fq & 1);
        f32x4 d0 = *(const f32x4*)(dsk + g * 16 + i0) * *(const f32x4*)(g0 + g * 16 + i0), d1 = *(const f32x4*)(dsk + g * 16 + i0 + 4) * *(const f32x4*)(g0 + g * 16 + i0 + 4);
        const bf16* const up = ua + (size_t)(u.pm * 256 + wr * 64 + fr) * UAK + 32 * wc + 8 * fq;
#define S5C_LD(s_) (*(const v4u*)(up + (size_t)((((s_) >> 3) & 1) * 128 + (((s_) >> 1) & 3) * 16) * UAK + 128 * ((s_) & 1)))
        v4u un0 = S5C_LD(0), un1 = S5C_LD(1);
#pragma unroll
        for (int ai = 0; ai < 2; ++ai)
#pragma unroll
            for (int m = 0; m < 4; ++m) { const int r = ai * 128 + wr * 64 + m * 16 + fr, rowg = (u.pm & 7) * 256 + r, b = rowg >> 7, c = rowg & 127;
#pragma unroll
                for (int bj = 0; bj < 2; ++bj) { const int col = 128 * bj + 32 * wc + 8 * fq, t = col >> 4; const int st = (ai * 4 + m) * 2 + bj;
                    const v4u uu = un0; un0 = un1; if (st + 2 < 16) un1 = S5C_LD(st + 2);
                    f32x4 y0 = acc[ai][bj][m][0], y1 = acc[ai][bj][m][1];
                    y0[0] += d0[0] * bf2f(uu.x & 0xffffu); y0[1] += d0[1] * bf2f(uu.x >> 16); y0[2] += d0[2] * bf2f(uu.y & 0xffffu); y0[3] += d0[3] * bf2f(uu.y >> 16);
                    y1[0] += d1[0] * bf2f(uu.z & 0xffffu); y1[1] += d1[1] * bf2f(uu.z >> 16); y1[2] += d1[2] * bf2f(uu.w & 0xffffu); y1[3] += d1[3] * bf2f(uu.w >> 16);
#pragma unroll
                    for (int k = 0; k < 4; ++k) { const float a = y0[k], bq = y1[k]; y0[k] = a * fast_sigmoid(1.5957691216f * (a + 0.044715f * a * a * a)); y1[k] = bq * fast_sigmoid(1.5957691216f * (bq + 0.044715f * bq * bq * bq)); }
                    v4u w; w.x = cvt_pk_bf16(y0[0], y0[1]); w.y = cvt_pk_bf16(y0[2], y0[3]); w.z = cvt_pk_bf16(y1[0], y1[1]); w.w = cvt_pk_bf16(y1[2], y1[3]);
                    *(v4u*)(gbuf + (size_t)(b * SEQ + c * CL + t) * DM + g * 16 + i0) = w; }
                asm volatile("" ::: "memory"); }
#undef S5C_LD
    } };
template <int MODE> struct EpiGated { static constexpr bool PERM = true, LDSS = false; static constexpr int MM = 0; bf16* out; int ldc; float* rowss; int rowsel;
    __device__ __forceinline__ void operator()(AccRef acc, const GUnit& u, int wr, int wc, int fr, int fq) const {
#pragma unroll
        for (int ai = 0; ai < 2; ++ai)
#pragma unroll
            for (int m = 0; m < 4; ++m) { const int row = u.pm * 256 + ai * 128 + wr * 64 + m * 16 + fr; float o[8]; float ss = 0.f;
#pragma unroll
                for (int n = 0; n < 2; ++n)
#pragma unroll
                    for (int k = 0; k < 4; ++k) { const float a = acc[ai][0][m][n][k], bq = acc[ai][1][m][n][k]; const float v = (MODE == 0) ? a * fast_sigmoid(bq) : a * fast_sigmoid(a) * bq; o[n * 4 + k] = v; ss += v * v; }
                v4u w; w.x = cvt_pk_bf16(o[0], o[1]); w.y = cvt_pk_bf16(o[2], o[3]); w.z = cvt_pk_bf16(o[4], o[5]); w.w = cvt_pk_bf16(o[6], o[7]);
                *(v4u*)(out + (size_t)row * ldc + u.pn * 128 + wc * 32 + fq * 8) = w;
                if (MODE == 0) { ss += __shfl_xor(ss, 16); ss += __shfl_xor(ss, 32); if (fq == 0) rowss[(size_t)row * 32 + u.pn * 4 + wc] = ss; } } } };
__device__ __forceinline__ void scales_to_lds(const float* rs256, const float* cm256, int buf, LAS unsigned char* lds) {
    const int wid = __builtin_amdgcn_readfirstlane(threadIdx.x >> 6), lane = threadIdx.x & 63;
    const float* src = (wid < 4) ? rs256 + wid * 64 + lane : cm256 + (wid - 4) * 64 + lane;
    __builtin_amdgcn_global_load_lds((const unsigned*)src, (LAS unsigned*)(lds + SCL_OFF + buf * 2048 + wid * 256), 4, 0, 0);
}
template <bool F8OUT> struct EpiGatedI8 { static constexpr bool PERM = true, LDSS = true; static constexpr int MM = 1; bf16* out; int ldc; const float* rowscale; const float* colmax; int cstride; unsigned char* out2;
    __device__ __forceinline__ void prefetch_scales(const GUnit& u, int buf, LAS unsigned char* lds) const { scales_to_lds(rowscale + u.rs, colmax + (size_t)u.e * cstride + u.pn * 256, buf, lds); }
    __device__ __forceinline__ void operator()(const i32x4 (&acc)[2][2][4][2], const GUnit& u, int wr, int wc, int fr, int fq, LAS unsigned char* tab) const {
        const LAS float* cm = (const LAS float*)(tab + 1024) + wc * 32 + 8 * fq; const float k127 = 1.0f / 127.0f;
        float fscale = 1.0f; if constexpr (F8OUT) fscale = __builtin_bit_cast(float, (unsigned)(254 - u.sa) << 23);
        const float L2E = 1.4426950408889634f, k1 = k127 * L2E, k3 = k127 * fscale * (1.0f / L2E);
        const f32x4 s1a = *(const LAS f32x4*)cm * k1, s1b = *(const LAS f32x4*)(cm + 4) * k1, s3a = *(const LAS f32x4*)(cm + 128) * k3, s3b = *(const LAS f32x4*)(cm + 132) * k3;
        const f32x2 c1[4] = {{s1a[0], s1a[1]}, {s1a[2], s1a[3]}, {s1b[0], s1b[1]}, {s1b[2], s1b[3]}}, c3[4] = {{s3a[0], s3a[1]}, {s3a[2], s3a[3]}, {s3b[0], s3b[1]}, {s3b[2], s3b[3]}};
        const LAS float* rsc = (const LAS float*)tab + wr * 64 + fr;
        [[maybe_unused]] unsigned px0 = 0u, px1 = 0u;
#pragma unroll
        for (int ai = 0; ai < 2; ++ai)
#pragma unroll
            for (int m = 0; m < 4; ++m) { const int r = ai * 128 + wr * 64 + m * 16 + fr; const float sA = rsc[ai * 128 + m * 16]; const f32x2 sAA = {sA, sA}; float o[8];
#pragma unroll
                for (int q = 0; q < 4; ++q) { const int n = q >> 1, k0 = (q & 1) * 2;
                    const f32x2 av = (f32x2){(float)acc[ai][0][m][n][k0], (float)acc[ai][0][m][n][k0 + 1]} * (c1[q] * sAA), bv = (f32x2){(float)acc[ai][1][m][n][k0], (float)acc[ai][1][m][n][k0 + 1]} * (c3[q] * sAA);
                    const f32x2 d = (f32x2){__builtin_amdgcn_exp2f(-av[0]), __builtin_amdgcn_exp2f(-av[1])} + (f32x2){1.0f, 1.0f};
                    const f32x2 ov = (av * bv) * (f32x2){__builtin_amdgcn_rcpf(d[0]), __builtin_amdgcn_rcpf(d[1])};
                    o[2 * q] = ov[0]; o[2 * q + 1] = ov[1]; }
                if constexpr (F8OUT) {
                    int p0 = __builtin_amdgcn_cvt_pk_fp8_f32(o[0], o[1], 0, false); p0 = __builtin_amdgcn_cvt_pk_fp8_f32(o[2], o[3], p0, true);
                    int p1 = __builtin_amdgcn_cvt_pk_fp8_f32(o[4], o[5], 0, false); p1 = __builtin_amdgcn_cvt_pk_fp8_f32(o[6], o[7], p1, true);
                    if ((m & 1) == 0) { px0 = (unsigned)p0; px1 = (unsigned)p1; }
                    else { const auto s0 = __builtin_amdgcn_permlane16_swap(px0, (unsigned)p0, false, false); const auto s1 = __builtin_amdgcn_permlane16_swap(px1, (unsigned)p1, false, false);
                        v4u w; w.x = s0[0]; w.y = s1[0]; w.z = s0[1]; w.w = s1[1];
                        unsigned char* const ob = (u.pm < ASPLIT) ? (unsigned char*)out + (size_t)(u.pm * 256) * ldc : out2 + (size_t)((u.pm - ASPLIT) * 256) * ldc;
                        const int rw = r - 16 + 16 * (fq & 1);
                        *(v4u*)(ob + (size_t)rw * ldc + u.pn * 128 + wc * 32 + (fq & 2) * 8) = w; } }
                else {
                v4u w; w.x = cvt_pk_bf16(o[0], o[1]); w.y = cvt_pk_bf16(o[2], o[3]); w.z = cvt_pk_bf16(o[4], o[5]); w.w = cvt_pk_bf16(o[6], o[7]);
                *(v4u*)(out + (size_t)(u.pm * 256 + r) * ldc + u.pn * 128 + wc * 32 + fq * 8) = w; } } } };
template <bool SS, bool USEAUX, int MMODE = 0> struct EpiPlain { static constexpr bool PERM = true, LDSS = false; static constexpr int MM = MMODE; bf16* out; int ldc; float* rowss;
    __device__ __forceinline__ void operator()(AccRef acc, const GUnit& u, int wr, int wc, int fr, int fq) const {
        const int rb = (USEAUX ? u.aux : u.pm) * 256;
#pragma unroll
        for (int ai = 0; ai < 2; ++ai)
#pragma unroll
            for (int m = 0; m < 4; ++m) { const int row = rb + ai * 128 + wr * 64 + m * 16 + fr; float ss = 0.f;
#pragma unroll
                for (int bj = 0; bj < 2; ++bj) { const f32x4 v0 = acc[ai][bj][m][0], v1 = acc[ai][bj][m][1];
                    if (SS) ss += (v0[0] * v0[0] + v0[1] * v0[1]) + (v0[2] * v0[2] + v0[3] * v0[3]) + (v1[0] * v1[0] + v1[1] * v1[1]) + (v1[2] * v1[2] + v1[3] * v1[3]);
                    v4u w; w.x = cvt_pk_bf16(v0[0], v0[1]); w.y = cvt_pk_bf16(v0[2], v0[3]); w.z = cvt_pk_bf16(v1[0], v1[1]); w.w = cvt_pk_bf16(v1[2], v1[3]);
                    *(v4u*)(out + (size_t)row * ldc + u.pn * 256 + bj * 128 + wc * 32 + fq * 8) = w; }
                if (SS) { ss += __shfl_xor(ss, 16); ss += __shfl_xor(ss, 32); if (fq == 0) rowss[(size_t)row * 32 + u.pn * 4 + wc] = ss; } } } };
template <bool I8Q> struct EpiQKV { static constexpr bool PERM = true, LDSS = I8Q; static constexpr int MM = I8Q ? 1 : 0; bf16* qkv; const float* rope; float* kmean; const float* rowscale; const float* colmax;
    __device__ __forceinline__ void prefetch_scales(const GUnit& u, int buf, LAS unsigned char* lds) const { scales_to_lds(rowscale + u.rs, colmax + u.pn * 256, buf, lds); }
    template <class AccT> __device__ __forceinline__ void operator()(const AccT (&acc)[2][2][4][2], const GUnit& u, int wr, int wc, int fr, int fq, LAS unsigned char* tab = nullptr) const {
        const int sel = u.pn >> 2; bf16* const outb = qkv + (size_t)sel * (size_t)(32u << 20);
        const int colt = (u.pn & 3) * 256;
        f32x4 sb[2][2];
        if constexpr (I8Q) { const LAS float* cm = (const LAS float*)(tab + 1024) + wc * 32 + 8 * fq; const float k127 = 1.0f / 127.0f;
            sb[0][0] = *(const LAS f32x4*)cm * k127; sb[0][1] = *(const LAS f32x4*)(cm + 4) * k127; sb[1][0] = *(const LAS f32x4*)(cm + 128) * k127; sb[1][1] = *(const LAS f32x4*)(cm + 132) * k127; }
        float cs[2][2][4];
#pragma unroll
        for (int bj = 0; bj < 2; ++bj)
#pragma unroll
            for (int n = 0; n < 2; ++n)
#pragma unroll
                for (int kk = 0; kk < 4; ++kk) cs[bj][n][kk] = 0.f;
        const bool rot = sel < 2 && wc == 0; const float* const rp = rope + (size_t)(u.pm * 256 + wr * 64 + fr) * 32 + 4 * fq;
        f32x4 co0 = (f32x4){1.f, 1.f, 1.f, 1.f}, si0 = (f32x4){0.f, 0.f, 0.f, 0.f}, co1 = co0, si1 = si0;
        if (rot) { co0 = *(const f32x4*)rp; si0 = *(const f32x4*)(rp + 16); co1 = *(const f32x4*)(rp + 16 * 32); si1 = *(const f32x4*)(rp + 16 * 32 + 16); }
#pragma unroll
        for (int ai = 0; ai < 2; ++ai)
#pragma unroll
            for (int m = 0; m < 4; ++m) { const int rl = ai * 128 + wr * 64 + m * 16 + fr, row = u.pm * 256 + rl;
                float sA = 1.0f; if constexpr (I8Q) sA = ((const LAS float*)tab)[rl];
                const f32x4 co = co0, si = si0; co0 = co1; si0 = si1;
                if (rot && ai * 4 + m + 2 < 8) { const int s2 = ai * 4 + m + 2; const float* q = rp + (size_t)((s2 >> 2) * 128 + (s2 & 3) * 16) * 32; co1 = *(const f32x4*)q; si1 = *(const f32x4*)(q + 16); }
#pragma unroll
                for (int bj = 0; bj < 2; ++bj) { f32x4 v0, v1;
                    if constexpr (I8Q) {
#pragma unroll
                        for (int kk = 0; kk < 4; ++kk) { v0[kk] = (float)acc[ai][bj][m][0][kk] * (sA * sb[bj][0][kk]); v1[kk] = (float)acc[ai][bj][m][1][kk] * (sA * sb[bj][1][kk]); } }
                    else {
#pragma unroll
                        for (int kk = 0; kk < 4; ++kk) { v0[kk] = acc[ai][bj][m][0][kk]; v1[kk] = acc[ai][bj][m][1][kk]; } }
                    if (sel < 2 && wc == 0) {
                        const float a0 = v0[0] * co[0] - v0[1] * si[0], a1 = v0[1] * co[0] + v0[0] * si[0], a2 = v0[2] * co[1] - v0[3] * si[1], a3 = v0[3] * co[1] + v0[2] * si[1];
                        const float b0 = v1[0] * co[2] - v1[1] * si[2], b1 = v1[1] * co[2] + v1[0] * si[2], b2 = v1[2] * co[3] - v1[3] * si[3], b3 = v1[3] * co[3] + v1[2] * si[3];
                        v0 = (f32x4){a0, a1, a2, a3}; v1 = (f32x4){b0, b1, b2, b3}; }
                    if (sel == 1) {
#pragma unroll
                        for (int kk = 0; kk < 4; ++kk) { cs[bj][0][kk] += v0[kk]; cs[bj][1][kk] += v1[kk]; } }
                    v4u w; w.x = cvt_pk_bf16(v0[0], v0[1]); w.y = cvt_pk_bf16(v0[2], v0[3]); w.z = cvt_pk_bf16(v1[0], v1[1]); w.w = cvt_pk_bf16(v1[2], v1[3]);
                    *(v4u*)(outb + (size_t)row * DM + colt + bj * 128 + wc * 32 + fq * 8) = w; } }
        if (sel == 1) {
            const int b = u.pm >> 3, blk = u.pm & 7;
#pragma unroll
            for (int bj = 0; bj < 2; ++bj)
#pragma unroll
                for (int n = 0; n < 2; ++n)
#pragma unroll
                    for (int kk = 0; kk < 4; ++kk) { float s = cs[bj][n][kk]; s += __shfl_xor(s, 1); s += __shfl_xor(s, 2); s += __shfl_xor(s, 4); s += __shfl_xor(s, 8);
                        if (fr == 0) { const int h = (u.pn & 3) * 2 + bj; atomicAdd(kmean + ((size_t)((b * NH + h) * NBLK + blk)) * HD + wc * 32 + fq * 8 + n * 4 + kk, s * (1.0f / 256.0f)); } } } } };

namespace attn {
constexpr int D = 128, TS = DM;
constexpr float SCALE = 0.08838834764831845f, THR = 8.f;
constexpr int NW = 8, QBLK = 32, KVBLK = 64, QB = NW * QBLK;
constexpr int SHM_V = KVBLK * D * 2, SHM_K = KVBLK * D * 2;
constexpr int ATT_LDS = 2 * SHM_V + 2 * SHM_K + NW * 64 * 4;
#define KSWZ(row, colB) ((row) * 256 + ((colB) ^ (((row) & 7) << 4)))
#define SBAR() __builtin_amdgcn_sched_barrier(0)
__device__ __forceinline__ int v_st(int k, int c) { const int kk = (k & ~0xC) | ((k & 4) << 1) | ((k & 8) >> 1); return ((kk >> 3) * 4 + (c >> 5)) * 512 + ((kk & 7) * 32 + (c & 31)) * 2; }
__device__ __forceinline__ int v_rd_base(int lane) { return ((lane & 3) << 3) | (((lane >> 2) & 3) << 6) | (((lane >> 4) & 1) << 5) | (((lane >> 5) & 1) << 8); }
constexpr int v_rd_off(int d0, int ks, int half) { return d0 * 512 + ks * 4096 + half * 2048; }
__device__ __forceinline__ int crow(int r, int hi) { return (r & 3) + 8 * (r >> 2) + 4 * hi; }
__device__ __forceinline__ bf16x8 load8(const bf16* p) { return *reinterpret_cast<const bf16x8*>(p); }
__device__ __forceinline__ void mask_tile(f32x16& p0, f32x16& p1, int dq) {
    const float NEG = -__builtin_inff();
#pragma unroll
    for (int r = 0; r < 16; ++r) { const int c = (r & 3) + 8 * (r >> 2); if (dq - c < 0) p0[r] = NEG; if (dq - c - 32 < 0) p1[r] = NEG; }
}
__device__ __forceinline__ void drop_tile(f32x16& p0, f32x16& p1, bool drop) {
    const float NEG = -__builtin_inff();
#pragma unroll
    for (int r = 0; r < 16; ++r) { p0[r] = drop ? NEG : p0[r]; p1[r] = drop ? NEG : p1[r]; }
}
__device__ __forceinline__ void partialSM(f32x16& p0, f32x16& p1, float& m_reg, float& mn, float& alpha, bool drop = false) {
    float pmax = p0[0];
#pragma unroll
    for (int r = 1; r < 16; ++r) pmax = fmaxf(pmax, p0[r]);
#pragma unroll
    for (int r = 0; r < 16; ++r) pmax = fmaxf(pmax, p1[r]);
    { auto rr = __builtin_amdgcn_permlane32_swap(__float_as_uint(pmax), __float_as_uint(pmax), false, false);
      pmax = fmaxf(__uint_as_float(rr[0]), __uint_as_float(rr[1])); }
    pmax = drop ? -__builtin_inff() : pmax;
    constexpr float C2 = 1.4426950408889634f * SCALE;
    if (__builtin_expect(__all((pmax - m_reg) * SCALE <= THR), 1)) { mn = m_reg; alpha = 1.f; }
    else { mn = fmaxf(m_reg, pmax); alpha = __builtin_amdgcn_exp2f((m_reg - mn) * C2); m_reg = mn; }
    const float mnL = drop ? -__builtin_inff() : -mn * C2;
#pragma unroll
    for (int r = 0; r < 16; ++r) p0[r] = fmaf(p0[r], C2, mnL);
#pragma unroll
    for (int r = 0; r < 16; ++r) p1[r] = fmaf(p1[r], C2, mnL);
#pragma unroll
    for (int r = 0; r < 16; ++r) p0[r] = __builtin_amdgcn_exp2f(p0[r]);
}
__device__ __forceinline__ void finishSM(f32x16& p0, f32x16& p1, float alpha, float& l_reg, bf16x8& pa0, bf16x8& pa1, bf16x8& pa2, bf16x8& pa3) {
#pragma unroll
    for (int r = 0; r < 16; ++r) p1[r] = __builtin_amdgcn_exp2f(p1[r]);
    float ps = 0;
#pragma unroll
    for (int r = 0; r < 16; ++r) ps += p0[r];
#pragma unroll
    for (int r = 0; r < 16; ++r) ps += p1[r];
    { auto rr = __builtin_amdgcn_permlane32_swap(__float_as_uint(ps), __float_as_uint(ps), false, false);
      ps = __uint_as_float(rr[0]) + __uint_as_float(rr[1]); }
    l_reg = l_reg * alpha + ps;
#define PK4(P, B_, OUT) do { unsigned a0 = cvt_pk_bf16(P[B_+0], P[B_+1]), a1 = cvt_pk_bf16(P[B_+2], P[B_+3]);                          \
        unsigned b0 = cvt_pk_bf16(P[B_+4], P[B_+5]), b1 = cvt_pk_bf16(P[B_+6], P[B_+7]);                                             \
        auto r0 = __builtin_amdgcn_permlane32_swap(a0, b0, false, false); auto r1 = __builtin_amdgcn_permlane32_swap(a1, b1, false, false); \
        v4u w = {r0[0], r1[0], r0[1], r1[1]}; OUT = *reinterpret_cast<bf16x8*>(&w); } while (0)
    PK4(p0, 0, pa0); PK4(p0, 8, pa1); PK4(p1, 0, pa2); PK4(p1, 8, pa3);
#undef PK4
}
template <int KB>
__device__ __forceinline__ void qkt(f32x16& p0, f32x16& p1, const char* K_lds, int r32, int hi, const bf16x8* qr) {
    p0 = f32x16{}; p1 = f32x16{};
    const char* kb[4];
#pragma unroll
    for (int dd = 0; dd < 4; ++dd) kb[dd] = K_lds + KB * SHM_K + KSWZ(r32, (dd * 16 + hi * 8) * 2);
#pragma unroll
    for (int d0 = 0; d0 < 8; ++d0) { const char* a = kb[d0 & 3] + (d0 >> 2) * 128;
        bf16x8 b0 = *reinterpret_cast<const bf16x8*>(a);
        bf16x8 b1 = *reinterpret_cast<const bf16x8*>(a + 32 * 256);
        p0 = __builtin_amdgcn_mfma_f32_32x32x16_bf16(b0, qr[d0], p0, 0, 0, 0);
        p1 = __builtin_amdgcn_mfma_f32_32x32x16_bf16(b1, qr[d0], p1, 0, 0, 0); }
}
template <int VB>
__device__ __forceinline__ void pv_tile(f32x16* o, int vb0, bf16x8 pa0, bf16x8 pa1, bf16x8 pa2, bf16x8 pa3) {
#define TRRD(dst, off) asm volatile("ds_read_b64_tr_b16 %0, %1 offset:%2" : "=&v"(dst) : "v"(vb0), "i"(off) : "memory")
#define PV_RD(d0, X) do { constexpr int b_ = VB * SHM_V + v_rd_off(d0, 0, 0); \
        TRRD(X##l0, b_); TRRD(X##h0, b_ + 2048); TRRD(X##l1, b_ + 4096); TRRD(X##h1, b_ + 6144); TRRD(X##l2, b_ + 8192); TRRD(X##h2, b_ + 10240); TRRD(X##l3, b_ + 12288); TRRD(X##h3, b_ + 14336); } while (0)
#define PV_MM(d0, X) do { \
        o[d0] = __builtin_amdgcn_mfma_f32_32x32x16_bf16(pa0, (bf16x8){X##l0[0], X##l0[1], X##l0[2], X##l0[3], X##h0[0], X##h0[1], X##h0[2], X##h0[3]}, o[d0], 0, 0, 0);   \
        o[d0] = __builtin_amdgcn_mfma_f32_32x32x16_bf16(pa1, (bf16x8){X##l1[0], X##l1[1], X##l1[2], X##l1[3], X##h1[0], X##h1[1], X##h1[2], X##h1[3]}, o[d0], 0, 0, 0);   \
        o[d0] = __builtin_amdgcn_mfma_f32_32x32x16_bf16(pa2, (bf16x8){X##l2[0], X##l2[1], X##l2[2], X##l2[3], X##h2[0], X##h2[1], X##h2[2], X##h2[3]}, o[d0], 0, 0, 0);   \
        o[d0] = __builtin_amdgcn_mfma_f32_32x32x16_bf16(pa3, (bf16x8){X##l3[0], X##l3[1], X##l3[2], X##l3[3], X##h3[0], X##h3[1], X##h3[2], X##h3[3]}, o[d0], 0, 0, 0); } while (0)
#define PV_WAIT(n) do { asm volatile("s_waitcnt lgkmcnt(" #n ")" ::: "memory"); SBAR(); } while (0)
    { s16x4 al0, al1, al2, al3, ah0, ah1, ah2, ah3, bl0, bl1, bl2, bl3, bh0, bh1, bh2, bh3;
      PV_RD(0, a); PV_RD(1, b);
      PV_WAIT(8); PV_MM(0, a); SBAR(); PV_RD(2, a);
      PV_WAIT(8); PV_MM(1, b); SBAR(); PV_RD(3, b);
      PV_WAIT(8); PV_MM(2, a);
      PV_WAIT(0); PV_MM(3, b); }
#undef PV_RD
#undef PV_MM
#undef PV_WAIT
#undef TRRD
}
struct BlockRef { const bf16* Q; const bf16* K; const bf16* V; bf16* O; const float* KM; int P0; };
struct Seam { bf16x8 qr[8]; bf16x8 st_v0, st_v1, st_k0, st_k1; };
#define ROW(p, k0, rr) ((p) + (size_t)((k0) + (rr)) * TS + sc)
#define VMW() asm volatile("s_waitcnt vmcnt(0)" ::: "memory")
#define VMWN(n) asm volatile("s_waitcnt vmcnt(%0)" :: "i"(n) : "memory")
#define SLOAD_H(Kp, Vp, k0) do { S.st_v0 = load8(ROW(Vp, k0, sr)); S.st_v1 = load8(ROW(Vp, k0, 32 + sr));              \
                         S.st_k0 = load8(ROW(Kp, k0, sr)); S.st_k1 = load8(ROW(Kp, k0, 32 + sr)); } while (0)
#define SWRITE_HK(bf) do { *(bf16x8*)(K_lds + (bf) * SHM_K + kws) = S.st_k0; *(bf16x8*)(K_lds + (bf) * SHM_K + kws + 32 * 256) = S.st_k1; } while (0)
#define SWRITE_HV(bf) do { *(bf16x8*)(V_lds + (bf) * SHM_V + vst0) = S.st_v0; *(bf16x8*)(V_lds + (bf) * SHM_V + vst1) = S.st_v1; } while (0)
#define SWRITE_H(bf) do { SWRITE_HV(bf); SWRITE_HK(bf); } while (0)
__device__ __forceinline__ void moba_prime(const BlockRef& cur, char* lds, Seam& S) {
    const int tid = threadIdx.x, wid = __builtin_amdgcn_readfirstlane(tid >> 6), lane = tid & 63, r32 = lane & 31, hi = lane >> 5;
    const int sr = tid >> 4, sc = (tid & 15) * 8, kws = KSWZ(sr, sc * 2); char* K_lds = lds + 2 * SHM_V;
#pragma unroll
    for (int d0 = 0; d0 < 8; ++d0) S.qr[d0] = load8(cur.Q + (size_t)(wid * QBLK + r32) * TS + d0 * 16 + hi * 8);
    SLOAD_H(cur.K, cur.V, 0); VMW(); SWRITE_HK(0);
    __syncthreads();
}
__device__ __forceinline__ void moba_block(const BlockRef& cur, const BlockRef& nxt, char* lds, Seam& S) {
    const int tid = threadIdx.x, wid = __builtin_amdgcn_readfirstlane(tid >> 6), lane = tid & 63, r32 = lane & 31, hi = lane >> 5;
    const int NT = cur.P0 / KVBLK + QB / KVBLK;
    const int qlo = cur.P0 + wid * QBLK, qm = qlo + r32 - 4 * hi;
    char* V_lds = lds; char* K_lds = lds + 2 * SHM_V;
    float* ws = (float*)(lds + 2 * SHM_V + 2 * SHM_K) + wid * 64; float* li_l = ws, * al_l = ws + 32;
    int sel = 0xff; const int qb = cur.P0 >> 8;
    if (qb > 3) {
        float g[7];
#pragma unroll
        for (int j = 0; j < 7; ++j) { float s = -__builtin_inff();
            asm volatile("" ::: "memory");
            if (j < qb) { int hoff = hi * 8; asm volatile("" : "+v"(hoff)); const float* km = cur.KM + j * HD + hoff; s = 0.f;
#pragma unroll
                for (int d0 = 0; d0 < 8; ++d0) { const f32x4 k0 = *(const f32x4*)(km + d0 * 16), k1 = *(const f32x4*)(km + d0 * 16 + 4); const bf16x8 qv = S.qr[d0];
                    s += bf2f((unsigned short)qv[0]) * k0[0] + bf2f((unsigned short)qv[1]) * k0[1] + bf2f((unsigned short)qv[2]) * k0[2] + bf2f((unsigned short)qv[3]) * k0[3]
                       + bf2f((unsigned short)qv[4]) * k1[0] + bf2f((unsigned short)qv[5]) * k1[1] + bf2f((unsigned short)qv[6]) * k1[2] + bf2f((unsigned short)qv[7]) * k1[3]; }
                auto rr = __builtin_amdgcn_permlane32_swap(__float_as_uint(s), __float_as_uint(s), false, false); s = __uint_as_float(rr[0]) + __uint_as_float(rr[1]); }
            g[j] = s; }
        sel = 0;
#pragma unroll
        for (int j = 0; j < 7; ++j) { int rank = 0;
#pragma unroll
            for (int k = 0; k < 7; ++k) if (k != j) rank += (g[k] > g[j] || (g[k] == g[j] && k < j)) ? 1 : 0;
            if (j < qb && rank < 3) sel |= 1 << j; }
        sel |= 1 << qb;
    }
    float m_reg = -1e30f, l_reg = 0; f32x16 o[4] = {};
    const int sr = tid >> 4, sc = (tid & 15) * 8, vst0 = v_st(sr, sc), vst1 = v_st(32 + sr, sc), kws = KSWZ(sr, sc * 2);
    const int vb0 = (int)(uintptr_t)V_lds + v_rd_base(lane);
    const bf16* Kh = cur.K; const bf16* Vh = cur.V;
#define RESC(a) do { if (__any((a) < 1.f)) { if (hi == 0) al_l[r32] = (a); asm volatile("s_waitcnt lgkmcnt(0)" ::: "memory");              \
                     for (int d_ = 0; d_ < 4; ++d_) for (int r = 0; r < 16; ++r) o[d_][r] *= al_l[crow(r, hi)]; } } while (0)
#define KBASE(t) ((t) * KVBLK)
#define MASKT(P0_, P1_, t) do { const int kb_ = KBASE(t); if (kb_ + KVBLK - 1 > qlo) mask_tile(P0_, P1_, qm - kb_); \
        dropT = (kb_ < cur.P0) && ((sel >> (kb_ >> 8)) & 1) == 0; } while (0)
    constexpr int NQL = 8;
#define SEAM_K0() do { VMWN(NQL); SWRITE_HK(0); SBAR(); } while (0)
    f32x16 pA0, pA1, pB0, pB1; float mnA, mnB, alA, alB; bf16x8 pa0, pa1, pa2, pa3; bool dropT = false;
    SWRITE_HV(0); SBAR();
    if (NT > 1) SLOAD_H(Kh, Vh, KBASE(1));
    SBAR(); qkt<0>(pA0, pA1, K_lds, r32, hi, S.qr);
    MASKT(pA0, pA1, 0); partialSM(pA0, pA1, m_reg, mnA, alA, dropT);
    if (NT > 1) { VMW(); SWRITE_H(1); }
    __syncthreads();
#define HALF_STEP(PX0, PX1, mnX, alX, PY0, PY1, alY, t, KB, VB, SB) do {                                                      \
        SBAR(); qkt<KB>(PX0, PX1, K_lds, r32, hi, S.qr);                                                                      \
        finishSM(PY0, PY1, alY, l_reg, pa0, pa1, pa2, pa3); SBAR();                                                           \
        if ((t) + 1 < NT) { SLOAD_H(Kh, Vh, KBASE((t) + 1)); SBAR(); }                                                        \
        pv_tile<VB>(o, vb0, pa0, pa1, pa2, pa3); MASKT(PX0, PX1, (t)); partialSM(PX0, PX1, m_reg, mnX, alX, dropT);            \
        __syncthreads();                                                                                                      \
        if ((t) + 1 < NT) { VMW(); SWRITE_H(SB); }                                                                            \
        RESC(alX); __syncthreads(); } while (0)
    for (int t = 1; t + 1 < NT; t += 2) {
        HALF_STEP(pB0, pB1, mnB, alB, pA0, pA1, alA, t, 1, 0, 0);
        HALF_STEP(pA0, pA1, mnA, alA, pB0, pB1, alB, t + 1, 0, 1, 1);
    }
    SBAR(); qkt<1>(pB0, pB1, K_lds, r32, hi, S.qr); SBAR();
    SLOAD_H(nxt.K, nxt.V, 0); SBAR();
#pragma unroll
    for (int d0 = 0; d0 < 8; ++d0) S.qr[d0] = load8(nxt.Q + (size_t)(wid * QBLK + r32) * TS + d0 * 16 + hi * 8);
    SBAR();
    finishSM(pA0, pA1, alA, l_reg, pa0, pa1, pa2, pa3); SBAR();
    pv_tile<0>(o, vb0, pa0, pa1, pa2, pa3);
    MASKT(pB0, pB1, NT - 1); partialSM(pB0, pB1, m_reg, mnB, alB, dropT); __syncthreads(); RESC(alB);
    finishSM(pB0, pB1, alB, l_reg, pa0, pa1, pa2, pa3); SBAR(); pv_tile<1>(o, vb0, pa0, pa1, pa2, pa3);
    SBAR(); SEAM_K0();
    if (hi == 0) li_l[r32] = l_reg; asm volatile("s_waitcnt lgkmcnt(0)" ::: "memory");
    float rli[16];
#pragma unroll
    for (int r = 0; r < 16; ++r) rli[r] = __builtin_amdgcn_rcpf(li_l[crow(r, hi)]);
    bf16* Ow = cur.O + (size_t)(wid * QBLK) * TS;
#pragma unroll
    for (int r = 0; r < 16; ++r) { const int orow = crow(r, hi);
#pragma unroll
        for (int d0 = 0; d0 < 4; ++d0) { const float v = o[d0][r] * rli[r];
            const float vn = __shfl_xor(v, 1);
            if ((r32 & 1) == 0) *(unsigned*)(Ow + (size_t)orow * TS + d0 * 32 + r32) = cvt_pk_bf16(v, vn); } }
    __syncthreads();
#undef RESC
#undef KBASE
#undef MASKT
#undef SEAM_K0
#undef HALF_STEP
}
#undef ROW
#undef VMW
#undef VMWN
#undef SLOAD_H
#undef SWRITE_HK
#undef SWRITE_HV
#undef SWRITE_H
}

#define XB_TMO      128
#define XB_XCNT(j)  (256  + 64 * (j))
#define XB_XSUB(j)  (1280 + 64 * (j))
#define XB_XGEN(j)  (2304 + 64 * (j))
#define XB_TOP      3328
#define XB_TOPGEN   3392
#define XCD_BAR_WORDS 3456
#define XB_SPIN_CAP (1u << 18)
__device__ __forceinline__ unsigned xb_ld(unsigned* p)              { return __hip_atomic_load(p, __ATOMIC_RELAXED, __HIP_MEMORY_SCOPE_AGENT); }
__device__ __forceinline__ unsigned xb_add(unsigned* p, unsigned v) { return __hip_atomic_fetch_add(p, v, __ATOMIC_RELAXED, __HIP_MEMORY_SCOPE_AGENT); }
__device__ __forceinline__ unsigned xb_xcc_id() { return (unsigned)__builtin_amdgcn_s_getreg((3 << 11) | 20) & 0xFu; }
#define XB_SPIN(cond, bar) do { unsigned _sp = 0; while (cond) { __builtin_amdgcn_s_sleep(1); \
    if ((++_sp & 255u) == 0u) { if (xb_ld(&(bar)[XB_TMO])) break; if (_sp > XB_SPIN_CAP) { atomicAdd(&(bar)[XB_TMO], 1u); break; } } } } while (0)
struct XcdBarrier { unsigned* bar; unsigned x; volatile LAS unsigned* st; };
__device__ __forceinline__ XcdBarrier xcd_barrier_post(unsigned* bar, volatile LAS unsigned* st) {
    XcdBarrier b; b.bar = bar; b.x = xb_xcc_id(); b.st = st;
    if (threadIdx.x == 0) (void)xb_add(&bar[XB_XCNT(b.x)], 1u);
    return b;
}
__device__ __forceinline__ void xcd_barrier_complete(unsigned* bar, unsigned x, unsigned& nloc, unsigned& nx) {
    const unsigned G = gridDim.x * gridDim.y * gridDim.z;
    unsigned sum, cnt, mine, sp = 0u;
    for (;;) {
        sum = 0u; cnt = 0u;
#pragma unroll 1
        for (unsigned j = 0; j < 16; ++j) { const unsigned c = xb_ld(&bar[XB_XCNT(j)]); sum += c; cnt += (c > 0u) ? 1u : 0u; }
        if (sum == G) break;
        __builtin_amdgcn_s_sleep(1);
        if ((++sp & 255u) == 0u) { if (xb_ld(&bar[XB_TMO])) break; if (sp > XB_SPIN_CAP) { atomicAdd(&bar[XB_TMO], 1u); break; } }
    }
    mine = xb_ld(&bar[XB_XCNT(x)]);
    nloc = mine > 0u ? mine : 1u; nx = cnt > 0u ? cnt : 1u;
}
__device__ __forceinline__ void xcd_barrier(const XcdBarrier& b) {
    asm volatile("s_waitcnt vmcnt(0)" ::: "memory");
    __syncthreads();
    if (threadIdx.x == 0) {
        unsigned* bar = b.bar;
        __builtin_amdgcn_s_waitcnt(0);
        unsigned nloc = b.st[0], nx = b.st[1];
        if (nloc == 0u) { xcd_barrier_complete(bar, b.x, nloc, nx); b.st[0] = nloc; b.st[1] = nx; }
        const unsigned old = xb_add(&bar[XB_XSUB(b.x)], 1u);
        const unsigned gen = old / nloc;
        if (old + 1u == (gen + 1u) * nloc) {
            __builtin_amdgcn_fence(__ATOMIC_RELEASE, "agent");
            asm volatile("s_waitcnt vmcnt(0)" ::: "memory");
            const unsigned og = xb_add(&bar[XB_TOP], 1u);
            const unsigned tg = og / nx;
            if (og + 1u == (tg + 1u) * nx) xb_add(&bar[XB_TOPGEN], 1u);
            else XB_SPIN(xb_ld(&bar[XB_TOPGEN]) == tg, bar);
            __builtin_amdgcn_fence(__ATOMIC_ACQUIRE, "agent");
            xb_add(&bar[XB_XGEN(b.x)], 1u);
            asm volatile("s_waitcnt vmcnt(0)" ::: "memory");
        } else {
            XB_SPIN(xb_ld(&bar[XB_XGEN(b.x)]) == gen, bar);
            __builtin_amdgcn_fence(__ATOMIC_ACQUIRE, "agent");
            asm volatile("s_waitcnt vmcnt(0)" ::: "memory");
        }
    }
    __syncthreads();
}

struct Frame {
    LAS unsigned char* lds; volatile LAS unsigned* MISC; unsigned* ctl;
    int tid, lane, wave, vcu, G, bx, lo, hi;
    unsigned char* ws;
};
struct Args { const void* in[24]; float* out; unsigned char* ws; int ph_lo, ph_hi; };
typedef const __attribute__((address_space(4))) Args* KArgs;
__device__ __forceinline__ KArgs kargs() { KArgs p = (KArgs)__builtin_amdgcn_kernarg_segment_ptr(); asm volatile("" : "+s"(p)); return p; }
__device__ __forceinline__ void refresh(Frame& F) {
    KArgs k = kargs();
    int t = threadIdx.x; asm volatile("" : "+v"(t)); F.tid = t; F.lane = t & 63; F.wave = __builtin_amdgcn_readfirstlane(t >> 6);
    int g = gridDim.x, bx = blockIdx.x; asm volatile("" : "+s"(g), "+s"(bx)); F.G = g; F.bx = bx; F.vcu = (g % 8 == 0) ? (bx % 8) * (g / 8) + bx / 8 : bx;
    F.ws = k->ws; F.ctl = (unsigned*)(F.ws + WS_CTL); F.lo = k->ph_lo; F.hi = k->ph_hi;
    F.lds = (LAS unsigned char*)0; F.MISC = (volatile LAS unsigned*)(F.lds + MISC_OFF);
}
__device__ __forceinline__ XcdBarrier frame_bar(Frame& F) { XcdBarrier b; b.bar = F.ctl + CW_BAR; b.x = xb_xcc_id(); b.st = F.MISC + 8; return b; }
enum { I_X = 0, I_POS, I_NORMS, I_LAMRE, I_LAMIM, I_LOGDT, I_BRE, I_BIM, I_CRE, I_CIM, I_SD, I_WGLU, I_KVN, I_WKV, I_WQ, I_WO, I_FW1, I_FW3, I_FW2, I_ROUTER, I_RBIAS, I_MW1, I_MW3, I_MW2 };

__device__ __forceinline__ int rot32(int d) { return 8 * ((d & 15) >> 2) + 2 * (d & 3) + (d >> 4); }
constexpr int NKIND = 31;
struct WK { const float* W; const float* gain; unsigned char* dst; unsigned* colmax; float* psq; int ldw, K, N, mode, base, which, ot; };
__device__ __forceinline__ void wk_get(KArgs ap, unsigned char* ws, int kind, WK& k) {
    const auto& a = *ap; const float* norms = (const float*)a.in[I_NORMS]; k.gain = nullptr; k.colmax = nullptr; k.psq = nullptr; k.mode = 0; k.base = 0; k.which = 0; k.ot = 0; k.ldw = DM; k.K = DM; k.N = DM;
    if (kind == 0) { k.W = (const float*)a.in[I_WGLU]; k.ldw = 2 * DM; k.N = 2 * DM; k.dst = ws + WS_WGLU; k.mode = 3; }
    else if (kind == 1) { k.W = (const float*)a.in[I_WQ]; k.gain = norms + 4 * DM; k.mode = 2; k.ot = MK_QKV8; k.dst = MK_QKV8 ? ws + WS_WQQKV : ws + WS_WQKV; k.colmax = (unsigned*)(ws + WS_COLMAX_QKV); }
    else if (kind == 2) { k.W = (const float*)a.in[I_WKV]; k.ldw = 2 * DM; k.N = 2 * DM; k.gain = (const float*)a.in[I_KVN]; k.mode = 4; k.base = DM; k.ot = MK_QKV8; k.dst = MK_QKV8 ? ws + WS_WQQKV : ws + WS_WQKV; k.colmax = (unsigned*)(ws + WS_COLMAX_QKV); }
    else if (kind == 3) { k.W = (const float*)a.in[I_WO]; k.dst = ws + WS_WO; }
    else if (kind == 4 || kind == 5) { k.W = (const float*)a.in[kind == 4 ? I_FW1 : I_FW3]; k.ldw = FFD; k.N = FFD; k.gain = norms + 2 * DM; k.mode = 1; k.which = kind - 4; k.ot = 1; k.dst = ws + WS_WQF13; k.colmax = (unsigned*)(ws + WS_COLMAX_F); k.psq = (float*)(ws + WS_PSQD); }
    else if (kind == 6) { k.W = (const float*)a.in[I_FW2]; k.K = FFD; k.dst = ws + WS_WF2; if (MK_FFN2F8) { k.ot = 2; k.colmax = (unsigned*)(ws + WS_COLMAX_W2) + NE * DM; } }
    else if (kind < 23) { const int e = (kind - 7) & 7, wh = (kind - 7) >> 3; k.W = (const float*)a.in[wh ? I_MW3 : I_MW1] + (size_t)e * DM * FFE; k.ldw = FFE; k.N = FFE; k.gain = norms + 6 * DM; k.mode = 1; k.which = wh; k.ot = 1;
        k.dst = ws + WS_WQ13 + (size_t)e * 2 * FFE * DM; k.colmax = (unsigned*)(ws + WS_COLMAX) + e * 2 * FFE; k.psq = (float*)(ws + WS_PSQ) + e * 2 * FFE; }
    else { const int e = kind - 23; k.W = (const float*)a.in[I_MW2] + (size_t)e * FFE * DM; k.K = FFE; k.ot = 2; k.dst = ws + WS_W8M2 + (size_t)e * DM * FFE; k.colmax = (unsigned*)(ws + WS_COLMAX_W2) + e * DM; }
}
__device__ __forceinline__ int wk_drow(const WK& k, int n) {
    if (k.mode == 1) return (n >> 7) * 256 + k.which * 128 + (n & 127);
    if (k.mode == 3) { const int chn = n & 1023; return (chn >> 7) * 256 + (n >> 10) * 128 + (chn & 127); }
    if (k.mode == 2 || (k.mode == 4 && n < DM)) { const int d = n & 127; return k.base + (n & ~127) + (d < 32 ? rot32(d) : d); }
    return k.base + n;
}
__device__ __forceinline__ int wk_f8ex(float cm) { int ex = 0; if (cm > 0.f) { ex = 134 - (int)((__float_as_uint(cm) >> 23) & 0xffu); ex = ex < -60 ? -60 : (ex > 60 ? 60 : ex); } return ex; }
__device__ __forceinline__ unsigned q8(float x) { int q = (int)rintf(x); q = q < -127 ? -127 : (q > 127 ? 127 : q); return (unsigned)q & 0xffu; }
__device__ __forceinline__ unsigned q8x4(float a, float b, float c, float d, float f) {
    unsigned p = 0;
    p = __builtin_amdgcn_cvt_pk_u8_f32(rintf(fmaf(a, f, 128.0f)), 0, p); p = __builtin_amdgcn_cvt_pk_u8_f32(rintf(fmaf(b, f, 128.0f)), 1, p);
    p = __builtin_amdgcn_cvt_pk_u8_f32(rintf(fmaf(c, f, 128.0f)), 2, p); p = __builtin_amdgcn_cvt_pk_u8_f32(rintf(fmaf(d, f, 128.0f)), 3, p);
    return p ^ 0x80808080u;
}
__device__ __forceinline__ void wk_stats_item(const WK& k, int kb, int nb, int lane) {
    const int nc = nb * 256 + 4 * lane; float mx[4] = {0.f, 0.f, 0.f, 0.f}, sq[4] = {0.f, 0.f, 0.f, 0.f};
#pragma unroll 1
    for (int i0 = 0; i0 < 64; i0 += 16) { f32x4 v[16];
#pragma unroll
        for (int i = 0; i < 16; ++i) v[i] = *(const f32x4*)(k.W + (size_t)(kb * 64 + i0 + i) * k.ldw + nc);
#pragma unroll
        for (int i = 0; i < 16; ++i) { const float gs = k.gain ? k.gain[kb * 64 + i0 + i] : 1.0f;
#pragma unroll
            for (int c = 0; c < 4; ++c) { const float x = v[i][c] * gs; mx[c] = fmaxf(mx[c], fabsf(x)); sq[c] += x * x; } } }
#pragma unroll
    for (int c = 0; c < 4; ++c) { const int dr = wk_drow(k, nc + c); atomicMax(k.colmax + dr, __float_as_uint(mx[c])); if (k.psq) k.psq[(size_t)kb * (NE * 2 * FFE) + dr] = sq[c]; }
}
__device__ __forceinline__ void wk_item(const WK& k, int kb, int nb, int* sb8, LAS float* scr, int lane) {
    const int k0 = kb * 64, n0 = nb * 64;
    f32x4 v[16]; const int r4 = lane >> 4, c4 = (lane & 15) * 4;
#pragma unroll
    for (int i = 0; i < 16; ++i) v[i] = *(const f32x4*)(k.W + (size_t)(k0 + 4 * i + r4) * k.ldw + n0 + c4);
    const int k8 = lane & 3, nl = lane >> 2;
    int dr[4]; float qs[4];
#pragma unroll
    for (int st = 0; st < 4; ++st) { dr[st] = wk_drow(k, n0 + 16 * st + nl); qs[st] = 1.0f;
        if (k.ot == 1) { const float cm = __uint_as_float(k.colmax[dr[st]]); qs[st] = cm > 0.f ? 127.0f / cm : 0.f; }
        if (k.ot == 2) { const int ex = wk_f8ex(__uint_as_float(k.colmax[dr[st]])); qs[st] = __builtin_bit_cast(float, (unsigned)(127 + ex) << 23); if (kb == 0 && k8 == 0) sb8[dr[st]] = 127 - ex; } }
#pragma unroll
    for (int hf = 0; hf < 2; ++hf) {
#pragma unroll
        for (int i = 0; i < 8; ++i) { const int kk = 4 * i + r4; const float gs = k.gain ? k.gain[k0 + hf * 32 + kk] : 1.0f; LAS float* d = scr + kk * 65 + c4; const f32x4 x = v[hf * 8 + i];
            d[0] = x.x * gs; d[1] = x.y * gs; d[2] = x.z * gs; d[3] = x.w * gs; }
        LDS_WAIT(); asm volatile("" ::: "memory");
#pragma unroll
        for (int st = 0; st < 4; ++st) { const int n = 16 * st + nl; const LAS float* sp = scr + (8 * k8) * 65 + n; const float f = qs[st];
            if (k.ot == 0) { v4u o; o.x = cvt_pk_bf16(sp[0 * 65], sp[1 * 65]); o.y = cvt_pk_bf16(sp[2 * 65], sp[3 * 65]); o.z = cvt_pk_bf16(sp[4 * 65], sp[5 * 65]); o.w = cvt_pk_bf16(sp[6 * 65], sp[7 * 65]);
                *(v4u*)((bf16*)k.dst + (size_t)dr[st] * k.K + k0 + hf * 32 + 8 * k8) = o; }
            else { v2u o;
                if (k.ot == 1) { o.x = q8x4(sp[0 * 65], sp[1 * 65], sp[2 * 65], sp[3 * 65], f); o.y = q8x4(sp[4 * 65], sp[5 * 65], sp[6 * 65], sp[7 * 65], f); }
                else { int p0 = __builtin_amdgcn_cvt_pk_fp8_f32(sp[0 * 65] * f, sp[1 * 65] * f, 0, false); p0 = __builtin_amdgcn_cvt_pk_fp8_f32(sp[2 * 65] * f, sp[3 * 65] * f, p0, true);
                       int p1 = __builtin_amdgcn_cvt_pk_fp8_f32(sp[4 * 65] * f, sp[5 * 65] * f, 0, false); p1 = __builtin_amdgcn_cvt_pk_fp8_f32(sp[6 * 65] * f, sp[7 * 65] * f, p1, true); o.x = (unsigned)p0; o.y = (unsigned)p1; }
                *(v2u*)(k.dst + (size_t)dr[st] * k.K + k0 + hf * 32 + 8 * k8) = o; } }
        LDS_WAIT(); asm volatile("" ::: "memory");
    }
}
__device__ __forceinline__ void wk_shape(int kind, int& nkb, int& nn, bool& quant) {
    nkb = DM / 64; nn = DM; quant = false;
    if (kind == 0) nn = 2 * DM;
    else if (kind == 1) quant = MK_QKV8 != 0;
    else if (kind == 2) { nn = 2 * DM; quant = MK_QKV8 != 0; }
    else if (kind == 4 || kind == 5) { nn = FFD; quant = true; }
    else if (kind == 6) { nkb = FFD / 64; quant = MK_FFN2F8 != 0; }
    else if (kind >= 7 && kind < 23) { nn = FFE; quant = true; }
    else if (kind >= 23) { nkb = FFE / 64; quant = true; }
}
template <bool GAIN> __device__ __forceinline__ void wk_tile_stats(const WK& k, int kb, int r4, const f32x4 (&v)[16], float (&mx)[4], float (&sq)[4]) {
    const float* gp = GAIN ? k.gain + kb * 64 + 16 * r4 : nullptr; if (GAIN) asm volatile("" : "+v"(gp));
#pragma unroll
    for (int i = 0; i < 16; ++i) { const float gs = GAIN ? gp[i] : 1.0f;
#pragma unroll
        for (int c = 0; c < 4; ++c) { const float x = v[i][c] * gs; mx[c] = fmaxf(mx[c], fabsf(x)); sq[c] += x * x; } }
}
template <bool GAIN> __device__ __forceinline__ void wk_tile_out(const WK& k, int kb, int r4, const f32x4 (&v)[16], const int (&dr)[4], const float (&qs)[4]) {
    const float* gp = GAIN ? k.gain + kb * 64 + 16 * r4 : nullptr; if (GAIN) asm volatile("" : "+v"(gp));
    float g[16];
#pragma unroll
    for (int i = 0; i < 16; ++i) g[i] = GAIN ? gp[i] : 1.0f;
#pragma unroll
    for (int c = 0; c < 4; ++c) { const float f = qs[c]; v4u o;
        if (k.ot == 1) { o.x = q8x4(v[0][c] * g[0], v[1][c] * g[1], v[2][c] * g[2], v[3][c] * g[3], f); o.y = q8x4(v[4][c] * g[4], v[5][c] * g[5], v[6][c] * g[6], v[7][c] * g[7], f);
                         o.z = q8x4(v[8][c] * g[8], v[9][c] * g[9], v[10][c] * g[10], v[11][c] * g[11], f); o.w = q8x4(v[12][c] * g[12], v[13][c] * g[13], v[14][c] * g[14], v[15][c] * g[15], f); }
        else { unsigned w[4];
#pragma unroll
            for (int q = 0; q < 4; ++q) { int pw = __builtin_amdgcn_cvt_pk_fp8_f32(v[4 * q][c] * g[4 * q] * f, v[4 * q + 1][c] * g[4 * q + 1] * f, 0, false);
                pw = __builtin_amdgcn_cvt_pk_fp8_f32(v[4 * q + 2][c] * g[4 * q + 2] * f, v[4 * q + 3][c] * g[4 * q + 3] * f, pw, true); w[q] = (unsigned)pw; }
            o.x = w[0]; o.y = w[1]; o.z = w[2]; o.w = w[3]; }
        *(v4u*)(k.dst + (size_t)dr[c] * k.K + kb * 64 + 16 * r4) = o; }
}
#define SCHED_FENCE() __builtin_amdgcn_sched_barrier(0)
template <int TPW> __device__ __forceinline__ void wk_super(const WK& k, Frame& F, int sbslot, int nb) {
    LAS float* smax = (LAS float*)(F.lds + F.wave * 16384) + 2080; LAS float* ssq = smax + 64;
    const int lane = F.lane, r4 = lane >> 4, c4 = (lane & 15) * 4, tpw = TPW;
    const float* wbase = k.W + (size_t)(16 * r4) * k.ldw + nb * 64 + c4;
#define WK_LOAD(v, kb) do { const float* p_ = wbase + (size_t)((kb) * 64) * k.ldw; _Pragma("unroll") for (int i_ = 0; i_ < 16; ++i_) { v[i_] = *(const f32x4*)p_; p_ += k.ldw; asm volatile("" : "+v"(p_)); } } while (0)
    float mx[4] = {0.f, 0.f, 0.f, 0.f}, sq[4] = {0.f, 0.f, 0.f, 0.f};
    f32x4 va[16], vb[16];
    const int kbase = F.wave * tpw;
    if constexpr (TPW == 2) { WK_LOAD(va, kbase); WK_LOAD(vb, kbase + 1); wk_tile_stats<TPW == 2>(k, kbase, r4, va, mx, sq); wk_tile_stats<TPW == 2>(k, kbase + 1, r4, vb, mx, sq); }
    else {
        static_assert(TPW == 2 || TPW == 7, "tile schedule below is written for 7 tiles");
        WK_LOAD(va, kbase);
#pragma unroll 1
        for (int t = 0; t < 6; t += 2) { WK_LOAD(vb, kbase + t + 1); SCHED_FENCE(); wk_tile_stats<TPW == 2>(k, kbase + t, r4, va, mx, sq); SCHED_FENCE(); WK_LOAD(va, kbase + t + 2); SCHED_FENCE(); wk_tile_stats<TPW == 2>(k, kbase + t + 1, r4, vb, mx, sq); SCHED_FENCE(); }
        wk_tile_stats<TPW == 2>(k, kbase + 6, r4, va, mx, sq); }
#pragma unroll
    for (int c = 0; c < 4; ++c) { mx[c] = fmaxf(mx[c], __shfl_xor(mx[c], 16)); mx[c] = fmaxf(mx[c], __shfl_xor(mx[c], 32)); sq[c] += __shfl_xor(sq[c], 16); sq[c] += __shfl_xor(sq[c], 32); }
    if (lane < 16) {
#pragma unroll
        for (int c = 0; c < 4; ++c) { smax[c4 + c] = mx[c]; ssq[c4 + c] = sq[c]; } }
    __syncthreads();
    int dr[4]; float qs[4];
#pragma unroll
    for (int c = 0; c < 4; ++c) { const int n = c4 + c; float cm = 0.f;
#pragma unroll
        for (int w = 0; w < NWAVES; ++w) cm = fmaxf(cm, ((const LAS float*)(F.lds + w * 16384))[2080 + n]);
        dr[c] = wk_drow(k, nb * 64 + n); qs[c] = 1.0f;
        if (k.ot == 1) qs[c] = cm > 0.f ? 127.0f / cm : 0.f;
        if (k.ot == 2) { const int ex = wk_f8ex(cm); qs[c] = __builtin_bit_cast(float, (unsigned)(127 + ex) << 23); } }
    if (F.tid < 64) { const int n = F.tid; float cm = 0.f, ss = 0.f;
#pragma unroll
        for (int w = 0; w < NWAVES; ++w) { cm = fmaxf(cm, ((const LAS float*)(F.lds + w * 16384))[2080 + n]); ss += ((const LAS float*)(F.lds + w * 16384))[2144 + n]; }
        const int d = wk_drow(k, nb * 64 + n); k.colmax[d] = __float_as_uint(cm); if (k.psq) k.psq[d] = ss;
        if (k.ot == 2) ((int*)(F.ws + WS_SB8))[sbslot * DM + d] = 127 - wk_f8ex(cm); }
    if constexpr (TPW == 2) { wk_tile_out<TPW == 2>(k, kbase, r4, va, dr, qs); wk_tile_out<TPW == 2>(k, kbase + 1, r4, vb, dr, qs); }
    else {
        wk_tile_out<TPW == 2>(k, kbase + 6, r4, va, dr, qs); SCHED_FENCE();
        WK_LOAD(va, kbase + 4); SCHED_FENCE(); wk_tile_out<TPW == 2>(k, kbase + 5, r4, vb, dr, qs); SCHED_FENCE();
#pragma unroll 1
        for (int t = 4; t >= 2; t -= 2) { WK_LOAD(vb, kbase + t - 1); SCHED_FENCE(); wk_tile_out<TPW == 2>(k, kbase + t, r4, va, dr, qs); SCHED_FENCE(); WK_LOAD(va, kbase + t - 2); SCHED_FENCE(); wk_tile_out<TPW == 2>(k, kbase + t - 1, r4, vb, dr, qs); SCHED_FENCE(); }
        wk_tile_out<TPW == 2>(k, kbase, r4, va, dr, qs); }
#undef WK_LOAD
    __syncthreads();
}
__device__ __forceinline__ void wk_super_g(const WK& k, Frame& F, int sbslot, int nb) {
    LAS float* smax = (LAS float*)(F.lds + F.wave * 16384) + 2080; LAS float* ssq = smax + 64;
    const int lane = F.lane, r4 = lane >> 4, c4 = (lane & 15) * 4, nkb = k.K / 64;
    const float* wbase = k.W + (size_t)(16 * r4) * k.ldw + nb * 64 + c4;
#define WK_LOAD(v, kb) do { const float* p_ = wbase + (size_t)((kb) * 64) * k.ldw; _Pragma("unroll") for (int i_ = 0; i_ < 16; ++i_) { v[i_] = *(const f32x4*)p_; p_ += k.ldw; asm volatile("" : "+v"(p_)); } } while (0)
    float mx[4] = {0.f, 0.f, 0.f, 0.f}, sq[4] = {0.f, 0.f, 0.f, 0.f};
    f32x4 va[16];
#pragma unroll 1
    for (int kb = F.wave; kb < nkb; kb += NWAVES) { WK_LOAD(va, kb); wk_tile_stats<false>(k, kb, r4, va, mx, sq); }
#pragma unroll
    for (int c = 0; c < 4; ++c) { mx[c] = fmaxf(mx[c], __shfl_xor(mx[c], 16)); mx[c] = fmaxf(mx[c], __shfl_xor(mx[c], 32)); sq[c] += __shfl_xor(sq[c], 16); sq[c] += __shfl_xor(sq[c], 32); }
    if (lane < 16) {
#pragma unroll
        for (int c = 0; c < 4; ++c) { smax[c4 + c] = mx[c]; ssq[c4 + c] = sq[c]; } }
    __syncthreads();
    int dr[4]; float qs[4];
#pragma unroll
    for (int c = 0; c < 4; ++c) { const int n = c4 + c; float cm = 0.f;
#pragma unroll
        for (int w = 0; w < NWAVES; ++w) cm = fmaxf(cm, ((const LAS float*)(F.lds + w * 16384))[2080 + n]);
        dr[c] = wk_drow(k, nb * 64 + n); const int ex = wk_f8ex(cm); qs[c] = __builtin_bit_cast(float, (unsigned)(127 + ex) << 23); }
    if (F.tid < 64) { const int n = F.tid; float cm = 0.f;
#pragma unroll
        for (int w = 0; w < NWAVES; ++w) cm = fmaxf(cm, ((const LAS float*)(F.lds + w * 16384))[2080 + n]);
        const int d = wk_drow(k, nb * 64 + n); k.colmax[d] = __float_as_uint(cm); ((int*)(F.ws + WS_SB8))[sbslot * DM + d] = 127 - wk_f8ex(cm); }
#pragma unroll 1
    for (int kb = F.wave; kb < nkb; kb += NWAVES) { WK_LOAD(va, kb); wk_tile_out<false>(k, kb, r4, va, dr, qs); }
#undef WK_LOAD
    __syncthreads();
}
constexpr int WQ_TOTAL = NE * (DM / 64) + 2 * NE * (FFE / 64) + 2 * (FFD / 64) + (MK_QKV8 ? 3 * DM / 64 : 0) + (MK_FFN2F8 ? DM / 64 : 0);
__device__ __forceinline__ void wk_convert_super(KArgs ap, Frame& F) {
    volatile LAS unsigned* qw = F.MISC + 16;
    if (F.tid == 0) qw[0] = __hip_atomic_fetch_add(F.ctl + CW_WQ, 1u, __ATOMIC_RELAXED, __HIP_MEMORY_SCOPE_AGENT);
    __syncthreads();
    int it = __builtin_amdgcn_readfirstlane((int)qw[0]);
#pragma unroll 1
    while (it < WQ_TOTAL) {
        unsigned nxt = 0; if (F.tid == 0) nxt = __hip_atomic_fetch_add(F.ctl + CW_WQ, 1u, __ATOMIC_RELAXED, __HIP_MEMORY_SCOPE_AGENT);
        int kind = 6, rem = it, nkb = 16;
        if (!(MK_FFN2F8 && rem < DM / 64)) { if (MK_FFN2F8) rem -= DM / 64;
#pragma unroll 1
            for (kind = NKIND - 1;; --kind) { if (kind == 6) continue; int nn; bool quant; wk_shape(kind, nkb, nn, quant); const int cnt = quant ? nn / 64 : 0; if (rem < cnt) break; rem -= cnt; } }
        { WK k; wk_get(ap, F.ws, kind, k);
          if (kind == 6) wk_super_g(k, F, NE, rem); else if (nkb == 16) wk_super<2>(k, F, kind - 23, rem); else wk_super<7>(k, F, kind - 23, rem); }
        if (F.tid == 0) qw[0] = nxt;
        __syncthreads();
        it = __builtin_amdgcn_readfirstlane((int)qw[0]);
    }
}
__device__ __forceinline__ void wk_convert(KArgs ap, Frame& F, int pass) {
    LAS float* scr = (LAS float*)(F.lds + F.wave * 16384);
    const int gw = F.vcu * NWAVES + F.wave, NGW = F.G * NWAVES;
    int it = gw;
#pragma unroll 1
    for (int kind = 0; kind < NKIND; ++kind) { WK k; wk_get(ap, F.ws, kind, k);
        const bool quant = k.ot != 0;
        if (pass == 0 && quant) { if (MK_SUPER) continue; const int nkb = k.K / 64, nnb = k.N / 256, cnt = nkb * nnb;
            for (; it < cnt; it += NGW) wk_stats_item(k, it % nkb, it / nkb, F.lane);
            it -= cnt; }
        else if ((pass == 0) != quant) { const int nkb = k.K / 64, nnb = k.N / 64, cnt = nkb * nnb;
            int* sb8 = (int*)(F.ws + WS_SB8) + (kind >= 23 ? (kind - 23) * DM : 0);
            for (; it < cnt; it += NGW) wk_item(k, it / nnb, it % nnb, sb8, scr, F.lane);
            it -= cnt; }
    }
}
__device__ __forceinline__ void p0_s5_group(KArgs ap, Frame& F, int g, int qtr) {
    const auto& a = *ap;
    const float* lam_re = (const float*)a.in[I_LAMRE]; const float* lam_im = (const float*)a.in[I_LAMIM]; const float* log_dt = (const float*)a.in[I_LOGDT];
    const float* b_re = (const float*)a.in[I_BRE]; const float* b_im = (const float*)a.in[I_BIM]; const float* c_re = (const float*)a.in[I_CRE]; const float* c_im = (const float*)a.in[I_CIM];
    const float* g0 = (const float*)a.in[I_NORMS];
    LAS float* apr = (LAS float*)F.lds;
    LAS float* api = apr + 17 * 64;
    LAS float* bbr = api + 17 * 64;
    LAS float* bbi = bbr + 1024;
    LAS float* ccr = bbi + 1024;
    LAS float* cci = ccr + 1024;
    LAS float* ktab = cci + 1024;
    const float dt = expf(log_dt[g]);
    for (int idx = F.tid; idx < 17 * 64; idx += NWAVES * 64) { const int l = idx >> 6, p = idx & 63; const float zr = lam_re[g * 64 + p] * dt, zi = lam_im[g * 64 + p] * dt;
        const float mag = expf((float)l * zr); float sn, cs; sincosf((float)l * zi, &sn, &cs); apr[idx] = mag * cs; api[idx] = mag * sn; }
    for (int idx = F.tid; idx < 1024; idx += NWAVES * 64) { const int p = idx >> 4, j = idx & 15; const float lr = lam_re[g * 64 + p], li = lam_im[g * 64 + p]; const float zr = lr * dt, zi = li * dt;
        const float mag = expf(zr); float sn, cs; sincosf(zi, &sn, &cs); const float ar = mag * cs, ai = mag * sn, den = lr * lr + li * li;
        const float cfr = ((ar - 1.0f) * lr + ai * li) / den, cfi = (ai * lr - (ar - 1.0f) * li) / den;
        const float br = b_re[(size_t)(g * 64 + p) * 16 + j], bi = b_im[(size_t)(g * 64 + p) * 16 + j], gn = g0[g * 16 + j];
        bbr[idx] = (cfr * br - cfi * bi) * gn; bbi[idx] = (cfr * bi + cfi * br) * gn;
        ccr[idx] = c_re[(size_t)g * 1024 + idx]; cci[idx] = c_im[(size_t)g * 1024 + idx]; }
    __syncthreads();
    for (int idx0 = F.tid; idx0 < 1024; idx0 += NWAVES * 64) { const int l = idx0 >> 6, i = 4 * qtr + ((idx0 >> 4) & 3), j = idx0 & 15, idx = (l * 16 + i) * 16 + j; float s = 0.f;
        for (int p = 0; p < 64; ++p) { const float cr = ccr[i * 64 + p], ci = cci[i * 64 + p], ar = apr[l * 64 + p], ai = api[l * 64 + p]; const float car = cr * ar - ci * ai, cai = cr * ai + ci * ar; s += car * bbr[p * 16 + j] - cai * bbi[p * 16 + j]; }
        ktab[idx] = s; }
    __syncthreads();
    bf16* btc = (bf16*)(F.ws + WS_BTC) + (size_t)g * 256 * UAK; bf16* bta = (bf16*)(F.ws + WS_BTA) + (size_t)g * 256 * 256;
    for (int pc = F.tid; pc < 64 * 48; pc += NWAVES * 64) { const int nq = pc / 48, k8 = pc % 48, t = nq >> 2, i = 4 * qtr + (nq & 3), n = t * 16 + i; float v[8];
        if (k8 < 32) { const int s = k8 >> 1, j0 = (k8 & 1) * 8;
#pragma unroll
            for (int jj = 0; jj < 8; ++jj) v[jj] = (t >= s) ? ktab[((t - s) * 16 + i) * 16 + j0 + jj] : 0.f; }
        else { const int pb = (k8 - 32) * 8;
#pragma unroll
            for (int jj = 0; jj < 8; ++jj) { const int p = (pb + jj) & 63; const float cr = ccr[i * 64 + p], ci = cci[i * 64 + p], ar = apr[(t + 1) * 64 + p], ai = api[(t + 1) * 64 + p];
                v[jj] = (pb < 64) ? (cr * ar - ci * ai) : -(cr * ai + ci * ar); } }
        v4u o; o.x = pk2(v[0], v[1]); o.y = pk2(v[2], v[3]); o.z = pk2(v[4], v[5]); o.w = pk2(v[6], v[7]);
        *(v4u*)(btc + (size_t)n * UAK + k8 * 8) = o; }
    for (int pc = F.tid; pc < 64 * 32; pc += NWAVES * 64) { const int n = (pc >> 5) * 4 + qtr, k8 = pc & 31, s = k8 >> 1, j0 = (k8 & 1) * 8; float v[8];
        const int p = n & 63, l = 15 - s; const float ar = apr[l * 64 + p], ai = api[l * 64 + p];
#pragma unroll
        for (int jj = 0; jj < 8; ++jj) { const float br = bbr[p * 16 + j0 + jj], bi = bbi[p * 16 + j0 + jj]; v[jj] = (n < 64) ? (ar * br - ai * bi) : ((n < 128) ? (ar * bi + ai * br) : 0.f); }
        v4u o; o.x = pk2(v[0], v[1]); o.y = pk2(v[2], v[3]); o.z = pk2(v[4], v[5]); o.w = pk2(v[6], v[7]);
        *(v4u*)(bta + (size_t)n * 256 + k8 * 8) = o; }
    float* spar = (float*)(F.ws + WS_SPAR) + g * 128;
    if (qtr == 0 && F.tid < 64) { spar[F.tid] = apr[16 * 64 + F.tid]; spar[64 + F.tid] = api[16 * 64 + F.tid]; }
    __syncthreads();
}
__device__ __forceinline__ void p0_chunk_load(const float* x, Frame& F, int ch, f32x4 (&v)[2][4]) {
    const int b = ch >> 7, c = ch & 127;
#pragma unroll
    for (int rr = 0; rr < 2; ++rr) { const int tok = F.wave * 2 + rr; const f32x4* xr = (const f32x4*)(x + (size_t)(b * SEQ + c * CL + tok) * DM) + F.lane;
#pragma unroll
        for (int j = 0; j < 4; ++j) v[rr][j] = xr[64 * j]; }
}
__device__ __forceinline__ void p0_chunk_store(Frame& F, int ch, const f32x4 (&v)[2][4]) {
    const int b = ch >> 7, c = ch & 127; LAS unsigned short* tile = (LAS unsigned short*)F.lds;
#pragma unroll
    for (int rr = 0; rr < 2; ++rr) { const int tok = F.wave * 2 + rr; float s = 0.f;
#pragma unroll
        for (int j = 0; j < 4; ++j) s += (v[rr][j].x * v[rr][j].x + v[rr][j].y * v[rr][j].y) + (v[rr][j].z * v[rr][j].z + v[rr][j].w * v[rr][j].w);
        const float rstd = 1.0f / sqrtf(wave_sum(s) * (1.0f / DM) + NORM_EPS);
#pragma unroll
        for (int j = 0; j < 4; ++j) { v2u w; w.x = pk2(v[rr][j].x * rstd, v[rr][j].y * rstd); w.y = pk2(v[rr][j].z * rstd, v[rr][j].w * rstd); *(LAS v2u*)(tile + tok * 1032 + 4 * F.lane + 256 * j) = w; } }
    __syncthreads();
    bf16* ua = (bf16*)(F.ws + WS_UA);
#pragma unroll
    for (int it = 0; it < 4; ++it) { const int q = it * 512 + F.tid, g = q >> 5, piece = q & 31, tok = piece >> 1, half = piece & 1;
        const v4u w = *(const LAS v4u*)(tile + tok * 1032 + g * 16 + half * 8);
        *(v4u*)(ua + ((size_t)g * GROWS + b * NCH + c) * UAK + tok * 16 + half * 8) = w; }
    __syncthreads();
}
__device__ __forceinline__ void p0_prologue(KArgs ap, Frame& F) {
    const auto& a = *ap;
    const float* norms = (const float*)a.in[I_NORMS];
    for (int task = F.vcu; task < NG * 4; task += F.G) p0_s5_group(ap, F, task >> 2, task & 3);
    { const int gt = F.vcu * (NWAVES * 64) + F.tid, NT = F.G * NWAVES * 64; const int* pos = (const int*)a.in[I_POS]; float* rope = (float*)(F.ws + WS_ROPE);
      for (int idx = gt; idx < NTOK * 16; idx += NT) { const int n = idx >> 4, i = idx & 15; const float inv = 1.0f / powf(500000.0f, (float)i * (1.0f / 16.0f)); const float ang = (float)pos[n] * inv; float sn, cs; sincosf(ang, &sn, &cs); rope[(size_t)n * 32 + i] = cs; rope[(size_t)n * 32 + 16 + i] = sn; }
      const float* wr = (const float*)a.in[I_ROUTER]; float* wro = (float*)(F.ws + WS_WR);
      for (int idx = gt; idx < DM * NE; idx += NT) wro[idx] = wr[idx] * norms[(1 * 4 + 2) * DM + (idx >> 3)]; }
    { const float* x = (const float*)a.in[I_X]; f32x4 va[2][4], vb[2][4]; int ch = F.vcu;
      if (ch < BATCH * NCH) p0_chunk_load(x, F, ch, va);
#pragma unroll 1
      for (; ch < BATCH * NCH; ch += 2 * F.G) {
          const bool h1 = ch + F.G < BATCH * NCH, h2 = ch + 2 * F.G < BATCH * NCH;
          if (h1) p0_chunk_load(x, F, ch + F.G, vb);
          p0_chunk_store(F, ch, va);
          if (h2) p0_chunk_load(x, F, ch + 2 * F.G, va);
          if (h1) p0_chunk_store(F, ch + F.G, vb); } }
    wk_convert(ap, F, 0);
}
__device__ __forceinline__ void expert_act_scale(Frame& F) {
    if (F.vcu < NE + (MK_FFN2F8 ? 1 : 0)) { const int e = F.vcu; const bool dense = e == NE; const float* pq = dense ? (const float*)(F.ws + WS_PSQD) : (const float*)(F.ws + WS_PSQ) + e * 2 * FFE; float m1 = 0.f, m3 = 0.f;
        const int nrow = dense ? 2 * FFD : 2 * FFE;
        for (int i = F.tid; i < nrow; i += NWAVES * 64) { float ss = 0.f;
#pragma unroll
            for (int kc = 0; kc < (MK_SUPER ? 1 : DM / 64); ++kc) ss += pq[(size_t)kc * (NE * 2 * FFE) + i];
            const float v = sqrtf(ss); if ((i >> 7) & 1) m3 = fmaxf(m3, v); else m1 = fmaxf(m1, v); }
#pragma unroll
        for (int o = 1; o < 64; o <<= 1) { m1 = fmaxf(m1, __shfl_xor(m1, o)); m3 = fmaxf(m3, __shfl_xor(m3, o)); }
        LAS float* red = (LAS float*)(F.lds + 8192);
        if (F.lane == 0) { red[F.wave] = m1; red[8 + F.wave] = m3; }
        __syncthreads();
        if (F.tid == 0) { float a1 = 0.f, a3 = 0.f; for (int w = 0; w < NWAVES; ++w) { a1 = fmaxf(a1, red[w]); a3 = fmaxf(a3, red[8 + w]); }
            const float bound = 1.1f * 1024.0f * a1 * a3;
            const int ex = wk_f8ex(bound);
            __hip_atomic_store(F.ctl + CW_EA + e, (unsigned)(127 - ex), __ATOMIC_RELAXED, __HIP_MEMORY_SCOPE_AGENT); }
        __syncthreads(); }
}
__device__ __forceinline__ void s5_scan_local(Frame& F) {
    const float* spar = (const float*)(F.ws + WS_SPAR); const float* sloc = (const float*)(F.ws + WS_SLOC); bf16* ua = (bf16*)(F.ws + WS_UA);
    const int nunits = (NG * 8 - F.bx + F.G - 1) / F.G;
    for (int t = F.wave; t < 2 * nunits; t += NWAVES) { int pm, pn; pg8::tile_of((t >> 1) * F.G + F.bx, NG * 8, 1, pm, pn);
        const int g = pm >> 3, b = (pm & 7) * 2 + (t & 1), p = F.lane;
        const float ar = spar[g * 128 + p], ai = spar[g * 128 + 64 + p]; float sr = 0.f, si = 0.f;
        const size_t row0 = (size_t)g * GROWS + b * NCH;
        constexpr int SB = 16; float l0r[SB], l0i[SB], l1r[SB], l1i[SB];
#define S5_LD(R, I, c0) do { _Pragma("unroll") for (int j = 0; j < SB; ++j) { R[j] = sloc[(row0 + (c0) + j) * 128 + p]; I[j] = sloc[(row0 + (c0) + j) * 128 + 64 + p]; } } while (0)
#define S5_RUN(R, I, c0) do { _Pragma("unroll") for (int j = 0; j < SB; ++j) { ua[(row0 + (c0) + j) * UAK + 256 + p] = (bf16)f2bf(sr); ua[(row0 + (c0) + j) * UAK + 320 + p] = (bf16)f2bf(si); \
            const float nr = ar * sr - ai * si + R[j], ni = ar * si + ai * sr + I[j]; sr = nr; si = ni; } } while (0)
        S5_LD(l0r, l0i, 0);
#pragma unroll 1
        for (int c0 = 0; c0 < NCH; c0 += 2 * SB) {
            S5_LD(l1r, l1i, c0 + SB); __builtin_amdgcn_sched_barrier(0);
            S5_RUN(l0r, l0i, c0); __builtin_amdgcn_sched_barrier(0);
            if (c0 + 2 * SB < NCH) S5_LD(l0r, l0i, c0 + 2 * SB);
            __builtin_amdgcn_sched_barrier(0);
            S5_RUN(l1r, l1i, c0 + SB); __builtin_amdgcn_sched_barrier(0); }
#undef S5_LD
#undef S5_RUN
    }
}
struct RRow { v4u m0, m1, a0, a1; f32x4 h0, h1, h2, h3; float sc, ssq; };
template <bool SRC> __device__ __forceinline__ void rr_load(RRow& R, int lane, const float* xin, const bf16* xhin, const bf16* mix, const float* rowss, const float* rs, int row, int nslots) {
    R.m0 = *(const v4u*)(mix + (size_t)row * DM + 8 * lane); R.m1 = *(const v4u*)(mix + (size_t)row * DM + 512 + 8 * lane);
    if (SRC) { R.a0 = *(const v4u*)(xhin + (size_t)row * DM + 8 * lane); R.a1 = *(const v4u*)(xhin + (size_t)row * DM + 512 + 8 * lane); R.sc = rs[row]; }
    else { const f32x4* hp = (const f32x4*)(xin + (size_t)row * DM); R.h0 = hp[2 * lane]; R.h1 = hp[2 * lane + 1]; R.h2 = hp[128 + 2 * lane]; R.h3 = hp[128 + 2 * lane + 1]; }
    R.ssq = lane < nslots ? rowss[(size_t)row * 32 + lane] : 0.f;
}
template <bool ROUTE, bool SRC, bool QOUT>
__device__ __forceinline__ void resid_pass(Frame& F, const float* xin, const bf16* xhin, const bf16* mix, int nslots, const float* gain, bf16* xh, const float* rbias) {
    const float* rowss = (const float*)(F.ws + WS_ROWSS); float* rs = (float*)(F.ws + WS_RS);
    LAS int* l_e = (LAS int*)F.lds; LAS float* l_w = (LAS float*)(F.lds + 1024); LAS int* l_cnt = (LAS int*)(F.lds + 2048); LAS int* l_base = (LAS int*)(F.lds + 2048 + 64); LAS float* l_s = (LAS float*)(F.lds + 3072);
    for (int blk = F.vcu; blk < NTOK / 128; blk += F.G) {
        if (ROUTE) { if (F.tid < NE) l_cnt[F.tid] = 0; __syncthreads(); }
        RRow cur, nxt; rr_load<SRC>(cur, F.lane, xin, xhin, mix, rowss, rs, blk * 128 + F.wave * 16, nslots);
#pragma unroll 1
        for (int k = 0; k < 16; ++k) { const int row = blk * 128 + F.wave * 16 + k;
            nxt = cur; if (k + 1 < 16) rr_load<SRC>(nxt, F.lane, xin, xhin, mix, rowss, rs, row + 1, nslots);
            __builtin_amdgcn_sched_barrier(0);
            const v4u m0 = cur.m0, m1 = cur.m1;
            float hn[16];
            if (SRC) { const v4u a0 = cur.a0, a1 = cur.a1; const float sc = cur.sc;
                hn[0] = bf2f(a0.x & 0xffffu) * sc; hn[1] = bf2f(a0.x >> 16) * sc; hn[2] = bf2f(a0.y & 0xffffu) * sc; hn[3] = bf2f(a0.y >> 16) * sc; hn[4] = bf2f(a0.z & 0xffffu) * sc; hn[5] = bf2f(a0.z >> 16) * sc; hn[6] = bf2f(a0.w & 0xffffu) * sc; hn[7] = bf2f(a0.w >> 16) * sc;
                hn[8] = bf2f(a1.x & 0xffffu) * sc; hn[9] = bf2f(a1.x >> 16) * sc; hn[10] = bf2f(a1.y & 0xffffu) * sc; hn[11] = bf2f(a1.y >> 16) * sc; hn[12] = bf2f(a1.z & 0xffffu) * sc; hn[13] = bf2f(a1.z >> 16) * sc; hn[14] = bf2f(a1.w & 0xffffu) * sc; hn[15] = bf2f(a1.w >> 16) * sc; }
            else { const f32x4 h0 = cur.h0, h1 = cur.h1, h2 = cur.h2, h3 = cur.h3;
#pragma unroll
                for (int j = 0; j < 4; ++j) { hn[j] = h0[j]; hn[4 + j] = h1[j]; hn[8 + j] = h2[j]; hn[12 + j] = h3[j]; } }
            const f32x4* gp = (const f32x4*)gain; const f32x4 g0 = gp[2 * F.lane], g1 = gp[2 * F.lane + 1], g2 = gp[128 + 2 * F.lane], g3 = gp[128 + 2 * F.lane + 1];
            const float ssm = wave_sum(cur.ssq);
            const float rm = 1.0f / sqrtf(ssm * (1.0f / DM) + NORM_EPS);
            hn[0] += bf2f(m0.x & 0xffffu) * rm * g0[0]; hn[1] += bf2f(m0.x >> 16) * rm * g0[1]; hn[2] += bf2f(m0.y & 0xffffu) * rm * g0[2]; hn[3] += bf2f(m0.y >> 16) * rm * g0[3];
            hn[4] += bf2f(m0.z & 0xffffu) * rm * g1[0]; hn[5] += bf2f(m0.z >> 16) * rm * g1[1]; hn[6] += bf2f(m0.w & 0xffffu) * rm * g1[2]; hn[7] += bf2f(m0.w >> 16) * rm * g1[3];
            hn[8] += bf2f(m1.x & 0xffffu) * rm * g2[0]; hn[9] += bf2f(m1.x >> 16) * rm * g2[1]; hn[10] += bf2f(m1.y & 0xffffu) * rm * g2[2]; hn[11] += bf2f(m1.y >> 16) * rm * g2[3];
            hn[12] += bf2f(m1.z & 0xffffu) * rm * g3[0]; hn[13] += bf2f(m1.z >> 16) * rm * g3[1]; hn[14] += bf2f(m1.w & 0xffffu) * rm * g3[2]; hn[15] += bf2f(m1.w >> 16) * rm * g3[3];
            float s2 = 0.f;
#pragma unroll
            for (int j = 0; j < 16; ++j) s2 += hn[j] * hn[j];
            const float ms = wave_sum(s2) * (1.0f / DM) + NORM_EPS; const float rms = sqrtf(ms), rh = 1.0f / rms;
            if (F.lane == 0) rs[row] = rms;
            v4u w0, w1; w0.x = pk2(hn[0] * rh, hn[1] * rh); w0.y = pk2(hn[2] * rh, hn[3] * rh); w0.z = pk2(hn[4] * rh, hn[5] * rh); w0.w = pk2(hn[6] * rh, hn[7] * rh);
            w1.x = pk2(hn[8] * rh, hn[9] * rh); w1.y = pk2(hn[10] * rh, hn[11] * rh); w1.z = pk2(hn[12] * rh, hn[13] * rh); w1.w = pk2(hn[14] * rh, hn[15] * rh);
            *(v4u*)(xh + (size_t)row * DM + 8 * F.lane) = w0; *(v4u*)(xh + (size_t)row * DM + 512 + 8 * F.lane) = w1;
            if (QOUT) {
                { float am = 0.f;
#pragma unroll
                  for (int j = 0; j < 16; ++j) am = fmaxf(am, fabsf(hn[j]));
#pragma unroll
                  for (int o = 1; o < 64; o <<= 1) am = fmaxf(am, __shfl_xor(am, o));
                  am *= rh; const float inv = am > 0.f ? 127.0f / am : 0.f, qs = rh * inv;
                  v2u q0, q1;
                  q0.x = q8x4(hn[0], hn[1], hn[2], hn[3], qs); q0.y = q8x4(hn[4], hn[5], hn[6], hn[7], qs);
                  q1.x = q8x4(hn[8], hn[9], hn[10], hn[11], qs); q1.y = q8x4(hn[12], hn[13], hn[14], hn[15], qs);
                  unsigned char* xq = F.ws + WS_XQ3 + (size_t)row * DM; *(v2u*)(xq + 8 * F.lane) = q0; *(v2u*)(xq + 512 + 8 * F.lane) = q1;
                  if (F.lane == 0) { if (ROUTE) l_s[F.wave * 16 + k] = am * (1.0f / 127.0f); else ((float*)(F.ws + WS_RSC))[row] = am * (1.0f / 127.0f); } }
            }
            if (ROUTE) {
                const float* wr = (const float*)(F.ws + WS_WR); float lg[NE];
#pragma unroll
                for (int e = 0; e < NE; ++e) lg[e] = 0.f;
#pragma unroll
                for (int half = 0; half < 2; ++half)
#pragma unroll
                    for (int j = 0; j < 8; ++j) { const int cc = half * 512 + 8 * F.lane + j; const f32x4 wa = *(const f32x4*)(wr + cc * 8), wb = *(const f32x4*)(wr + cc * 8 + 4); const float xv = hn[half * 8 + j] * rh;
                        lg[0] += xv * wa[0]; lg[1] += xv * wa[1]; lg[2] += xv * wa[2]; lg[3] += xv * wa[3]; lg[4] += xv * wb[0]; lg[5] += xv * wb[1]; lg[6] += xv * wb[2]; lg[7] += xv * wb[3]; }
#pragma unroll
                for (int e = 0; e < NE; ++e) lg[e] = wave_sum(lg[e]) + rbias[e];
                int e0 = 0; float v0 = lg[0];
#pragma unroll
                for (int e = 1; e < NE; ++e) if (lg[e] > v0) { v0 = lg[e]; e0 = e; }
                int e1 = -1; float v1 = -__builtin_inff();
#pragma unroll
                for (int e = 0; e < NE; ++e) if (e != e0 && lg[e] > v1) { v1 = lg[e]; e1 = e; }
                const float w1s = 1.0f / (1.0f + __expf(v0 - v1)), w0s = 1.0f - w1s;
                if (F.lane == 0) { const int ai = (F.wave * 16 + k) * 2; l_e[ai] = e0; l_e[ai + 1] = e1; l_w[ai] = w0s; l_w[ai + 1] = w1s; }
            }
            cur = nxt;
        }
        if (ROUTE) {
            __syncthreads();
            int* list = (int*)(F.ws + WS_LIST); int* slot = (int*)(F.ws + WS_SLOT); float* tokw = (float*)(F.ws + WS_TOKW);
            int e = 0, rank = 0;
            if (F.tid < 256) { e = l_e[F.tid]; rank = atomicAdd((int*)&l_cnt[e], 1); }
            __syncthreads();
            if (F.tid < NE) l_base[F.tid] = (int)__hip_atomic_fetch_add(F.ctl + CW_ECNT + 64 * F.tid, (unsigned)l_cnt[F.tid], __ATOMIC_RELAXED, __HIP_MEMORY_SCOPE_AGENT);
            __syncthreads();
            if (F.tid < 256) { const int pos = l_base[e] + rank, token = blk * 128 + (F.tid >> 1);
                if (pos < LCAP) { list[e * LCAP + pos] = token; ((float*)(F.ws + WS_RSC))[e * LCAP + pos] = l_s[F.tid >> 1]; }
                slot[token * 2 + (F.tid & 1)] = e * LCAP + pos; tokw[token * 2 + (F.tid & 1)] = l_w[F.tid]; }
            __syncthreads();
        }
    }
}
__device__ __forceinline__ void final_pass(Frame& F, float* out, const bf16* xh, const bf16* y, const float* gain) {
    const int gw = F.vcu * NWAVES + F.wave, NGW = F.G * NWAVES;
    etab_build(F.lds, F.ctl);
    const int* slot = (const int*)(F.ws + WS_SLOT); const float* tokw = (const float*)(F.ws + WS_TOKW); const float* rsv = (const float*)(F.ws + WS_RS); const f32x4* gp = (const f32x4*)gain;
    if (gw >= NTOK) return;
#define FP_S1(row_, S, W) do { S = *(const v2u*)(slot + (size_t)(row_) * 2); W = *(const f32x2*)(tokw + (size_t)(row_) * 2); } while (0)
#define FP_S2(row_, S, R0, R1, YA, YB, XA, SC) do { const int e0_ = ((int)S.x >> 15) & 7, e1_ = ((int)S.y >> 15) & 7; const int ps0_ = *(const LAS int*)(F.lds + ET_OFF + 32 + 4 * e0_), ps1_ = *(const LAS int*)(F.lds + ET_OFF + 32 + 4 * e1_); \
        R0 = (size_t)ps0_ * 256 + (S.x & (LCAP - 1)); R1 = (size_t)ps1_ * 256 + (S.y & (LCAP - 1)); const bool fast_ = R0 < 65536 && R1 < 65536; const size_t q0_ = fast_ ? R0 : 0, q1_ = fast_ ? R1 : 0; \
        _Pragma("unroll") for (int half = 0; half < 2; ++half) { YA[half] = *(const v4u*)(y + q0_ * DM + half * 512 + 8 * F.lane); YB[half] = *(const v4u*)(y + q1_ * DM + half * 512 + 8 * F.lane); XA[half] = *(const v4u*)(xh + (size_t)(row_) * DM + half * 512 + 8 * F.lane); } \
        SC = rsv[row_]; } while (0)
    int row = gw, nrow = gw + NGW; v2u sc_ = {0u, 0u}, sn_ = {0u, 0u}; f32x2 wc_ = {0.f, 0.f}, wn_ = {0.f, 0.f};
    size_t r0c, r1c; v4u yac[2], ybc[2], xac[2]; float scc;
    FP_S1(row, sc_, wc_);
    FP_S2(row, sc_, r0c, r1c, yac, ybc, xac, scc);
    if (nrow < NTOK) FP_S1(nrow, sn_, wn_);
#pragma unroll 1
    for (;;) {
        const bool has_next = nrow < NTOK;
        size_t r0n = 0, r1n = 0; v4u yan[2] = {{0u, 0u, 0u, 0u}, {0u, 0u, 0u, 0u}}, ybn[2] = {{0u, 0u, 0u, 0u}, {0u, 0u, 0u, 0u}}, xan[2] = {{0u, 0u, 0u, 0u}, {0u, 0u, 0u, 0u}}; float scn = 0.f; v2u snn = {0u, 0u}; f32x2 wnn = {0.f, 0.f};
        if (has_next) { FP_S2(nrow, sn_, r0n, r1n, yan, ybn, xan, scn); const int nn = nrow + NGW; if (nn < NTOK) FP_S1(nn, snn, wnn); }
        __builtin_amdgcn_sched_barrier(0);
        const size_t r0 = r0c, r1 = r1c; const float w0 = wc_[0], w1 = wc_[1];
        float f[16];
        if (r0 >= 65536 || r1 >= 65536) {
            const bf16* yp = (const bf16*)(F.ws + WS_YP);
#pragma unroll
            for (int j = 0; j < 16; ++j) f[j] = 0.f;
#pragma unroll 1
            for (int side = 0; side < 2; ++side) { const size_t r = side ? r1 : r0; const float w = side ? w1 : w0; const int nk = r >= 65536 ? KSPLIT : 1;
                for (int kc = 0; kc < nk; ++kc) { const bf16* src = r >= 65536 ? yp + ((size_t)(kc * LPMAX) * 256 + (r - 65536)) * DM : y + r * DM;
#pragma unroll
                    for (int half = 0; half < 2; ++half) { const v4u a = *(const v4u*)(src + half * 512 + 8 * F.lane);
                        f[half * 8 + 0] += w * bf2f(a.x & 0xffffu); f[half * 8 + 1] += w * bf2f(a.x >> 16); f[half * 8 + 2] += w * bf2f(a.y & 0xffffu); f[half * 8 + 3] += w * bf2f(a.y >> 16);
                        f[half * 8 + 4] += w * bf2f(a.z & 0xffffu); f[half * 8 + 5] += w * bf2f(a.z >> 16); f[half * 8 + 6] += w * bf2f(a.w & 0xffffu); f[half * 8 + 7] += w * bf2f(a.w >> 16); } } } }
        else
#pragma unroll
        for (int half = 0; half < 2; ++half) { const v4u a = yac[half], bq = ybc[half];
            f[half * 8 + 0] = w0 * bf2f(a.x & 0xffffu) + w1 * bf2f(bq.x & 0xffffu); f[half * 8 + 1] = w0 * bf2f(a.x >> 16) + w1 * bf2f(bq.x >> 16);
            f[half * 8 + 2] = w0 * bf2f(a.y & 0xffffu) + w1 * bf2f(bq.y & 0xffffu); f[half * 8 + 3] = w0 * bf2f(a.y >> 16) + w1 * bf2f(bq.y >> 16);
            f[half * 8 + 4] = w0 * bf2f(a.z & 0xffffu) + w1 * bf2f(bq.z & 0xffffu); f[half * 8 + 5] = w0 * bf2f(a.z >> 16) + w1 * bf2f(bq.z >> 16);
            f[half * 8 + 6] = w0 * bf2f(a.w & 0xffffu) + w1 * bf2f(bq.w & 0xffffu); f[half * 8 + 7] = w0 * bf2f(a.w >> 16) + w1 * bf2f(bq.w >> 16); }
        float ss = 0.f;
#pragma unroll
        for (int j = 0; j < 16; ++j) ss += f[j] * f[j];
        const float rf = 1.0f / sqrtf(wave_sum(ss) * (1.0f / DM) + NORM_EPS);
        f32x4* hp = (f32x4*)(out + (size_t)row * DM); const float sc = scc;
#pragma unroll
        for (int half = 0; half < 2; ++half) { const v4u a = xac[half];
            const float hv[8] = {bf2f(a.x & 0xffffu), bf2f(a.x >> 16), bf2f(a.y & 0xffffu), bf2f(a.y >> 16), bf2f(a.z & 0xffffu), bf2f(a.z >> 16), bf2f(a.w & 0xffffu), bf2f(a.w >> 16)};
#pragma unroll
            for (int q = 0; q < 2; ++q) { const int idx = half * 128 + 2 * F.lane + q; f32x4 h; const f32x4 g = gp[idx];
#pragma unroll
                for (int j = 0; j < 4; ++j) h[j] = hv[q * 4 + j] * sc + f[half * 8 + q * 4 + j] * rf * g[j];
                hp[idx] = h; } }
        if (!has_next) break;
        row = nrow; nrow += NGW; wc_ = wn_; r0c = r0n; r1c = r1n; scc = scn; sn_ = snn; wn_ = wnn;
#pragma unroll
        for (int half = 0; half < 2; ++half) { yac[half] = yan[half]; ybc[half] = ybn[half]; xac[half] = xan[half]; }
    }
#undef FP_S1
#undef FP_S2
}

constexpr int N_PHASES = MK_F8 ? 14 : 20;
__global__ void __launch_bounds__(NWAVES * 64, 2) mk_fwd(Args args) {
    extern __shared__ __attribute__((aligned(16))) unsigned char lds_raw[];
    Frame F; refresh(F);
    for (int u = F.tid; u < (LDS_BYTES - LDSCTL_OFF) / 4; u += NWAVES * 64) ((LAS unsigned*)(F.lds + LDSCTL_OFF))[u] = 0u;
    __syncthreads();
    if (F.hi - F.lo > 1) (void)xcd_barrier_post(F.ctl + CW_BAR, F.MISC + 8);
#ifndef MK_ONLY
#define MK_ONLY -1
#endif
#define IN(k) ((MK_ONLY < 0 || (k) == MK_ONLY) && (refresh(F), F.lo <= (k) && (k) < F.hi))
#define SEAM(k) do { refresh(F); if (F.lo <= (k) && (k) + 1 < F.hi) xcd_barrier(frame_bar(F)); } while (0)
#define ws (F.ws)
#define cblk (F.bx)
    if (IN(0)) { p0_prologue(kargs(), F); } SEAM(0);
    if (IN(1)) {
        if (MK_SUPER) wk_convert_super(kargs(), F); else wk_convert(kargs(), F, 1);
        __syncthreads();
        { PlainSched S{(const char*)(ws + WS_UA), (const char*)(ws + WS_BTA), 256, UAK, 256, NG * 8, 1, F.G, cblk, 8, (size_t)256 * 256 * 2};
          EpiS5A E{(float*)(ws + WS_SLOC)};
          pg8::gemm_phase(F.lds, S, E); }
        __builtin_amdgcn_fence(__ATOMIC_ACQUIRE, "agent"); VM_WAIT(); __syncthreads();
        s5_scan_local(F);
        VM_WAIT(); __syncthreads(); __builtin_amdgcn_fence(__ATOMIC_ACQUIRE, "agent"); VM_WAIT(); __syncthreads();
        { KArgs ka = kargs(); PlainSched S{(const char*)(ws + WS_UA), (const char*)(ws + WS_BTC), UAK, UAK, UAK, NG * 8, 1, F.G, cblk, 8, (size_t)256 * UAK * 2};
          EpiS5C E{(const bf16*)(ws + WS_UA), (const float*)ka->in[I_SD], (const float*)ka->in[I_NORMS], (bf16*)(ws + WS_GBUF)};
          pg8::gemm_phase(F.lds, S, E); }
    } SEAM(1);
    if (IN(2)) {
        PlainSched S{(const char*)(ws + WS_GBUF), (const char*)(ws + WS_WGLU), DM, DM, DM, NTOK / 256, 8, F.G, cblk, 1 << 30, 0};
        EpiGated<0> E{(bf16*)(ws + WS_MIX0), DM, (float*)(ws + WS_ROWSS), 0};
        pg8::gemm_phase(F.lds, S, E);
    } SEAM(2);
    if (IN(3)) { KArgs ka = kargs(); resid_pass<false, false, true>(F, (const float*)ka->in[I_X], nullptr, (const bf16*)(ws + WS_MIX0), 32, (const float*)ka->in[I_NORMS] + 1 * DM, (bf16*)(ws + WS_XH1), nullptr);
        expert_act_scale(F); } SEAM(3);
    if (IN(4)) {
        const int sad = MK_FFN2F8 ? (int)__hip_atomic_load(F.ctl + CW_EA + NE, __ATOMIC_RELAXED, __HIP_MEMORY_SCOPE_AGENT) : 127;
        PlainSched S{(const char*)(ws + WS_XQ3), (const char*)(ws + WS_WQF13), DM / 2, DM / 2, DM / 2, NTOK / 256, 2 * FFD / 256, F.G, cblk, 1 << 30, 0, sad};
        EpiGatedI8<MK_FFN2F8 != 0> E{(bf16*)(ws + WS_ACTD), FFD, (const float*)(ws + WS_RSC), (const float*)(ws + WS_COLMAX_F), 0, nullptr};
        pg8::gemm_phase(F.lds, S, E);
    } SEAM(4);
    if (IN(5)) {
#if MK_FFN2F8
        const int sad = (int)__hip_atomic_load(F.ctl + CW_EA + NE, __ATOMIC_RELAXED, __HIP_MEMORY_SCOPE_AGENT);
        PlainSched S{(const char*)(ws + WS_ACTD), (const char*)(ws + WS_WF2), FFD / 2, FFD / 2, FFD / 2, NTOK / 256, DM / 256, F.G, cblk, 1 << 30, 0, sad, (const int*)(ws + WS_SB8) + NE * DM};
        EpiPlain<true, false, 2> E{(bf16*)(ws + WS_F0), DM, (float*)(ws + WS_ROWSS)};
#else
        PlainSched S{(const char*)(ws + WS_ACTD), (const char*)(ws + WS_WF2), FFD, FFD, FFD, NTOK / 256, DM / 256, F.G, cblk, 1 << 30, 0};
        EpiPlain<true, false> E{(bf16*)(ws + WS_F0), DM, (float*)(ws + WS_ROWSS)};
#endif
        pg8::gemm_phase(F.lds, S, E);
    } SEAM(5);
    if (IN(6)) { KArgs ka = kargs(); resid_pass<false, true, MK_QKV8 != 0>(F, nullptr, (const bf16*)(ws + WS_XH1), (const bf16*)(ws + WS_F0), 16, (const float*)ka->in[I_NORMS] + 3 * DM, (bf16*)(ws + WS_XH2), nullptr); } SEAM(6);
    if (IN(7)) {
#if MK_QKV8
        PlainSched S{(const char*)(ws + WS_XQ3), (const char*)(ws + WS_WQQKV), DM / 2, DM / 2, DM / 2, NTOK / 256, 12, F.G, cblk, 1 << 30, 0};
        EpiQKV<true> E{(bf16*)(ws + WS_Q), (const float*)(ws + WS_ROPE), (float*)(ws + WS_KMEAN), (const float*)(ws + WS_RSC), (const float*)(ws + WS_COLMAX_QKV)};
#else
        PlainSched S{(const char*)(ws + WS_XH2), (const char*)(ws + WS_WQKV), DM, DM, DM, NTOK / 256, 12, F.G, cblk, 1 << 30, 0};
        EpiQKV<false> E{(bf16*)(ws + WS_Q), (const float*)(ws + WS_ROPE), (float*)(ws + WS_KMEAN), nullptr, nullptr};
#endif
        pg8::gemm_phase(F.lds, S, E);
    } SEAM(7);
    if (IN(8)) {
        const bf16* Qb = (const bf16*)(ws + WS_Q); const bf16* Kb = (const bf16*)(ws + WS_K); const bf16* Vb = (const bf16*)(ws + WS_V); bf16* Ob = (bf16*)(ws + WS_O); const float* KM = (const float*)(ws + WS_KMEAN);
        const int nitems = (BATCH * NH * 4 - F.vcu + F.G - 1) / F.G, nblocks = 2 * nitems;
        attn::Seam Sm;
#define MK_REF(R, kk) do { const int it_ = F.vcu + ((kk) >> 1) * F.G, bh_ = it_ >> 2, x_ = it_ & 3, qb_ = ((kk) & 1) ? 7 - x_ : x_, b_ = bh_ >> 3, h_ = bh_ & 7; \
        const size_t base_ = (size_t)b_ * SEQ * DM + h_ * HD; R.Q = Qb + base_ + (size_t)qb_ * 256 * DM; R.K = Kb + base_; R.V = Vb + base_; R.O = Ob + base_ + (size_t)qb_ * 256 * DM; R.KM = KM + (size_t)bh_ * NBLK * HD; R.P0 = qb_ * 256; } while (0)
        if (nblocks > 0) {
            attn::BlockRef cur, nxt; MK_REF(cur, 0);
            attn::moba_prime(cur, (char*)lds_raw, Sm);
            for (int kb = 0; kb < nblocks; ++kb) { const int kn = kb + 1 < nblocks ? kb + 1 : kb; MK_REF(nxt, kn); attn::moba_block(cur, nxt, (char*)lds_raw, Sm); cur = nxt; }
        }
#undef MK_REF
    } SEAM(8);
    if (IN(9)) {
        PlainSched S{(const char*)(ws + WS_O), (const char*)(ws + WS_WO), DM, DM, DM, NTOK / 256, DM / 256, F.G, cblk, 1 << 30, 0};
        EpiPlain<true, false> E{(bf16*)(ws + WS_MIX1), DM, (float*)(ws + WS_ROWSS)};
        pg8::gemm_phase(F.lds, S, E);
    } SEAM(9);
    if (IN(10)) { KArgs ka = kargs(); resid_pass<true, true, true>(F, nullptr, (const bf16*)(ws + WS_XH2), (const bf16*)(ws + WS_MIX1), 16, (const float*)ka->in[I_NORMS] + (4 + 1) * DM, (bf16*)(ws + WS_XH3), (const float*)ka->in[I_RBIAS]); } SEAM(10);
#if MK_F8
    if (IN(11)) {
        etab_build(F.lds, F.ctl); int nM = et_ps(F.lds, NE); nM = nM > 264 ? 264 : nM;
        MoeSched1 S{(const char*)(ws + WS_XQ3), (const char*)(ws + WS_WQ13), (const int*)(ws + WS_LIST), DM / 2, DM / 2, nM, 2 * FFE / 256, F.G, cblk, 0, F.lds};
        EpiGatedI8<true> E{(bf16*)(ws + WS_ACTM), FFE, (const float*)(ws + WS_RSC), (const float*)(ws + WS_COLMAX), 2 * FFE, (unsigned char*)kargs()->out};
        pg8::gemm_phase(F.lds, S, E);
    } SEAM(11);
    if (IN(12)) {
        etab_build(F.lds, F.ctl); const int P = et_ps(F.lds, NE); const int nM = P > 256 ? 256 : P; int nLeft = P - 256; nLeft = nLeft < 0 ? 0 : (nLeft > LPMAX ? LPMAX : nLeft);
        { MoeSched2 S{(const char*)(ws + WS_ACTM), (const char*)kargs()->out, (const char*)(ws + WS_W8M2), (const int*)(ws + WS_SB8), FFE / 2, FFE / 2, FFE / 2, nM, DM / 256, F.G, cblk, 0, F.lds};
          EpiPlain<false, true, 2> E{(bf16*)(ws + WS_Y), DM, nullptr};
          pg8::gemm_phase(F.lds, S, E); }
        { MoeSched2K S{(const char*)(ws + WS_ACTM), (const char*)kargs()->out, (const char*)(ws + WS_W8M2), (const int*)(ws + WS_SB8), 256, FFE / 2, FFE / 2, nLeft, F.G, (F.G - 1) - cblk, F.lds};
          EpiPlain<false, true, 2> E{(bf16*)(ws + WS_YP), DM, nullptr};
          pg8::gemm_phase(F.lds, S, E); }
    } SEAM(12);
#else
#pragma unroll
    for (int q = 0; q < 4; ++q) {
        if (IN(11 + 2 * q)) {
            etab_build(F.lds, F.ctl); const int P = et_ps(F.lds, NE); const int p0 = 64 * q; int nM = (q < 3) ? 64 : P - 192; nM = nM > 72 ? 72 : nM; if (p0 + nM > P) nM = P - p0; if (nM < 0) nM = 0;
            MoeSched1 S{(const char*)(ws + WS_XQ3), (const char*)(ws + WS_WQ13), (const int*)(ws + WS_LIST), DM / 2, DM / 2, nM, 2 * FFE / 256, F.G, cblk, p0, F.lds};
            EpiGatedI8<false> E{(bf16*)(ws + WS_ACTM), FFE, (const float*)(ws + WS_RSC), (const float*)(ws + WS_COLMAX), 2 * FFE, nullptr};
            pg8::gemm_phase(F.lds, S, E);
        } SEAM(11 + 2 * q);
        if (IN(12 + 2 * q)) {
            etab_build(F.lds, F.ctl); const int P = et_ps(F.lds, NE); const int p0 = 64 * q; int nM = (q < 3) ? 64 : P - 192; nM = nM > 72 ? 72 : nM; if (p0 + nM > P) nM = P - p0; if (nM < 0) nM = 0;
            MoeSched2B S{(const char*)(ws + WS_ACTM), (const char*)(ws + WS_WM2), FFE, FFE, FFE, nM, DM / 256, F.G, cblk, p0, F.lds};
            EpiPlain<false, true, 0> E{(bf16*)(ws + WS_Y), DM, nullptr};
            pg8::gemm_phase(F.lds, S, E);
        } SEAM(12 + 2 * q);
    }
#endif
    if (IN(N_PHASES - 1)) { KArgs ka = kargs(); final_pass(F, ka->out, (const bf16*)(ws + WS_XH3), (const bf16*)(ws + WS_Y), (const float*)ka->in[I_NORMS] + (4 + 3) * DM); }
#undef IN
#undef SEAM
#undef ws
#undef cblk
}

extern "C" void kernel_launch(void* const* d_in, const int* in_sizes, int n_in, void* d_out, int out_size, void* d_ws, size_t ws_size, hipStream_t stream) {
    static int grid = 0;
    if (grid == 0) {
        if (n_in != 24 || in_sizes[0] != NTOK * DM || out_size != NTOK * DM || ws_size < WS_END) { fprintf(stderr, "kernel_launch: unexpected problem (n_in %d, in0 %d, out %d, ws %zu < %zu)\n", n_in, n_in > 0 ? in_sizes[0] : -1, out_size, ws_size, (size_t)WS_END); grid = -1; return; }
        int dev = 0, cus = 0, per_cu = 0;
        if (hipGetDevice(&dev) != hipSuccess || hipDeviceGetAttribute(&cus, hipDeviceAttributeMultiprocessorCount, dev) != hipSuccess) { grid = -1; return; }
        if (hipFuncSetAttribute((const void*)mk_fwd, hipFuncAttributeMaxDynamicSharedMemorySize, LDS_BYTES) != hipSuccess) { fprintf(stderr, "kernel_launch: hipFuncSetAttribute failed\n"); grid = -1; return; }
        if (hipOccupancyMaxActiveBlocksPerMultiprocessor(&per_cu, (const void*)mk_fwd, NWAVES * 64, LDS_BYTES) != hipSuccess || per_cu < 1) { fprintf(stderr, "kernel_launch: occupancy query says %d blocks per CU\n", per_cu); (void)hipGetLastError(); grid = -1; return; }
        grid = cus;
    }
    if (grid < 0) return;
    if (hipMemsetAsync((char*)d_ws + WS_CTL, 0, ZERO_BYTES, stream) != hipSuccess) return;
    Args a{};
    for (int i = 0; i < 24; ++i) a.in[i] = d_in[i];
    a.out = (float*)d_out; a.ws = (unsigned char*)d_ws;
#if MK_ONE_LAUNCH
    a.ph_lo = 0; a.ph_hi = N_PHASES;
    hipLaunchKernelGGL(mk_fwd, dim3(grid), dim3(NWAVES * 64), LDS_BYTES, stream, a);
#else
    for (int p = 0; p < N_PHASES; ++p) { a.ph_lo = p; a.ph_hi = p + 1; for (int r = 0; r < (((MK_DUP_MASK >> p) & 1u) ? 2 : 1); ++r) hipLaunchKernelGGL(mk_fwd, dim3(grid), dim3(NWAVES * 64), LDS_BYTES, stream, a); }
#endif
}
```
